# Optimizing an MI355X kernel written in HIP

```python
import jax, jax.numpy as jnp
from jax import lax
import numpy as np

D_MODEL = 1024
BATCH = 16
SEQ = 256
DEPTH = 1
DEC_BATCH = 8
DEC_SEQ = 4096
PAST_LEN = 512

GRID_W = 64
RWKV_HEADS = 8
RWKV_HEAD_DIM = 64
RWKV_WIDTH = RWKV_HEADS * RWKV_HEAD_DIM
DECAY_LORA = 64
ICLR_LORA = 64
GATE_LORA = 128
N_DIRS = 2
FOURIER_GROUPS = 4
FOURIER_GROUP_DIM = 128
FOURIER_WIDTH = FOURIER_GROUPS * FOURIER_GROUP_DIM
N_BRANCHES = 2
D_FF = 2816
N_MOD = 9
NORM_EPS = 1e-6
GN_EPS = 64e-5

OFF_WD = 3 * RWKV_WIDTH
OFF_AD = OFF_WD + N_DIRS * DECAY_LORA
OFF_GD = OFF_AD + N_DIRS * ICLR_LORA
OFF_F = OFF_GD + GATE_LORA
OFF_GATE = OFF_F + FOURIER_WIDTH
PROJ_W = OFF_GATE + N_BRANCHES * D_MODEL

kernel_name = "hybrid_rwkv7_fnet_macaron_diffusion_step"


def rmsnorm(x, w):
    xf = x.astype(jnp.float32)
    y = xf * lax.rsqrt(jnp.mean(xf * xf, axis=-1, keepdims=True) + NORM_EPS)
    return (y * w.astype(jnp.float32)).astype(x.dtype)


def swiglu(h, w13, w2):
    a, b = jnp.split(h @ w13, 2, axis=-1)
    return (jax.nn.silu(a) * b) @ w2


def short_conv(x, k):
    xp = jnp.pad(x, ((0, 0), (1, 1), (0, 0)))
    return xp[:, :-2] * k[0] + xp[:, 1:-1] * k[1] + xp[:, 2:] * k[2]


def heads(t):
    return t.reshape(t.shape[:-1] + (RWKV_HEADS, RWKV_HEAD_DIM))


def wkv_scan(r, w, k, v, kk, a, s0, reverse):
    xs = tuple(jnp.moveaxis(t, 1, 0) for t in (r, w, k, v, kk, a))

    def step(S, inp):
        r_t, w_t, k_t, v_t, kk_t, a_t = inp
        sa = jnp.einsum('bhij,bhj->bhi', S, kk_t)
        S = (S * w_t[:, :, None, :]
             - sa[..., None] * (kk_t * a_t)[:, :, None, :]
             + v_t[..., None] * k_t[:, :, None, :])
        o = jnp.einsum('bhij,bhj->bhi', S, r_t)
        return S, o

    s_final, o = lax.scan(step, s0, xs, reverse=reverse)
    return jnp.moveaxis(o, 0, 1), s_final


def fourier_mix(f, grid):
    B, T, _ = f.shape
    ff = f.astype(jnp.float32).reshape(B, T, FOURIER_GROUPS, FOURIER_GROUP_DIM)
    if grid:
        rows = T // GRID_W
        ff = ff.reshape(B, rows, GRID_W, FOURIER_GROUPS, FOURIER_GROUP_DIM)
        out = jnp.fft.fftn(ff, axes=(1, 2, 4), norm="ortho").real
    else:
        out = jnp.fft.fftn(ff, axes=(1, 3), norm="ortho").real
    return out.reshape(B, T, FOURIER_WIDTH).astype(f.dtype)


def token_mixer(h, s_fwd0, s_bwd0, grid, w_in, gate_b, conv_rkv, w0, w_up, a0, a_up, g_up,
                k_k, k_a, r_k, lnx_w, lnx_b, w_o_rwkv, w_fourier, w_out):
    B, T, _ = h.shape
    f32 = jnp.float32
    u = h @ w_in
    rkv = short_conv(u[..., :OFF_WD], conv_rkv).astype(f32)
    r, k, v = jnp.split(rkv, 3, axis=-1)
    wd = u[..., OFF_WD:OFF_AD].astype(f32).reshape(B, T, N_DIRS, DECAY_LORA)
    ad = u[..., OFF_AD:OFF_GD].astype(f32).reshape(B, T, N_DIRS, ICLR_LORA)
    gd = u[..., OFF_GD:OFF_F].astype(f32)
    f = u[..., OFF_F:OFF_GATE]
    gates = jax.nn.sigmoid(u[..., OFF_GATE:].astype(f32).reshape(B, T, N_BRANCHES, D_MODEL)
                           + gate_b.astype(f32))
    w_log = -jax.nn.softplus(-(w0.astype(f32) + jnp.einsum('btdr,drc->btdc', jnp.tanh(wd), w_up.astype(f32)))) - 0.5
    decay = heads(jnp.exp(-jnp.exp(w_log)))
    a = jax.nn.sigmoid(a0.astype(f32) + jnp.einsum('btdr,drc->btdc', ad, a_up.astype(f32)))
    g = jax.nn.sigmoid(gd) @ g_up.astype(f32)
    kk = heads(k * k_k.astype(f32))
    kk = kk / jnp.maximum(jnp.sqrt(jnp.sum(kk * kk, axis=-1, keepdims=True)), 1e-12)
    k_dir = heads(k[:, :, None] * (1.0 + (a - 1.0) * k_a.astype(f32)))
    a_h = heads(a)
    r_h, v_h = heads(r), heads(v)
    o_f, s_f = wkv_scan(r_h, decay[:, :, 0], k_dir[:, :, 0], v_h, kk, a_h[:, :, 0],
                        s_fwd0.astype(f32), False)
    o_b, s_b = wkv_scan(r_h, decay[:, :, 1], k_dir[:, :, 1], v_h, kk, a_h[:, :, 1],
                        s_bwd0.astype(f32), True)
    o = o_f + o_b
    mu = jnp.mean(o, axis=-1, keepdims=True)
    var = jnp.mean(jnp.square(o - mu), axis=-1, keepdims=True)
    o = (o - mu) * lax.rsqrt(var + GN_EPS) * heads(lnx_w.astype(f32)) + heads(lnx_b.astype(f32))
    bonus = jnp.sum(jnp.sum(r_h[:, :, None] * k_dir * r_k.astype(f32), axis=-1, keepdims=True)
                    * v_h[:, :, None], axis=2)
    o = (o + bonus).reshape(B, T, RWKV_WIDTH) * g
    y_rwkv = o.astype(h.dtype) @ w_o_rwkv
    y_four = fourier_mix(f, grid) @ w_fourier
    merged = (gates[:, :, 0] * y_rwkv + gates[:, :, 1] * y_four).astype(h.dtype)
    return merged @ w_out, s_f, s_b


def trunk_layer(x, mod, s_fwd0, s_bwd0, grid, norm_w, ffn1_w13, ffn1_w2, ffn2_w13, ffn2_w2, mixer_params):
    m = mod[:, None].astype(x.dtype)
    h = rmsnorm(x, norm_w[0]) * (1.0 + m[:, :, 1]) + m[:, :, 0]
    x = x + 0.5 * m[:, :, 2] * swiglu(h, ffn1_w13, ffn1_w2)
    h = rmsnorm(x, norm_w[1]) * (1.0 + m[:, :, 4]) + m[:, :, 3]
    y, s_f, s_b = token_mixer(h, s_fwd0, s_bwd0, grid, *mixer_params)
    x = x + m[:, :, 5] * y
    h = rmsnorm(x, norm_w[2]) * (1.0 + m[:, :, 7]) + m[:, :, 6]
    x = x + 0.5 * m[:, :, 8] * swiglu(h, ffn2_w13, ffn2_w2)
    return x, s_f, s_b


def setup_inputs(seed: int = 0) -> dict:
    key = jax.random.key(seed)
    ks = iter(jax.random.split(key, 40))
    nrm = lambda shape, s: jax.random.normal(next(ks), shape, jnp.float32) * s
    L, D = DEPTH, D_MODEL
    st_shape = (DEC_BATCH, DEPTH, RWKV_HEADS, RWKV_HEAD_DIM, RWKV_HEAD_DIM)
    conv = nrm((L, 3, 3 * RWKV_WIDTH), 0.2)
    conv = conv.at[:, 1].add(1.0)
    return {
        "x_prompt": nrm((BATCH, SEQ, D), 1.0),
        "x_sample": nrm((DEC_BATCH, DEC_SEQ, D), 1.0),
        "state_rwkv_fwd": nrm(st_shape, 0.5),
        "state_rwkv_bwd": nrm(st_shape, 0.5),
        "c": nrm((DEC_BATCH, D), 1.0),
        "c_ctx": nrm((D,), 1.0),
        "ada_w": nrm((L, D, N_MOD * D), 0.5 * D ** -0.5),
        "ada_b": nrm((L, N_MOD * D), 0.01),
        "norm_w": 1.0 + nrm((L, 3, D), 0.02),
        "ffn1_w13": nrm((L, D, 2 * D_FF), D ** -0.5),
        "ffn1_w2": nrm((L, D_FF, D), D_FF ** -0.5),
        "ffn2_w13": nrm((L, D, 2 * D_FF), D ** -0.5),
        "ffn2_w2": nrm((L, D_FF, D), D_FF ** -0.5),
        "w_in": nrm((L, D, PROJ_W), D ** -0.5),
        "gate_b": nrm((L, N_BRANCHES, D), 0.1),
        "conv_rkv": conv,
        "w0": nrm((L, N_DIRS, RWKV_WIDTH), 2.0) - 2.0,
        "w_up": nrm((L, N_DIRS, DECAY_LORA, RWKV_WIDTH), 0.5 * DECAY_LORA ** -0.5),
        "a0": nrm((L, N_DIRS, RWKV_WIDTH), 0.5),
        "a_up": nrm((L, N_DIRS, ICLR_LORA, RWKV_WIDTH), 0.5 * ICLR_LORA ** -0.5),
        "g_up": nrm((L, GATE_LORA, RWKV_WIDTH), GATE_LORA ** -0.5),
        "k_k": 0.85 + nrm((L, RWKV_WIDTH), 0.1),
        "k_a": 1.0 + nrm((L, RWKV_WIDTH), 0.1),
        "r_k": nrm((L, RWKV_HEADS, RWKV_HEAD_DIM), 0.1),
        "lnx_w": 1.0 + nrm((L, RWKV_WIDTH), 0.02),
        "lnx_b": nrm((L, RWKV_WIDTH), 0.02),
        "w_o_rwkv": nrm((L, RWKV_WIDTH, D), RWKV_WIDTH ** -0.5),
        "w_fourier": nrm((L, FOURIER_WIDTH, D), FOURIER_WIDTH ** -0.5),
        "w_out": nrm((L, D, D), D ** -0.5),
        "final_norm": 1.0 + nrm((D,), 0.02),
    }


def reference(x_prompt, x_sample, state_rwkv_fwd, state_rwkv_bwd, c, c_ctx, ada_w, ada_b, norm_w,
              ffn1_w13, ffn1_w2, ffn2_w13, ffn2_w2, w_in, gate_b, conv_rkv, w0, w_up, a0, a_up, g_up,
              k_k, k_a, r_k, lnx_w, lnx_b, w_o_rwkv, w_fourier, w_out, final_norm):
    x_p, x_s = x_prompt, x_sample
    b_p, b_s = x_prompt.shape[0], x_sample.shape[0]
    zero_state = jnp.zeros((b_p, RWKV_HEADS, RWKV_HEAD_DIM, RWKV_HEAD_DIM), jnp.float32)
    new_f, new_b = [], []
    for l in range(DEPTH):
        mixer_params = (w_in[l], gate_b[l], conv_rkv[l], w0[l], w_up[l], a0[l], a_up[l], g_up[l],
                        k_k[l], k_a[l], r_k[l], lnx_w[l], lnx_b[l], w_o_rwkv[l], w_fourier[l], w_out[l])
        ffn = (norm_w[l], ffn1_w13[l], ffn1_w2[l], ffn2_w13[l], ffn2_w2[l])
        mod_ctx = (jax.nn.silu(c_ctx) @ ada_w[l] + ada_b[l]).reshape(1, N_MOD, D_MODEL)
        x_p, s_f, s_b = trunk_layer(x_p, mod_ctx, zero_state, zero_state, False, *ffn, mixer_params)
        new_f.append(s_f)
        new_b.append(s_b)
        mod_lat = (jax.nn.silu(c) @ ada_w[l] + ada_b[l]).reshape(b_s, N_MOD, D_MODEL)
        x_s, _, _ = trunk_layer(x_s, mod_lat, state_rwkv_fwd[:, l], state_rwkv_bwd[:, l], True,
                                *ffn, mixer_params)
    y_prompt = rmsnorm(x_p, final_norm)
    y_sample = rmsnorm(x_s, final_norm)
    new_state_fwd = jnp.stack(new_f, axis=1)
    new_state_bwd = jnp.stack(new_b, axis=1)
    return (y_prompt, y_sample, new_state_fwd, new_state_bwd)
```

```cpp
#include <hip/hip_runtime.h>
#include <hip/hip_cooperative_groups.h>
#include <cstdio>
namespace cg = cooperative_groups;
namespace pg8 {
#define PG8_LAS __attribute__((address_space(3)))
typedef unsigned short bf16_t;
typedef short bf16x8 __attribute__((ext_vector_type(8)));
typedef float f32x4 __attribute__((ext_vector_type(4)));
typedef unsigned u32x4 __attribute__((ext_vector_type(4)));
constexpr int BM = 256, BK = 64, HALF = 128, HTB = HALF * BK * 2  , STAGE_BYTES = 8 * HTB, NXCD = 8, WGM = 8;

__host__ __device__ __forceinline__ int lds_byte(int r, int c) { const int st = (r >> 4) * 2 + (c >> 5), rr = r & 15, cc = c & 31, ob = rr * 64 + cc * 2; return st * 1024 + (ob ^ (((ob >> 9) & 1) << 5)); }
__host__ __device__ __forceinline__ void stage_rc(int b, int& R, int& C) { const int st = b / 1024, sb = b % 1024, swz = sb ^ (((sb >> 9) & 1) << 5); R = (st >> 1) * 16 + swz / 64; C = (st & 1) * 32 + (swz % 64) / 2; }
__host__ __device__ __forceinline__ int perm32(int rho) { const int n = rho >> 4, i = rho & 15; return 8 * (i >> 2) + 4 * n + (i & 3); }

struct Unit { int pm, pn; };
struct Gemm { const bf16_t* A; const bf16_t* Bt; int M, N, K; };

struct StaticOrder {
    int nM, nN, nwg, G, c;
    __host__ __device__ __forceinline__ void init(int M, int N, int G_, int c_) { nM = M / BM; nN = N / BM; nwg = nM * nN; G = G_; c = c_; }
    __host__ __device__ __forceinline__ bool next(int i, Unit& u) const {
        const long L = (long)i * G + c; if (L >= nwg) return false;
        int wgid = (int)L; { const int q = nwg / NXCD, r = nwg % NXCD, xcd = wgid % NXCD, off = wgid / NXCD; wgid = (xcd < r ? xcd * (q + 1) : r * (q + 1) + (xcd - r) * q) + off; }
        const int nig = WGM * nN, gid = wgid / nig, fm = gid * WGM, gsz = (nM - fm) < WGM ? (nM - fm) : WGM;
        u.pm = fm + ((wgid % nig) % gsz); u.pn = (wgid % nig) / gsz; return true;
    }
    __device__ __forceinline__ void a_ready(const Unit&) const {}
    __device__ __forceinline__ void done(const Unit&) const {}
};
__device__ __forceinline__ unsigned cvt_pk_bf16(float lo, float hi) { unsigned r; asm volatile("v_cvt_pk_bf16_f32 %0, %1, %2" : "=v"(r) : "v"(lo), "v"(hi)); return r; }
template <class Epi, class Sched, bool STAMP = false>
__device__ __forceinline__ void gemm_phase(PG8_LAS unsigned char* lds, const Gemm g, const Sched& S, const Epi& E, unsigned long long* stamps) {
    int tid_ = threadIdx.x; asm volatile("" : "+v"(tid_));
    const int tid = tid_, wid = __builtin_amdgcn_readfirstlane(tid >> 6), lane = tid & 63, wr = wid >> 2, wc = wid & 3, fr = lane & 15, fq = lane >> 4;
    const int K = g.K, nt = K / BK;
    int ts_lo = 0, ts_hi = 0, nts = 0; const unsigned long long rt_entry = STAMP ? (unsigned long long)wall_clock64() : 0ull;
#define PG8_STAMP() do { if (STAMP && wid == 0 && nts < 64) { const unsigned long long _c = (unsigned long long)clock64(); \
        ts_lo = (lane == nts) ? (int)(unsigned)_c : ts_lo; ts_hi = (lane == nts) ? (int)(unsigned)(_c >> 32) : ts_hi; ++nts; } } while (0)
    PG8_STAMP();
    unsigned voffA[2], voffB[2];
#pragma unroll
    for (int i = 0; i < 2; ++i) { int R, C; stage_rc(tid * 16 + i * 8192, R, C); const int Rb = Epi::PERM ? ((R & ~31) + perm32(R & 31)) : R;
        voffA[i] = (unsigned)(R * K + C) * 2u; voffB[i] = (unsigned)(Rb * K + C) * 2u; }
    const size_t kstep = (size_t)(BK * 2);
    const size_t hstep = (size_t)HALF * K * 2;
    const size_t tstep = 2 * hstep;
    const unsigned ldsw = (unsigned)wid * 1024u;
    const int aoff = lds_byte(wr * 64 + fr, fq * 8), boff = lds_byte(wc * 32 + fr, fq * 8);
#define PG8_SA(b, h) (((b) * 2 + (h)) * HTB)
#define PG8_SB(b, h) ((4 + (b) * 2 + (h)) * HTB)
#define PG8_STAGE(bufoff, gbase, voff) do { _Pragma("unroll") for (int _i = 0; _i < 2; ++_i) \
        __builtin_amdgcn_global_load_lds((const unsigned*)((const char*)(gbase) + (voff)[_i]), (PG8_LAS unsigned*)(lds + (bufoff) + ldsw + _i * 8192), 16, 0, 0); } while (0)
#define PG8_LDA(dst, b, h) do { _Pragma("unroll") for (int m = 0; m < 4; ++m) _Pragma("unroll") for (int k = 0; k < 2; ++k) dst[m][k] = *(const PG8_LAS bf16x8*)(lds + PG8_SA(b, h) + aoff + m * 2048 + k * 1024); } while (0)
#define PG8_LDB(dst, b, h) do { _Pragma("unroll") for (int n = 0; n < 2; ++n) _Pragma("unroll") for (int k = 0; k < 2; ++k) dst[n][k] = *(const PG8_LAS bf16x8*)(lds + PG8_SB(b, h) + boff + n * 2048 + k * 1024); } while (0)
#define PG8_MMA(ai, bj, At, Bt) do { __builtin_amdgcn_s_setprio(1); _Pragma("unroll") for (int m = 0; m < 4; ++m) _Pragma("unroll") for (int n = 0; n < 2; ++n) _Pragma("unroll") for (int k = 0; k < 2; ++k) \
        acc[ai][bj][m][n] = __builtin_amdgcn_mfma_f32_16x16x32_bf16(Bt[n][k], At[m][k], acc[ai][bj][m][n], 0, 0, 0); __builtin_amdgcn_s_setprio(0); } while (0)
#define PG8_WAIT_V(n) asm volatile("s_waitcnt vmcnt(" #n ")" ::: "memory")
#define PG8_WAIT_L(n) asm volatile("s_waitcnt lgkmcnt(" #n ")" ::: "memory")
#define PG8_BAR __builtin_amdgcn_s_barrier()
#define PG8_SCHED __builtin_amdgcn_sched_barrier(0)
    Unit cur, nxt; int ui = 0;
    if (!S.next(0, cur)) return;
    f32x4 acc[2][2][4][2];
#pragma unroll
    for (int a = 0; a < 2; ++a)
#pragma unroll
        for (int b = 0; b < 2; ++b)
#pragma unroll
            for (int m = 0; m < 4; ++m)
#pragma unroll
                for (int n = 0; n < 2; ++n) acc[a][b][m][n] = (f32x4){0.f, 0.f, 0.f, 0.f};
    bf16x8 At[4][2], B0[2][2], B1[2][2];
    const char* cA = (const char*)g.A + (size_t)cur.pm * tstep; const char* cB = (const char*)g.Bt + (size_t)cur.pn * tstep;
    S.a_ready(cur);
    PG8_STAGE(PG8_SB(0, 0), cB, voffB); PG8_STAGE(PG8_SA(0, 0), cA, voffA); PG8_STAGE(PG8_SB(0, 1), cB + hstep, voffB); PG8_STAGE(PG8_SA(0, 1), cA + hstep, voffA);
    if (wr == 1) PG8_BAR;
    PG8_WAIT_V(4); PG8_BAR;
    PG8_STAGE(PG8_SB(1, 0), cB + kstep, voffB); PG8_STAGE(PG8_SA(1, 0), cA + kstep, voffA); PG8_STAGE(PG8_SB(1, 1), cB + hstep + kstep, voffB);
    PG8_WAIT_V(6); PG8_BAR;
    PG8_STAMP();
    for (;;) {
        const bool has_next = S.next(ui + 1, nxt);
        const char* nA = has_next ? (const char*)g.A + (size_t)nxt.pm * tstep : cA; const char* nB = has_next ? (const char*)g.Bt + (size_t)nxt.pn * tstep : cB;
        for (int t = 0; t < nt; t += 2) {
            const bool last = (t == nt - 2);
            const char* a1 = cA + (size_t)(t + 1) * kstep;
            const char* a2 = last ? nA : cA + (size_t)(t + 2) * kstep; const char* b2 = last ? nB : cB + (size_t)(t + 2) * kstep;
            const char* a3 = a2 + kstep; const char* b3 = b2 + kstep;
            if (last && has_next) S.a_ready(nxt);
            PG8_LDB(B0, 0, 0); PG8_SCHED; PG8_LDA(At, 0, 0); PG8_STAGE(PG8_SA(1, 1), a1 + hstep, voffA);
            PG8_WAIT_L(8); PG8_BAR; PG8_WAIT_L(0); PG8_MMA(0, 0, At, B0); PG8_BAR; PG8_SCHED;
            PG8_LDB(B1, 0, 1); PG8_STAGE(PG8_SB(0, 0), b2, voffB);
            PG8_BAR; PG8_WAIT_L(0); PG8_MMA(0, 1, At, B1); PG8_BAR;
            PG8_LDA(At, 0, 1); PG8_STAGE(PG8_SA(0, 0), a2, voffA);
            PG8_BAR; PG8_WAIT_L(0); PG8_MMA(1, 0, At, B0); PG8_BAR; PG8_SCHED;
            PG8_STAGE(PG8_SB(0, 1), b2 + hstep, voffB);
            PG8_WAIT_V(6); PG8_BAR; PG8_MMA(1, 1, At, B1); PG8_BAR;
            PG8_LDB(B0, 1, 0); PG8_SCHED; PG8_LDA(At, 1, 0); PG8_STAGE(PG8_SA(0, 1), a2 + hstep, voffA);
            PG8_WAIT_L(8); PG8_BAR; PG8_WAIT_L(0); PG8_MMA(0, 0, At, B0); PG8_BAR; PG8_SCHED;
            PG8_LDB(B1, 1, 1); PG8_STAGE(PG8_SB(1, 0), b3, voffB);
            PG8_BAR; PG8_WAIT_L(0); PG8_MMA(0, 1, At, B1); PG8_BAR;
            PG8_LDA(At, 1, 1); PG8_STAGE(PG8_SA(1, 0), a3, voffA);
            PG8_BAR; PG8_WAIT_L(0); PG8_MMA(1, 0, At, B0); PG8_BAR; PG8_SCHED;
            PG8_STAGE(PG8_SB(1, 1), b3 + hstep, voffB);
            PG8_WAIT_V(6); PG8_BAR; PG8_MMA(1, 1, At, B1); PG8_BAR;
        }
        PG8_STAMP();
        if constexpr (!Epi::AFTER_DRAIN) { E(acc, cur, wr, wc, fr, fq); S.done(cur); }
        PG8_STAMP();
        if (!has_next) break;
#pragma unroll
        for (int a = 0; a < 2; ++a)
#pragma unroll
            for (int b = 0; b < 2; ++b)
#pragma unroll
                for (int m = 0; m < 4; ++m)
#pragma unroll
                    for (int n = 0; n < 2; ++n) acc[a][b][m][n] = (f32x4){0.f, 0.f, 0.f, 0.f};
        cur = nxt; cA = nA; cB = nB; ++ui;
    }
    PG8_WAIT_V(0);
    if (wr == 0) PG8_BAR;
    PG8_BAR;
    if constexpr (Epi::AFTER_DRAIN) { E.fused(acc, cur, wr, wc, fr, fq, lds, wid, lane); S.done(cur); }
    PG8_STAMP();
    if (STAMP && wid == 0) { stamps[lane] = lane < nts ? (((unsigned long long)(unsigned)ts_hi << 32) | (unsigned)ts_lo) : 0ull;
        if (lane == 62) stamps[62] = rt_entry; if (lane == 63) stamps[63] = (unsigned long long)wall_clock64(); }
#undef PG8_STAMP
#undef PG8_SA
#undef PG8_SB
#undef PG8_STAGE
#undef PG8_LDA
#undef PG8_LDB
#undef PG8_MMA
#undef PG8_WAIT_V
#undef PG8_WAIT_L
#undef PG8_BAR
#undef PG8_SCHED
}
}

#define LAS __attribute__((address_space(3)))
typedef unsigned short u16;
typedef float f32x4 __attribute__((ext_vector_type(4)));
typedef unsigned u32x4 __attribute__((ext_vector_type(4)));
typedef unsigned u32x2 __attribute__((ext_vector_type(2)));
using pg8::cvt_pk_bf16;

constexpr int MT = 36864, NPR = 4096, DM = 1024, DFF = 2816;
constexpr int OUT_STATE = MT * DM;
constexpr int LDS_BYTES = 131072 + 256, PTAB_OFF = 131072;

constexpr size_t SZ_W13 = (size_t)5632 * 1024 * 2, SZ_W2 = (size_t)1024 * 2816 * 2;
constexpr size_t WS_W13A = 0, WS_W2A = WS_W13A + SZ_W13, WS_W13B = WS_W2A + SZ_W2, WS_W2B = WS_W13B + SZ_W13;
constexpr size_t WS_WIN = WS_W2B + SZ_W2;
constexpr size_t WS_WZ = WS_WIN + (size_t)4096 * 1024 * 2;
constexpr size_t WS_WO = WS_WZ + (size_t)1024 * 1024 * 2;
constexpr size_t WS_WF = WS_WO + (size_t)1024 * 512 * 2;
constexpr size_t WS_WOUT = WS_WF + (size_t)1024 * 512 * 2;
constexpr size_t WS_GUP = WS_WOUT + (size_t)1024 * 1024 * 2;
constexpr size_t WS_MOD = WS_GUP + (size_t)512 * 256 * 2;
constexpr size_t WS_BS = WS_MOD + (size_t)9 * 9216 * 4;
constexpr size_t WS_SG = WS_BS + (size_t)MT * 16 * 4;
constexpr size_t WS_H = WS_SG + (size_t)MT * 256 * 2;
constexpr size_t WS_BIG = WS_H + (size_t)MT * 1024 * 2;
constexpr size_t WS_U16 = WS_BIG;
constexpr size_t WS_FOUR = WS_U16 + (size_t)MT * 1792 * 2;
constexpr size_t WS_OPRE = WS_FOUR + (size_t)MT * 512 * 2;
constexpr size_t WS_R = WS_BIG + (size_t)MT * 2816 * 2;
constexpr size_t WS_T = WS_R;
constexpr size_t WS_T256 = WS_T + (size_t)4096 * 8192 * 2;
constexpr size_t WS_ZL = WS_T256 + (size_t)256 * 512 * 2;
constexpr size_t WS_ZP = WS_ZL + (size_t)4096 * 8192 * 2;
constexpr int GLD = 2304;
constexpr size_t WS_END = WS_R + (size_t)MT * GLD * 2;
static_assert(WS_ZP + (size_t)8192 * 512 * 2 <= WS_END, "R region");
static_assert(WS_OPRE + (size_t)MT * 512 * 2 <= WS_R, "BIG region");
static_assert(WS_END <= (size_t)536870912, "workspace");
static_assert(WS_ZP == WS_ZL + (size_t)4096 * 8192 * 2, "ZP behind ZL");

struct Params { const float* in[30]; float* out; unsigned char* ws; };
__device__ __forceinline__ unsigned long long ld_ptr(LAS unsigned char* lds, int i) {
    const u32x2 v = *(const LAS u32x2*)(lds + PTAB_OFF + i * 8);
    const unsigned lo = __builtin_amdgcn_readfirstlane(v.x), hi = __builtin_amdgcn_readfirstlane(v.y);
    return ((unsigned long long)hi << 32) | lo;
}
__device__ __forceinline__ Params get_params(LAS unsigned char* lds) {
    Params Q;
#pragma unroll
    for (int i = 0; i < 30; ++i) Q.in[i] = (const float*)ld_ptr(lds, i);
    Q.out = (float*)ld_ptr(lds, 30); Q.ws = (unsigned char*)ld_ptr(lds, 31);
    return Q;
}

__device__ __forceinline__ float bf2f(unsigned v16) { return __uint_as_float(v16 << 16); }
__device__ __forceinline__ float h2f(unsigned v16) { return (float)__builtin_bit_cast(_Float16, (unsigned short)v16); }
__device__ __forceinline__ unsigned pk_h(float a, float b) {
    const unsigned short ua = __builtin_bit_cast(unsigned short, (_Float16)a), ub = __builtin_bit_cast(unsigned short, (_Float16)b);
    return (unsigned)ua | ((unsigned)ub << 16);
}
__device__ __forceinline__ float sigmoidf_(float x) { return __builtin_amdgcn_rcpf(1.0f + __expf(-x)); }
__device__ __forceinline__ int modidx_pm(int pm) { return pm < 16 ? 8 : ((pm - 16) >> 4); }
__device__ __forceinline__ int modidx_m(int m) { return m < NPR ? 8 : ((m - NPR) >> 12); }

struct EpiSwiglu {
    static constexpr bool PERM = true, AFTER_DRAIN = false;
    u16* G;
    __device__ __forceinline__ void operator()(const f32x4 (&acc)[2][2][4][2], const pg8::Unit& u, int wr, int wc, int fr, int fq) const {
        const int row0 = u.pm * 256 + wr * 64 + fr, col0 = u.pn * 128 + wc * 32 + 8 * fq;
#pragma unroll
        for (int ai = 0; ai < 2; ++ai)
#pragma unroll
            for (int m = 0; m < 4; ++m) {
                float g[8];
#pragma unroll
                for (int n = 0; n < 2; ++n)
#pragma unroll
                    for (int j = 0; j < 4; ++j) { const float a = acc[ai][0][m][n][j], b = acc[ai][1][m][n][j]; g[n * 4 + j] = a * sigmoidf_(a) * b; }
                u32x4 w; w.x = cvt_pk_bf16(g[0], g[1]); w.y = cvt_pk_bf16(g[2], g[3]); w.z = cvt_pk_bf16(g[4], g[5]); w.w = cvt_pk_bf16(g[6], g[7]);
                *(u32x4*)(G + (size_t)(row0 + ai * 128 + m * 16) * DFF + col0) = w;
            }
    }
};
struct EpiResid {
    static constexpr bool PERM = false, AFTER_DRAIN = false;
    const float* xp; const float* xs; float* X; const float* MOD; int slot; float coef;
    __device__ __forceinline__ void operator()(const f32x4 (&acc)[2][2][4][2], const pg8::Unit& u, int wr, int wc, int fr, int fq) const {
        const int row0 = u.pm * 256 + wr * 64 + fr, col0 = u.pn * 256 + wc * 32 + 4 * fq;
        const float* g = MOD + (size_t)modidx_pm(u.pm) * 9216 + slot * 1024 + col0;
        f32x4 gv[2][2];
#pragma unroll
        for (int bj = 0; bj < 2; ++bj)
#pragma unroll
            for (int n = 0; n < 2; ++n) gv[bj][n] = *(const f32x4*)(g + bj * 128 + n * 16) * coef;
#pragma unroll
        for (int ai = 0; ai < 2; ++ai)
#pragma unroll
            for (int m = 0; m < 4; ++m) {
                const int row = row0 + ai * 128 + m * 16;
                const float* src = (xp ? (row < NPR ? xp + (size_t)row * DM : xs + (size_t)(row - NPR) * DM) : X + (size_t)row * DM) + col0;
                float* dst = X + (size_t)row * DM + col0;
#pragma unroll
                for (int bj = 0; bj < 2; ++bj)
#pragma unroll
                    for (int n = 0; n < 2; ++n) *(f32x4*)(dst + bj * 128 + n * 16) = *(const f32x4*)(src + bj * 128 + n * 16) + gv[bj][n] * acc[ai][bj][m][n];
            }
    }
};
struct EpiU {
    static constexpr bool PERM = true, AFTER_DRAIN = false;
    u16* U; u16* SG; u16* GATES; const float* gate_b;
    __device__ __forceinline__ void operator()(const f32x4 (&acc)[2][2][4][2], const pg8::Unit& u, int wr, int wc, int fr, int fq) const {
        const int row0 = u.pm * 256 + wr * 64 + fr, ct = wc * 32 + 8 * fq;
        if (u.pn < 7) {
#pragma unroll
            for (int ai = 0; ai < 2; ++ai)
#pragma unroll
                for (int m = 0; m < 4; ++m)
#pragma unroll
                    for (int bj = 0; bj < 2; ++bj) { const f32x4 v0 = acc[ai][bj][m][0], v1 = acc[ai][bj][m][1];
                        u32x4 w; w.x = pk_h(v0[0], v0[1]); w.y = pk_h(v0[2], v0[3]); w.z = pk_h(v1[0], v1[1]); w.w = pk_h(v1[2], v1[3]);
                        *(u32x4*)(U + (size_t)(row0 + ai * 128 + m * 16) * 1792 + u.pn * 256 + bj * 128 + ct) = w; }
        } else {
            const int gc0 = (u.pn == 7 ? 2048 : (u.pn - 8) * 256) + ct;
#pragma unroll
            for (int bj = 0; bj < 2; ++bj) {
                const int gbi = (u.pn == 7 ? 0 : (u.pn - 8) * 256) + ct; const float bsc = u.pn == 7 ? 0.f : 1.f;
                const f32x4 b0 = *(const f32x4*)(gate_b + gbi + bj * 128) * bsc, b1 = *(const f32x4*)(gate_b + gbi + bj * 128 + 4) * bsc;
#pragma unroll
                for (int ai = 0; ai < 2; ++ai)
#pragma unroll
                    for (int m = 0; m < 4; ++m) { const f32x4 v0 = acc[ai][bj][m][0] + b0, v1 = acc[ai][bj][m][1] + b1;
                        u32x4 w; w.x = pk_h(sigmoidf_(v0[0]), sigmoidf_(v0[1])); w.y = pk_h(sigmoidf_(v0[2]), sigmoidf_(v0[3]));
                        w.z = pk_h(sigmoidf_(v1[0]), sigmoidf_(v1[1])); w.w = pk_h(sigmoidf_(v1[2]), sigmoidf_(v1[3]));
                        *(u32x4*)(GATES + (size_t)(row0 + ai * 128 + m * 16) * GLD + gc0 + bj * 128) = w; }
            }
        }
    }
};
struct EpiZT {
    static constexpr bool PERM = true, AFTER_DRAIN = false;
    u16* ZL;
    __device__ __forceinline__ void operator()(const f32x4 (&acc)[2][2][4][2], const pg8::Unit& u, int wr, int wc, int fr, int fq) const {
#pragma unroll
        for (int bj = 0; bj < 2; ++bj) {
            const int c0 = u.pn * 256 + bj * 128 + wc * 32 + 8 * fq;
#pragma unroll
            for (int ai = 0; ai < 2; ++ai)
#pragma unroll
                for (int m = 0; m < 4; ++m) {
                    const int zr = u.pm * 256 + ai * 128 + wr * 64 + m * 16 + fr, g = zr >> 8, part = (zr >> 7) & 1, kn = zr & 127;
                    size_t off;
                    if (u.pn < 16) off = (size_t)4096 * 8192 + ((size_t)(u.pn * 512 + g * 128 + kn) * 512 + part * 256 + (c0 - u.pn * 256));
                    else { const int tok = c0 - NPR, b = tok >> 12, rc = tok & 4095; off = (size_t)(b * 512 + g * 128 + kn) * 8192 + part * 4096 + rc; }
                    u16* dst = ZL + off;
                    const f32x4 v0 = acc[ai][bj][m][0], v1 = acc[ai][bj][m][1];
                    u32x4 w; w.x = cvt_pk_bf16(v0[0], v0[1]); w.y = cvt_pk_bf16(v0[2], v0[3]); w.z = cvt_pk_bf16(v1[0], v1[1]); w.w = cvt_pk_bf16(v1[2], v1[3]);
                    *(u32x4*)dst = w;
                }
        }
    }
};
struct EpiFour {
    static constexpr bool PERM = true, AFTER_DRAIN = false;
    u16* FOUR; int latent;
    __device__ __forceinline__ void operator()(const f32x4 (&acc)[2][2][4][2], const pg8::Unit& u, int wr, int wc, int fr, int fq) const {
        const int b = u.pn >> 1, ch0 = (u.pn & 1) * 256 + wc * 32 + 8 * fq;
        const int tok0 = (latent ? NPR + b * 4096 : b * 256) + u.pm * 256 + wr * 64 + fr;
#pragma unroll
        for (int ai = 0; ai < 2; ++ai)
#pragma unroll
            for (int m = 0; m < 4; ++m)
#pragma unroll
                for (int bj = 0; bj < 2; ++bj) { const f32x4 v0 = acc[ai][bj][m][0], v1 = acc[ai][bj][m][1];
                    u32x4 w; w.x = cvt_pk_bf16(v0[0], v0[1]); w.y = cvt_pk_bf16(v0[2], v0[3]); w.z = cvt_pk_bf16(v1[0], v1[1]); w.w = cvt_pk_bf16(v1[2], v1[3]);
                    *(u32x4*)(FOUR + (size_t)(tok0 + ai * 128 + m * 16) * 512 + ch0 + bj * 128) = w; }
    }
};
struct EpiMul {
    static constexpr bool PERM = true, AFTER_DRAIN = false;
    u16* O; const u16* GATES; int mode;
    __device__ __forceinline__ void operator()(const f32x4 (&acc)[2][2][4][2], const pg8::Unit& u, int wr, int wc, int fr, int fq) const {
        const int row0 = u.pm * 256 + wr * 64 + fr, col0 = u.pn * 256 + wc * 32 + 8 * fq;
        const int ld = mode == 0 ? 512 : 1024;
#pragma unroll
        for (int ai = 0; ai < 2; ++ai)
#pragma unroll
            for (int m = 0; m < 4; ++m)
#pragma unroll
                for (int bj = 0; bj < 2; ++bj) {
                    const int row = row0 + ai * 128 + m * 16, col = col0 + bj * 128;
                    u16* p = O + (size_t)row * ld + col;
                    float v[8];
#pragma unroll
                    for (int j = 0; j < 4; ++j) { v[j] = acc[ai][bj][m][0][j]; v[4 + j] = acc[ai][bj][m][1][j]; }
                    if (mode == 0) {
                        const u32x4 q = *(const u32x4*)p;
#pragma unroll
                        for (int j = 0; j < 4; ++j) { v[2 * j] *= bf2f(q[j] & 0xffffu); v[2 * j + 1] *= bf2f(q[j] >> 16); }
                    } else {
                        const u32x4 gq = *(const u32x4*)(GATES + (size_t)row * GLD + (mode == 2 ? 1024 : 0) + col);
#pragma unroll
                        for (int j = 0; j < 4; ++j) { v[2 * j] *= h2f(gq[j] & 0xffffu); v[2 * j + 1] *= h2f(gq[j] >> 16); }
                        if (mode == 2) { const u32x4 q = *(const u32x4*)p;
#pragma unroll
                            for (int j = 0; j < 4; ++j) { v[2 * j] += bf2f(q[j] & 0xffffu); v[2 * j + 1] += bf2f(q[j] >> 16); } }
                    }
                    u32x4 w; w.x = cvt_pk_bf16(v[0], v[1]); w.y = cvt_pk_bf16(v[2], v[3]); w.z = cvt_pk_bf16(v[4], v[5]); w.w = cvt_pk_bf16(v[6], v[7]);
                    *(u32x4*)p = w;
                }
    }
};

template <class Epi>
__device__ __forceinline__ void run_gemm(LAS unsigned char* lds, const u16* A, const u16* Bt, int M, int N, int K, const Epi& E) {
    pg8::Gemm g{A, Bt, M, N, K}; pg8::StaticOrder S; S.init(M, N, (int)gridDim.x, (int)blockIdx.x);
    pg8::gemm_phase<Epi, pg8::StaticOrder, false>(lds, g, S, E, nullptr);
}

__device__ __forceinline__ void transpose_tile(const float* src, int ld_src, int col0, int k0, int krows, u16* dst, int n0, int K, LAS float* tile) {
    const int t = threadIdx.x;
#pragma unroll
    for (int i = 0; i < 8; ++i) { const int kk = (t >> 6) + 8 * i, nn = t & 63;
        float v = 0.f; if (col0 >= 0 && k0 + kk < krows) v = src[(size_t)(k0 + kk) * ld_src + col0 + nn];
        tile[kk * 65 + nn] = v; }
    __syncthreads();
    const int nn = t >> 3, ks = (t & 7) * 8;
    float v[8];
#pragma unroll
    for (int j = 0; j < 8; ++j) v[j] = tile[(ks + j) * 65 + nn];
    u32x4 w; w.x = cvt_pk_bf16(v[0], v[1]); w.y = cvt_pk_bf16(v[2], v[3]); w.z = cvt_pk_bf16(v[4], v[5]); w.w = cvt_pk_bf16(v[6], v[7]);
    *(u32x4*)(dst + (size_t)(n0 + nn) * K + k0 + ks) = w;
    __syncthreads();
}

__device__ __forceinline__ void phase_prep(const Params& P, LAS unsigned char* lds) {
    LAS float* L = (LAS float*)lds;
    LAS float* tile = L;
    LAS float* cs128 = L + 4160; LAS float* sn128 = cs128 + 128;
    LAS float* cs64 = sn128 + 128;  LAS float* sn64 = cs64 + 64;
    LAS float* cs256 = sn64 + 64;   LAS float* sn256 = cs256 + 256;
    LAS float* frow = sn256 + 256;
    LAS float* sc = frow + 512;
    LAS float* red = sc + 9216;
    const int tid = threadIdx.x, G = gridDim.x, bid = blockIdx.x;
    unsigned char* ws = P.ws;
    if (tid < 256) { float s, c; sincospif(2.0f * (float)tid / 256.0f, &s, &c); cs256[tid] = c; sn256[tid] = s; }
    if (tid < 128) { float s, c; sincospif(2.0f * (float)tid / 128.0f, &s, &c); cs128[tid] = c; sn128[tid] = s; }
    if (tid < 64)  { float s, c; sincospif(2.0f * (float)tid / 64.0f, &s, &c); cs64[tid] = c; sn64[tid] = s; }
    __syncthreads();

    if (bid < 144) {
        for (int i = tid; i < 9216; i += 512) { const int v = i >> 10, k = i & 1023; const float x = v < 8 ? P.in[4][v * 1024 + k] : P.in[5][k]; sc[i] = x / (1.0f + expf(-x)); }
        __syncthreads();
        const int c = tid & 63, kg = tid >> 6; const float* aw = P.in[6] + bid * 64 + c;
        float a[9];
#pragma unroll
        for (int v = 0; v < 9; ++v) a[v] = 0.f;
        for (int k = kg; k < 1024; k += 8) { const float w = aw[(size_t)k * 9216];
#pragma unroll
            for (int v = 0; v < 9; ++v) a[v] += sc[v * 1024 + k] * w; }
#pragma unroll
        for (int v = 0; v < 9; ++v) red[(kg * 9 + v) * 64 + c] = a[v];
        __syncthreads();
        float* MOD = (float*)(ws + WS_MOD);
        for (int i = tid; i < 576; i += 512) { const int v = i >> 6, cc = i & 63; float s = 0.f;
#pragma unroll
            for (int q = 0; q < 8; ++q) s += red[(q * 9 + v) * 64 + cc];
            MOD[v * 9216 + bid * 64 + cc] = s + P.in[7][bid * 64 + cc]; }
        __syncthreads();
    }

    {
        const int total = 5792;
        for (int q = bid; q < total; q += G) {
            int j = 0, r = q, nk = 16;
#define PREP_STEP(JJ, CNT, NKN) if (j == JJ && r >= (CNT)) { r -= (CNT); j = JJ + 1; nk = NKN; }
            PREP_STEP(0, 88 * 16, 44) PREP_STEP(1, 16 * 44, 16) PREP_STEP(2, 88 * 16, 44) PREP_STEP(3, 16 * 44, 16)
            PREP_STEP(4, 64 * 16, 8) PREP_STEP(5, 16 * 8, 8) PREP_STEP(6, 16 * 8, 16) PREP_STEP(7, 16 * 16, 4)
#undef PREP_STEP
            const int tn = r / nk, tk = r % nk, n0 = tn * 64, k0 = tk * 64;
            const float* src; int ld, krows, Kd, col0 = n0; u16* dst;
            if (j == 0 || j == 2) { src = j == 0 ? P.in[9] : P.in[11]; ld = 5632; krows = 1024; Kd = 1024; dst = (u16*)(ws + (j == 0 ? WS_W13A : WS_W13B));
                const int pn = n0 >> 8, rr = n0 & 255; col0 = rr < 128 ? 128 * pn + rr : 2816 + 128 * pn + (rr - 128); }
            else if (j == 1 || j == 3) { src = j == 1 ? P.in[10] : P.in[12]; ld = 1024; krows = 2816; Kd = 2816; dst = (u16*)(ws + (j == 1 ? WS_W2A : WS_W2B)); }
            else if (j == 4) { src = P.in[13]; ld = 4480; krows = 1024; Kd = 1024; dst = (u16*)(ws + WS_WIN);
                col0 = n0 < 1920 ? n0 : (n0 < 2048 ? -1 : 2432 + (n0 - 2048)); }
            else if (j == 5) { src = P.in[26]; ld = 1024; krows = 512; Kd = 512; dst = (u16*)(ws + WS_WO); }
            else if (j == 6) { src = P.in[27]; ld = 1024; krows = 512; Kd = 512; dst = (u16*)(ws + WS_WF); }
            else if (j == 7) { src = P.in[28]; ld = 1024; krows = 1024; Kd = 1024; dst = (u16*)(ws + WS_WOUT); }
            else { src = P.in[20]; ld = 512; krows = 128; Kd = 256; dst = (u16*)(ws + WS_GUP); }
            transpose_tile(src, ld, col0, k0, krows, dst, n0, Kd, tile);
        }
    }

    {
        u16* WZ = (u16*)(ws + WS_WZ);
        for (int k = bid; k < 1024; k += G) {
            frow[tid] = P.in[13][(size_t)k * 4480 + 1920 + tid];
            __syncthreads();
#pragma unroll
            for (int rep = 0; rep < 2; ++rep) { const int zc = tid + rep * 512, g = zc >> 8, part = (zc >> 7) & 1, kn = zc & 127;
                const LAS float* tab = part ? sn128 : cs128; float s = 0.f;
                for (int n = 0; n < 128; ++n) s += frow[g * 128 + n] * tab[(kn * n) & 127];
                s *= 0.08838834764831845f; if (part) s = -s;
                WZ[(size_t)zc * 1024 + k] = (u16)(cvt_pk_bf16(s, 0.f) & 0xffffu); }
            __syncthreads();
        }
    }

    {
        u16* T = (u16*)(ws + WS_T);
        for (size_t vi = (size_t)bid * 512 + tid; vi < (size_t)4096 * 1024; vi += (size_t)G * 512) {
            const int row = (int)(vi >> 10), cv = (int)(vi & 1023) * 8, part = cv >> 12, r = (cv >> 6) & 63, c0 = cv & 63, kr = row >> 6, kc = row & 63;
            const LAS float* tab = part ? sn64 : cs64; const int base = kr * r;
            float v[8];
#pragma unroll
            for (int j = 0; j < 8; ++j) v[j] = tab[(base + kc * (c0 + j)) & 63] * 0.015625f;
            u32x4 w; w.x = cvt_pk_bf16(v[0], v[1]); w.y = cvt_pk_bf16(v[2], v[3]); w.z = cvt_pk_bf16(v[4], v[5]); w.w = cvt_pk_bf16(v[6], v[7]);
            *(u32x4*)(T + vi * 8) = w;
        }
        u16* T2 = (u16*)(ws + WS_T256);
        for (int vi = bid * 512 + tid; vi < 256 * 64; vi += G * 512) {
            const int kt = vi >> 6, cv = (vi & 63) * 8, part = cv >> 8, t0 = cv & 255;
            const LAS float* tab = part ? sn256 : cs256;
            float v[8];
#pragma unroll
            for (int j = 0; j < 8; ++j) v[j] = tab[(kt * (t0 + j)) & 255] * 0.0625f;
            u32x4 w; w.x = cvt_pk_bf16(v[0], v[1]); w.y = cvt_pk_bf16(v[2], v[3]); w.z = cvt_pk_bf16(v[4], v[5]); w.w = cvt_pk_bf16(v[6], v[7]);
            *(u32x4*)(T2 + (size_t)vi * 8) = w;
        }
    }
}

__device__ __forceinline__ float wave_sum(float v) {
#pragma unroll
    for (int o = 32; o >= 1; o >>= 1) v += __shfl_xor(v, o);
    return v;
}
__device__ __forceinline__ void phase_norm(const Params& P, const float* X, int nwi, int slot_shift, int slot_scale, u16* H) {
    const int lane = threadIdx.x & 63, gw = blockIdx.x * 8 + (threadIdx.x >> 6), nw = gridDim.x * 8;
    const float* MOD = (const float*)(P.ws + WS_MOD); const float* normw = P.in[8] + nwi * 1024;
    for (int m = gw; m < MT; m += nw) {
        const float* xr = X ? X + (size_t)m * DM : (m < NPR ? P.in[0] + (size_t)m * DM : P.in[1] + (size_t)(m - NPR) * DM);
        f32x4 v[4]; float ss = 0.f;
#pragma unroll
        for (int i = 0; i < 4; ++i) { v[i] = *(const f32x4*)(xr + i * 256 + lane * 4); ss += v[i][0] * v[i][0] + v[i][1] * v[i][1] + v[i][2] * v[i][2] + v[i][3] * v[i][3]; }
        ss = wave_sum(ss);
        const float rs = rsqrtf(ss * (1.0f / 1024.0f) + 1e-6f);
        const float* md = MOD + (size_t)modidx_m(m) * 9216;
#pragma unroll
        for (int i = 0; i < 4; ++i) { const int c = i * 256 + lane * 4;
            const f32x4 w = *(const f32x4*)(normw + c), sc = *(const f32x4*)(md + slot_scale * 1024 + c), sh = *(const f32x4*)(md + slot_shift * 1024 + c);
            const f32x4 y = v[i] * rs * w * (sc + 1.0f) + sh;
            u32x2 o; o.x = cvt_pk_bf16(y[0], y[1]); o.y = cvt_pk_bf16(y[2], y[3]);
            *(u32x2*)(H + (size_t)m * DM + c) = o; }
    }
}
__device__ __forceinline__ void phase_final_norm(const Params& P) {
    const int lane = threadIdx.x & 63, gw = blockIdx.x * 8 + (threadIdx.x >> 6), nw = gridDim.x * 8;
    const float* fw = P.in[29];
    for (int m = gw; m < MT; m += nw) {
        float* xr = P.out + (size_t)m * DM;
        f32x4 v[4]; float ss = 0.f;
#pragma unroll
        for (int i = 0; i < 4; ++i) { v[i] = *(const f32x4*)(xr + i * 256 + lane * 4); ss += v[i][0] * v[i][0] + v[i][1] * v[i][1] + v[i][2] * v[i][2] + v[i][3] * v[i][3]; }
        ss = wave_sum(ss);
        const float rs = rsqrtf(ss * (1.0f / 1024.0f) + 1e-6f);
#pragma unroll
        for (int i = 0; i < 4; ++i) { const int c = i * 256 + lane * 4; *(f32x4*)(xr + c) = v[i] * rs * *(const f32x4*)(fw + c); }
    }
}

struct ScanRegs { u32x2 r[3], k[3], v[3], wd, ad; };
__device__ __forceinline__ void scan_load(ScanRegs& R, const u16* U, int tok0, int T, int t, int h, int d, int cg) {
    const u32x2 z = {0u, 0u};
#pragma unroll
    for (int tap = 0; tap < 3; ++tap) { const int tn = t + tap - 1;
        if (tn >= 0 && tn < T) { const u16* row = U + (size_t)(tok0 + tn) * 1792 + h * 64 + 4 * cg;
            R.r[tap] = *(const u32x2*)row; R.k[tap] = *(const u32x2*)(row + 512); R.v[tap] = *(const u32x2*)(row + 1024); }
        else { R.r[tap] = z; R.k[tap] = z; R.v[tap] = z; } }
    const u16* row = U + (size_t)(tok0 + t) * 1792 + 1536 + d * 64 + 4 * cg;
    R.wd = *(const u32x2*)row; R.ad = *(const u32x2*)(row + 128);
}
__device__ __forceinline__ void unpack4h(const u32x2 q, float (&o)[4]) { o[0] = h2f(q.x & 0xffffu); o[1] = h2f(q.x >> 16); o[2] = h2f(q.y & 0xffffu); o[3] = h2f(q.y >> 16); }

__device__ __forceinline__ void scan_unit(const Params& P, LAS float* L, int s, int h, int d, int half) {
    const int tid = threadIdx.x, lane = tid & 63;
    const int T = s < 16 ? 256 : 4096, tok0 = s < 16 ? s * 256 : NPR + (s - 16) * 4096;
    const u16* U = (const u16*)(P.ws + WS_U16);
    u16* Od = (u16*)(P.ws + WS_H) + (size_t)d * MT * 512;
    float* BS = (float*)(P.ws + WS_BS);
    LAS float* wup = L;            LAS float* aup = L + 4096;   LAS float* cst = L + 8192;
    LAS float* xwT = L + 9216;     LAS float* xaT = L + 11264;
    LAS float* r_s = L + 13312;    LAS float* w_s = L + 15360;  LAS float* kd_s = L + 17408;
    LAS float* v_s = L + 19456;    LAS float* kk_s = L + 21504; LAS float* kka_s = L + 23552;
    LAS float* o_s = L + 25600;
    for (int i = tid; i < 4096; i += 512) { const int r = i >> 6, c = i & 63;
        wup[i] = P.in[17][(size_t)(d * 64 + r) * 512 + h * 64 + c]; aup[i] = P.in[19][(size_t)(d * 64 + r) * 512 + h * 64 + c]; }
    if (tid < 64) { const int c = tid, ch = h * 64 + c;
        cst[c] = P.in[16][d * 512 + ch]; cst[64 + c] = P.in[18][d * 512 + ch]; cst[128 + c] = P.in[21][ch]; cst[192 + c] = P.in[22][ch]; cst[256 + c] = P.in[23][ch];
#pragma unroll
        for (int ten = 0; ten < 3; ++ten)
#pragma unroll
            for (int tap = 0; tap < 3; ++tap) cst[(5 + ten * 3 + tap) * 64 + c] = P.in[15][tap * 1536 + ten * 512 + ch]; }
    const int il = tid >> 4, c16 = tid & 15, irow = half * 32 + il;
    f32x4 S = {0.f, 0.f, 0.f, 0.f};
    if (s >= 16) S = *(const f32x4*)((d ? P.in[3] : P.in[2]) + ((size_t)((s - 16) * 8 + h) * 64 + irow) * 64 + 4 * c16);
    const int tt_a = tid >> 4, cg = tid & 15;
    const int nchunk = T / 32;
    ScanRegs R;
    { const int q = tt_a; scan_load(R, U, tok0, T, d ? T - 1 - q : q, h, d, cg); }
    __syncthreads();
    for (int ci = 0; ci < nchunk; ++ci) {
        {
            float rv[4] = {0.f, 0.f, 0.f, 0.f}, kv[4] = {0.f, 0.f, 0.f, 0.f}, vv[4] = {0.f, 0.f, 0.f, 0.f};
#pragma unroll
            for (int tap = 0; tap < 3; ++tap) { float a[4], b[4], c[4]; unpack4h(R.r[tap], a); unpack4h(R.k[tap], b); unpack4h(R.v[tap], c);
#pragma unroll
                for (int j = 0; j < 4; ++j) { rv[j] += a[j] * cst[(5 + tap) * 64 + 4 * cg + j]; kv[j] += b[j] * cst[(8 + tap) * 64 + 4 * cg + j]; vv[j] += c[j] * cst[(11 + tap) * 64 + 4 * cg + j]; } }
            float kkr[4], ss = 0.f;
#pragma unroll
            for (int j = 0; j < 4; ++j) { kkr[j] = kv[j] * cst[128 + 4 * cg + j]; ss += kkr[j] * kkr[j]; }
            ss += __shfl_xor(ss, 1); ss += __shfl_xor(ss, 2); ss += __shfl_xor(ss, 4); ss += __shfl_xor(ss, 8);
            const float inv = 1.0f / fmaxf(sqrtf(ss), 1e-12f);
            float wdv[4], adv[4]; unpack4h(R.wd, wdv); unpack4h(R.ad, adv);
#pragma unroll
            for (int j = 0; j < 4; ++j) { const int o = tt_a * 64 + 4 * cg + j;
                r_s[o] = rv[j]; v_s[o] = vv[j]; kd_s[o] = kv[j]; kk_s[o] = kkr[j] * inv;
                xwT[(4 * cg + j) * 32 + tt_a] = tanhf(wdv[j]); xaT[(4 * cg + j) * 32 + tt_a] = adv[j]; }
        }
        __syncthreads();
        {
            const int c = tid & 63, tg = tid >> 6;
            f32x4 aw = {0.f, 0.f, 0.f, 0.f}, aa = {0.f, 0.f, 0.f, 0.f};
#pragma unroll 8
            for (int r = 0; r < 64; ++r) { const float wv = wup[r * 64 + c], av = aup[r * 64 + c];
                const f32x4 x = *(const LAS f32x4*)(xwT + r * 32 + 4 * tg), y = *(const LAS f32x4*)(xaT + r * 32 + 4 * tg);
                aw += x * wv; aa += y * av; }
#pragma unroll
            for (int j = 0; j < 4; ++j) { const int tt = 4 * tg + j, o = tt * 64 + c;
                const float wl = cst[c] + aw[j];
                const float sp = (-wl > 20.0f) ? -wl : log1pf(expf(-wl));
                const float w = expf(-expf(-sp - 0.5f));
                const float a = 1.0f / (1.0f + expf(-(cst[64 + c] + aa[j])));
                const float k = kd_s[o], kk = kk_s[o];
                const float kd = k * (1.0f + (a - 1.0f) * cst[192 + c]);
                kd_s[o] = kd; kka_s[o] = kk * a; w_s[o] = w;
                const float bsum = wave_sum(r_s[o] * kd * cst[256 + c]);
                if (lane == 0 && half == 0) { const int q = ci * 32 + tt, t = d ? T - 1 - q : q; BS[(size_t)(tok0 + t) * 16 + h * 2 + d] = bsum; } }
        }
        __syncthreads();
        if (ci + 1 < nchunk) { const int q = (ci + 1) * 32 + tt_a; scan_load(R, U, tok0, T, d ? T - 1 - q : q, h, d, cg); }
#pragma unroll 4
        for (int tt = 0; tt < 32; ++tt) {
            const f32x4 w4 = *(const LAS f32x4*)(w_s + tt * 64 + 4 * c16), kk4 = *(const LAS f32x4*)(kk_s + tt * 64 + 4 * c16), ka4 = *(const LAS f32x4*)(kka_s + tt * 64 + 4 * c16);
            const f32x4 kd4 = *(const LAS f32x4*)(kd_s + tt * 64 + 4 * c16), r4 = *(const LAS f32x4*)(r_s + tt * 64 + 4 * c16);
            const float v = v_s[tt * 64 + irow];
            float sa = S[0] * kk4[0] + S[1] * kk4[1] + S[2] * kk4[2] + S[3] * kk4[3];
            sa += __shfl_xor(sa, 1); sa += __shfl_xor(sa, 2); sa += __shfl_xor(sa, 4); sa += __shfl_xor(sa, 8);
            S = S * w4 - ka4 * sa + kd4 * v;
            float o = S[0] * r4[0] + S[1] * r4[1] + S[2] * r4[2] + S[3] * r4[3];
            o += __shfl_xor(o, 1); o += __shfl_xor(o, 2); o += __shfl_xor(o, 4); o += __shfl_xor(o, 8);
            if (c16 == 0) o_s[tt * 32 + il] = o;
        }
        __syncthreads();
        { const int tt = tid >> 4, seg = tid & 15, q = ci * 32 + tt, t = d ? T - 1 - q : q;
          *(unsigned*)(Od + (size_t)(tok0 + t) * 512 + h * 64 + half * 32 + 2 * seg) = cvt_pk_bf16(o_s[tt * 32 + 2 * seg], o_s[tt * 32 + 2 * seg + 1]); }
    }
    if (s < 16) *(f32x4*)(P.out + OUT_STATE + (size_t)d * 524288 + ((size_t)(s * 8 + h) * 64 + irow) * 64 + 4 * c16) = S;
    __syncthreads();
}
__device__ __forceinline__ void phase_scan(const Params& P, LAS unsigned char* lds) {
    for (int q = blockIdx.x; q < 768; q += gridDim.x) {
        int s, rem;
        if (q < 256) { s = 16 + (q >> 5); rem = q & 31; } else { const int p = q - 256; s = p >> 5; rem = p & 31; }
        scan_unit(P, (LAS float*)lds, s, rem >> 2, (rem >> 1) & 1, rem & 1);
    }
}

__device__ __forceinline__ void phase_post(const Params& P, LAS unsigned char* lds) {
    const int lane = threadIdx.x & 63, gw = blockIdx.x * 8 + (threadIdx.x >> 6), nw = gridDim.x * 8;
    const u16* OF = (const u16*)(P.ws + WS_H); const u16* OB = OF + (size_t)MT * 512;
    const u16* U = (const u16*)(P.ws + WS_U16); const float* BS = (const float*)(P.ws + WS_BS);
    u16* OPRE = (u16*)(P.ws + WS_OPRE); const u16* GT = (const u16*)(P.ws + WS_R); const float* gup = P.in[20];
    LAS float* sgl = (LAS float*)lds + (threadIdx.x >> 6) * 128;
    const int ch = lane * 8, h = lane >> 3;
    float lw[8], lb[8], cv[3][8];
#pragma unroll
    for (int j = 0; j < 8; ++j) { lw[j] = P.in[24][ch + j]; lb[j] = P.in[25][ch + j];
#pragma unroll
        for (int tap = 0; tap < 3; ++tap) cv[tap][j] = P.in[15][tap * 1536 + 1024 + ch + j]; }
    for (int m = gw; m < MT; m += nw) {
        const int T = m < NPR ? 256 : 4096, t = m < NPR ? (m & 255) : ((m - NPR) & 4095);
        const u32x4 qf = *(const u32x4*)(OF + (size_t)m * 512 + ch), qb = *(const u32x4*)(OB + (size_t)m * 512 + ch);
        float o[8], s = 0.f;
#pragma unroll
        for (int j = 0; j < 4; ++j) { o[2 * j] = bf2f(qf[j] & 0xffffu) + bf2f(qb[j] & 0xffffu); o[2 * j + 1] = bf2f(qf[j] >> 16) + bf2f(qb[j] >> 16); s += o[2 * j] + o[2 * j + 1]; }
        s += __shfl_xor(s, 1); s += __shfl_xor(s, 2); s += __shfl_xor(s, 4);
        const float mean = s * (1.0f / 64.0f); float q2 = 0.f;
#pragma unroll
        for (int j = 0; j < 8; ++j) { o[j] -= mean; q2 += o[j] * o[j]; }
        q2 += __shfl_xor(q2, 1); q2 += __shfl_xor(q2, 2); q2 += __shfl_xor(q2, 4);
        const float rstd = rsqrtf(q2 * (1.0f / 64.0f) + 64e-5f);
        const float bsv = BS[(size_t)m * 16 + h * 2] + BS[(size_t)m * 16 + h * 2 + 1];
        float v[8];
#pragma unroll
        for (int j = 0; j < 8; ++j) v[j] = 0.f;
#pragma unroll
        for (int tap = 0; tap < 3; ++tap) { const int tn = t + tap - 1;
            if (tn >= 0 && tn < T) { const u32x4 qv = *(const u32x4*)(U + (size_t)(m + tap - 1) * 1792 + 1024 + ch);
#pragma unroll
                for (int j = 0; j < 4; ++j) { v[2 * j] += h2f(qv[j] & 0xffffu) * cv[tap][2 * j]; v[2 * j + 1] += h2f(qv[j] >> 16) * cv[tap][2 * j + 1]; } } }
        { const unsigned sq = *(const unsigned*)(GT + (size_t)m * GLD + 2048 + 2 * lane); sgl[2 * lane] = h2f(sq & 0xffffu); sgl[2 * lane + 1] = h2f(sq >> 16); }
        float g[8];
#pragma unroll
        for (int j = 0; j < 8; ++j) g[j] = 0.f;
#pragma unroll 4
        for (int k = 0; k < 128; ++k) { const float sk = sgl[k]; const f32x4 g0 = *(const f32x4*)(gup + (size_t)k * 512 + ch), g1 = *(const f32x4*)(gup + (size_t)k * 512 + ch + 4);
            g[0] += sk * g0[0]; g[1] += sk * g0[1]; g[2] += sk * g0[2]; g[3] += sk * g0[3]; g[4] += sk * g1[0]; g[5] += sk * g1[1]; g[6] += sk * g1[2]; g[7] += sk * g1[3]; }
        float y[8];
#pragma unroll
        for (int j = 0; j < 8; ++j) y[j] = (o[j] * rstd * lw[j] + lb[j] + bsv * v[j]) * g[j];
        u32x4 w; w.x = cvt_pk_bf16(y[0], y[1]); w.y = cvt_pk_bf16(y[2], y[3]); w.z = cvt_pk_bf16(y[4], y[5]); w.w = cvt_pk_bf16(y[6], y[7]);
        *(u32x4*)(OPRE + (size_t)m * 512 + ch) = w;
    }
}

__global__ void __launch_bounds__(512, 2) fwd_mega(Params P) {
    extern __shared__ __attribute__((aligned(16))) unsigned char lds_raw[];
    LAS unsigned char* lds = (LAS unsigned char*)lds_raw;
    cg::grid_group grid = cg::this_grid();
    if (threadIdx.x < 32) { const int i = threadIdx.x; const unsigned long long v = i < 30 ? (unsigned long long)P.in[i] : (i == 30 ? (unsigned long long)P.out : (unsigned long long)P.ws);
        *(LAS unsigned long long*)(lds + PTAB_OFF + i * 8) = v; }
    __syncthreads();
#define PH_BEGIN { const Params Q = get_params(lds); unsigned char* ws = Q.ws; (void)ws;
#define PH_END } asm volatile("s_waitcnt vmcnt(0)" ::: "memory");   grid.sync();
    PH_BEGIN phase_prep(Q, lds); PH_END
    PH_BEGIN phase_norm(Q, nullptr, 0, 0, 1, (u16*)(ws + WS_H)); PH_END
    PH_BEGIN run_gemm(lds, (const u16*)(ws + WS_H), (const u16*)(ws + WS_W13A), MT, 5632, 1024, EpiSwiglu{(u16*)(ws + WS_BIG)}); PH_END
    PH_BEGIN run_gemm(lds, (const u16*)(ws + WS_BIG), (const u16*)(ws + WS_W2A), MT, 1024, 2816, EpiResid{Q.in[0], Q.in[1], Q.out, (const float*)(ws + WS_MOD), 2, 0.5f}); PH_END
    PH_BEGIN phase_norm(Q, Q.out, 1, 3, 4, (u16*)(ws + WS_H)); PH_END
    PH_BEGIN run_gemm(lds, (const u16*)(ws + WS_WZ), (const u16*)(ws + WS_H), 1024, MT, 1024, EpiZT{(u16*)(ws + WS_ZL)}); PH_END
    PH_BEGIN run_gemm(lds, (const u16*)(ws + WS_T), (const u16*)(ws + WS_ZL), 4096, 4096, 8192, EpiFour{(u16*)(ws + WS_FOUR), 1});
             run_gemm(lds, (const u16*)(ws + WS_T256), (const u16*)(ws + WS_ZP), 256, 8192, 512, EpiFour{(u16*)(ws + WS_FOUR), 0}); PH_END
    PH_BEGIN run_gemm(lds, (const u16*)(ws + WS_H), (const u16*)(ws + WS_WIN), MT, 4096, 1024, EpiU{(u16*)(ws + WS_U16), (u16*)(ws + WS_SG), (u16*)(ws + WS_R), Q.in[14]}); PH_END
    PH_BEGIN phase_scan(Q, lds); PH_END
    PH_BEGIN phase_post(Q, lds); PH_END
    PH_BEGIN run_gemm(lds, (const u16*)(ws + WS_OPRE), (const u16*)(ws + WS_WO), MT, 1024, 512, EpiMul{(u16*)(ws + WS_H), (const u16*)(ws + WS_R), 1}); PH_END
    PH_BEGIN run_gemm(lds, (const u16*)(ws + WS_FOUR), (const u16*)(ws + WS_WF), MT, 1024, 512, EpiMul{(u16*)(ws + WS_H), (const u16*)(ws + WS_R), 2}); PH_END
    PH_BEGIN run_gemm(lds, (const u16*)(ws + WS_H), (const u16*)(ws + WS_WOUT), MT, 1024, 1024, EpiResid{nullptr, nullptr, Q.out, (const float*)(ws + WS_MOD), 5, 1.0f}); PH_END
    PH_BEGIN phase_norm(Q, Q.out, 2, 6, 7, (u16*)(ws + WS_H)); PH_END
    PH_BEGIN run_gemm(lds, (const u16*)(ws + WS_H), (const u16*)(ws + WS_W13B), MT, 5632, 1024, EpiSwiglu{(u16*)(ws + WS_BIG)}); PH_END
    PH_BEGIN run_gemm(lds, (const u16*)(ws + WS_BIG), (const u16*)(ws + WS_W2B), MT, 1024, 2816, EpiResid{nullptr, nullptr, Q.out, (const float*)(ws + WS_MOD), 8, 0.5f}); PH_END
    { const Params Q = get_params(lds); phase_final_norm(Q); }
#undef PH_BEGIN
#undef PH_END
}

extern "C" void kernel_launch(void* const* d_in, const int* in_sizes, int n_in, void* d_out, int out_size, void* d_ws, size_t ws_size, hipStream_t stream) {
    static int grid_blocks = 0;
    if (grid_blocks == 0) {
        if (n_in != 30 || ws_size < WS_END) { fprintf(stderr, "kernel_launch: unexpected n_in %d / ws_size %zu (need %zu)\n", n_in, ws_size, (size_t)WS_END); grid_blocks = -1; return; }
        int dev = 0, cus = 0, per_cu = 0;
        (void)hipGetDevice(&dev);
        (void)hipDeviceGetAttribute(&cus, hipDeviceAttributeMultiprocessorCount, dev);
        (void)hipFuncSetAttribute((const void*)fwd_mega, hipFuncAttributeMaxDynamicSharedMemorySize, LDS_BYTES);
        (void)hipOccupancyMaxActiveBlocksPerMultiprocessor(&per_cu, (const void*)fwd_mega, 512, LDS_BYTES);
        if (per_cu < 1) { fprintf(stderr, "kernel_launch: occupancy query reports %d blocks per CU\n", per_cu); per_cu = 1; }
        if (per_cu > 1) per_cu = 1;
        grid_blocks = cus * per_cu;
        (void)hipGetLastError();
    }
    if (grid_blocks < 0) return;
    Params p{};
    for (int i = 0; i < 30; ++i) p.in[i] = (const float*)d_in[i];
    p.out = (float*)d_out; p.ws = (unsigned char*)d_ws;
    void* args[] = {&p};
    hipError_t e = hipLaunchCooperativeKernel((const void*)fwd_mega, dim3(grid_blocks), dim3(512), args, LDS_BYTES, stream);
    if (e != hipSuccess) fprintf(stderr, "cooperative launch failed: %s (grid %d)\n", hipGetErrorString(e), grid_blocks);
}
```

```cpp
#include <hip/hip_runtime.h>
#include <hip/hip_cooperative_groups.h>
#include <cstdio>
namespace cg = cooperative_groups;
namespace pg8 {
#define PG8_LAS __attribute__((address_space(3)))
typedef unsigned short bf16_t;
typedef short bf16x8 __attribute__((ext_vector_type(8)));
typedef float f32x4 __attribute__((ext_vector_type(4)));
typedef unsigned u32x4 __attribute__((ext_vector_type(4)));
constexpr int BM = 256, BK = 64, HALF = 128, HTB = HALF * BK * 2  , STAGE_BYTES = 8 * HTB, NXCD = 8, WGM = 8;

__host__ __device__ __forceinline__ int lds_byte(int r, int c) { const int st = (r >> 4) * 2 + (c >> 5), rr = r & 15, cc = c & 31, ob = rr * 64 + cc * 2; return st * 1024 + (ob ^ (((ob >> 9) & 1) << 5)); }
__host__ __device__ __forceinline__ void stage_rc(int b, int& R, int& C) { const int st = b / 1024, sb = b % 1024, swz = sb ^ (((sb >> 9) & 1) << 5); R = (st >> 1) * 16 + swz / 64; C = (st & 1) * 32 + (swz % 64) / 2; }
__host__ __device__ __forceinline__ int perm32(int rho) { const int n = rho >> 4, i = rho & 15; return 8 * (i >> 2) + 4 * n + (i & 3); }

struct Unit { int pm, pn; };
struct Gemm { const bf16_t* A; const bf16_t* Bt; int M, N, K; };

struct StaticOrder {
    int nM, nN, nwg, G, c;
    __host__ __device__ __forceinline__ void init(int M, int N, int G_, int c_) { nM = M / BM; nN = N / BM; nwg = nM * nN; G = G_; c = c_; }
    __host__ __device__ __forceinline__ bool next(int i, Unit& u) const {
        const long L = (long)i * G + c; if (L >= nwg) return false;
        int wgid = (int)L; { const int q = nwg / NXCD, r = nwg % NXCD, xcd = wgid % NXCD, off = wgid / NXCD; wgid = (xcd < r ? xcd * (q + 1) : r * (q + 1) + (xcd - r) * q) + off; }
        const int nig = WGM * nN, gid = wgid / nig, fm = gid * WGM, gsz = (nM - fm) < WGM ? (nM - fm) : WGM;
        u.pm = fm + ((wgid % nig) % gsz); u.pn = (wgid % nig) / gsz; return true;
    }
    __device__ __forceinline__ void a_ready(const Unit&) const {}
    __device__ __forceinline__ void done(const Unit&) const {}
};
__device__ __forceinline__ unsigned cvt_pk_bf16(float lo, float hi) { unsigned r; asm volatile("v_cvt_pk_bf16_f32 %0, %1, %2" : "=v"(r) : "v"(lo), "v"(hi)); return r; }
template <class Epi, class Sched, bool STAMP = false>
__device__ __forceinline__ void gemm_phase(PG8_LAS unsigned char* lds, const Gemm g, const Sched& S, const Epi& E, unsigned long long* stamps) {
    int tid_ = threadIdx.x; asm volatile("" : "+v"(tid_));
    const int tid = tid_, wid = __builtin_amdgcn_readfirstlane(tid >> 6), lane = tid & 63, wr = wid >> 2, wc = wid & 3, fr = lane & 15, fq = lane >> 4;
    const int K = g.K, nt = K / BK;
    int ts_lo = 0, ts_hi = 0, nts = 0; const unsigned long long rt_entry = STAMP ? (unsigned long long)wall_clock64() : 0ull;
#define PG8_STAMP() do { if (STAMP && wid == 0 && nts < 64) { const unsigned long long _c = (unsigned long long)clock64(); \
        ts_lo = (lane == nts) ? (int)(unsigned)_c : ts_lo; ts_hi = (lane == nts) ? (int)(unsigned)(_c >> 32) : ts_hi; ++nts; } } while (0)
    PG8_STAMP();
    unsigned voffA[2], voffB[2];
#pragma unroll
    for (int i = 0; i < 2; ++i) { int R, C; stage_rc(tid * 16 + i * 8192, R, C); const int Rb = Epi::PERM ? ((R & ~31) + perm32(R & 31)) : R;
        voffA[i] = (unsigned)(R * K + C) * 2u; voffB[i] = (unsigned)(Rb * K + C) * 2u; }
    const size_t kstep = (size_t)(BK * 2);
    const size_t hstep = (size_t)HALF * K * 2;
    const size_t tstep = 2 * hstep;
    const unsigned ldsw = (unsigned)wid * 1024u;
    const int aoff = lds_byte(wr * 64 + fr, fq * 8), boff = lds_byte(wc * 32 + fr, fq * 8);
#define PG8_SA(b, h) (((b) * 2 + (h)) * HTB)
#define PG8_SB(b, h) ((4 + (b) * 2 + (h)) * HTB)
#define PG8_STAGE(bufoff, gbase, voff) do { _Pragma("unroll") for (int _i = 0; _i < 2; ++_i) \
        __builtin_amdgcn_global_load_lds((const unsigned*)((const char*)(gbase) + (voff)[_i]), (PG8_LAS unsigned*)(lds + (bufoff) + ldsw + _i * 8192), 16, 0, 0); } while (0)
#define PG8_LDA(dst, b, h) do { _Pragma("unroll") for (int m = 0; m < 4; ++m) _Pragma("unroll") for (int k = 0; k < 2; ++k) dst[m][k] = *(const PG8_LAS bf16x8*)(lds + PG8_SA(b, h) + aoff + m * 2048 + k * 1024); } while (0)
#define PG8_LDB(dst, b, h) do { _Pragma("unroll") for (int n = 0; n < 2; ++n) _Pragma("unroll") for (int k = 0; k < 2; ++k) dst[n][k] = *(const PG8_LAS bf16x8*)(lds + PG8_SB(b, h) + boff + n * 2048 + k * 1024); } while (0)
#define PG8_MMA(ai, bj, At, Bt) do { __builtin_amdgcn_s_setprio(1); _Pragma("unroll") for (int m = 0; m < 4; ++m) _Pragma("unroll") for (int n = 0; n < 2; ++n) _Pragma("unroll") for (int k = 0; k < 2; ++k) \
        acc[ai][bj][m][n] = __builtin_amdgcn_mfma_f32_16x16x32_bf16(Bt[n][k], At[m][k], acc[ai][bj][m][n], 0, 0, 0); __builtin_amdgcn_s_setprio(0); } while (0)
#define PG8_WAIT_V(n) asm volatile("s_waitcnt vmcnt(" #n ")" ::: "memory")
#define PG8_WAIT_L(n) asm volatile("s_waitcnt lgkmcnt(" #n ")" ::: "memory")
#define PG8_BAR __builtin_amdgcn_s_barrier()
#define PG8_SCHED __builtin_amdgcn_sched_barrier(0)
    Unit cur, nxt; int ui = 0;
    if (!S.next(0, cur)) return;
    f32x4 acc[2][2][4][2];
#pragma unroll
    for (int a = 0; a < 2; ++a)
#pragma unroll
        for (int b = 0; b < 2; ++b)
#pragma unroll
            for (int m = 0; m < 4; ++m)
#pragma unroll
                for (int n = 0; n < 2; ++n) acc[a][b][m][n] = (f32x4){0.f, 0.f, 0.f, 0.f};
    bf16x8 At[4][2], B0[2][2], B1[2][2];
    const char* cA = (const char*)g.A + (size_t)cur.pm * tstep; const char* cB = (const char*)g.Bt + (size_t)cur.pn * tstep;
    S.a_ready(cur);
    PG8_STAGE(PG8_SB(0, 0), cB, voffB); PG8_STAGE(PG8_SA(0, 0), cA, voffA); PG8_STAGE(PG8_SB(0, 1), cB + hstep, voffB); PG8_STAGE(PG8_SA(0, 1), cA + hstep, voffA);
    if (wr == 1) PG8_BAR;
    PG8_WAIT_V(4); PG8_BAR;
    PG8_STAGE(PG8_SB(1, 0), cB + kstep, voffB); PG8_STAGE(PG8_SA(1, 0), cA + kstep, voffA); PG8_STAGE(PG8_SB(1, 1), cB + hstep + kstep, voffB);
    PG8_WAIT_V(6); PG8_BAR;
    PG8_STAMP();
    for (;;) {
        const bool has_next = S.next(ui + 1, nxt);
        const char* nA = has_next ? (const char*)g.A + (size_t)nxt.pm * tstep : cA; const char* nB = has_next ? (const char*)g.Bt + (size_t)nxt.pn * tstep : cB;
        for (int t = 0; t < nt; t += 2) {
            const bool last = (t == nt - 2);
            const char* a1 = cA + (size_t)(t + 1) * kstep;
            const char* a2 = last ? nA : cA + (size_t)(t + 2) * kstep; const char* b2 = last ? nB : cB + (size_t)(t + 2) * kstep;
            const char* a3 = a2 + kstep; const char* b3 = b2 + kstep;
            if (last && has_next) S.a_ready(nxt);
            PG8_LDB(B0, 0, 0); PG8_SCHED; PG8_LDA(At, 0, 0); PG8_STAGE(PG8_SA(1, 1), a1 + hstep, voffA);
            PG8_WAIT_L(8); PG8_BAR; PG8_WAIT_L(0); PG8_MMA(0, 0, At, B0); PG8_BAR; PG8_SCHED;
            PG8_LDB(B1, 0, 1); PG8_STAGE(PG8_SB(0, 0), b2, voffB);
            PG8_BAR; PG8_WAIT_L(0); PG8_MMA(0, 1, At, B1); PG8_BAR;
            PG8_LDA(At, 0, 1); PG8_STAGE(PG8_SA(0, 0), a2, voffA);
            PG8_BAR; PG8_WAIT_L(0); PG8_MMA(1, 0, At, B0); PG8_BAR; PG8_SCHED;
            PG8_STAGE(PG8_SB(0, 1), b2 + hstep, voffB);
            PG8_WAIT_V(6); PG8_BAR; PG8_MMA(1, 1, At, B1); PG8_BAR;
            PG8_LDB(B0, 1, 0); PG8_SCHED; PG8_LDA(At, 1, 0); PG8_STAGE(PG8_SA(0, 1), a2 + hstep, voffA);
            PG8_WAIT_L(8); PG8_BAR; PG8_WAIT_L(0); PG8_MMA(0, 0, At, B0); PG8_BAR; PG8_SCHED;
            PG8_LDB(B1, 1, 1); PG8_STAGE(PG8_SB(1, 0), b3, voffB);
            PG8_BAR; PG8_WAIT_L(0); PG8_MMA(0, 1, At, B1); PG8_BAR;
            PG8_LDA(At, 1, 1); PG8_STAGE(PG8_SA(1, 0), a3, voffA);
            PG8_BAR; PG8_WAIT_L(0); PG8_MMA(1, 0, At, B0); PG8_BAR; PG8_SCHED;
            PG8_STAGE(PG8_SB(1, 1), b3 + hstep, voffB);
            PG8_WAIT_V(6); PG8_BAR; PG8_MMA(1, 1, At, B1); PG8_BAR;
        }
        PG8_STAMP();
        if constexpr (!Epi::AFTER_DRAIN) { E(acc, cur, wr, wc, fr, fq); S.done(cur); }
        PG8_STAMP();
        if (!has_next) break;
#pragma unroll
        for (int a = 0; a < 2; ++a)
#pragma unroll
            for (int b = 0; b < 2; ++b)
#pragma unroll
                for (int m = 0; m < 4; ++m)
#pragma unroll
                    for (int n = 0; n < 2; ++n) acc[a][b][m][n] = (f32x4){0.f, 0.f, 0.f, 0.f};
        cur = nxt; cA = nA; cB = nB; ++ui;
    }
    PG8_WAIT_V(0);
    if (wr == 0) PG8_BAR;
    PG8_BAR;
    if constexpr (Epi::AFTER_DRAIN) { E.fused(acc, cur, wr, wc, fr, fq, lds, wid, lane); S.done(cur); }
    PG8_STAMP();
    if (STAMP && wid == 0) { stamps[lane] = lane < nts ? (((unsigned long long)(unsigned)ts_hi << 32) | (unsigned)ts_lo) : 0ull;
        if (lane == 62) stamps[62] = rt_entry; if (lane == 63) stamps[63] = (unsigned long long)wall_clock64(); }
#undef PG8_STAMP
#undef PG8_SA
#undef PG8_SB
#undef PG8_STAGE
#undef PG8_LDA
#undef PG8_LDB
#undef PG8_MMA
#undef PG8_WAIT_V
#undef PG8_WAIT_L
#undef PG8_BAR
#undef PG8_SCHED
}
}

#define LAS __attribute__((address_space(3)))
typedef unsigned short u16;
typedef float f32x4 __attribute__((ext_vector_type(4)));
typedef unsigned u32x4 __attribute__((ext_vector_type(4)));
typedef unsigned u32x2 __attribute__((ext_vector_type(2)));
using pg8::cvt_pk_bf16;

constexpr int MT = 36864, NPR = 4096, DM = 1024, DFF = 2816;
constexpr int OUT_STATE = MT * DM;
constexpr int LDS_BYTES = 163840, PTAB_OFF = 163840 - 256;

constexpr size_t SZ_W13 = (size_t)5632 * 1024 * 2, SZ_W2 = (size_t)1024 * 2816 * 2;
constexpr size_t WS_W13A = 0, WS_W2A = WS_W13A + SZ_W13, WS_W13B = WS_W2A + SZ_W2, WS_W2B = WS_W13B + SZ_W13;
constexpr size_t WS_WIN = WS_W2B + SZ_W2;
constexpr size_t WS_WZ = WS_WIN + (size_t)4096 * 1024 * 2;
constexpr size_t WS_WO = WS_WZ + (size_t)1024 * 1024 * 2;
constexpr size_t WS_WF = WS_WO + (size_t)1024 * 512 * 2;
constexpr size_t WS_WOUT = WS_WF + (size_t)1024 * 512 * 2;
constexpr size_t WS_GUP = WS_WOUT + (size_t)1024 * 1024 * 2;
constexpr size_t WS_MOD = WS_GUP + (size_t)512 * 256 * 2;
constexpr size_t WS_BS = WS_MOD + (size_t)9 * 9216 * 4;
constexpr size_t WS_SG = WS_BS + (size_t)MT * 16 * 4;
constexpr size_t WS_H = WS_SG + (size_t)MT * 256 * 2;
constexpr size_t WS_BIG = WS_H + (size_t)MT * 1024 * 2;
constexpr size_t WS_U16 = WS_BIG;
constexpr size_t WS_FOUR = WS_U16 + (size_t)MT * 1792 * 2;
constexpr size_t WS_OPRE = WS_FOUR + (size_t)MT * 512 * 2;
constexpr size_t WS_R = WS_BIG + (size_t)MT * 2816 * 2;
constexpr size_t WS_T = WS_R;
constexpr size_t WS_T256 = WS_T + (size_t)4096 * 8192 * 2;
constexpr size_t WS_ZL = WS_T256 + (size_t)256 * 512 * 2;
constexpr size_t WS_ZP = WS_ZL + (size_t)4096 * 8192 * 2;
constexpr int GLD = 2304;
constexpr size_t WS_END = WS_R + (size_t)MT * GLD * 2;
static_assert(WS_ZP + (size_t)8192 * 512 * 2 <= WS_END, "R region");
static_assert(WS_OPRE + (size_t)MT * 512 * 2 <= WS_R, "BIG region");
static_assert(WS_END <= (size_t)536870912, "workspace");
static_assert(WS_ZP == WS_ZL + (size_t)4096 * 8192 * 2, "ZP behind ZL");

struct Params { const float* in[30]; float* out; unsigned char* ws; };
__device__ __forceinline__ unsigned long long ld_ptr(LAS unsigned char* lds, int i) {
    const u32x2 v = *(const LAS u32x2*)(lds + PTAB_OFF + i * 8);
    const unsigned lo = __builtin_amdgcn_readfirstlane(v.x), hi = __builtin_amdgcn_readfirstlane(v.y);
    return ((unsigned long long)hi << 32) | lo;
}
template <class T> __device__ __forceinline__ T* as_global(unsigned long long v) {
    return (T*)(__attribute__((address_space(1))) T*)v;
}
__device__ __forceinline__ Params get_params(LAS unsigned char* lds) {
    Params Q;
#pragma unroll
    for (int i = 0; i < 30; ++i) Q.in[i] = as_global<const float>(ld_ptr(lds, i));
    Q.out = as_global<float>(ld_ptr(lds, 30)); Q.ws = as_global<unsigned char>(ld_ptr(lds, 31));
    return Q;
}
__device__ __forceinline__ float bf2f(unsigned v16) { return __uint_as_float(v16 << 16); }
__device__ __forceinline__ float h2f(unsigned v16) { return (float)__builtin_bit_cast(_Float16, (unsigned short)v16); }
__device__ __forceinline__ unsigned pk_h(float a, float b) {
    const unsigned short ua = __builtin_bit_cast(unsigned short, (_Float16)a), ub = __builtin_bit_cast(unsigned short, (_Float16)b);
    return (unsigned)ua | ((unsigned)ub << 16);
}
__device__ __forceinline__ float sigmoidf_(float x) { return __builtin_amdgcn_rcpf(1.0f + __expf(-x)); }
__device__ __forceinline__ int modidx_pm(int pm) { return pm < 16 ? 8 : ((pm - 16) >> 4); }
__device__ __forceinline__ int modidx_m(int m) { return m < NPR ? 8 : ((m - NPR) >> 12); }

struct EpiSwiglu {
    static constexpr bool PERM = true, AFTER_DRAIN = false;
    u16* G;
    __device__ __forceinline__ void operator()(const f32x4 (&acc)[2][2][4][2], const pg8::Unit& u, int wr, int wc, int fr, int fq) const {
        const int row0 = u.pm * 256 + wr * 64 + fr, col0 = u.pn * 128 + wc * 32 + 8 * fq;
#pragma unroll
        for (int ai = 0; ai < 2; ++ai)
#pragma unroll
            for (int m = 0; m < 4; ++m) {
                float g[8];
#pragma unroll
                for (int n = 0; n < 2; ++n)
#pragma unroll
                    for (int j = 0; j < 4; ++j) { const float a = acc[ai][0][m][n][j], b = acc[ai][1][m][n][j]; g[n * 4 + j] = a * sigmoidf_(a) * b; }
                u32x4 w; w.x = cvt_pk_bf16(g[0], g[1]); w.y = cvt_pk_bf16(g[2], g[3]); w.z = cvt_pk_bf16(g[4], g[5]); w.w = cvt_pk_bf16(g[6], g[7]);
                *(u32x4*)(G + (size_t)(row0 + ai * 128 + m * 16) * DFF + col0) = w;
            }
    }
};
struct EpiResid {
    static constexpr bool PERM = false, AFTER_DRAIN = false;
    const float* xp; const float* xs; float* X; const float* MOD; int slot; float coef;
    __device__ __forceinline__ void operator()(const f32x4 (&acc)[2][2][4][2], const pg8::Unit& u, int wr, int wc, int fr, int fq) const {
        const int row0 = u.pm * 256 + wr * 64 + fr, col0 = u.pn * 256 + wc * 32 + 4 * fq;
        const float* g = MOD + (size_t)modidx_pm(u.pm) * 9216 + slot * 1024 + col0;
        f32x4 gv[2][2];
#pragma unroll
        for (int bj = 0; bj < 2; ++bj)
#pragma unroll
            for (int n = 0; n < 2; ++n) gv[bj][n] = *(const f32x4*)(g + bj * 128 + n * 16) * coef;
#pragma unroll
        for (int ai = 0; ai < 2; ++ai)
#pragma unroll
            for (int m = 0; m < 4; ++m) {
                const int row = row0 + ai * 128 + m * 16;
                const float* src = (xp ? (row < NPR ? xp + (size_t)row * DM : xs + (size_t)(row - NPR) * DM) : X + (size_t)row * DM) + col0;
                float* dst = X + (size_t)row * DM + col0;
#pragma unroll
                for (int bj = 0; bj < 2; ++bj)
#pragma unroll
                    for (int n = 0; n < 2; ++n) *(f32x4*)(dst + bj * 128 + n * 16) = *(const f32x4*)(src + bj * 128 + n * 16) + gv[bj][n] * acc[ai][bj][m][n];
            }
    }
};
struct EpiU {
    static constexpr bool PERM = true, AFTER_DRAIN = false;
    u16* U; u16* SG; u16* GATES; const float* gate_b;
    __device__ __forceinline__ void operator()(const f32x4 (&acc)[2][2][4][2], const pg8::Unit& u, int wr, int wc, int fr, int fq) const {
        const int row0 = u.pm * 256 + wr * 64 + fr, ct = wc * 32 + 8 * fq;
        if (u.pn < 7) {
#pragma unroll
            for (int ai = 0; ai < 2; ++ai)
#pragma unroll
                for (int m = 0; m < 4; ++m)
#pragma unroll
                    for (int bj = 0; bj < 2; ++bj) { const f32x4 v0 = acc[ai][bj][m][0], v1 = acc[ai][bj][m][1];
                        u32x4 w; w.x = pk_h(v0[0], v0[1]); w.y = pk_h(v0[2], v0[3]); w.z = pk_h(v1[0], v1[1]); w.w = pk_h(v1[2], v1[3]);
                        *(u32x4*)(U + (size_t)(row0 + ai * 128 + m * 16) * 1792 + u.pn * 256 + bj * 128 + ct) = w; }
        } else {
            const int gc0 = (u.pn == 7 ? 2048 : (u.pn - 8) * 256) + ct;
#pragma unroll
            for (int bj = 0; bj < 2; ++bj) {
                const int gbi = (u.pn == 7 ? 0 : (u.pn - 8) * 256) + ct; const float bsc = u.pn == 7 ? 0.f : 1.f;
                const f32x4 b0 = *(const f32x4*)(gate_b + gbi + bj * 128) * bsc, b1 = *(const f32x4*)(gate_b + gbi + bj * 128 + 4) * bsc;
#pragma unroll
                for (int ai = 0; ai < 2; ++ai)
#pragma unroll
                    for (int m = 0; m < 4; ++m) { const f32x4 v0 = acc[ai][bj][m][0] + b0, v1 = acc[ai][bj][m][1] + b1;
                        u32x4 w; w.x = pk_h(sigmoidf_(v0[0]), sigmoidf_(v0[1])); w.y = pk_h(sigmoidf_(v0[2]), sigmoidf_(v0[3]));
                        w.z = pk_h(sigmoidf_(v1[0]), sigmoidf_(v1[1])); w.w = pk_h(sigmoidf_(v1[2]), sigmoidf_(v1[3]));
                        *(u32x4*)(GATES + (size_t)(row0 + ai * 128 + m * 16) * GLD + gc0 + bj * 128) = w; }
            }
        }
    }
};
struct EpiZT {
    static constexpr bool PERM = true, AFTER_DRAIN = false;
    u16* ZL;
    __device__ __forceinline__ void operator()(const f32x4 (&acc)[2][2][4][2], const pg8::Unit& u, int wr, int wc, int fr, int fq) const {
#pragma unroll
        for (int bj = 0; bj < 2; ++bj) {
            const int c0 = u.pn * 256 + bj * 128 + wc * 32 + 8 * fq;
#pragma unroll
            for (int ai = 0; ai < 2; ++ai)
#pragma unroll
                for (int m = 0; m < 4; ++m) {
                    const int zr = u.pm * 256 + ai * 128 + wr * 64 + m * 16 + fr, g = zr >> 8, part = (zr >> 7) & 1, kn = zr & 127;
                    size_t off;
                    if (u.pn < 16) off = (size_t)4096 * 8192 + ((size_t)(u.pn * 512 + g * 128 + kn) * 512 + part * 256 + (c0 - u.pn * 256));
                    else { const int tok = c0 - NPR, b = tok >> 12, rc = tok & 4095; off = (size_t)(b * 512 + g * 128 + kn) * 8192 + part * 4096 + rc; }
                    u16* dst = ZL + off;
                    const f32x4 v0 = acc[ai][bj][m][0], v1 = acc[ai][bj][m][1];
                    u32x4 w; w.x = cvt_pk_bf16(v0[0], v0[1]); w.y = cvt_pk_bf16(v0[2], v0[3]); w.z = cvt_pk_bf16(v1[0], v1[1]); w.w = cvt_pk_bf16(v1[2], v1[3]);
                    *(u32x4*)dst = w;
                }
        }
    }
};
struct EpiFour {
    static constexpr bool PERM = true, AFTER_DRAIN = false;
    u16* FOUR; int latent;
    __device__ __forceinline__ void operator()(const f32x4 (&acc)[2][2][4][2], const pg8::Unit& u, int wr, int wc, int fr, int fq) const {
        const int b = u.pn >> 1, ch0 = (u.pn & 1) * 256 + wc * 32 + 8 * fq;
        const int tok0 = (latent ? NPR + b * 4096 : b * 256) + u.pm * 256 + wr * 64 + fr;
#pragma unroll
        for (int ai = 0; ai < 2; ++ai)
#pragma unroll
            for (int m = 0; m < 4; ++m)
#pragma unroll
                for (int bj = 0; bj < 2; ++bj) { const f32x4 v0 = acc[ai][bj][m][0], v1 = acc[ai][bj][m][1];
                    u32x4 w; w.x = cvt_pk_bf16(v0[0], v0[1]); w.y = cvt_pk_bf16(v0[2], v0[3]); w.z = cvt_pk_bf16(v1[0], v1[1]); w.w = cvt_pk_bf16(v1[2], v1[3]);
                    *(u32x4*)(FOUR + (size_t)(tok0 + ai * 128 + m * 16) * 512 + ch0 + bj * 128) = w; }
    }
};
struct EpiMul {
    static constexpr bool PERM = true, AFTER_DRAIN = false;
    u16* O; const u16* GATES; int mode;
    __device__ __forceinline__ void operator()(const f32x4 (&acc)[2][2][4][2], const pg8::Unit& u, int wr, int wc, int fr, int fq) const {
        const int row0 = u.pm * 256 + wr * 64 + fr, col0 = u.pn * 256 + wc * 32 + 8 * fq;
        const int ld = mode == 0 ? 512 : 1024;
#pragma unroll
        for (int ai = 0; ai < 2; ++ai)
#pragma unroll
            for (int m = 0; m < 4; ++m)
#pragma unroll
                for (int bj = 0; bj < 2; ++bj) {
                    const int row = row0 + ai * 128 + m * 16, col = col0 + bj * 128;
                    u16* p = O + (size_t)row * ld + col;
                    float v[8];
#pragma unroll
                    for (int j = 0; j < 4; ++j) { v[j] = acc[ai][bj][m][0][j]; v[4 + j] = acc[ai][bj][m][1][j]; }
                    if (mode == 0) {
                        const u32x4 q = *(const u32x4*)p;
#pragma unroll
                        for (int j = 0; j < 4; ++j) { v[2 * j] *= bf2f(q[j] & 0xffffu); v[2 * j + 1] *= bf2f(q[j] >> 16); }
                    } else {
                        const u32x4 gq = *(const u32x4*)(GATES + (size_t)row * GLD + (mode == 2 ? 1024 : 0) + col);
#pragma unroll
                        for (int j = 0; j < 4; ++j) { v[2 * j] *= h2f(gq[j] & 0xffffu); v[2 * j + 1] *= h2f(gq[j] >> 16); }
                        if (mode == 2) { const u32x4 q = *(const u32x4*)p;
#pragma unroll
                            for (int j = 0; j < 4; ++j) { v[2 * j] += bf2f(q[j] & 0xffffu); v[2 * j + 1] += bf2f(q[j] >> 16); } }
                    }
                    u32x4 w; w.x = cvt_pk_bf16(v[0], v[1]); w.y = cvt_pk_bf16(v[2], v[3]); w.z = cvt_pk_bf16(v[4], v[5]); w.w = cvt_pk_bf16(v[6], v[7]);
                    *(u32x4*)p = w;
                }
    }
};

template <class Epi>
__device__ __forceinline__ void run_gemm(LAS unsigned char* lds, const u16* A, const u16* Bt, int M, int N, int K, const Epi& E) {
    pg8::Gemm g{A, Bt, M, N, K}; pg8::StaticOrder S; S.init(M, N, (int)gridDim.x, (int)blockIdx.x);
    pg8::gemm_phase<Epi, pg8::StaticOrder, false>(lds, g, S, E, nullptr);
}

__device__ __forceinline__ void transpose_tile(const float* src, int ld_src, int col0, int k0, int krows, u16* dst, int n0, int K, LAS float* tile) {
    const int t = threadIdx.x;
#pragma unroll
    for (int i = 0; i < 8; ++i) { const int kk = (t >> 6) + 8 * i, nn = t & 63;
        float v = 0.f; if (col0 >= 0 && k0 + kk < krows) v = src[(size_t)(k0 + kk) * ld_src + col0 + nn];
        tile[kk * 65 + nn] = v; }
    __syncthreads();
    const int nn = t >> 3, ks = (t & 7) * 8;
    float v[8];
#pragma unroll
    for (int j = 0; j < 8; ++j) v[j] = tile[(ks + j) * 65 + nn];
    u32x4 w; w.x = cvt_pk_bf16(v[0], v[1]); w.y = cvt_pk_bf16(v[2], v[3]); w.z = cvt_pk_bf16(v[4], v[5]); w.w = cvt_pk_bf16(v[6], v[7]);
    *(u32x4*)(dst + (size_t)(n0 + nn) * K + k0 + ks) = w;
    __syncthreads();
}

__device__ __forceinline__ void phase_prep(const Params& P, LAS unsigned char* lds) {
    LAS float* L = (LAS float*)lds;
    LAS float* tile = L;
    LAS float* cs128 = L + 4160; LAS float* sn128 = cs128 + 128;
    LAS float* cs64 = sn128 + 128;  LAS float* sn64 = cs64 + 64;
    LAS float* cs256 = sn64 + 64;   LAS float* sn256 = cs256 + 256;
    LAS float* frow = sn256 + 256;
    LAS float* sc = frow + 512;
    LAS float* red = sc + 9216;
    const int tid = threadIdx.x, G = gridDim.x, bid = blockIdx.x;
    unsigned char* ws = P.ws;
    if (tid < 256) { float s, c; sincospif(2.0f * (float)tid / 256.0f, &s, &c); cs256[tid] = c; sn256[tid] = s; }
    if (tid < 128) { float s, c; sincospif(2.0f * (float)tid / 128.0f, &s, &c); cs128[tid] = c; sn128[tid] = s; }
    if (tid < 64)  { float s, c; sincospif(2.0f * (float)tid / 64.0f, &s, &c); cs64[tid] = c; sn64[tid] = s; }
    __syncthreads();

    if (bid < 144) {
        for (int i = tid; i < 9216; i += 512) { const int v = i >> 10, k = i & 1023; const float x = v < 8 ? P.in[4][v * 1024 + k] : P.in[5][k]; sc[i] = x / (1.0f + expf(-x)); }
        __syncthreads();
        const int c = tid & 63, kg = tid >> 6; const float* aw = P.in[6] + bid * 64 + c;
        float a[9];
#pragma unroll
        for (int v = 0; v < 9; ++v) a[v] = 0.f;
        for (int k = kg; k < 1024; k += 8) { const float w = aw[(size_t)k * 9216];
#pragma unroll
            for (int v = 0; v < 9; ++v) a[v] += sc[v * 1024 + k] * w; }
#pragma unroll
        for (int v = 0; v < 9; ++v) red[(kg * 9 + v) * 64 + c] = a[v];
        __syncthreads();
        float* MOD = (float*)(ws + WS_MOD);
        for (int i = tid; i < 576; i += 512) { const int v = i >> 6, cc = i & 63; float s = 0.f;
#pragma unroll
            for (int q = 0; q < 8; ++q) s += red[(q * 9 + v) * 64 + cc];
            MOD[v * 9216 + bid * 64 + cc] = s + P.in[7][bid * 64 + cc]; }
        __syncthreads();
    }

    {
        const int total = 5792;
        for (int q = bid; q < total; q += G) {
            int j = 0, r = q, nk = 16;
#define PREP_STEP(JJ, CNT, NKN) if (j == JJ && r >= (CNT)) { r -= (CNT); j = JJ + 1; nk = NKN; }
            PREP_STEP(0, 88 * 16, 44) PREP_STEP(1, 16 * 44, 16) PREP_STEP(2, 88 * 16, 44) PREP_STEP(3, 16 * 44, 16)
            PREP_STEP(4, 64 * 16, 8) PREP_STEP(5, 16 * 8, 8) PREP_STEP(6, 16 * 8, 16) PREP_STEP(7, 16 * 16, 4)
#undef PREP_STEP
            const int tn = r / nk, tk = r % nk, n0 = tn * 64, k0 = tk * 64;
            const float* src; int ld, krows, Kd, col0 = n0; u16* dst;
            if (j == 0 || j == 2) { src = j == 0 ? P.in[9] : P.in[11]; ld = 5632; krows = 1024; Kd = 1024; dst = (u16*)(ws + (j == 0 ? WS_W13A : WS_W13B));
                const int pn = n0 >> 8, rr = n0 & 255; col0 = rr < 128 ? 128 * pn + rr : 2816 + 128 * pn + (rr - 128); }
            else if (j == 1 || j == 3) { src = j == 1 ? P.in[10] : P.in[12]; ld = 1024; krows = 2816; Kd = 2816; dst = (u16*)(ws + (j == 1 ? WS_W2A : WS_W2B)); }
            else if (j == 4) { src = P.in[13]; ld = 4480; krows = 1024; Kd = 1024; dst = (u16*)(ws + WS_WIN);
                col0 = n0 < 1920 ? n0 : (n0 < 2048 ? -1 : 2432 + (n0 - 2048)); }
            else if (j == 5) { src = P.in[26]; ld = 1024; krows = 512; Kd = 512; dst = (u16*)(ws + WS_WO); }
            else if (j == 6) { src = P.in[27]; ld = 1024; krows = 512; Kd = 512; dst = (u16*)(ws + WS_WF); }
            else if (j == 7) { src = P.in[28]; ld = 1024; krows = 1024; Kd = 1024; dst = (u16*)(ws + WS_WOUT); }
            else { src = P.in[20]; ld = 512; krows = 128; Kd = 256; dst = (u16*)(ws + WS_GUP); }
            transpose_tile(src, ld, col0, k0, krows, dst, n0, Kd, tile);
        }
    }

    {
        u16* WZ = (u16*)(ws + WS_WZ);
        for (int k = bid; k < 1024; k += G) {
            frow[tid] = P.in[13][(size_t)k * 4480 + 1920 + tid];
            __syncthreads();
#pragma unroll
            for (int rep = 0; rep < 2; ++rep) { const int zc = tid + rep * 512, g = zc >> 8, part = (zc >> 7) & 1, kn = zc & 127;
                const LAS float* tab = part ? sn128 : cs128; float s = 0.f;
                for (int n = 0; n < 128; ++n) s += frow[g * 128 + n] * tab[(kn * n) & 127];
                s *= 0.08838834764831845f; if (part) s = -s;
                WZ[(size_t)zc * 1024 + k] = (u16)(cvt_pk_bf16(s, 0.f) & 0xffffu); }
            __syncthreads();
        }
    }

    {
        u16* T = (u16*)(ws + WS_T);
        for (size_t vi = (size_t)bid * 512 + tid; vi < (size_t)4096 * 1024; vi += (size_t)G * 512) {
            const int row = (int)(vi >> 10), cv = (int)(vi & 1023) * 8, part = cv >> 12, r = (cv >> 6) & 63, c0 = cv & 63, kr = row >> 6, kc = row & 63;
            const LAS float* tab = part ? sn64 : cs64; const int base = kr * r;
            float v[8];
#pragma unroll
            for (int j = 0; j < 8; ++j) v[j] = tab[(base + kc * (c0 + j)) & 63] * 0.015625f;
            u32x4 w; w.x = cvt_pk_bf16(v[0], v[1]); w.y = cvt_pk_bf16(v[2], v[3]); w.z = cvt_pk_bf16(v[4], v[5]); w.w = cvt_pk_bf16(v[6], v[7]);
            *(u32x4*)(T + vi * 8) = w;
        }
        u16* T2 = (u16*)(ws + WS_T256);
        for (int vi = bid * 512 + tid; vi < 256 * 64; vi += G * 512) {
            const int kt = vi >> 6, cv = (vi & 63) * 8, part = cv >> 8, t0 = cv & 255;
            const LAS float* tab = part ? sn256 : cs256;
            float v[8];
#pragma unroll
            for (int j = 0; j < 8; ++j) v[j] = tab[(kt * (t0 + j)) & 255] * 0.0625f;
            u32x4 w; w.x = cvt_pk_bf16(v[0], v[1]); w.y = cvt_pk_bf16(v[2], v[3]); w.z = cvt_pk_bf16(v[4], v[5]); w.w = cvt_pk_bf16(v[6], v[7]);
            *(u32x4*)(T2 + (size_t)vi * 8) = w;
        }
    }
}

__device__ __forceinline__ float wave_sum(float v) {
#pragma unroll
    for (int o = 32; o >= 1; o >>= 1) v += __shfl_xor(v, o);
    return v;
}
__device__ __forceinline__ void phase_norm(const Params& P, const float* X, int nwi, int slot_shift, int slot_scale, u16* H) {
    const int lane = threadIdx.x & 63, gw = blockIdx.x * 8 + (threadIdx.x >> 6), nw = gridDim.x * 8;
    const float* MOD = (const float*)(P.ws + WS_MOD); const float* normw = P.in[8] + nwi * 1024;
    for (int m = gw; m < MT; m += nw) {
        const float* xr = X ? X + (size_t)m * DM : (m < NPR ? P.in[0] + (size_t)m * DM : P.in[1] + (size_t)(m - NPR) * DM);
        f32x4 v[4]; float ss = 0.f;
#pragma unroll
        for (int i = 0; i < 4; ++i) { v[i] = *(const f32x4*)(xr + i * 256 + lane * 4); ss += v[i][0] * v[i][0] + v[i][1] * v[i][1] + v[i][2] * v[i][2] + v[i][3] * v[i][3]; }
        ss = wave_sum(ss);
        const float rs = rsqrtf(ss * (1.0f / 1024.0f) + 1e-6f);
        const float* md = MOD + (size_t)modidx_m(m) * 9216;
#pragma unroll
        for (int i = 0; i < 4; ++i) { const int c = i * 256 + lane * 4;
            const f32x4 w = *(const f32x4*)(normw + c), sc = *(const f32x4*)(md + slot_scale * 1024 + c), sh = *(const f32x4*)(md + slot_shift * 1024 + c);
            const f32x4 y = v[i] * rs * w * (sc + 1.0f) + sh;
            u32x2 o; o.x = cvt_pk_bf16(y[0], y[1]); o.y = cvt_pk_bf16(y[2], y[3]);
            *(u32x2*)(H + (size_t)m * DM + c) = o; }
    }
}
__device__ __forceinline__ void phase_final_norm(const Params& P) {
    const int lane = threadIdx.x & 63, gw = blockIdx.x * 8 + (threadIdx.x >> 6), nw = gridDim.x * 8;
    const float* fw = P.in[29];
    for (int m = gw; m < MT; m += nw) {
        float* xr = P.out + (size_t)m * DM;
        f32x4 v[4]; float ss = 0.f;
#pragma unroll
        for (int i = 0; i < 4; ++i) { v[i] = *(const f32x4*)(xr + i * 256 + lane * 4); ss += v[i][0] * v[i][0] + v[i][1] * v[i][1] + v[i][2] * v[i][2] + v[i][3] * v[i][3]; }
        ss = wave_sum(ss);
        const float rs = rsqrtf(ss * (1.0f / 1024.0f) + 1e-6f);
#pragma unroll
        for (int i = 0; i < 4; ++i) { const int c = i * 256 + lane * 4; *(f32x4*)(xr + c) = v[i] * rs * *(const f32x4*)(fw + c); }
    }
}

template <int CTRL> __device__ __forceinline__ float dpp_add(float v) {
    return v + __int_as_float(__builtin_amdgcn_update_dpp(0, __float_as_int(v), CTRL, 0xF, 0xF, true));
}
__device__ __forceinline__ float sum16(float v) {
    v = dpp_add<0xB1>(v); v = dpp_add<0x4E>(v); v = dpp_add<0x141>(v); v = dpp_add<0x140>(v); return v;
}
__device__ __forceinline__ float fsig(float x) { return __builtin_amdgcn_rcpf(1.0f + __expf(-x)); }
struct ScanRegs { u32x2 r[3], k[3], v[3], wd, ad; };
__device__ __forceinline__ void scan_load(ScanRegs& R, const u16* U, int tok0, int T, int t, int h, int d, int cg) {
    const u32x2 z = {0u, 0u};
#pragma unroll
    for (int tap = 0; tap < 3; ++tap) { const int tn = t + tap - 1;
        if (tn >= 0 && tn < T) { const u16* row = U + (size_t)(tok0 + tn) * 1792 + h * 64 + 4 * cg;
            R.r[tap] = *(const u32x2*)row; R.k[tap] = *(const u32x2*)(row + 512); R.v[tap] = *(const u32x2*)(row + 1024); }
        else { R.r[tap] = z; R.k[tap] = z; R.v[tap] = z; } }
    const u16* row = U + (size_t)(tok0 + t) * 1792 + 1536 + d * 64 + 4 * cg;
    R.wd = *(const u32x2*)row; R.ad = *(const u32x2*)(row + 128);
}
__device__ __forceinline__ void unpack4h(const u32x2 q, float (&o)[4]) { o[0] = h2f(q.x & 0xffffu); o[1] = h2f(q.x >> 16); o[2] = h2f(q.y & 0xffffu); o[3] = h2f(q.y >> 16); }

#define LDS_BARRIER() do { asm volatile("s_waitcnt lgkmcnt(0)" ::: "memory"); __builtin_amdgcn_s_barrier(); asm volatile("" ::: "memory"); } while (0)
__device__ __forceinline__ float sum64(float v) {
    const float t = sum16(v);
    const int ti = __float_as_int(t);
    return __int_as_float(__builtin_amdgcn_readlane(ti, 0)) + __int_as_float(__builtin_amdgcn_readlane(ti, 16)) + __int_as_float(__builtin_amdgcn_readlane(ti, 32)) + __int_as_float(__builtin_amdgcn_readlane(ti, 48));
}
__device__ __forceinline__ void scan_unit(const Params& P, LAS float* L, int s, int h, int d, int half) {
    typedef float f32x16 __attribute__((ext_vector_type(16)));
    const int tid = threadIdx.x, lane = tid & 63;
    const bool producer = tid >= 256;
    const int T = s < 16 ? 256 : 4096, tok0 = s < 16 ? s * 256 : NPR + (s - 16) * 4096, nchunk = T / 32;
    const u16* U = (const u16*)(P.ws + WS_U16);
    u16* Od = (u16*)(P.ws + WS_H) + (size_t)d * MT * 512;
    float* BS = (float*)(P.ws + WS_BS);
    LAS float* cst = L;            LAS float* xwT = L + 1024;    LAS float* xaT = L + 3072;   LAS float* lora_s = L + 5120;
    LAS float* o_sb = L + 13312;   LAS float* cb = L + 15360;
    if (tid < 64) { const int c = tid, ch = h * 64 + c;
        cst[c] = P.in[16][d * 512 + ch]; cst[64 + c] = P.in[18][d * 512 + ch]; cst[128 + c] = P.in[21][ch]; cst[192 + c] = P.in[22][ch]; cst[256 + c] = P.in[23][ch];
#pragma unroll
        for (int ten = 0; ten < 3; ++ten)
#pragma unroll
            for (int tap = 0; tap < 3; ++tap) cst[(5 + ten * 3 + tap) * 64 + c] = P.in[15][tap * 1536 + ten * 512 + ch]; }
    const int c16 = tid & 15, rp = (tid >> 4) & 15, rA = half * 32 + rp, rB = rA + 16;
    f32x4 SA = {0.f, 0.f, 0.f, 0.f}, SB = {0.f, 0.f, 0.f, 0.f};
    if (!producer && s >= 16) { const float* st = (d ? P.in[3] : P.in[2]) + (size_t)((s - 16) * 8 + h) * 4096;
        SA = *(const f32x4*)(st + rA * 64 + 4 * c16); SB = *(const f32x4*)(st + rB * 64 + 4 * c16); }
    const int pt = tid - 256, pw = (pt >> 6) & 3, nt = pw & 1, kh = pw >> 1, li = lane & 31, lk = lane >> 5;
    float Bw[16], Ba[16];
    if (producer) {
#pragma unroll
        for (int s2 = 0; s2 < 16; ++s2) { const size_t o = (size_t)(d * 64 + kh * 32 + 2 * s2 + lk) * 512 + h * 64 + nt * 32 + li; Bw[s2] = P.in[17][o]; Ba[s2] = P.in[19][o]; }
    } else {
#pragma unroll
        for (int s2 = 0; s2 < 16; ++s2) { Bw[s2] = 0.f; Ba[s2] = 0.f; }
    }
    const int it0 = pt & 255, tt0 = it0 >> 4, cg0 = it0 & 15, tt1 = tt0 + 16, cg1 = cg0;
    ScanRegs R0, R1;
    if (producer) { scan_load(R0, U, tok0, T, d ? T - 1 - tt0 : tt0, h, d, cg0); scan_load(R1, U, tok0, T, d ? T - 1 - tt1 : tt1, h, d, cg1); }
    __syncthreads();
    for (int ci = -1; ci < nchunk; ++ci) {
        const int pc = ci + 1;
        LAS float* pb = cb + (pc & 1) * 12288;
        const LAS float* qb = cb + (ci & 1) * 12288;
        LAS float* o_s = o_sb + (ci & 1) * 1024;
        const bool do_prep = producer && pc < nchunk, do_step = !producer && ci >= 0;
        LAS float* r_s = pb; LAS float* w_s = pb + 2048; LAS float* kd_s = pb + 4096; LAS float* v_s = pb + 6144; LAS float* kk_s = pb + 8192; LAS float* kka_s = pb + 10240;
#define SCAN_STEPS(SEG) if (do_step) { float oAr[8], oBr[8]; float pA = 0.f, pB = 0.f;     \
        _Pragma("unroll") for (int u8 = 0; u8 < 8; ++u8) { const int tt = (SEG) * 8 + u8; \
            const f32x4 w4 = *(const LAS f32x4*)(qb + 2048 + tt * 64 + 4 * c16), kk4 = *(const LAS f32x4*)(qb + 8192 + tt * 64 + 4 * c16), ka4 = *(const LAS f32x4*)(qb + 10240 + tt * 64 + 4 * c16); \
            const f32x4 kd4 = *(const LAS f32x4*)(qb + 4096 + tt * 64 + 4 * c16), r4 = *(const LAS f32x4*)(qb + tt * 64 + 4 * c16); \
            const float vA = qb[6144 + tt * 64 + rA], vB = qb[6144 + tt * 64 + rB]; \
            float saA = SA[0] * kk4[0] + SA[1] * kk4[1] + SA[2] * kk4[2] + SA[3] * kk4[3], saB = SB[0] * kk4[0] + SB[1] * kk4[1] + SB[2] * kk4[2] + SB[3] * kk4[3]; \
            saA = dpp_add<0xB1>(saA); saB = dpp_add<0xB1>(saB); pA = dpp_add<0xB1>(pA); pB = dpp_add<0xB1>(pB); \
            saA = dpp_add<0x4E>(saA); saB = dpp_add<0x4E>(saB); pA = dpp_add<0x4E>(pA); pB = dpp_add<0x4E>(pB); \
            saA = dpp_add<0x141>(saA); saB = dpp_add<0x141>(saB); pA = dpp_add<0x141>(pA); pB = dpp_add<0x141>(pB); \
            saA = dpp_add<0x140>(saA); saB = dpp_add<0x140>(saB); pA = dpp_add<0x140>(pA); pB = dpp_add<0x140>(pB); \
            if (u8 > 0) { oAr[u8 - 1] = pA; oBr[u8 - 1] = pB; } \
            SA = SA * w4 - ka4 * saA + kd4 * vA; SB = SB * w4 - ka4 * saB + kd4 * vB; \
            pA = SA[0] * r4[0] + SA[1] * r4[1] + SA[2] * r4[2] + SA[3] * r4[3]; pB = SB[0] * r4[0] + SB[1] * r4[1] + SB[2] * r4[2] + SB[3] * r4[3]; } \
        pA = dpp_add<0xB1>(pA); pB = dpp_add<0xB1>(pB); pA = dpp_add<0x4E>(pA); pB = dpp_add<0x4E>(pB); pA = dpp_add<0x141>(pA); pB = dpp_add<0x141>(pB); pA = dpp_add<0x140>(pA); pB = dpp_add<0x140>(pB); \
        oAr[7] = pA; oBr[7] = pB; \
        if (c16 == 0) { _Pragma("unroll") for (int u8 = 0; u8 < 8; ++u8) { o_s[((SEG) * 8 + u8) * 32 + rp] = oAr[u8]; o_s[((SEG) * 8 + u8) * 32 + 16 + rp] = oBr[u8]; } } }
        if (do_prep) {
#pragma unroll
            for (int it = 0; it < 2; ++it) { const ScanRegs& R = it ? R1 : R0; const int tt_a = it ? tt1 : tt0, cg = cg0;
                float rv[4] = {0.f, 0.f, 0.f, 0.f}, kv[4] = {0.f, 0.f, 0.f, 0.f}, vv[4] = {0.f, 0.f, 0.f, 0.f};
#pragma unroll
                for (int tap = 0; tap < 3; ++tap) { float a[4], bb[4], c[4]; unpack4h(R.r[tap], a); unpack4h(R.k[tap], bb); unpack4h(R.v[tap], c);
#pragma unroll
                    for (int j = 0; j < 4; ++j) { rv[j] += a[j] * cst[(5 + tap) * 64 + 4 * cg + j]; kv[j] += bb[j] * cst[(8 + tap) * 64 + 4 * cg + j]; vv[j] += c[j] * cst[(11 + tap) * 64 + 4 * cg + j]; } }
                float kkr[4], ss = 0.f;
#pragma unroll
                for (int j = 0; j < 4; ++j) { kkr[j] = kv[j] * cst[128 + 4 * cg + j]; ss += kkr[j] * kkr[j]; }
                ss = sum16(ss);
                const float inv = __builtin_amdgcn_rsqf(fmaxf(ss, 1e-24f));
                float wdv[4], adv[4]; unpack4h(R.wd, wdv); unpack4h(R.ad, adv);
#pragma unroll
                for (int j = 0; j < 4; ++j) { const int o = tt_a * 64 + 4 * cg + j;
                    r_s[o] = rv[j]; v_s[o] = vv[j]; kd_s[o] = kv[j]; kk_s[o] = kkr[j] * inv;
                    xwT[(4 * cg + j) * 32 + tt_a] = 1.0f - 2.0f * __builtin_amdgcn_rcpf(1.0f + __expf(2.0f * wdv[j])); xaT[(4 * cg + j) * 32 + tt_a] = adv[j]; } }
            if (pc + 1 < nchunk) { const int q0 = (pc + 1) * 32 + tt0, q1 = (pc + 1) * 32 + tt1;
                scan_load(R0, U, tok0, T, d ? T - 1 - q0 : q0, h, d, cg0); scan_load(R1, U, tok0, T, d ? T - 1 - q1 : q1, h, d, cg1); }
        }
        SCAN_STEPS(0)
        LDS_BARRIER();
        if (do_prep) {
            f32x16 accw, acca;
#pragma unroll
            for (int i = 0; i < 16; ++i) { accw[i] = 0.f; acca[i] = 0.f; }
#pragma unroll
            for (int s2 = 0; s2 < 16; ++s2) { const int r = kh * 32 + 2 * s2 + lk;
                accw = __builtin_amdgcn_mfma_f32_32x32x2f32(xwT[r * 32 + li], Bw[s2], accw, 0, 0, 0);
                acca = __builtin_amdgcn_mfma_f32_32x32x2f32(xaT[r * 32 + li], Ba[s2], acca, 0, 0, 0); }
#pragma unroll
            for (int reg = 0; reg < 16; ++reg) { const int o = ((reg & 3) + 8 * (reg >> 2) + 4 * lk) * 64 + nt * 32 + li;
                lora_s[(0 * 2 + kh) * 2048 + o] = accw[reg]; lora_s[(1 * 2 + kh) * 2048 + o] = acca[reg]; }
        }
        SCAN_STEPS(1)
        LDS_BARRIER();
        if (do_prep) {
            const int c = pt & 63, tg = pt >> 6;
#pragma unroll
            for (int j = 0; j < 8; ++j) { const int tt = 8 * tg + j, o = tt * 64 + c;
                const float wl = cst[c] + lora_s[o] + lora_s[2048 + o];
                const float w = __expf(-0.6065306597f * fsig(wl));
                const float a = fsig(cst[64 + c] + lora_s[4096 + o] + lora_s[6144 + o]);
                const float k = kd_s[o], kk = kk_s[o];
                const float kd = k * (1.0f + (a - 1.0f) * cst[192 + c]);
                kd_s[o] = kd; kka_s[o] = kk * a; w_s[o] = w;
                const float bsum = sum64(r_s[o] * kd * cst[256 + c]);
                if (lane == 0 && half == 0) { const int q = pc * 32 + tt, t = d ? T - 1 - q : q; BS[(size_t)(tok0 + t) * 16 + h * 2 + d] = bsum; } }
        }
        SCAN_STEPS(2)
        LDS_BARRIER();
        SCAN_STEPS(3)
        LDS_BARRIER();
        if (do_step) { const int tt = tid >> 3, seg = tid & 7, q = ci * 32 + tt, t = d ? T - 1 - q : q;
            u32x2 w2; w2.x = cvt_pk_bf16(o_s[tt * 32 + 4 * seg], o_s[tt * 32 + 4 * seg + 1]); w2.y = cvt_pk_bf16(o_s[tt * 32 + 4 * seg + 2], o_s[tt * 32 + 4 * seg + 3]);
            *(u32x2*)(Od + (size_t)(tok0 + t) * 512 + h * 64 + half * 32 + 4 * seg) = w2; }
#undef SCAN_STEPS
    }
    if (!producer && s < 16) { float* so = P.out + OUT_STATE + (size_t)d * 524288 + (size_t)(s * 8 + h) * 4096;
        *(f32x4*)(so + rA * 64 + 4 * c16) = SA; *(f32x4*)(so + rB * 64 + 4 * c16) = SB; }
    __syncthreads();
}
__device__ __forceinline__ void phase_scan(const Params& P, LAS unsigned char* lds) {
    for (int q = blockIdx.x; q < 768; q += gridDim.x) {
        int s, rem;
        if (q < 256) { s = 16 + (q >> 5); rem = q & 31; } else { const int p = q - 256; s = p >> 5; rem = p & 31; }
        scan_unit(P, (LAS float*)lds, s, rem >> 2, (rem >> 1) & 1, rem & 1);
    }
}

struct PostRaw { unsigned of, ob, v0, v1, v2, sg; float b0, b1; };
__device__ __forceinline__ void post_load(PostRaw& r, int m, int ch, int h, int lane, const u16* OF, const u16* OB, const u16* U, const float* BS, const u16* GT) {
    const int T = m < NPR ? 256 : 4096, t = m < NPR ? (m & 255) : ((m - NPR) & 4095);
    r.of = OF[(size_t)m * 512 + ch]; r.ob = OB[(size_t)m * 512 + ch];
    r.v1 = U[(size_t)m * 1792 + 1024 + ch];
    r.v0 = t > 0 ? U[(size_t)(m - 1) * 1792 + 1024 + ch] : 0u;
    r.v2 = t < T - 1 ? U[(size_t)(m + 1) * 1792 + 1024 + ch] : 0u;
    r.sg = *(const unsigned*)(GT + (size_t)m * GLD + 2048 + 2 * lane);
    r.b0 = BS[(size_t)m * 16 + h * 2]; r.b1 = BS[(size_t)m * 16 + h * 2 + 1];
}
__device__ __forceinline__ void phase_post(const Params& P, LAS unsigned char* lds) {
    const int lane = threadIdx.x & 63, h = threadIdx.x >> 6, ch = h * 64 + lane, G = gridDim.x;
    const u16* OF = (const u16*)(P.ws + WS_H); const u16* OB = OF + (size_t)MT * 512;
    const u16* U = (const u16*)(P.ws + WS_U16); const float* BS = (const float*)(P.ws + WS_BS);
    u16* OPRE = (u16*)(P.ws + WS_OPRE); const u16* GT = (const u16*)(P.ws + WS_R);
    LAS float* sgl = (LAS float*)lds + h * 128;
    float gu[128];
#pragma unroll
    for (int k = 0; k < 128; ++k) gu[k] = P.in[20][(size_t)k * 512 + ch];
    const float lw = P.in[24][ch], lb = P.in[25][ch];
    const float cv0 = P.in[15][0 * 1536 + 1024 + ch], cv1 = P.in[15][1 * 1536 + 1024 + ch], cv2 = P.in[15][2 * 1536 + 1024 + ch];
    PostRaw cur, nxt;
    int m = blockIdx.x;
    post_load(cur, m, ch, h, lane, OF, OB, U, BS, GT);
    for (; m < MT; m += G) {
        const int mn = m + G < MT ? m + G : m;
        post_load(nxt, mn, ch, h, lane, OF, OB, U, BS, GT);
        sgl[2 * lane] = h2f(cur.sg & 0xffffu); sgl[2 * lane + 1] = h2f(cur.sg >> 16);
        const float o = bf2f(cur.of) + bf2f(cur.ob);
        const float mean = sum64(o) * (1.0f / 64.0f), d = o - mean;
        const float rstd = rsqrtf(sum64(d * d) * (1.0f / 64.0f) + 64e-5f);
        const float v = h2f(cur.v0) * cv0 + h2f(cur.v1) * cv1 + h2f(cur.v2) * cv2;
        float g0 = 0.f, g1 = 0.f, g2 = 0.f, g3 = 0.f;
#pragma unroll
        for (int k = 0; k < 128; k += 4) { const f32x4 s4 = *(const LAS f32x4*)(sgl + k);
            g0 += s4[0] * gu[k]; g1 += s4[1] * gu[k + 1]; g2 += s4[2] * gu[k + 2]; g3 += s4[3] * gu[k + 3]; }
        const float y = (d * rstd * lw + lb + (cur.b0 + cur.b1) * v) * ((g0 + g1) + (g2 + g3));
        OPRE[(size_t)m * 512 + ch] = (u16)(cvt_pk_bf16(y, 0.f) & 0xffffu);
        cur = nxt;
    }
}


constexpr size_t WS_BAR = WS_END + 65536;
static_assert(WS_BAR + 4096 <= (size_t)536870912, "barrier words");
__device__ __forceinline__ void fast_grid_sync(unsigned char* ws, unsigned k) {
    asm volatile("s_waitcnt vmcnt(0) lgkmcnt(0)" ::: "memory");
    __builtin_amdgcn_s_barrier();
    if (threadIdx.x == 0) {
        unsigned* bar = (unsigned*)(ws + WS_BAR);
        const unsigned G = gridDim.x, g = blockIdx.x & 7u, gsz = (G - g + 7u) >> 3, ngrp = G < 8u ? G : 8u;
        __builtin_amdgcn_fence(__ATOMIC_RELEASE, "agent");
        asm volatile("s_waitcnt vmcnt(0)" ::: "memory");
        const unsigned old = __hip_atomic_fetch_add(bar + g * 32, 1u, __ATOMIC_RELAXED, __HIP_MEMORY_SCOPE_AGENT);
        if (old + 1u == k * gsz) __hip_atomic_fetch_add(bar + 8 * 32, 1u, __ATOMIC_RELAXED, __HIP_MEMORY_SCOPE_AGENT);
        unsigned spins = 0;
        while (__hip_atomic_load(bar + 8 * 32, __ATOMIC_RELAXED, __HIP_MEMORY_SCOPE_AGENT) < k * ngrp) { if (++spins > (1u << 24)) break; __builtin_amdgcn_s_sleep(1); }
        __builtin_amdgcn_fence(__ATOMIC_ACQUIRE, "agent");
        asm volatile("s_waitcnt vmcnt(0)" ::: "memory");
    }
    __builtin_amdgcn_s_barrier();
    asm volatile("" ::: "memory");
}

__global__ void __launch_bounds__(512, 2) fwd_mega(Params P) {
    extern __shared__ __attribute__((aligned(16))) unsigned char lds_raw[];
    LAS unsigned char* lds = (LAS unsigned char*)lds_raw;
    cg::grid_group grid = cg::this_grid();
    if (threadIdx.x < 32) { const int i = threadIdx.x; const unsigned long long v = i < 30 ? (unsigned long long)P.in[i] : (i == 30 ? (unsigned long long)P.out : (unsigned long long)P.ws);
        *(LAS unsigned long long*)(lds + PTAB_OFF + i * 8) = v; }
    __syncthreads();
unsigned bark_ = 0; unsigned char* P_ws_ = P.ws;
#define PH_BEGIN { const Params Q = get_params(lds); unsigned char* ws = Q.ws; (void)ws;
#define PH_END } asm volatile("s_waitcnt vmcnt(0)" ::: "memory");   grid.sync();
#define PH_ENDF } fast_grid_sync(P_ws_, ++bark_);
    PH_BEGIN phase_prep(Q, lds); PH_END
    PH_BEGIN phase_norm(Q, nullptr, 0, 0, 1, (u16*)(ws + WS_H)); PH_ENDF
    PH_BEGIN run_gemm(lds, (const u16*)(ws + WS_H), (const u16*)(ws + WS_W13A), MT, 5632, 1024, EpiSwiglu{(u16*)(ws + WS_BIG)}); PH_ENDF
    PH_BEGIN run_gemm(lds, (const u16*)(ws + WS_BIG), (const u16*)(ws + WS_W2A), MT, 1024, 2816, EpiResid{Q.in[0], Q.in[1], Q.out, (const float*)(ws + WS_MOD), 2, 0.5f}); PH_ENDF
    PH_BEGIN phase_norm(Q, Q.out, 1, 3, 4, (u16*)(ws + WS_H)); PH_ENDF
    PH_BEGIN run_gemm(lds, (const u16*)(ws + WS_WZ), (const u16*)(ws + WS_H), 1024, MT, 1024, EpiZT{(u16*)(ws + WS_ZL)}); PH_ENDF
    PH_BEGIN run_gemm(lds, (const u16*)(ws + WS_T), (const u16*)(ws + WS_ZL), 4096, 4096, 8192, EpiFour{(u16*)(ws + WS_FOUR), 1});
             run_gemm(lds, (const u16*)(ws + WS_T256), (const u16*)(ws + WS_ZP), 256, 8192, 512, EpiFour{(u16*)(ws + WS_FOUR), 0}); PH_ENDF
    PH_BEGIN run_gemm(lds, (const u16*)(ws + WS_H), (const u16*)(ws + WS_WIN), MT, 4096, 1024, EpiU{(u16*)(ws + WS_U16), (u16*)(ws + WS_SG), (u16*)(ws + WS_R), Q.in[14]}); PH_ENDF
    PH_BEGIN phase_scan(Q, lds); PH_ENDF
    PH_BEGIN phase_post(Q, lds); PH_ENDF
    PH_BEGIN run_gemm(lds, (const u16*)(ws + WS_OPRE), (const u16*)(ws + WS_WO), MT, 1024, 512, EpiMul{(u16*)(ws + WS_H), (const u16*)(ws + WS_R), 1}); PH_ENDF
    PH_BEGIN run_gemm(lds, (const u16*)(ws + WS_FOUR), (const u16*)(ws + WS_WF), MT, 1024, 512, EpiMul{(u16*)(ws + WS_H), (const u16*)(ws + WS_R), 2}); PH_ENDF
    PH_BEGIN run_gemm(lds, (const u16*)(ws + WS_H), (const u16*)(ws + WS_WOUT), MT, 1024, 1024, EpiResid{nullptr, nullptr, Q.out, (const float*)(ws + WS_MOD), 5, 1.0f}); PH_ENDF
    PH_BEGIN phase_norm(Q, Q.out, 2, 6, 7, (u16*)(ws + WS_H)); PH_ENDF
    PH_BEGIN run_gemm(lds, (const u16*)(ws + WS_H), (const u16*)(ws + WS_W13B), MT, 5632, 1024, EpiSwiglu{(u16*)(ws + WS_BIG)}); PH_ENDF
    PH_BEGIN run_gemm(lds, (const u16*)(ws + WS_BIG), (const u16*)(ws + WS_W2B), MT, 1024, 2816, EpiResid{nullptr, nullptr, Q.out, (const float*)(ws + WS_MOD), 8, 0.5f}); PH_ENDF
    { const Params Q = get_params(lds); phase_final_norm(Q); }
#undef PH_BEGIN
#undef PH_END
#undef PH_ENDF
}

extern "C" void kernel_launch(void* const* d_in, const int* in_sizes, int n_in, void* d_out, int out_size, void* d_ws, size_t ws_size, hipStream_t stream) {
    static int grid_blocks = 0;
    if (grid_blocks == 0) {
        if (n_in != 30 || ws_size < WS_END) { fprintf(stderr, "kernel_launch: unexpected n_in %d / ws_size %zu (need %zu)\n", n_in, ws_size, (size_t)WS_END); grid_blocks = -1; return; }
        int dev = 0, cus = 0, per_cu = 0;
        (void)hipGetDevice(&dev);
        (void)hipDeviceGetAttribute(&cus, hipDeviceAttributeMultiprocessorCount, dev);
        (void)hipFuncSetAttribute((const void*)fwd_mega, hipFuncAttributeMaxDynamicSharedMemorySize, LDS_BYTES);
        (void)hipOccupancyMaxActiveBlocksPerMultiprocessor(&per_cu, (const void*)fwd_mega, 512, LDS_BYTES);
        if (per_cu < 1) { fprintf(stderr, "kernel_launch: occupancy query reports %d blocks per CU\n", per_cu); per_cu = 1; }
        if (per_cu > 1) per_cu = 1;
        grid_blocks = cus * per_cu;
        (void)hipGetLastError();
    }
    if (grid_blocks < 0) return;
    (void)hipMemsetAsync((unsigned char*)d_ws + WS_BAR, 0, 4096, stream);
    Params p{};
    for (int i = 0; i < 30; ++i) p.in[i] = (const float*)d_in[i];
    p.out = (float*)d_out; p.ws = (unsigned char*)d_ws;
    void* args[] = {&p};
    hipError_t e = hipLaunchCooperativeKernel((const void*)fwd_mega, dim3(grid_blocks), dim3(512), args, LDS_BYTES, stream);
    if (e != hipSuccess) fprintf(stderr, "cooperative launch failed: %s (grid %d)\n", hipGetErrorString(e), grid_blocks);
}
```

```cpp
#include <hip/hip_runtime.h>
#include <hip/hip_cooperative_groups.h>
#include <cstdio>
namespace cg = cooperative_groups;
namespace pg8 {
#define PG8_LAS __attribute__((address_space(3)))
typedef unsigned short bf16_t;
typedef short bf16x8 __attribute__((ext_vector_type(8)));
typedef float f32x4 __attribute__((ext_vector_type(4)));
typedef unsigned u32x4 __attribute__((ext_vector_type(4)));
constexpr int BM = 256, BK = 64, HALF = 128, HTB = HALF * BK * 2  , STAGE_BYTES = 8 * HTB, NXCD = 8, WGM = 8;

__host__ __device__ __forceinline__ int lds_byte(int r, int c) { const int st = (r >> 4) * 2 + (c >> 5), rr = r & 15, cc = c & 31, ob = rr * 64 + cc * 2; return st * 1024 + (ob ^ (((ob >> 9) & 1) << 5)); }
__host__ __device__ __forceinline__ void stage_rc(int b, int& R, int& C) { const int st = b / 1024, sb = b % 1024, swz = sb ^ (((sb >> 9) & 1) << 5); R = (st >> 1) * 16 + swz / 64; C = (st & 1) * 32 + (swz % 64) / 2; }
__host__ __device__ __forceinline__ int perm32(int rho) { const int n = rho >> 4, i = rho & 15; return 8 * (i >> 2) + 4 * n + (i & 3); }

struct Unit { int pm, pn; };
struct Gemm { const bf16_t* A; const bf16_t* Bt; int M, N, K; };

struct StaticOrder {
    int nM, nN, nwg, G, c;
    __host__ __device__ __forceinline__ void init(int M, int N, int G_, int c_) { nM = M / BM; nN = N / BM; nwg = nM * nN; G = G_; c = c_; }
    __host__ __device__ __forceinline__ bool next(int i, Unit& u) const {
        const long L = (long)i * G + c; if (L >= nwg) return false;
        int wgid = (int)L; { const int q = nwg / NXCD, r = nwg % NXCD, xcd = wgid % NXCD, off = wgid / NXCD; wgid = (xcd < r ? xcd * (q + 1) : r * (q + 1) + (xcd - r) * q) + off; }
        const int nig = WGM * nN, gid = wgid / nig, fm = gid * WGM, gsz = (nM - fm) < WGM ? (nM - fm) : WGM;
        u.pm = fm + ((wgid % nig) % gsz); u.pn = (wgid % nig) / gsz; return true;
    }
    __device__ __forceinline__ void a_ready(const Unit&) const {}
    __device__ __forceinline__ void done(const Unit&) const {}
};
__device__ __forceinline__ unsigned cvt_pk_bf16(float lo, float hi) { unsigned r; asm volatile("v_cvt_pk_bf16_f32 %0, %1, %2" : "=v"(r) : "v"(lo), "v"(hi)); return r; }
template <class Epi, class Sched, bool STAMP = false>
__device__ __forceinline__ void gemm_phase(PG8_LAS unsigned char* lds, const Gemm g, const Sched& S, const Epi& E, unsigned long long* stamps) {
    int tid_ = threadIdx.x; asm volatile("" : "+v"(tid_));
    const int tid = tid_, wid = __builtin_amdgcn_readfirstlane(tid >> 6), lane = tid & 63, wr = wid >> 2, wc = wid & 3, fr = lane & 15, fq = lane >> 4;
    const int K = g.K, nt = K / BK;
    int ts_lo = 0, ts_hi = 0, nts = 0; const unsigned long long rt_entry = STAMP ? (unsigned long long)wall_clock64() : 0ull;
#define PG8_STAMP() do { if (STAMP && wid == 0 && nts < 64) { const unsigned long long _c = (unsigned long long)clock64(); \
        ts_lo = (lane == nts) ? (int)(unsigned)_c : ts_lo; ts_hi = (lane == nts) ? (int)(unsigned)(_c >> 32) : ts_hi; ++nts; } } while (0)
    PG8_STAMP();
    unsigned voffA[2], voffB[2];
#pragma unroll
    for (int i = 0; i < 2; ++i) { int R, C; stage_rc(tid * 16 + i * 8192, R, C); const int Rb = Epi::PERM ? ((R & ~31) + perm32(R & 31)) : R;
        voffA[i] = (unsigned)(R * K + C) * 2u; voffB[i] = (unsigned)(Rb * K + C) * 2u; }
    const size_t kstep = (size_t)(BK * 2);
    const size_t hstep = (size_t)HALF * K * 2;
    const size_t tstep = 2 * hstep;
    const unsigned ldsw = (unsigned)wid * 1024u;
    const int aoff = lds_byte(wr * 64 + fr, fq * 8), boff = lds_byte(wc * 32 + fr, fq * 8);
#define PG8_SA(b, h) (((b) * 2 + (h)) * HTB)
#define PG8_SB(b, h) ((4 + (b) * 2 + (h)) * HTB)
#define PG8_STAGE(bufoff, gbase, voff) do { _Pragma("unroll") for (int _i = 0; _i < 2; ++_i) \
        __builtin_amdgcn_global_load_lds((const unsigned*)((const char*)(gbase) + (voff)[_i]), (PG8_LAS unsigned*)(lds + (bufoff) + ldsw + _i * 8192), 16, 0, 0); } while (0)
#define PG8_LDA(dst, b, h) do { _Pragma("unroll") for (int m = 0; m < 4; ++m) _Pragma("unroll") for (int k = 0; k < 2; ++k) dst[m][k] = *(const PG8_LAS bf16x8*)(lds + PG8_SA(b, h) + aoff + m * 2048 + k * 1024); } while (0)
#define PG8_LDB(dst, b, h) do { _Pragma("unroll") for (int n = 0; n < 2; ++n) _Pragma("unroll") for (int k = 0; k < 2; ++k) dst[n][k] = *(const PG8_LAS bf16x8*)(lds + PG8_SB(b, h) + boff + n * 2048 + k * 1024); } while (0)
#define PG8_MMA(ai, bj, At, Bt) do { __builtin_amdgcn_s_setprio(1); _Pragma("unroll") for (int m = 0; m < 4; ++m) _Pragma("unroll") for (int n = 0; n < 2; ++n) _Pragma("unroll") for (int k = 0; k < 2; ++k) \
        acc[ai][bj][m][n] = __builtin_amdgcn_mfma_f32_16x16x32_bf16(Bt[n][k], At[m][k], acc[ai][bj][m][n], 0, 0, 0); __builtin_amdgcn_s_setprio(0); } while (0)
#define PG8_WAIT_V(n) asm volatile("s_waitcnt vmcnt(" #n ")" ::: "memory")
#define PG8_WAIT_L(n) asm volatile("s_waitcnt lgkmcnt(" #n ")" ::: "memory")
#define PG8_BAR __builtin_amdgcn_s_barrier()
#define PG8_SCHED __builtin_amdgcn_sched_barrier(0)
    Unit cur, nxt; int ui = 0;
    if (!S.next(0, cur)) return;
    f32x4 acc[2][2][4][2];
#pragma unroll
    for (int a = 0; a < 2; ++a)
#pragma unroll
        for (int b = 0; b < 2; ++b)
#pragma unroll
            for (int m = 0; m < 4; ++m)
#pragma unroll
                for (int n = 0; n < 2; ++n) acc[a][b][m][n] = (f32x4){0.f, 0.f, 0.f, 0.f};
    bf16x8 At[4][2], B0[2][2], B1[2][2];
    const char* cA = (const char*)g.A + (size_t)cur.pm * tstep; const char* cB = (const char*)g.Bt + (size_t)cur.pn * tstep;
    S.a_ready(cur);
    PG8_STAGE(PG8_SB(0, 0), cB, voffB); PG8_STAGE(PG8_SA(0, 0), cA, voffA); PG8_STAGE(PG8_SB(0, 1), cB + hstep, voffB); PG8_STAGE(PG8_SA(0, 1), cA + hstep, voffA);
    if (wr == 1) PG8_BAR;
    PG8_WAIT_V(4); PG8_BAR;
    PG8_STAGE(PG8_SB(1, 0), cB + kstep, voffB); PG8_STAGE(PG8_SA(1, 0), cA + kstep, voffA); PG8_STAGE(PG8_SB(1, 1), cB + hstep + kstep, voffB);
    PG8_WAIT_V(6); PG8_BAR;
    PG8_STAMP();
    for (;;) {
        const bool has_next = S.next(ui + 1, nxt);
        const char* nA = has_next ? (const char*)g.A + (size_t)nxt.pm * tstep : cA; const char* nB = has_next ? (const char*)g.Bt + (size_t)nxt.pn * tstep : cB;
        for (int t = 0; t < nt; t += 2) {
            const bool last = (t == nt - 2);
            const char* a1 = cA + (size_t)(t + 1) * kstep;
            const char* a2 = last ? nA : cA + (size_t)(t + 2) * kstep; const char* b2 = last ? nB : cB + (size_t)(t + 2) * kstep;
            const char* a3 = a2 + kstep; const char* b3 = b2 + kstep;
            if (last && has_next) S.a_ready(nxt);
            PG8_LDB(B0, 0, 0); PG8_SCHED; PG8_LDA(At, 0, 0); PG8_STAGE(PG8_SA(1, 1), a1 + hstep, voffA);
            PG8_WAIT_L(8); PG8_BAR; PG8_WAIT_L(0); PG8_MMA(0, 0, At, B0); PG8_BAR; PG8_SCHED;
            PG8_LDB(B1, 0, 1); PG8_STAGE(PG8_SB(0, 0), b2, voffB);
            PG8_BAR; PG8_WAIT_L(0); PG8_MMA(0, 1, At, B1); PG8_BAR;
            PG8_LDA(At, 0, 1); PG8_STAGE(PG8_SA(0, 0), a2, voffA);
            PG8_BAR; PG8_WAIT_L(0); PG8_MMA(1, 0, At, B0); PG8_BAR; PG8_SCHED;
            PG8_STAGE(PG8_SB(0, 1), b2 + hstep, voffB);
            PG8_WAIT_V(6); PG8_BAR; PG8_MMA(1, 1, At, B1); PG8_BAR;
            PG8_LDB(B0, 1, 0); PG8_SCHED; PG8_LDA(At, 1, 0); PG8_STAGE(PG8_SA(0, 1), a2 + hstep, voffA);
            PG8_WAIT_L(8); PG8_BAR; PG8_WAIT_L(0); PG8_MMA(0, 0, At, B0); PG8_BAR; PG8_SCHED;
            PG8_LDB(B1, 1, 1); PG8_STAGE(PG8_SB(1, 0), b3, voffB);
            PG8_BAR; PG8_WAIT_L(0); PG8_MMA(0, 1, At, B1); PG8_BAR;
            PG8_LDA(At, 1, 1); PG8_STAGE(PG8_SA(1, 0), a3, voffA);
            PG8_BAR; PG8_WAIT_L(0); PG8_MMA(1, 0, At, B0); PG8_BAR; PG8_SCHED;
            PG8_STAGE(PG8_SB(1, 1), b3 + hstep, voffB);
            PG8_WAIT_V(6); PG8_BAR; PG8_MMA(1, 1, At, B1); PG8_BAR;
        }
        PG8_STAMP();
        if constexpr (!Epi::AFTER_DRAIN) { E(acc, cur, wr, wc, fr, fq); S.done(cur); }
        PG8_STAMP();
        if (!has_next) break;
#pragma unroll
        for (int a = 0; a < 2; ++a)
#pragma unroll
            for (int b = 0; b < 2; ++b)
#pragma unroll
                for (int m = 0; m < 4; ++m)
#pragma unroll
                    for (int n = 0; n < 2; ++n) acc[a][b][m][n] = (f32x4){0.f, 0.f, 0.f, 0.f};
        cur = nxt; cA = nA; cB = nB; ++ui;
    }
    PG8_WAIT_V(0);
    if (wr == 0) PG8_BAR;
    PG8_BAR;
    if constexpr (Epi::AFTER_DRAIN) { E.fused(acc, cur, wr, wc, fr, fq, lds, wid, lane); S.done(cur); }
    PG8_STAMP();
    if (STAMP && wid == 0) { stamps[lane] = lane < nts ? (((unsigned long long)(unsigned)ts_hi << 32) | (unsigned)ts_lo) : 0ull;
        if (lane == 62) stamps[62] = rt_entry; if (lane == 63) stamps[63] = (unsigned long long)wall_clock64(); }
#undef PG8_STAMP
#undef PG8_SA
#undef PG8_SB
#undef PG8_STAGE
#undef PG8_LDA
#undef PG8_LDB
#undef PG8_MMA
#undef PG8_WAIT_V
#undef PG8_WAIT_L
#undef PG8_BAR
#undef PG8_SCHED
}
}

#define LAS __attribute__((address_space(3)))
typedef unsigned short u16;
typedef float f32x4 __attribute__((ext_vector_type(4)));
typedef unsigned u32x4 __attribute__((ext_vector_type(4)));
typedef unsigned u32x2 __attribute__((ext_vector_type(2)));
using pg8::cvt_pk_bf16;

constexpr int MT = 36864, NPR = 4096, DM = 1024, DFF = 2816;
constexpr int OUT_STATE = MT * DM;
constexpr int LDS_BYTES = 163840, PTAB_OFF = 163840 - 256;

constexpr size_t SZ_W13 = (size_t)5632 * 1024 * 2, SZ_W2 = (size_t)1024 * 2816 * 2;
constexpr size_t WS_W13A = 0, WS_W2A = WS_W13A + SZ_W13, WS_W13B = WS_W2A + SZ_W2, WS_W2B = WS_W13B + SZ_W13;
constexpr size_t WS_WIN = WS_W2B + SZ_W2;
constexpr size_t WS_WZ = WS_WIN + (size_t)4096 * 1024 * 2;
constexpr size_t WS_WO = WS_WZ + (size_t)1024 * 1024 * 2;
constexpr size_t WS_WF = WS_WO + (size_t)1024 * 512 * 2;
constexpr size_t WS_WOUT = WS_WF + (size_t)1024 * 512 * 2;
constexpr size_t WS_GUP = WS_WOUT + (size_t)1024 * 1024 * 2;
constexpr size_t WS_MOD = WS_GUP + (size_t)512 * 256 * 2;
constexpr size_t WS_BS = WS_MOD + (size_t)9 * 9216 * 4;
constexpr size_t WS_SG = WS_BS + (size_t)MT * 16 * 4;
constexpr size_t WS_H = WS_SG + (size_t)MT * 256 * 2;
constexpr size_t WS_BIG = WS_H + (size_t)MT * 1024 * 2;
constexpr size_t WS_U16 = WS_BIG;
constexpr size_t WS_FOUR = WS_U16 + (size_t)MT * 1792 * 2;
constexpr size_t WS_OPRE = WS_FOUR + (size_t)MT * 512 * 2;
constexpr size_t WS_R = WS_BIG + (size_t)MT * 2816 * 2;
constexpr size_t WS_T = WS_R;
constexpr size_t WS_T256 = WS_T + (size_t)4096 * 8192 * 2;
constexpr size_t WS_ZL = WS_T256 + (size_t)256 * 512 * 2;
constexpr size_t WS_ZP = WS_ZL + (size_t)4096 * 8192 * 2;
constexpr int GLD = 2304;
constexpr size_t WS_END = WS_R + (size_t)MT * GLD * 2;
static_assert(WS_ZP + (size_t)8192 * 512 * 2 <= WS_END, "R region");
static_assert(WS_OPRE + (size_t)MT * 512 * 2 <= WS_R, "BIG region");
static_assert(WS_END <= (size_t)536870912, "workspace");
static_assert(WS_ZP == WS_ZL + (size_t)4096 * 8192 * 2, "ZP behind ZL");

struct Params { const float* in[30]; float* out; unsigned char* ws; };
__device__ __forceinline__ unsigned long long ld_ptr(LAS unsigned char* lds, int i) {
    const u32x2 v = *(const LAS u32x2*)(lds + PTAB_OFF + i * 8);
    const unsigned lo = __builtin_amdgcn_readfirstlane(v.x), hi = __builtin_amdgcn_readfirstlane(v.y);
    return ((unsigned long long)hi << 32) | lo;
}
template <class T> __device__ __forceinline__ T* as_global(unsigned long long v) {
    return (T*)(__attribute__((address_space(1))) T*)v;
}
__device__ __forceinline__ Params get_params(LAS unsigned char* lds) {
    Params Q;
#pragma unroll
    for (int i = 0; i < 30; ++i) Q.in[i] = as_global<const float>(ld_ptr(lds, i));
    Q.out = as_global<float>(ld_ptr(lds, 30)); Q.ws = as_global<unsigned char>(ld_ptr(lds, 31));
    return Q;
}
__device__ __forceinline__ float bf2f(unsigned v16) { return __uint_as_float(v16 << 16); }
__device__ __forceinline__ float h2f(unsigned v16) { return (float)__builtin_bit_cast(_Float16, (unsigned short)v16); }
__device__ __forceinline__ unsigned pk_h(float a, float b) {
    const unsigned short ua = __builtin_bit_cast(unsigned short, (_Float16)a), ub = __builtin_bit_cast(unsigned short, (_Float16)b);
    return (unsigned)ua | ((unsigned)ub << 16);
}
__device__ __forceinline__ float sigmoidf_(float x) { return __builtin_amdgcn_rcpf(1.0f + __expf(-x)); }
__device__ __forceinline__ int modidx_pm(int pm) { return pm < 16 ? 8 : ((pm - 16) >> 4); }
__device__ __forceinline__ int modidx_m(int m) { return m < NPR ? 8 : ((m - NPR) >> 12); }

struct EpiSwiglu {
    static constexpr bool PERM = true, AFTER_DRAIN = false;
    u16* G;
    __device__ __forceinline__ void operator()(const f32x4 (&acc)[2][2][4][2], const pg8::Unit& u, int wr, int wc, int fr, int fq) const {
        const int row0 = u.pm * 256 + wr * 64 + fr, col0 = u.pn * 128 + wc * 32 + 8 * fq;
#pragma unroll
        for (int ai = 0; ai < 2; ++ai)
#pragma unroll
            for (int m = 0; m < 4; ++m) {
                float g[8];
#pragma unroll
                for (int n = 0; n < 2; ++n)
#pragma unroll
                    for (int j = 0; j < 4; ++j) { const float a = acc[ai][0][m][n][j], b = acc[ai][1][m][n][j]; g[n * 4 + j] = a * sigmoidf_(a) * b; }
                u32x4 w; w.x = cvt_pk_bf16(g[0], g[1]); w.y = cvt_pk_bf16(g[2], g[3]); w.z = cvt_pk_bf16(g[4], g[5]); w.w = cvt_pk_bf16(g[6], g[7]);
                *(u32x4*)(G + (size_t)(row0 + ai * 128 + m * 16) * DFF + col0) = w;
            }
    }
};
struct EpiResid {
    static constexpr bool PERM = false, AFTER_DRAIN = false;
    const float* xp; const float* xs; float* X; const float* MOD; int slot; float coef;
    __device__ __forceinline__ void operator()(const f32x4 (&acc)[2][2][4][2], const pg8::Unit& u, int wr, int wc, int fr, int fq) const {
        const int row0 = u.pm * 256 + wr * 64 + fr, col0 = u.pn * 256 + wc * 32 + 4 * fq;
        const float* g = MOD + (size_t)modidx_pm(u.pm) * 9216 + slot * 1024 + col0;
        f32x4 gv[2][2];
#pragma unroll
        for (int bj = 0; bj < 2; ++bj)
#pragma unroll
            for (int n = 0; n < 2; ++n) gv[bj][n] = *(const f32x4*)(g + bj * 128 + n * 16) * coef;
#pragma unroll
        for (int ai = 0; ai < 2; ++ai)
#pragma unroll
            for (int m = 0; m < 4; ++m) {
                const int row = row0 + ai * 128 + m * 16;
                const float* src = (xp ? (row < NPR ? xp + (size_t)row * DM : xs + (size_t)(row - NPR) * DM) : X + (size_t)row * DM) + col0;
                float* dst = X + (size_t)row * DM + col0;
#pragma unroll
                for (int bj = 0; bj < 2; ++bj)
#pragma unroll
                    for (int n = 0; n < 2; ++n) *(f32x4*)(dst + bj * 128 + n * 16) = *(const f32x4*)(src + bj * 128 + n * 16) + gv[bj][n] * acc[ai][bj][m][n];
            }
    }
};
struct EpiU {
    static constexpr bool PERM = true, AFTER_DRAIN = false;
    u16* U; u16* SG; u16* GATES; const float* gate_b;
    __device__ __forceinline__ void operator()(const f32x4 (&acc)[2][2][4][2], const pg8::Unit& u, int wr, int wc, int fr, int fq) const {
        const int row0 = u.pm * 256 + wr * 64 + fr, ct = wc * 32 + 8 * fq;
        if (u.pn < 7) {
#pragma unroll
            for (int ai = 0; ai < 2; ++ai)
#pragma unroll
                for (int m = 0; m < 4; ++m)
#pragma unroll
                    for (int bj = 0; bj < 2; ++bj) { const f32x4 v0 = acc[ai][bj][m][0], v1 = acc[ai][bj][m][1];
                        u32x4 w; w.x = pk_h(v0[0], v0[1]); w.y = pk_h(v0[2], v0[3]); w.z = pk_h(v1[0], v1[1]); w.w = pk_h(v1[2], v1[3]);
                        *(u32x4*)(U + (size_t)(row0 + ai * 128 + m * 16) * 1792 + u.pn * 256 + bj * 128 + ct) = w; }
        } else {
            const int gc0 = (u.pn == 7 ? 2048 : (u.pn - 8) * 256) + ct;
#pragma unroll
            for (int bj = 0; bj < 2; ++bj) {
                const int gbi = (u.pn == 7 ? 0 : (u.pn - 8) * 256) + ct; const float bsc = u.pn == 7 ? 0.f : 1.f;
                const f32x4 b0 = *(const f32x4*)(gate_b + gbi + bj * 128) * bsc, b1 = *(const f32x4*)(gate_b + gbi + bj * 128 + 4) * bsc;
#pragma unroll
                for (int ai = 0; ai < 2; ++ai)
#pragma unroll
                    for (int m = 0; m < 4; ++m) { const f32x4 v0 = acc[ai][bj][m][0] + b0, v1 = acc[ai][bj][m][1] + b1;
                        u32x4 w; w.x = pk_h(sigmoidf_(v0[0]), sigmoidf_(v0[1])); w.y = pk_h(sigmoidf_(v0[2]), sigmoidf_(v0[3]));
                        w.z = pk_h(sigmoidf_(v1[0]), sigmoidf_(v1[1])); w.w = pk_h(sigmoidf_(v1[2]), sigmoidf_(v1[3]));
                        *(u32x4*)(GATES + (size_t)(row0 + ai * 128 + m * 16) * GLD + gc0 + bj * 128) = w; }
            }
        }
    }
};
struct EpiZT {
    static constexpr bool PERM = true, AFTER_DRAIN = false;
    u16* ZL;
    __device__ __forceinline__ void operator()(const f32x4 (&acc)[2][2][4][2], const pg8::Unit& u, int wr, int wc, int fr, int fq) const {
#pragma unroll
        for (int bj = 0; bj < 2; ++bj) {
            const int c0 = u.pn * 256 + bj * 128 + wc * 32 + 8 * fq;
#pragma unroll
            for (int ai = 0; ai < 2; ++ai)
#pragma unroll
                for (int m = 0; m < 4; ++m) {
                    const int zr = u.pm * 256 + ai * 128 + wr * 64 + m * 16 + fr, g = zr >> 8, part = (zr >> 7) & 1, kn = zr & 127;
                    size_t off;
                    if (u.pn < 16) off = (size_t)4096 * 8192 + ((size_t)(u.pn * 512 + g * 128 + kn) * 512 + part * 256 + (c0 - u.pn * 256));
                    else { const int tok = c0 - NPR, b = tok >> 12, rc = tok & 4095; off = (size_t)(b * 512 + g * 128 + kn) * 8192 + part * 4096 + rc; }
                    u16* dst = ZL + off;
                    const f32x4 v0 = acc[ai][bj][m][0], v1 = acc[ai][bj][m][1];
                    u32x4 w; w.x = cvt_pk_bf16(v0[0], v0[1]); w.y = cvt_pk_bf16(v0[2], v0[3]); w.z = cvt_pk_bf16(v1[0], v1[1]); w.w = cvt_pk_bf16(v1[2], v1[3]);
                    *(u32x4*)dst = w;
                }
        }
    }
};
struct EpiFour {
    static constexpr bool PERM = true, AFTER_DRAIN = false;
    u16* FOUR; int latent;
    __device__ __forceinline__ void operator()(const f32x4 (&acc)[2][2][4][2], const pg8::Unit& u, int wr, int wc, int fr, int fq) const {
        const int b = u.pn >> 1, ch0 = (u.pn & 1) * 256 + wc * 32 + 8 * fq;
        const int tok0 = (latent ? NPR + b * 4096 : b * 256) + u.pm * 256 + wr * 64 + fr;
#pragma unroll
        for (int ai = 0; ai < 2; ++ai)
#pragma unroll
            for (int m = 0; m < 4; ++m)
#pragma unroll
                for (int bj = 0; bj < 2; ++bj) { const f32x4 v0 = acc[ai][bj][m][0], v1 = acc[ai][bj][m][1];
                    u32x4 w; w.x = cvt_pk_bf16(v0[0], v0[1]); w.y = cvt_pk_bf16(v0[2], v0[3]); w.z = cvt_pk_bf16(v1[0], v1[1]); w.w = cvt_pk_bf16(v1[2], v1[3]);
                    *(u32x4*)(FOUR + (size_t)(tok0 + ai * 128 + m * 16) * 512 + ch0 + bj * 128) = w; }
    }
};
struct EpiMul {
    static constexpr bool PERM = true, AFTER_DRAIN = false;
    u16* O; const u16* GATES; int mode;
    __device__ __forceinline__ void operator()(const f32x4 (&acc)[2][2][4][2], const pg8::Unit& u, int wr, int wc, int fr, int fq) const {
        const int row0 = u.pm * 256 + wr * 64 + fr, col0 = u.pn * 256 + wc * 32 + 8 * fq;
        const int ld = mode == 0 ? 512 : 1024;
#pragma unroll
        for (int ai = 0; ai < 2; ++ai)
#pragma unroll
            for (int m = 0; m < 4; ++m)
#pragma unroll
                for (int bj = 0; bj < 2; ++bj) {
                    const int row = row0 + ai * 128 + m * 16, col = col0 + bj * 128;
                    u16* p = O + (size_t)row * ld + col;
                    float v[8];
#pragma unroll
                    for (int j = 0; j < 4; ++j) { v[j] = acc[ai][bj][m][0][j]; v[4 + j] = acc[ai][bj][m][1][j]; }
                    if (mode == 0) {
                        const u32x4 q = *(const u32x4*)p;
#pragma unroll
                        for (int j = 0; j < 4; ++j) { v[2 * j] *= bf2f(q[j] & 0xffffu); v[2 * j + 1] *= bf2f(q[j] >> 16); }
                    } else {
                        const u32x4 gq = *(const u32x4*)(GATES + (size_t)row * GLD + (mode == 2 ? 1024 : 0) + col);
#pragma unroll
                        for (int j = 0; j < 4; ++j) { v[2 * j] *= h2f(gq[j] & 0xffffu); v[2 * j + 1] *= h2f(gq[j] >> 16); }
                        if (mode == 2) { const u32x4 q = *(const u32x4*)p;
#pragma unroll
                            for (int j = 0; j < 4; ++j) { v[2 * j] += bf2f(q[j] & 0xffffu); v[2 * j + 1] += bf2f(q[j] >> 16); } }
                    }
                    u32x4 w; w.x = cvt_pk_bf16(v[0], v[1]); w.y = cvt_pk_bf16(v[2], v[3]); w.z = cvt_pk_bf16(v[4], v[5]); w.w = cvt_pk_bf16(v[6], v[7]);
                    *(u32x4*)p = w;
                }
    }
};

template <class Epi>
__device__ __forceinline__ void run_gemm(LAS unsigned char* lds, const u16* A, const u16* Bt, int M, int N, int K, const Epi& E) {
    pg8::Gemm g{A, Bt, M, N, K}; pg8::StaticOrder S; S.init(M, N, (int)gridDim.x, (int)blockIdx.x);
    pg8::gemm_phase<Epi, pg8::StaticOrder, false>(lds, g, S, E, nullptr);
}

__device__ __forceinline__ void transpose_tile(const float* src, int ld_src, int col0, int k0, int krows, u16* dst, int n0, int K, LAS float* tile) {
    const int t = threadIdx.x;
#pragma unroll
    for (int i = 0; i < 8; ++i) { const int kk = (t >> 6) + 8 * i, nn = t & 63;
        float v = 0.f; if (col0 >= 0 && k0 + kk < krows) v = src[(size_t)(k0 + kk) * ld_src + col0 + nn];
        tile[kk * 65 + nn] = v; }
    __syncthreads();
    const int nn = t >> 3, ks = (t & 7) * 8;
    float v[8];
#pragma unroll
    for (int j = 0; j < 8; ++j) v[j] = tile[(ks + j) * 65 + nn];
    u32x4 w; w.x = cvt_pk_bf16(v[0], v[1]); w.y = cvt_pk_bf16(v[2], v[3]); w.z = cvt_pk_bf16(v[4], v[5]); w.w = cvt_pk_bf16(v[6], v[7]);
    *(u32x4*)(dst + (size_t)(n0 + nn) * K + k0 + ks) = w;
    __syncthreads();
}

__device__ __forceinline__ void phase_prep(const Params& P, LAS unsigned char* lds) {
    LAS float* L = (LAS float*)lds;
    LAS float* tile = L;
    LAS float* cs128 = L + 4160; LAS float* sn128 = cs128 + 128;
    LAS float* cs64 = sn128 + 128;  LAS float* sn64 = cs64 + 64;
    LAS float* cs256 = sn64 + 64;   LAS float* sn256 = cs256 + 256;
    LAS float* frow = sn256 + 256;
    LAS float* sc = frow + 512;
    LAS float* red = sc + 9216;
    const int tid = threadIdx.x, G = gridDim.x, bid = blockIdx.x;
    unsigned char* ws = P.ws;
    if (tid < 256) { float s, c; sincospif(2.0f * (float)tid / 256.0f, &s, &c); cs256[tid] = c; sn256[tid] = s; }
    if (tid < 128) { float s, c; sincospif(2.0f * (float)tid / 128.0f, &s, &c); cs128[tid] = c; sn128[tid] = s; }
    if (tid < 64)  { float s, c; sincospif(2.0f * (float)tid / 64.0f, &s, &c); cs64[tid] = c; sn64[tid] = s; }
    __syncthreads();

    if (bid < 144) {
        for (int i = tid; i < 9216; i += 512) { const int v = i >> 10, k = i & 1023; const float x = v < 8 ? P.in[4][v * 1024 + k] : P.in[5][k]; sc[i] = x / (1.0f + expf(-x)); }
        __syncthreads();
        const int c = tid & 63, kg = tid >> 6; const float* aw = P.in[6] + bid * 64 + c;
        float a[9];
#pragma unroll
        for (int v = 0; v < 9; ++v) a[v] = 0.f;
        for (int k = kg; k < 1024; k += 8) { const float w = aw[(size_t)k * 9216];
#pragma unroll
            for (int v = 0; v < 9; ++v) a[v] += sc[v * 1024 + k] * w; }
#pragma unroll
        for (int v = 0; v < 9; ++v) red[(kg * 9 + v) * 64 + c] = a[v];
        __syncthreads();
        float* MOD = (float*)(ws + WS_MOD);
        for (int i = tid; i < 576; i += 512) { const int v = i >> 6, cc = i & 63; float s = 0.f;
#pragma unroll
            for (int q = 0; q < 8; ++q) s += red[(q * 9 + v) * 64 + cc];
            MOD[v * 9216 + bid * 64 + cc] = s + P.in[7][bid * 64 + cc]; }
        __syncthreads();
    }

    {
        const int total = 5792;
        for (int q = bid; q < total; q += G) {
            int j = 0, r = q, nk = 16;
#define PREP_STEP(JJ, CNT, NKN) if (j == JJ && r >= (CNT)) { r -= (CNT); j = JJ + 1; nk = NKN; }
            PREP_STEP(0, 88 * 16, 44) PREP_STEP(1, 16 * 44, 16) PREP_STEP(2, 88 * 16, 44) PREP_STEP(3, 16 * 44, 16)
            PREP_STEP(4, 64 * 16, 8) PREP_STEP(5, 16 * 8, 8) PREP_STEP(6, 16 * 8, 16) PREP_STEP(7, 16 * 16, 4)
#undef PREP_STEP
            const int tn = r / nk, tk = r % nk, n0 = tn * 64, k0 = tk * 64;
            const float* src; int ld, krows, Kd, col0 = n0; u16* dst;
            if (j == 0 || j == 2) { src = j == 0 ? P.in[9] : P.in[11]; ld = 5632; krows = 1024; Kd = 1024; dst = (u16*)(ws + (j == 0 ? WS_W13A : WS_W13B));
                const int pn = n0 >> 8, rr = n0 & 255; col0 = rr < 128 ? 128 * pn + rr : 2816 + 128 * pn + (rr - 128); }
            else if (j == 1 || j == 3) { src = j == 1 ? P.in[10] : P.in[12]; ld = 1024; krows = 2816; Kd = 2816; dst = (u16*)(ws + (j == 1 ? WS_W2A : WS_W2B)); }
            else if (j == 4) { src = P.in[13]; ld = 4480; krows = 1024; Kd = 1024; dst = (u16*)(ws + WS_WIN);
                col0 = n0 < 1920 ? n0 : (n0 < 2048 ? -1 : 2432 + (n0 - 2048)); }
            else if (j == 5) { src = P.in[26]; ld = 1024; krows = 512; Kd = 512; dst = (u16*)(ws + WS_WO); }
            else if (j == 6) { src = P.in[27]; ld = 1024; krows = 512; Kd = 512; dst = (u16*)(ws + WS_WF); }
            else if (j == 7) { src = P.in[28]; ld = 1024; krows = 1024; Kd = 1024; dst = (u16*)(ws + WS_WOUT); }
            else { src = P.in[20]; ld = 512; krows = 128; Kd = 256; dst = (u16*)(ws + WS_GUP); }
            transpose_tile(src, ld, col0, k0, krows, dst, n0, Kd, tile);
        }
    }

    {
        u16* WZ = (u16*)(ws + WS_WZ);
        for (int k = bid; k < 1024; k += G) {
            frow[tid] = P.in[13][(size_t)k * 4480 + 1920 + tid];
            __syncthreads();
#pragma unroll
            for (int rep = 0; rep < 2; ++rep) { const int zc = tid + rep * 512, g = zc >> 8, part = (zc >> 7) & 1, kn = zc & 127;
                const LAS float* tab = part ? sn128 : cs128; float s = 0.f;
                for (int n = 0; n < 128; ++n) s += frow[g * 128 + n] * tab[(kn * n) & 127];
                s *= 0.08838834764831845f; if (part) s = -s;
                WZ[(size_t)zc * 1024 + k] = (u16)(cvt_pk_bf16(s, 0.f) & 0xffffu); }
            __syncthreads();
        }
    }

    {
        u16* T = (u16*)(ws + WS_T);
        for (size_t vi = (size_t)bid * 512 + tid; vi < (size_t)4096 * 1024; vi += (size_t)G * 512) {
            const int row = (int)(vi >> 10), cv = (int)(vi & 1023) * 8, part = cv >> 12, r = (cv >> 6) & 63, c0 = cv & 63, kr = row >> 6, kc = row & 63;
            const LAS float* tab = part ? sn64 : cs64; const int base = kr * r;
            float v[8];
#pragma unroll
            for (int j = 0; j < 8; ++j) v[j] = tab[(base + kc * (c0 + j)) & 63] * 0.015625f;
            u32x4 w; w.x = cvt_pk_bf16(v[0], v[1]); w.y = cvt_pk_bf16(v[2], v[3]); w.z = cvt_pk_bf16(v[4], v[5]); w.w = cvt_pk_bf16(v[6], v[7]);
            *(u32x4*)(T + vi * 8) = w;
        }
        u16* T2 = (u16*)(ws + WS_T256);
        for (int vi = bid * 512 + tid; vi < 256 * 64; vi += G * 512) {
            const int kt = vi >> 6, cv = (vi & 63) * 8, part = cv >> 8, t0 = cv & 255;
            const LAS float* tab = part ? sn256 : cs256;
            float v[8];
#pragma unroll
            for (int j = 0; j < 8; ++j) v[j] = tab[(kt * (t0 + j)) & 255] * 0.0625f;
            u32x4 w; w.x = cvt_pk_bf16(v[0], v[1]); w.y = cvt_pk_bf16(v[2], v[3]); w.z = cvt_pk_bf16(v[4], v[5]); w.w = cvt_pk_bf16(v[6], v[7]);
            *(u32x4*)(T2 + (size_t)vi * 8) = w;
        }
    }
}

template <int CTRL> __device__ __forceinline__ float dpp_add(float v) {
    return v + __int_as_float(__builtin_amdgcn_update_dpp(0, __float_as_int(v), CTRL, 0xF, 0xF, true));
}
__device__ __forceinline__ float sum16(float v) {
    v = dpp_add<0xB1>(v); v = dpp_add<0x4E>(v); v = dpp_add<0x141>(v); v = dpp_add<0x140>(v); return v;
}
__device__ __forceinline__ float sum64(float v) {
    const float t = sum16(v);
    const int ti = __float_as_int(t);
    return __int_as_float(__builtin_amdgcn_readlane(ti, 0)) + __int_as_float(__builtin_amdgcn_readlane(ti, 16)) + __int_as_float(__builtin_amdgcn_readlane(ti, 32)) + __int_as_float(__builtin_amdgcn_readlane(ti, 48));
}
__device__ __forceinline__ float wave_sum(float v) {
#pragma unroll
    for (int o = 32; o >= 1; o >>= 1) v += __shfl_xor(v, o);
    return v;
}
__device__ __forceinline__ const float* norm_row(const Params& P, const float* X, int m) {
    return X ? X + (size_t)m * DM : (m < NPR ? P.in[0] + (size_t)m * DM : P.in[1] + (size_t)(m - NPR) * DM);
}
__device__ __forceinline__ void phase_norm(const Params& P, const float* X, int nwi, int slot_shift, int slot_scale, u16* H) {
    const int lane = threadIdx.x & 63, gw = blockIdx.x * 8 + (threadIdx.x >> 6), nw = gridDim.x * 8;
    const float* MOD = (const float*)(P.ws + WS_MOD); const float* normw = P.in[8] + nwi * 1024;
    f32x4 v[4], vn[4];
    if (gw < MT) { const float* xr = norm_row(P, X, gw);
#pragma unroll
        for (int i = 0; i < 4; ++i) v[i] = *(const f32x4*)(xr + i * 256 + lane * 4); }
    for (int m = gw; m < MT; m += nw) {
        const int mn = m + nw < MT ? m + nw : m;
        { const float* xr = norm_row(P, X, mn);
#pragma unroll
          for (int i = 0; i < 4; ++i) vn[i] = *(const f32x4*)(xr + i * 256 + lane * 4); }
        float ss = 0.f;
#pragma unroll
        for (int i = 0; i < 4; ++i) ss += v[i][0] * v[i][0] + v[i][1] * v[i][1] + v[i][2] * v[i][2] + v[i][3] * v[i][3];
        ss = sum64(ss);
        const float rs = rsqrtf(ss * (1.0f / 1024.0f) + 1e-6f);
        const float* md = MOD + (size_t)modidx_m(m) * 9216;
#pragma unroll
        for (int i = 0; i < 4; ++i) { const int c = i * 256 + lane * 4;
            const f32x4 w = *(const f32x4*)(normw + c), sc = *(const f32x4*)(md + slot_scale * 1024 + c), sh = *(const f32x4*)(md + slot_shift * 1024 + c);
            const f32x4 y = v[i] * rs * w * (sc + 1.0f) + sh;
            u32x2 o; o.x = cvt_pk_bf16(y[0], y[1]); o.y = cvt_pk_bf16(y[2], y[3]);
            *(u32x2*)(H + (size_t)m * DM + c) = o; }
#pragma unroll
        for (int i = 0; i < 4; ++i) v[i] = vn[i];
    }
}
__device__ __forceinline__ void phase_final_norm(const Params& P) {
    const int lane = threadIdx.x & 63, gw = blockIdx.x * 8 + (threadIdx.x >> 6), nw = gridDim.x * 8;
    const float* fw = P.in[29];
    f32x4 v[4], vn[4];
    if (gw < MT) { const float* xr = P.out + (size_t)gw * DM;
#pragma unroll
        for (int i = 0; i < 4; ++i) v[i] = *(const f32x4*)(xr + i * 256 + lane * 4); }
    for (int m = gw; m < MT; m += nw) {
        const int mn = m + nw < MT ? m + nw : m;
        { const float* xr = P.out + (size_t)mn * DM;
#pragma unroll
          for (int i = 0; i < 4; ++i) vn[i] = *(const f32x4*)(xr + i * 256 + lane * 4); }
        float ss = 0.f;
#pragma unroll
        for (int i = 0; i < 4; ++i) ss += v[i][0] * v[i][0] + v[i][1] * v[i][1] + v[i][2] * v[i][2] + v[i][3] * v[i][3];
        ss = sum64(ss);
        const float rs = rsqrtf(ss * (1.0f / 1024.0f) + 1e-6f);
        float* xo = P.out + (size_t)m * DM;
#pragma unroll
        for (int i = 0; i < 4; ++i) { const int c = i * 256 + lane * 4; *(f32x4*)(xo + c) = v[i] * rs * *(const f32x4*)(fw + c); }
#pragma unroll
        for (int i = 0; i < 4; ++i) v[i] = vn[i];
    }
}

__device__ __forceinline__ float fsig(float x) { return __builtin_amdgcn_rcpf(1.0f + __expf(-x)); }
struct ScanRegs { u32x2 r[3], k[3], v[3], wd, ad; };
__device__ __forceinline__ void scan_load(ScanRegs& R, const u16* U, int tok0, int T, int t, int h, int d, int cg) {
    const u32x2 z = {0u, 0u};
#pragma unroll
    for (int tap = 0; tap < 3; ++tap) { const int tn = t + tap - 1;
        if (tn >= 0 && tn < T) { const u16* row = U + (size_t)(tok0 + tn) * 1792 + h * 64 + 4 * cg;
            R.r[tap] = *(const u32x2*)row; R.k[tap] = *(const u32x2*)(row + 512); R.v[tap] = *(const u32x2*)(row + 1024); }
        else { R.r[tap] = z; R.k[tap] = z; R.v[tap] = z; } }
    const u16* row = U + (size_t)(tok0 + t) * 1792 + 1536 + d * 64 + 4 * cg;
    R.wd = *(const u32x2*)row; R.ad = *(const u32x2*)(row + 128);
}
__device__ __forceinline__ void unpack4h(const u32x2 q, float (&o)[4]) { o[0] = h2f(q.x & 0xffffu); o[1] = h2f(q.x >> 16); o[2] = h2f(q.y & 0xffffu); o[3] = h2f(q.y >> 16); }

#define LDS_BARRIER() do { asm volatile("s_waitcnt lgkmcnt(0)" ::: "memory"); __builtin_amdgcn_s_barrier(); asm volatile("" ::: "memory"); } while (0)
__device__ __forceinline__ void scan_unit(const Params& P, LAS float* L, int s, int h, int d, int half) {
    typedef float f32x16 __attribute__((ext_vector_type(16)));
    const int tid = threadIdx.x, lane = tid & 63;
    const bool producer = tid >= 256;
    const int T = s < 16 ? 256 : 4096, tok0 = s < 16 ? s * 256 : NPR + (s - 16) * 4096, nchunk = T / 32;
    const u16* U = (const u16*)(P.ws + WS_U16);
    u16* Od = (u16*)(P.ws + WS_H) + (size_t)d * MT * 512;
    float* BS = (float*)(P.ws + WS_BS);
    LAS float* cst = L;            LAS float* xwT = L + 1024;    LAS float* xaT = L + 3072;   LAS float* lora_s = L + 5120;
    LAS float* o_sb = L + 13312;   LAS float* cb = L + 15360;
    if (tid < 64) { const int c = tid, ch = h * 64 + c;
        cst[c] = P.in[16][d * 512 + ch]; cst[64 + c] = P.in[18][d * 512 + ch]; cst[128 + c] = P.in[21][ch]; cst[192 + c] = P.in[22][ch]; cst[256 + c] = P.in[23][ch];
#pragma unroll
        for (int ten = 0; ten < 3; ++ten)
#pragma unroll
            for (int tap = 0; tap < 3; ++tap) cst[(5 + ten * 3 + tap) * 64 + c] = P.in[15][tap * 1536 + ten * 512 + ch]; }
    const int c16 = tid & 15, rp = (tid >> 4) & 15, rA = half * 32 + rp, rB = rA + 16;
    f32x4 SA = {0.f, 0.f, 0.f, 0.f}, SB = {0.f, 0.f, 0.f, 0.f};
    if (!producer && s >= 16) { const float* st = (d ? P.in[3] : P.in[2]) + (size_t)((s - 16) * 8 + h) * 4096;
        SA = *(const f32x4*)(st + rA * 64 + 4 * c16); SB = *(const f32x4*)(st + rB * 64 + 4 * c16); }
    const int pt = tid - 256, pw = (pt >> 6) & 3, nt = pw & 1, kh = pw >> 1, li = lane & 31, lk = lane >> 5;
    float Bw[16], Ba[16];
    if (producer) {
#pragma unroll
        for (int s2 = 0; s2 < 16; ++s2) { const size_t o = (size_t)(d * 64 + kh * 32 + 2 * s2 + lk) * 512 + h * 64 + nt * 32 + li; Bw[s2] = P.in[17][o]; Ba[s2] = P.in[19][o]; }
    } else {
#pragma unroll
        for (int s2 = 0; s2 < 16; ++s2) { Bw[s2] = 0.f; Ba[s2] = 0.f; }
    }
    const int it0 = pt & 255, tt0 = it0 >> 4, cg0 = it0 & 15, tt1 = tt0 + 16, cg1 = cg0;
    ScanRegs R0, R1;
    if (producer) { scan_load(R0, U, tok0, T, d ? T - 1 - tt0 : tt0, h, d, cg0); scan_load(R1, U, tok0, T, d ? T - 1 - tt1 : tt1, h, d, cg1); }
    __syncthreads();
    for (int ci = -1; ci < nchunk; ++ci) {
        const int pc = ci + 1;
        LAS float* pb = cb + (pc & 1) * 12288;
        const LAS float* qb = cb + (ci & 1) * 12288;
        LAS float* o_s = o_sb + (ci & 1) * 1024;
        const bool do_prep = producer && pc < nchunk, do_step = !producer && ci >= 0;
        LAS float* r_s = pb; LAS float* w_s = pb + 2048; LAS float* kd_s = pb + 4096; LAS float* v_s = pb + 6144; LAS float* kk_s = pb + 8192; LAS float* kka_s = pb + 10240;
#define SCAN_STEPS(SEG) if (do_step) { float oAr[8], oBr[8]; float pA = 0.f, pB = 0.f;     \
        _Pragma("unroll") for (int u8 = 0; u8 < 8; ++u8) { const int tt = (SEG) * 8 + u8; \
            const f32x4 w4 = *(const LAS f32x4*)(qb + 2048 + tt * 64 + 4 * c16), kk4 = *(const LAS f32x4*)(qb + 8192 + tt * 64 + 4 * c16), ka4 = *(const LAS f32x4*)(qb + 10240 + tt * 64 + 4 * c16); \
            const f32x4 kd4 = *(const LAS f32x4*)(qb + 4096 + tt * 64 + 4 * c16), r4 = *(const LAS f32x4*)(qb + tt * 64 + 4 * c16); \
            const float vA = qb[6144 + tt * 64 + rA], vB = qb[6144 + tt * 64 + rB]; \
            float saA = SA[0] * kk4[0] + SA[1] * kk4[1] + SA[2] * kk4[2] + SA[3] * kk4[3], saB = SB[0] * kk4[0] + SB[1] * kk4[1] + SB[2] * kk4[2] + SB[3] * kk4[3]; \
            saA = dpp_add<0xB1>(saA); saB = dpp_add<0xB1>(saB); pA = dpp_add<0xB1>(pA); pB = dpp_add<0xB1>(pB); \
            saA = dpp_add<0x4E>(saA); saB = dpp_add<0x4E>(saB); pA = dpp_add<0x4E>(pA); pB = dpp_add<0x4E>(pB); \
            saA = dpp_add<0x141>(saA); saB = dpp_add<0x141>(saB); pA = dpp_add<0x141>(pA); pB = dpp_add<0x141>(pB); \
            saA = dpp_add<0x140>(saA); saB = dpp_add<0x140>(saB); pA = dpp_add<0x140>(pA); pB = dpp_add<0x140>(pB); \
            if (u8 > 0) { oAr[u8 - 1] = pA; oBr[u8 - 1] = pB; } \
            SA = SA * w4 - ka4 * saA + kd4 * vA; SB = SB * w4 - ka4 * saB + kd4 * vB; \
            pA = SA[0] * r4[0] + SA[1] * r4[1] + SA[2] * r4[2] + SA[3] * r4[3]; pB = SB[0] * r4[0] + SB[1] * r4[1] + SB[2] * r4[2] + SB[3] * r4[3]; } \
        pA = dpp_add<0xB1>(pA); pB = dpp_add<0xB1>(pB); pA = dpp_add<0x4E>(pA); pB = dpp_add<0x4E>(pB); pA = dpp_add<0x141>(pA); pB = dpp_add<0x141>(pB); pA = dpp_add<0x140>(pA); pB = dpp_add<0x140>(pB); \
        oAr[7] = pA; oBr[7] = pB; \
        if (c16 == 0) { _Pragma("unroll") for (int u8 = 0; u8 < 8; ++u8) { o_s[((SEG) * 8 + u8) * 32 + rp] = oAr[u8]; o_s[((SEG) * 8 + u8) * 32 + 16 + rp] = oBr[u8]; } } }
        if (do_prep) {
#pragma unroll
            for (int it = 0; it < 2; ++it) { const ScanRegs& R = it ? R1 : R0; const int tt_a = it ? tt1 : tt0, cg = cg0;
                float rv[4] = {0.f, 0.f, 0.f, 0.f}, kv[4] = {0.f, 0.f, 0.f, 0.f}, vv[4] = {0.f, 0.f, 0.f, 0.f};
#pragma unroll
                for (int tap = 0; tap < 3; ++tap) { float a[4], bb[4], c[4]; unpack4h(R.r[tap], a); unpack4h(R.k[tap], bb); unpack4h(R.v[tap], c);
#pragma unroll
                    for (int j = 0; j < 4; ++j) { rv[j] += a[j] * cst[(5 + tap) * 64 + 4 * cg + j]; kv[j] += bb[j] * cst[(8 + tap) * 64 + 4 * cg + j]; vv[j] += c[j] * cst[(11 + tap) * 64 + 4 * cg + j]; } }
                float kkr[4], ss = 0.f;
#pragma unroll
                for (int j = 0; j < 4; ++j) { kkr[j] = kv[j] * cst[128 + 4 * cg + j]; ss += kkr[j] * kkr[j]; }
                ss = sum16(ss);
                const float inv = __builtin_amdgcn_rsqf(fmaxf(ss, 1e-24f));
                float wdv[4], adv[4]; unpack4h(R.wd, wdv); unpack4h(R.ad, adv);
#pragma unroll
                for (int j = 0; j < 4; ++j) { const int o = tt_a * 64 + 4 * cg + j;
                    r_s[o] = rv[j]; v_s[o] = vv[j]; kd_s[o] = kv[j]; kk_s[o] = kkr[j] * inv;
                    xwT[(4 * cg + j) * 32 + tt_a] = 1.0f - 2.0f * __builtin_amdgcn_rcpf(1.0f + __expf(2.0f * wdv[j])); xaT[(4 * cg + j) * 32 + tt_a] = adv[j]; } }
            if (pc + 1 < nchunk) { const int q0 = (pc + 1) * 32 + tt0, q1 = (pc + 1) * 32 + tt1;
                scan_load(R0, U, tok0, T, d ? T - 1 - q0 : q0, h, d, cg0); scan_load(R1, U, tok0, T, d ? T - 1 - q1 : q1, h, d, cg1); }
        }
        SCAN_STEPS(0)
        LDS_BARRIER();
        if (do_prep) {
            f32x16 accw, acca;
#pragma unroll
            for (int i = 0; i < 16; ++i) { accw[i] = 0.f; acca[i] = 0.f; }
#pragma unroll
            for (int s2 = 0; s2 < 16; ++s2) { const int r = kh * 32 + 2 * s2 + lk;
                accw = __builtin_amdgcn_mfma_f32_32x32x2f32(xwT[r * 32 + li], Bw[s2], accw, 0, 0, 0);
                acca = __builtin_amdgcn_mfma_f32_32x32x2f32(xaT[r * 32 + li], Ba[s2], acca, 0, 0, 0); }
#pragma unroll
            for (int reg = 0; reg < 16; ++reg) { const int o = ((reg & 3) + 8 * (reg >> 2) + 4 * lk) * 64 + nt * 32 + li;
                lora_s[(0 * 2 + kh) * 2048 + o] = accw[reg]; lora_s[(1 * 2 + kh) * 2048 + o] = acca[reg]; }
        }
        SCAN_STEPS(1)
        LDS_BARRIER();
        if (do_prep) {
            const int c = pt & 63, tg = pt >> 6;
#pragma unroll
            for (int j = 0; j < 8; ++j) { const int tt = 8 * tg + j, o = tt * 64 + c;
                const float wl = cst[c] + lora_s[o] + lora_s[2048 + o];
                const float w = __expf(-0.6065306597f * fsig(wl));
                const float a = fsig(cst[64 + c] + lora_s[4096 + o] + lora_s[6144 + o]);
                const float k = kd_s[o], kk = kk_s[o];
                const float kd = k * (1.0f + (a - 1.0f) * cst[192 + c]);
                kd_s[o] = kd; kka_s[o] = kk * a; w_s[o] = w;
                const float bsum = sum64(r_s[o] * kd * cst[256 + c]);
                if (lane == 0 && half == 0) { const int q = pc * 32 + tt, t = d ? T - 1 - q : q; BS[(size_t)(tok0 + t) * 16 + h * 2 + d] = bsum; } }
        }
        SCAN_STEPS(2)
        LDS_BARRIER();
        SCAN_STEPS(3)
        LDS_BARRIER();
        if (do_step) { const int tt = tid >> 3, seg = tid & 7, q = ci * 32 + tt, t = d ? T - 1 - q : q;
            u32x2 w2; w2.x = cvt_pk_bf16(o_s[tt * 32 + 4 * seg], o_s[tt * 32 + 4 * seg + 1]); w2.y = cvt_pk_bf16(o_s[tt * 32 + 4 * seg + 2], o_s[tt * 32 + 4 * seg + 3]);
            *(u32x2*)(Od + (size_t)(tok0 + t) * 512 + h * 64 + half * 32 + 4 * seg) = w2; }
#undef SCAN_STEPS
    }
    if (!producer && s < 16) { float* so = P.out + OUT_STATE + (size_t)d * 524288 + (size_t)(s * 8 + h) * 4096;
        *(f32x4*)(so + rA * 64 + 4 * c16) = SA; *(f32x4*)(so + rB * 64 + 4 * c16) = SB; }
    __syncthreads();
}
__device__ __forceinline__ void phase_scan(const Params& P, LAS unsigned char* lds) {
    for (int q = blockIdx.x; q < 768; q += gridDim.x) {
        int s, rem;
        if (q < 256) { s = 16 + (q >> 5); rem = q & 31; } else { const int p = q - 256; s = p >> 5; rem = p & 31; }
        scan_unit(P, (LAS float*)lds, s, rem >> 2, (rem >> 1) & 1, rem & 1);
    }
}

struct PostRaw { unsigned of, ob, v0, v1, v2, sg; float b0, b1; };
__device__ __forceinline__ void post_load(PostRaw& r, int m, int ch, int h, int lane, const u16* OF, const u16* OB, const u16* U, const float* BS, const u16* GT) {
    const int T = m < NPR ? 256 : 4096, t = m < NPR ? (m & 255) : ((m - NPR) & 4095);
    r.of = OF[(size_t)m * 512 + ch]; r.ob = OB[(size_t)m * 512 + ch];
    r.v1 = U[(size_t)m * 1792 + 1024 + ch];
    r.v0 = t > 0 ? U[(size_t)(m - 1) * 1792 + 1024 + ch] : 0u;
    r.v2 = t < T - 1 ? U[(size_t)(m + 1) * 1792 + 1024 + ch] : 0u;
    r.sg = *(const unsigned*)(GT + (size_t)m * GLD + 2048 + 2 * lane);
    r.b0 = BS[(size_t)m * 16 + h * 2]; r.b1 = BS[(size_t)m * 16 + h * 2 + 1];
}
__device__ __forceinline__ void phase_post(const Params& P, LAS unsigned char* lds) {
    const int lane = threadIdx.x & 63, h = threadIdx.x >> 6, ch = h * 64 + lane, G = gridDim.x;
    const u16* OF = (const u16*)(P.ws + WS_H); const u16* OB = OF + (size_t)MT * 512;
    const u16* U = (const u16*)(P.ws + WS_U16); const float* BS = (const float*)(P.ws + WS_BS);
    u16* OPRE = (u16*)(P.ws + WS_OPRE); const u16* GT = (const u16*)(P.ws + WS_R);
    LAS float* sgl = (LAS float*)lds + h * 128;
    float gu[128];
#pragma unroll
    for (int k = 0; k < 128; ++k) gu[k] = P.in[20][(size_t)k * 512 + ch];
    const float lw = P.in[24][ch], lb = P.in[25][ch];
    const float cv0 = P.in[15][0 * 1536 + 1024 + ch], cv1 = P.in[15][1 * 1536 + 1024 + ch], cv2 = P.in[15][2 * 1536 + 1024 + ch];
    PostRaw cur, nxt;
    int m = blockIdx.x;
    post_load(cur, m, ch, h, lane, OF, OB, U, BS, GT);
    for (; m < MT; m += G) {
        const int mn = m + G < MT ? m + G : m;
        post_load(nxt, mn, ch, h, lane, OF, OB, U, BS, GT);
        sgl[2 * lane] = h2f(cur.sg & 0xffffu); sgl[2 * lane + 1] = h2f(cur.sg >> 16);
        const float o = bf2f(cur.of) + bf2f(cur.ob);
        const float mean = sum64(o) * (1.0f / 64.0f), d = o - mean;
        const float rstd = rsqrtf(sum64(d * d) * (1.0f / 64.0f) + 64e-5f);
        const float v = h2f(cur.v0) * cv0 + h2f(cur.v1) * cv1 + h2f(cur.v2) * cv2;
        float g0 = 0.f, g1 = 0.f, g2 = 0.f, g3 = 0.f;
#pragma unroll
        for (int k = 0; k < 128; k += 4) { const f32x4 s4 = *(const LAS f32x4*)(sgl + k);
            g0 += s4[0] * gu[k]; g1 += s4[1] * gu[k + 1]; g2 += s4[2] * gu[k + 2]; g3 += s4[3] * gu[k + 3]; }
        const float y = (d * rstd * lw + lb + (cur.b0 + cur.b1) * v) * ((g0 + g1) + (g2 + g3));
        OPRE[(size_t)m * 512 + ch] = (u16)(cvt_pk_bf16(y, 0.f) & 0xffffu);
        cur = nxt;
    }
}


constexpr size_t WS_BAR = WS_END + 65536;
static_assert(WS_BAR + 4096 <= (size_t)536870912, "barrier words");
__device__ __forceinline__ void fast_grid_sync(unsigned char* ws, unsigned k) {
    asm volatile("s_waitcnt vmcnt(0) lgkmcnt(0)" ::: "memory");
    __builtin_amdgcn_s_barrier();
    if (threadIdx.x == 0) {
        unsigned* bar = (unsigned*)(ws + WS_BAR);
        const unsigned G = gridDim.x, g = blockIdx.x & 7u, gsz = (G - g + 7u) >> 3, ngrp = G < 8u ? G : 8u;
        __builtin_amdgcn_fence(__ATOMIC_RELEASE, "agent");
        asm volatile("s_waitcnt vmcnt(0)" ::: "memory");
        const unsigned old = __hip_atomic_fetch_add(bar + g * 32, 1u, __ATOMIC_RELAXED, __HIP_MEMORY_SCOPE_AGENT);
        if (old + 1u == k * gsz) __hip_atomic_fetch_add(bar + 8 * 32, 1u, __ATOMIC_RELAXED, __HIP_MEMORY_SCOPE_AGENT);
        unsigned spins = 0;
        while (__hip_atomic_load(bar + 8 * 32, __ATOMIC_RELAXED, __HIP_MEMORY_SCOPE_AGENT) < k * ngrp) { if (++spins > (1u << 24)) break; __builtin_amdgcn_s_sleep(1); }
        __builtin_amdgcn_fence(__ATOMIC_ACQUIRE, "agent");
        asm volatile("s_waitcnt vmcnt(0)" ::: "memory");
    }
    __builtin_amdgcn_s_barrier();
    asm volatile("" ::: "memory");
}

__global__ void __launch_bounds__(512, 2) fwd_mega(Params P) {
    extern __shared__ __attribute__((aligned(16))) unsigned char lds_raw[];
    LAS unsigned char* lds = (LAS unsigned char*)lds_raw;
    cg::grid_group grid = cg::this_grid();
    if (threadIdx.x < 32) { const int i = threadIdx.x; const unsigned long long v = i < 30 ? (unsigned long long)P.in[i] : (i == 30 ? (unsigned long long)P.out : (unsigned long long)P.ws);
        *(LAS unsigned long long*)(lds + PTAB_OFF + i * 8) = v; }
    __syncthreads();
unsigned bark_ = 0; unsigned char* P_ws_ = P.ws;
#define PH_BEGIN { const Params Q = get_params(lds); unsigned char* ws = Q.ws; (void)ws;
#define PH_END } asm volatile("s_waitcnt vmcnt(0)" ::: "memory");   grid.sync();
#define PH_ENDF } fast_grid_sync(P_ws_, ++bark_);
    PH_BEGIN phase_prep(Q, lds); PH_END
    PH_BEGIN phase_norm(Q, nullptr, 0, 0, 1, (u16*)(ws + WS_H)); PH_ENDF
    PH_BEGIN run_gemm(lds, (const u16*)(ws + WS_H), (const u16*)(ws + WS_W13A), MT, 5632, 1024, EpiSwiglu{(u16*)(ws + WS_BIG)}); PH_ENDF
    PH_BEGIN run_gemm(lds, (const u16*)(ws + WS_BIG), (const u16*)(ws + WS_W2A), MT, 1024, 2816, EpiResid{Q.in[0], Q.in[1], Q.out, (const float*)(ws + WS_MOD), 2, 0.5f}); PH_ENDF
    PH_BEGIN phase_norm(Q, Q.out, 1, 3, 4, (u16*)(ws + WS_H)); PH_ENDF
    PH_BEGIN run_gemm(lds, (const u16*)(ws + WS_WZ), (const u16*)(ws + WS_H), 1024, MT, 1024, EpiZT{(u16*)(ws + WS_ZL)}); PH_ENDF
    PH_BEGIN run_gemm(lds, (const u16*)(ws + WS_T), (const u16*)(ws + WS_ZL), 4096, 4096, 8192, EpiFour{(u16*)(ws + WS_FOUR), 1});
             run_gemm(lds, (const u16*)(ws + WS_T256), (const u16*)(ws + WS_ZP), 256, 8192, 512, EpiFour{(u16*)(ws + WS_FOUR), 0}); PH_ENDF
    PH_BEGIN run_gemm(lds, (const u16*)(ws + WS_H), (const u16*)(ws + WS_WIN), MT, 4096, 1024, EpiU{(u16*)(ws + WS_U16), (u16*)(ws + WS_SG), (u16*)(ws + WS_R), Q.in[14]}); PH_ENDF
    PH_BEGIN phase_scan(Q, lds); PH_ENDF
    PH_BEGIN phase_post(Q, lds); PH_ENDF
    PH_BEGIN run_gemm(lds, (const u16*)(ws + WS_OPRE), (const u16*)(ws + WS_WO), MT, 1024, 512, EpiMul{(u16*)(ws + WS_H), (const u16*)(ws + WS_R), 1}); PH_ENDF
    PH_BEGIN run_gemm(lds, (const u16*)(ws + WS_FOUR), (const u16*)(ws + WS_WF), MT, 1024, 512, EpiMul{(u16*)(ws + WS_H), (const u16*)(ws + WS_R), 2}); PH_ENDF
    PH_BEGIN run_gemm(lds, (const u16*)(ws + WS_H), (const u16*)(ws + WS_WOUT), MT, 1024, 1024, EpiResid{nullptr, nullptr, Q.out, (const float*)(ws + WS_MOD), 5, 1.0f}); PH_ENDF
    PH_BEGIN phase_norm(Q, Q.out, 2, 6, 7, (u16*)(ws + WS_H)); PH_ENDF
    PH_BEGIN run_gemm(lds, (const u16*)(ws + WS_H), (const u16*)(ws + WS_W13B), MT, 5632, 1024, EpiSwiglu{(u16*)(ws + WS_BIG)}); PH_ENDF
    PH_BEGIN run_gemm(lds, (const u16*)(ws + WS_BIG), (const u16*)(ws + WS_W2B), MT, 1024, 2816, EpiResid{nullptr, nullptr, Q.out, (const float*)(ws + WS_MOD), 8, 0.5f}); PH_ENDF
    { const Params Q = get_params(lds); phase_final_norm(Q); }
#undef PH_BEGIN
#undef PH_END
#undef PH_ENDF
}

extern "C" void kernel_launch(void* const* d_in, const int* in_sizes, int n_in, void* d_out, int out_size, void* d_ws, size_t ws_size, hipStream_t stream) {
    static int grid_blocks = 0;
    if (grid_blocks == 0) {
        if (n_in != 30 || ws_size < WS_END) { fprintf(stderr, "kernel_launch: unexpected n_in %d / ws_size %zu (need %zu)\n", n_in, ws_size, (size_t)WS_END); grid_blocks = -1; return; }
        int dev = 0, cus = 0, per_cu = 0;
        (void)hipGetDevice(&dev);
        (void)hipDeviceGetAttribute(&cus, hipDeviceAttributeMultiprocessorCount, dev);
        (void)hipFuncSetAttribute((const void*)fwd_mega, hipFuncAttributeMaxDynamicSharedMemorySize, LDS_BYTES);
        (void)hipOccupancyMaxActiveBlocksPerMultiprocessor(&per_cu, (const void*)fwd_mega, 512, LDS_BYTES);
        if (per_cu < 1) { fprintf(stderr, "kernel_launch: occupancy query reports %d blocks per CU\n", per_cu); per_cu = 1; }
        if (per_cu > 1) per_cu = 1;
        grid_blocks = cus * per_cu;
        (void)hipGetLastError();
    }
    if (grid_blocks < 0) return;
    (void)hipMemsetAsync((unsigned char*)d_ws + WS_BAR, 0, 4096, stream);
    Params p{};
    for (int i = 0; i < 30; ++i) p.in[i] = (const float*)d_in[i];
    p.out = (float*)d_out; p.ws = (unsigned char*)d_ws;
    void* args[] = {&p};
    hipError_t e = hipLaunchCooperativeKernel((const void*)fwd_mega, dim3(grid_blocks), dim3(512), args, LDS_BYTES, stream);
    if (e != hipSuccess) fprintf(stderr, "cooperative launch failed: %s (grid %d)\n", hipGetErrorString(e), grid_blocks);
}
```

```cpp
#include <hip/hip_runtime.h>
#include <hip/hip_cooperative_groups.h>
#include <cstdio>
namespace cg = cooperative_groups;
namespace pg8 {
#define PG8_LAS __attribute__((address_space(3)))
typedef unsigned short bf16_t;
typedef short bf16x8 __attribute__((ext_vector_type(8)));
typedef float f32x4 __attribute__((ext_vector_type(4)));
typedef unsigned u32x4 __attribute__((ext_vector_type(4)));
constexpr int BM = 256, BK = 64, HALF = 128, HTB = HALF * BK * 2  , STAGE_BYTES = 8 * HTB, NXCD = 8, WGM = 8;

__host__ __device__ __forceinline__ int lds_byte(int r, int c) { const int st = (r >> 4) * 2 + (c >> 5), rr = r & 15, cc = c & 31, ob = rr * 64 + cc * 2; return st * 1024 + (ob ^ (((ob >> 9) & 1) << 5)); }
__host__ __device__ __forceinline__ void stage_rc(int b, int& R, int& C) { const int st = b / 1024, sb = b % 1024, swz = sb ^ (((sb >> 9) & 1) << 5); R = (st >> 1) * 16 + swz / 64; C = (st & 1) * 32 + (swz % 64) / 2; }
__host__ __device__ __forceinline__ int perm32(int rho) { const int n = rho >> 4, i = rho & 15; return 8 * (i >> 2) + 4 * n + (i & 3); }

struct Unit { int pm, pn; };
struct Gemm { const bf16_t* A; const bf16_t* Bt; int M, N, K; };

struct StaticOrder {
    int nM, nN, nwg, G, c;
    __host__ __device__ __forceinline__ void init(int M, int N, int G_, int c_) { nM = M / BM; nN = N / BM; nwg = nM * nN; G = G_; c = c_; }
    __host__ __device__ __forceinline__ bool next(int i, Unit& u) const {
        const long L = (long)i * G + c; if (L >= nwg) return false;
        int wgid = (int)L; { const int q = nwg / NXCD, r = nwg % NXCD, xcd = wgid % NXCD, off = wgid / NXCD; wgid = (xcd < r ? xcd * (q + 1) : r * (q + 1) + (xcd - r) * q) + off; }
        const int nig = WGM * nN, gid = wgid / nig, fm = gid * WGM, gsz = (nM - fm) < WGM ? (nM - fm) : WGM;
        u.pm = fm + ((wgid % nig) % gsz); u.pn = (wgid % nig) / gsz; return true;
    }
    __device__ __forceinline__ void a_ready(const Unit&) const {}
    __device__ __forceinline__ void done(const Unit&) const {}
};
__device__ __forceinline__ unsigned cvt_pk_bf16(float lo, float hi) { unsigned r; asm volatile("v_cvt_pk_bf16_f32 %0, %1, %2" : "=v"(r) : "v"(lo), "v"(hi)); return r; }
template <class Epi, class Sched, bool STAMP = false>
__device__ __forceinline__ void gemm_phase(PG8_LAS unsigned char* lds, const Gemm g, const Sched& S, const Epi& E, unsigned long long* stamps) {
    int tid_ = threadIdx.x; asm volatile("" : "+v"(tid_));
    const int tid = tid_, wid = __builtin_amdgcn_readfirstlane(tid >> 6), lane = tid & 63, wr = wid >> 2, wc = wid & 3, fr = lane & 15, fq = lane >> 4;
    const int K = g.K, nt = K / BK;
    int ts_lo = 0, ts_hi = 0, nts = 0; const unsigned long long rt_entry = STAMP ? (unsigned long long)wall_clock64() : 0ull;
#define PG8_STAMP() do { if (STAMP && wid == 0 && nts < 64) { const unsigned long long _c = (unsigned long long)clock64(); \
        ts_lo = (lane == nts) ? (int)(unsigned)_c : ts_lo; ts_hi = (lane == nts) ? (int)(unsigned)(_c >> 32) : ts_hi; ++nts; } } while (0)
    PG8_STAMP();
    unsigned voffA[2], voffB[2];
#pragma unroll
    for (int i = 0; i < 2; ++i) { int R, C; stage_rc(tid * 16 + i * 8192, R, C); const int Rb = Epi::PERM ? ((R & ~31) + perm32(R & 31)) : R;
        voffA[i] = (unsigned)(R * K + C) * 2u; voffB[i] = (unsigned)(Rb * K + C) * 2u; }
    const size_t kstep = (size_t)(BK * 2);
    const size_t hstep = (size_t)HALF * K * 2;
    const size_t tstep = 2 * hstep;
    const unsigned ldsw = (unsigned)wid * 1024u;
    const int aoff = lds_byte(wr * 64 + fr, fq * 8), boff = lds_byte(wc * 32 + fr, fq * 8);
#define PG8_SA(b, h) (((b) * 2 + (h)) * HTB)
#define PG8_SB(b, h) ((4 + (b) * 2 + (h)) * HTB)
#define PG8_STAGE(bufoff, gbase, voff) do { _Pragma("unroll") for (int _i = 0; _i < 2; ++_i) \
        __builtin_amdgcn_global_load_lds((const unsigned*)((const char*)(gbase) + (voff)[_i]), (PG8_LAS unsigned*)(lds + (bufoff) + ldsw + _i * 8192), 16, 0, 0); } while (0)
#define PG8_LDA(dst, b, h) do { _Pragma("unroll") for (int m = 0; m < 4; ++m) _Pragma("unroll") for (int k = 0; k < 2; ++k) dst[m][k] = *(const PG8_LAS bf16x8*)(lds + PG8_SA(b, h) + aoff + m * 2048 + k * 1024); } while (0)
#define PG8_LDB(dst, b, h) do { _Pragma("unroll") for (int n = 0; n < 2; ++n) _Pragma("unroll") for (int k = 0; k < 2; ++k) dst[n][k] = *(const PG8_LAS bf16x8*)(lds + PG8_SB(b, h) + boff + n * 2048 + k * 1024); } while (0)
#define PG8_MMA(ai, bj, At, Bt) do { __builtin_amdgcn_s_setprio(1); _Pragma("unroll") for (int m = 0; m < 4; ++m) _Pragma("unroll") for (int n = 0; n < 2; ++n) _Pragma("unroll") for (int k = 0; k < 2; ++k) \
        acc[ai][bj][m][n] = __builtin_amdgcn_mfma_f32_16x16x32_bf16(Bt[n][k], At[m][k], acc[ai][bj][m][n], 0, 0, 0); __builtin_amdgcn_s_setprio(0); } while (0)
#define PG8_WAIT_V(n) asm volatile("s_waitcnt vmcnt(" #n ")" ::: "memory")
#define PG8_WAIT_L(n) asm volatile("s_waitcnt lgkmcnt(" #n ")" ::: "memory")
#define PG8_BAR __builtin_amdgcn_s_barrier()
#define PG8_SCHED __builtin_amdgcn_sched_barrier(0)
    Unit cur, nxt; int ui = 0;
    if (!S.next(0, cur)) return;
    f32x4 acc[2][2][4][2];
#pragma unroll
    for (int a = 0; a < 2; ++a)
#pragma unroll
        for (int b = 0; b < 2; ++b)
#pragma unroll
            for (int m = 0; m < 4; ++m)
#pragma unroll
                for (int n = 0; n < 2; ++n) acc[a][b][m][n] = (f32x4){0.f, 0.f, 0.f, 0.f};
    bf16x8 At[4][2], B0[2][2], B1[2][2];
    const char* cA = (const char*)g.A + (size_t)cur.pm * tstep; const char* cB = (const char*)g.Bt + (size_t)cur.pn * tstep;
    S.a_ready(cur);
    PG8_STAGE(PG8_SB(0, 0), cB, voffB); PG8_STAGE(PG8_SA(0, 0), cA, voffA); PG8_STAGE(PG8_SB(0, 1), cB + hstep, voffB); PG8_STAGE(PG8_SA(0, 1), cA + hstep, voffA);
    if (wr == 1) PG8_BAR;
    PG8_WAIT_V(4); PG8_BAR;
    PG8_STAGE(PG8_SB(1, 0), cB + kstep, voffB); PG8_STAGE(PG8_SA(1, 0), cA + kstep, voffA); PG8_STAGE(PG8_SB(1, 1), cB + hstep + kstep, voffB);
    PG8_WAIT_V(6); PG8_BAR;
    PG8_STAMP();
    for (;;) {
        const bool has_next = S.next(ui + 1, nxt);
        const char* nA = has_next ? (const char*)g.A + (size_t)nxt.pm * tstep : cA; const char* nB = has_next ? (const char*)g.Bt + (size_t)nxt.pn * tstep : cB;
        for (int t = 0; t < nt; t += 2) {
            const bool last = (t == nt - 2);
            const char* a1 = cA + (size_t)(t + 1) * kstep;
            const char* a2 = last ? nA : cA + (size_t)(t + 2) * kstep; const char* b2 = last ? nB : cB + (size_t)(t + 2) * kstep;
            const char* a3 = a2 + kstep; const char* b3 = b2 + kstep;
            if (last && has_next) S.a_ready(nxt);
            PG8_LDB(B0, 0, 0); PG8_SCHED; PG8_LDA(At, 0, 0); PG8_STAGE(PG8_SA(1, 1), a1 + hstep, voffA);
            PG8_WAIT_L(8); PG8_BAR; PG8_WAIT_L(0); PG8_MMA(0, 0, At, B0); PG8_BAR; PG8_SCHED;
            PG8_LDB(B1, 0, 1); PG8_STAGE(PG8_SB(0, 0), b2, voffB);
            PG8_BAR; PG8_WAIT_L(0); PG8_MMA(0, 1, At, B1); PG8_BAR;
            PG8_LDA(At, 0, 1); PG8_STAGE(PG8_SA(0, 0), a2, voffA);
            PG8_BAR; PG8_WAIT_L(0); PG8_MMA(1, 0, At, B0); PG8_BAR; PG8_SCHED;
            PG8_STAGE(PG8_SB(0, 1), b2 + hstep, voffB);
            PG8_WAIT_V(6); PG8_BAR; PG8_MMA(1, 1, At, B1); PG8_BAR;
            PG8_LDB(B0, 1, 0); PG8_SCHED; PG8_LDA(At, 1, 0); PG8_STAGE(PG8_SA(0, 1), a2 + hstep, voffA);
            PG8_WAIT_L(8); PG8_BAR; PG8_WAIT_L(0); PG8_MMA(0, 0, At, B0); PG8_BAR; PG8_SCHED;
            PG8_LDB(B1, 1, 1); PG8_STAGE(PG8_SB(1, 0), b3, voffB);
            PG8_BAR; PG8_WAIT_L(0); PG8_MMA(0, 1, At, B1); PG8_BAR;
            PG8_LDA(At, 1, 1); PG8_STAGE(PG8_SA(1, 0), a3, voffA);
            PG8_BAR; PG8_WAIT_L(0); PG8_MMA(1, 0, At, B0); PG8_BAR; PG8_SCHED;
            PG8_STAGE(PG8_SB(1, 1), b3 + hstep, voffB);
            PG8_WAIT_V(6); PG8_BAR; PG8_MMA(1, 1, At, B1); PG8_BAR;
        }
        PG8_STAMP();
        if constexpr (!Epi::AFTER_DRAIN) { E(acc, cur, wr, wc, fr, fq); S.done(cur); }
        PG8_STAMP();
        if (!has_next) break;
#pragma unroll
        for (int a = 0; a < 2; ++a)
#pragma unroll
            for (int b = 0; b < 2; ++b)
#pragma unroll
                for (int m = 0; m < 4; ++m)
#pragma unroll
                    for (int n = 0; n < 2; ++n) acc[a][b][m][n] = (f32x4){0.f, 0.f, 0.f, 0.f};
        cur = nxt; cA = nA; cB = nB; ++ui;
    }
    PG8_WAIT_V(0);
    if (wr == 0) PG8_BAR;
    PG8_BAR;
    if constexpr (Epi::AFTER_DRAIN) { E.fused(acc, cur, wr, wc, fr, fq, lds, wid, lane); S.done(cur); }
    PG8_STAMP();
    if (STAMP && wid == 0) { stamps[lane] = lane < nts ? (((unsigned long long)(unsigned)ts_hi << 32) | (unsigned)ts_lo) : 0ull;
        if (lane == 62) stamps[62] = rt_entry; if (lane == 63) stamps[63] = (unsigned long long)wall_clock64(); }
#undef PG8_STAMP
#undef PG8_SA
#undef PG8_SB
#undef PG8_STAGE
#undef PG8_LDA
#undef PG8_LDB
#undef PG8_MMA
#undef PG8_WAIT_V
#undef PG8_WAIT_L
#undef PG8_BAR
#undef PG8_SCHED
}
}

#define LAS __attribute__((address_space(3)))
typedef unsigned short u16;
typedef float f32x4 __attribute__((ext_vector_type(4)));
typedef unsigned u32x4 __attribute__((ext_vector_type(4)));
typedef unsigned u32x2 __attribute__((ext_vector_type(2)));
using pg8::cvt_pk_bf16;

constexpr int MT = 36864, NPR = 4096, DM = 1024, DFF = 2816;
constexpr int OUT_STATE = MT * DM;
constexpr int LDS_BYTES = 163840, PTAB_OFF = 163840 - 256;

constexpr size_t SZ_W13 = (size_t)5632 * 1024 * 2, SZ_W2 = (size_t)1024 * 2816 * 2;
constexpr size_t WS_W13A = 0, WS_W2A = WS_W13A + SZ_W13, WS_W13B = WS_W2A + SZ_W2, WS_W2B = WS_W13B + SZ_W13;
constexpr size_t WS_WIN = WS_W2B + SZ_W2;
constexpr size_t WS_WZ = WS_WIN + (size_t)4096 * 1024 * 2;
constexpr size_t WS_WO = WS_WZ + (size_t)1024 * 1024 * 2;
constexpr size_t WS_WF = WS_WO + (size_t)1024 * 512 * 2;
constexpr size_t WS_WOUT = WS_WF + (size_t)1024 * 512 * 2;
constexpr size_t WS_GUP = WS_WOUT + (size_t)1024 * 1024 * 2;
constexpr size_t WS_MOD = WS_GUP + (size_t)512 * 256 * 2;
constexpr size_t WS_BS = WS_MOD + (size_t)9 * 9216 * 4;
constexpr size_t WS_SG = WS_BS + (size_t)MT * 16 * 4;
constexpr size_t WS_H = WS_SG + (size_t)MT * 256 * 2;
constexpr size_t WS_BIG = WS_H + (size_t)MT * 1024 * 2;
constexpr size_t WS_U16 = WS_BIG;
constexpr size_t WS_FOUR = WS_U16 + (size_t)MT * 1792 * 2;
constexpr size_t WS_OPRE = WS_FOUR + (size_t)MT * 512 * 2;
constexpr size_t WS_R = WS_BIG + (size_t)MT * 2816 * 2;
constexpr size_t WS_T = WS_R;
constexpr size_t WS_T256 = WS_T + (size_t)4096 * 8192 * 2;
constexpr size_t WS_ZL = WS_T256 + (size_t)256 * 512 * 2;
constexpr size_t WS_ZP = WS_ZL + (size_t)4096 * 8192 * 2;
constexpr int GLD = 2304;
constexpr size_t WS_END = WS_R + (size_t)MT * GLD * 2;
static_assert(WS_ZP + (size_t)8192 * 512 * 2 <= WS_END, "R region");
static_assert(WS_OPRE + (size_t)MT * 512 * 2 <= WS_R, "BIG region");
static_assert(WS_END <= (size_t)536870912, "workspace");
static_assert(WS_ZP == WS_ZL + (size_t)4096 * 8192 * 2, "ZP behind ZL");

struct Params { const float* in[30]; float* out; unsigned char* ws; };
__device__ __forceinline__ unsigned long long ld_ptr(LAS unsigned char* lds, int i) {
    const u32x2 v = *(const LAS u32x2*)(lds + PTAB_OFF + i * 8);
    const unsigned lo = __builtin_amdgcn_readfirstlane(v.x), hi = __builtin_amdgcn_readfirstlane(v.y);
    return ((unsigned long long)hi << 32) | lo;
}
template <class T> __device__ __forceinline__ T* as_global(unsigned long long v) {
    return (T*)(__attribute__((address_space(1))) T*)v;
}
__device__ __forceinline__ Params get_params(LAS unsigned char* lds) {
    Params Q;
#pragma unroll
    for (int i = 0; i < 30; ++i) Q.in[i] = as_global<const float>(ld_ptr(lds, i));
    Q.out = as_global<float>(ld_ptr(lds, 30)); Q.ws = as_global<unsigned char>(ld_ptr(lds, 31));
    return Q;
}
__device__ __forceinline__ float bf2f(unsigned v16) { return __uint_as_float(v16 << 16); }
__device__ __forceinline__ float h2f(unsigned v16) { return (float)__builtin_bit_cast(_Float16, (unsigned short)v16); }
__device__ __forceinline__ unsigned pk_h(float a, float b) {
    const unsigned short ua = __builtin_bit_cast(unsigned short, (_Float16)a), ub = __builtin_bit_cast(unsigned short, (_Float16)b);
    return (unsigned)ua | ((unsigned)ub << 16);
}
__device__ __forceinline__ float sigmoidf_(float x) { return __builtin_amdgcn_rcpf(1.0f + __expf(-x)); }
__device__ __forceinline__ int modidx_pm(int pm) { return pm < 16 ? 8 : ((pm - 16) >> 4); }
__device__ __forceinline__ int modidx_m(int m) { return m < NPR ? 8 : ((m - NPR) >> 12); }

struct EpiSwiglu {
    static constexpr bool PERM = true, AFTER_DRAIN = false;
    u16* G;
    __device__ __forceinline__ void operator()(const f32x4 (&acc)[2][2][4][2], const pg8::Unit& u, int wr, int wc, int fr, int fq) const {
        const int row0 = u.pm * 256 + wr * 64 + fr, col0 = u.pn * 128 + wc * 32 + 8 * fq;
#pragma unroll
        for (int ai = 0; ai < 2; ++ai)
#pragma unroll
            for (int m = 0; m < 4; ++m) {
                float g[8];
#pragma unroll
                for (int n = 0; n < 2; ++n)
#pragma unroll
                    for (int j = 0; j < 4; ++j) { const float a = acc[ai][0][m][n][j], b = acc[ai][1][m][n][j]; g[n * 4 + j] = a * sigmoidf_(a) * b; }
                u32x4 w; w.x = cvt_pk_bf16(g[0], g[1]); w.y = cvt_pk_bf16(g[2], g[3]); w.z = cvt_pk_bf16(g[4], g[5]); w.w = cvt_pk_bf16(g[6], g[7]);
                *(u32x4*)(G + (size_t)(row0 + ai * 128 + m * 16) * DFF + col0) = w;
            }
    }
};
struct EpiResid {
    static constexpr bool PERM = false, AFTER_DRAIN = false;
    const float* xp; const float* xs; float* X; const float* MOD; int slot; float coef;
    __device__ __forceinline__ void operator()(const f32x4 (&acc)[2][2][4][2], const pg8::Unit& u, int wr, int wc, int fr, int fq) const {
        const int row0 = u.pm * 256 + wr * 64 + fr, col0 = u.pn * 256 + wc * 32 + 4 * fq;
        const float* g = MOD + (size_t)modidx_pm(u.pm) * 9216 + slot * 1024 + col0;
        f32x4 gv[2][2];
#pragma unroll
        for (int bj = 0; bj < 2; ++bj)
#pragma unroll
            for (int n = 0; n < 2; ++n) gv[bj][n] = *(const f32x4*)(g + bj * 128 + n * 16) * coef;
#pragma unroll
        for (int ai = 0; ai < 2; ++ai)
#pragma unroll
            for (int m = 0; m < 4; ++m) {
                const int row = row0 + ai * 128 + m * 16;
                const float* src = (xp ? (row < NPR ? xp + (size_t)row * DM : xs + (size_t)(row - NPR) * DM) : X + (size_t)row * DM) + col0;
                float* dst = X + (size_t)row * DM + col0;
#pragma unroll
                for (int bj = 0; bj < 2; ++bj)
#pragma unroll
                    for (int n = 0; n < 2; ++n) *(f32x4*)(dst + bj * 128 + n * 16) = *(const f32x4*)(src + bj * 128 + n * 16) + gv[bj][n] * acc[ai][bj][m][n];
            }
    }
};
struct EpiU {
    static constexpr bool PERM = true, AFTER_DRAIN = false;
    u16* U; u16* SG; u16* GATES; const float* gate_b;
    __device__ __forceinline__ void operator()(const f32x4 (&acc)[2][2][4][2], const pg8::Unit& u, int wr, int wc, int fr, int fq) const {
        const int row0 = u.pm * 256 + wr * 64 + fr, ct = wc * 32 + 8 * fq;
        if (u.pn < 7) {
#pragma unroll
            for (int ai = 0; ai < 2; ++ai)
#pragma unroll
                for (int m = 0; m < 4; ++m)
#pragma unroll
                    for (int bj = 0; bj < 2; ++bj) { const f32x4 v0 = acc[ai][bj][m][0], v1 = acc[ai][bj][m][1];
                        u32x4 w; w.x = pk_h(v0[0], v0[1]); w.y = pk_h(v0[2], v0[3]); w.z = pk_h(v1[0], v1[1]); w.w = pk_h(v1[2], v1[3]);
                        *(u32x4*)(U + (size_t)(row0 + ai * 128 + m * 16) * 1792 + u.pn * 256 + bj * 128 + ct) = w; }
        } else {
            const int gc0 = (u.pn == 7 ? 2048 : (u.pn - 8) * 256) + ct;
#pragma unroll
            for (int bj = 0; bj < 2; ++bj) {
                const int gbi = (u.pn == 7 ? 0 : (u.pn - 8) * 256) + ct; const float bsc = u.pn == 7 ? 0.f : 1.f;
                const f32x4 b0 = *(const f32x4*)(gate_b + gbi + bj * 128) * bsc, b1 = *(const f32x4*)(gate_b + gbi + bj * 128 + 4) * bsc;
#pragma unroll
                for (int ai = 0; ai < 2; ++ai)
#pragma unroll
                    for (int m = 0; m < 4; ++m) { const f32x4 v0 = acc[ai][bj][m][0] + b0, v1 = acc[ai][bj][m][1] + b1;
                        u32x4 w; w.x = pk_h(sigmoidf_(v0[0]), sigmoidf_(v0[1])); w.y = pk_h(sigmoidf_(v0[2]), sigmoidf_(v0[3]));
                        w.z = pk_h(sigmoidf_(v1[0]), sigmoidf_(v1[1])); w.w = pk_h(sigmoidf_(v1[2]), sigmoidf_(v1[3]));
                        *(u32x4*)(GATES + (size_t)(row0 + ai * 128 + m * 16) * GLD + gc0 + bj * 128) = w; }
            }
        }
    }
};
struct EpiZT {
    static constexpr bool PERM = true, AFTER_DRAIN = false;
    u16* ZL;
    __device__ __forceinline__ void operator()(const f32x4 (&acc)[2][2][4][2], const pg8::Unit& u, int wr, int wc, int fr, int fq) const {
#pragma unroll
        for (int bj = 0; bj < 2; ++bj) {
            const int c0 = u.pn * 256 + bj * 128 + wc * 32 + 8 * fq;
#pragma unroll
            for (int ai = 0; ai < 2; ++ai)
#pragma unroll
                for (int m = 0; m < 4; ++m) {
                    const int zr = u.pm * 256 + ai * 128 + wr * 64 + m * 16 + fr, g = zr >> 8, part = (zr >> 7) & 1, kn = zr & 127;
                    size_t off;
                    if (u.pn < 16) off = (size_t)4096 * 8192 + ((size_t)(u.pn * 512 + g * 128 + kn) * 512 + part * 256 + (c0 - u.pn * 256));
                    else { const int tok = c0 - NPR, b = tok >> 12, rc = tok & 4095; off = (size_t)(b * 512 + g * 128 + kn) * 8192 + part * 4096 + rc; }
                    u16* dst = ZL + off;
                    const f32x4 v0 = acc[ai][bj][m][0], v1 = acc[ai][bj][m][1];
                    u32x4 w; w.x = cvt_pk_bf16(v0[0], v0[1]); w.y = cvt_pk_bf16(v0[2], v0[3]); w.z = cvt_pk_bf16(v1[0], v1[1]); w.w = cvt_pk_bf16(v1[2], v1[3]);
                    *(u32x4*)dst = w;
                }
        }
    }
};
struct EpiFour {
    static constexpr bool PERM = true, AFTER_DRAIN = false;
    u16* FOUR; int latent;
    __device__ __forceinline__ void operator()(const f32x4 (&acc)[2][2][4][2], const pg8::Unit& u, int wr, int wc, int fr, int fq) const {
        const int b = u.pn >> 1, ch0 = (u.pn & 1) * 256 + wc * 32 + 8 * fq;
        const int tok0 = (latent ? NPR + b * 4096 : b * 256) + u.pm * 256 + wr * 64 + fr;
#pragma unroll
        for (int ai = 0; ai < 2; ++ai)
#pragma unroll
            for (int m = 0; m < 4; ++m)
#pragma unroll
                for (int bj = 0; bj < 2; ++bj) { const f32x4 v0 = acc[ai][bj][m][0], v1 = acc[ai][bj][m][1];
                    u32x4 w; w.x = cvt_pk_bf16(v0[0], v0[1]); w.y = cvt_pk_bf16(v0[2], v0[3]); w.z = cvt_pk_bf16(v1[0], v1[1]); w.w = cvt_pk_bf16(v1[2], v1[3]);
                    *(u32x4*)(FOUR + (size_t)(tok0 + ai * 128 + m * 16) * 512 + ch0 + bj * 128) = w; }
    }
};
struct EpiMul {
    static constexpr bool PERM = true, AFTER_DRAIN = false;
    u16* O; const u16* GATES; int mode;
    __device__ __forceinline__ void operator()(const f32x4 (&acc)[2][2][4][2], const pg8::Unit& u, int wr, int wc, int fr, int fq) const {
        const int row0 = u.pm * 256 + wr * 64 + fr, col0 = u.pn * 256 + wc * 32 + 8 * fq;
        const int ld = mode == 0 ? 512 : 1024;
#pragma unroll
        for (int ai = 0; ai < 2; ++ai)
#pragma unroll
            for (int m = 0; m < 4; ++m)
#pragma unroll
                for (int bj = 0; bj < 2; ++bj) {
                    const int row = row0 + ai * 128 + m * 16, col = col0 + bj * 128;
                    u16* p = O + (size_t)row * ld + col;
                    float v[8];
#pragma unroll
                    for (int j = 0; j < 4; ++j) { v[j] = acc[ai][bj][m][0][j]; v[4 + j] = acc[ai][bj][m][1][j]; }
                    if (mode == 0) {
                        const u32x4 q = *(const u32x4*)p;
#pragma unroll
                        for (int j = 0; j < 4; ++j) { v[2 * j] *= bf2f(q[j] & 0xffffu); v[2 * j + 1] *= bf2f(q[j] >> 16); }
                    } else {
                        const u32x4 gq = *(const u32x4*)(GATES + (size_t)row * GLD + (mode == 2 ? 1024 : 0) + col);
#pragma unroll
                        for (int j = 0; j < 4; ++j) { v[2 * j] *= h2f(gq[j] & 0xffffu); v[2 * j + 1] *= h2f(gq[j] >> 16); }
                        if (mode == 2) { const u32x4 q = *(const u32x4*)p;
#pragma unroll
                            for (int j = 0; j < 4; ++j) { v[2 * j] += bf2f(q[j] & 0xffffu); v[2 * j + 1] += bf2f(q[j] >> 16); } }
                    }
                    u32x4 w; w.x = cvt_pk_bf16(v[0], v[1]); w.y = cvt_pk_bf16(v[2], v[3]); w.z = cvt_pk_bf16(v[4], v[5]); w.w = cvt_pk_bf16(v[6], v[7]);
                    *(u32x4*)p = w;
                }
    }
};

template <class Epi>
__device__ __forceinline__ void run_gemm(LAS unsigned char* lds, const u16* A, const u16* Bt, int M, int N, int K, const Epi& E) {
    pg8::Gemm g{A, Bt, M, N, K}; pg8::StaticOrder S; S.init(M, N, (int)gridDim.x, (int)blockIdx.x);
    pg8::gemm_phase<Epi, pg8::StaticOrder, false>(lds, g, S, E, nullptr);
}

__device__ __forceinline__ void transpose_tile(const float* src, int ld_src, int col0, int k0, int krows, u16* dst, int n0, int K, LAS float* tile) {
    const int t = threadIdx.x;
#pragma unroll
    for (int i = 0; i < 8; ++i) { const int kk = (t >> 6) + 8 * i, nn = t & 63;
        float v = 0.f; if (col0 >= 0 && k0 + kk < krows) v = src[(size_t)(k0 + kk) * ld_src + col0 + nn];
        tile[kk * 65 + nn] = v; }
    __syncthreads();
    const int nn = t >> 3, ks = (t & 7) * 8;
    float v[8];
#pragma unroll
    for (int j = 0; j < 8; ++j) v[j] = tile[(ks + j) * 65 + nn];
    u32x4 w; w.x = cvt_pk_bf16(v[0], v[1]); w.y = cvt_pk_bf16(v[2], v[3]); w.z = cvt_pk_bf16(v[4], v[5]); w.w = cvt_pk_bf16(v[6], v[7]);
    *(u32x4*)(dst + (size_t)(n0 + nn) * K + k0 + ks) = w;
    __syncthreads();
}

__device__ __forceinline__ void phase_prep(const Params& P, LAS unsigned char* lds) {
    LAS float* L = (LAS float*)lds;
    LAS float* tile = L;
    LAS float* cs128 = L + 4160; LAS float* sn128 = cs128 + 128;
    LAS float* cs64 = sn128 + 128;  LAS float* sn64 = cs64 + 64;
    LAS float* cs256 = sn64 + 64;   LAS float* sn256 = cs256 + 256;
    LAS float* frow = sn256 + 256;
    LAS float* sc = frow + 512;
    LAS float* red = sc + 9216;
    const int tid = threadIdx.x, G = gridDim.x, bid = blockIdx.x;
    unsigned char* ws = P.ws;
    if (tid < 256) { float s, c; sincospif(2.0f * (float)tid / 256.0f, &s, &c); cs256[tid] = c; sn256[tid] = s; }
    if (tid < 128) { float s, c; sincospif(2.0f * (float)tid / 128.0f, &s, &c); cs128[tid] = c; sn128[tid] = s; }
    if (tid < 64)  { float s, c; sincospif(2.0f * (float)tid / 64.0f, &s, &c); cs64[tid] = c; sn64[tid] = s; }
    __syncthreads();

    if (bid < 144) {
        for (int i = tid; i < 9216; i += 512) { const int v = i >> 10, k = i & 1023; const float x = v < 8 ? P.in[4][v * 1024 + k] : P.in[5][k]; sc[i] = x / (1.0f + expf(-x)); }
        __syncthreads();
        const int c = tid & 63, kg = tid >> 6; const float* aw = P.in[6] + bid * 64 + c;
        float a[9];
#pragma unroll
        for (int v = 0; v < 9; ++v) a[v] = 0.f;
        for (int k = kg; k < 1024; k += 8) { const float w = aw[(size_t)k * 9216];
#pragma unroll
            for (int v = 0; v < 9; ++v) a[v] += sc[v * 1024 + k] * w; }
#pragma unroll
        for (int v = 0; v < 9; ++v) red[(kg * 9 + v) * 64 + c] = a[v];
        __syncthreads();
        float* MOD = (float*)(ws + WS_MOD);
        for (int i = tid; i < 576; i += 512) { const int v = i >> 6, cc = i & 63; float s = 0.f;
#pragma unroll
            for (int q = 0; q < 8; ++q) s += red[(q * 9 + v) * 64 + cc];
            MOD[v * 9216 + bid * 64 + cc] = s + P.in[7][bid * 64 + cc]; }
        __syncthreads();
    }

    {
        const int total = 5792;
        for (int q = bid; q < total; q += G) {
            int j = 0, r = q, nk = 16;
#define PREP_STEP(JJ, CNT, NKN) if (j == JJ && r >= (CNT)) { r -= (CNT); j = JJ + 1; nk = NKN; }
            PREP_STEP(0, 88 * 16, 44) PREP_STEP(1, 16 * 44, 16) PREP_STEP(2, 88 * 16, 44) PREP_STEP(3, 16 * 44, 16)
            PREP_STEP(4, 64 * 16, 8) PREP_STEP(5, 16 * 8, 8) PREP_STEP(6, 16 * 8, 16) PREP_STEP(7, 16 * 16, 4)
#undef PREP_STEP
            const int tn = r / nk, tk = r % nk, n0 = tn * 64, k0 = tk * 64;
            const float* src; int ld, krows, Kd, col0 = n0; u16* dst;
            if (j == 0 || j == 2) { src = j == 0 ? P.in[9] : P.in[11]; ld = 5632; krows = 1024; Kd = 1024; dst = (u16*)(ws + (j == 0 ? WS_W13A : WS_W13B));
                const int pn = n0 >> 8, rr = n0 & 255; col0 = rr < 128 ? 128 * pn + rr : 2816 + 128 * pn + (rr - 128); }
            else if (j == 1 || j == 3) { src = j == 1 ? P.in[10] : P.in[12]; ld = 1024; krows = 2816; Kd = 2816; dst = (u16*)(ws + (j == 1 ? WS_W2A : WS_W2B)); }
            else if (j == 4) { src = P.in[13]; ld = 4480; krows = 1024; Kd = 1024; dst = (u16*)(ws + WS_WIN);
                col0 = n0 < 1920 ? n0 : (n0 < 2048 ? -1 : 2432 + (n0 - 2048)); }
            else if (j == 5) { src = P.in[26]; ld = 1024; krows = 512; Kd = 512; dst = (u16*)(ws + WS_WO); }
            else if (j == 6) { src = P.in[27]; ld = 1024; krows = 512; Kd = 512; dst = (u16*)(ws + WS_WF); }
            else if (j == 7) { src = P.in[28]; ld = 1024; krows = 1024; Kd = 1024; dst = (u16*)(ws + WS_WOUT); }
            else { src = P.in[20]; ld = 512; krows = 128; Kd = 256; dst = (u16*)(ws + WS_GUP); }
            transpose_tile(src, ld, col0, k0, krows, dst, n0, Kd, tile);
        }
    }

    {
        u16* WZ = (u16*)(ws + WS_WZ);
        for (int k = bid; k < 1024; k += G) {
            frow[tid] = P.in[13][(size_t)k * 4480 + 1920 + tid];
            __syncthreads();
#pragma unroll
            for (int rep = 0; rep < 2; ++rep) { const int zc = tid + rep * 512, g = zc >> 8, part = (zc >> 7) & 1, kn = zc & 127;
                const LAS float* tab = part ? sn128 : cs128; float s = 0.f;
                for (int n = 0; n < 128; ++n) s += frow[g * 128 + n] * tab[(kn * n) & 127];
                s *= 0.08838834764831845f; if (part) s = -s;
                WZ[(size_t)zc * 1024 + k] = (u16)(cvt_pk_bf16(s, 0.f) & 0xffffu); }
            __syncthreads();
        }
    }

    {
        u16* T = (u16*)(ws + WS_T);
        for (size_t vi = (size_t)bid * 512 + tid; vi < (size_t)4096 * 1024; vi += (size_t)G * 512) {
            const int row = (int)(vi >> 10), cv = (int)(vi & 1023) * 8, part = cv >> 12, r = (cv >> 6) & 63, c0 = cv & 63, kr = row >> 6, kc = row & 63;
            const LAS float* tab = part ? sn64 : cs64; const int base = kr * r;
            float v[8];
#pragma unroll
            for (int j = 0; j < 8; ++j) v[j] = tab[(base + kc * (c0 + j)) & 63] * 0.015625f;
            u32x4 w; w.x = cvt_pk_bf16(v[0], v[1]); w.y = cvt_pk_bf16(v[2], v[3]); w.z = cvt_pk_bf16(v[4], v[5]); w.w = cvt_pk_bf16(v[6], v[7]);
            *(u32x4*)(T + vi * 8) = w;
        }
        u16* T2 = (u16*)(ws + WS_T256);
        for (int vi = bid * 512 + tid; vi < 256 * 64; vi += G * 512) {
            const int kt = vi >> 6, cv = (vi & 63) * 8, part = cv >> 8, t0 = cv & 255;
            const LAS float* tab = part ? sn256 : cs256;
            float v[8];
#pragma unroll
            for (int j = 0; j < 8; ++j) v[j] = tab[(kt * (t0 + j)) & 255] * 0.0625f;
            u32x4 w; w.x = cvt_pk_bf16(v[0], v[1]); w.y = cvt_pk_bf16(v[2], v[3]); w.z = cvt_pk_bf16(v[4], v[5]); w.w = cvt_pk_bf16(v[6], v[7]);
            *(u32x4*)(T2 + (size_t)vi * 8) = w;
        }
    }
}

template <int CTRL> __device__ __forceinline__ float dpp_add(float v) {
    return v + __int_as_float(__builtin_amdgcn_update_dpp(0, __float_as_int(v), CTRL, 0xF, 0xF, true));
}
__device__ __forceinline__ float sum16(float v) {
    v = dpp_add<0xB1>(v); v = dpp_add<0x4E>(v); v = dpp_add<0x141>(v); v = dpp_add<0x140>(v); return v;
}
__device__ __forceinline__ float sum64(float v) {
    const float t = sum16(v);
    const int ti = __float_as_int(t);
    return __int_as_float(__builtin_amdgcn_readlane(ti, 0)) + __int_as_float(__builtin_amdgcn_readlane(ti, 16)) + __int_as_float(__builtin_amdgcn_readlane(ti, 32)) + __int_as_float(__builtin_amdgcn_readlane(ti, 48));
}
__device__ __forceinline__ float wave_sum(float v) {
#pragma unroll
    for (int o = 32; o >= 1; o >>= 1) v += __shfl_xor(v, o);
    return v;
}
__device__ __forceinline__ const float* norm_row(const Params& P, const float* X, int m) {
    return X ? X + (size_t)m * DM : (m < NPR ? P.in[0] + (size_t)m * DM : P.in[1] + (size_t)(m - NPR) * DM);
}
__device__ __forceinline__ void phase_norm(const Params& P, const float* X, int nwi, int slot_shift, int slot_scale, u16* H) {
    const int lane = threadIdx.x & 63, gw = blockIdx.x * 8 + (threadIdx.x >> 6), nw = gridDim.x * 8;
    const float* MOD = (const float*)(P.ws + WS_MOD); const float* normw = P.in[8] + nwi * 1024;
    f32x4 v[4], vn[4];
    if (gw < MT) { const float* xr = norm_row(P, X, gw);
#pragma unroll
        for (int i = 0; i < 4; ++i) v[i] = *(const f32x4*)(xr + i * 256 + lane * 4); }
    for (int m = gw; m < MT; m += nw) {
        const int mn = m + nw < MT ? m + nw : m;
        { const float* xr = norm_row(P, X, mn);
#pragma unroll
          for (int i = 0; i < 4; ++i) vn[i] = *(const f32x4*)(xr + i * 256 + lane * 4); }
        float ss = 0.f;
#pragma unroll
        for (int i = 0; i < 4; ++i) ss += v[i][0] * v[i][0] + v[i][1] * v[i][1] + v[i][2] * v[i][2] + v[i][3] * v[i][3];
        ss = sum64(ss);
        const float rs = rsqrtf(ss * (1.0f / 1024.0f) + 1e-6f);
        const float* md = MOD + (size_t)modidx_m(m) * 9216;
#pragma unroll
        for (int i = 0; i < 4; ++i) { const int c = i * 256 + lane * 4;
            const f32x4 w = *(const f32x4*)(normw + c), sc = *(const f32x4*)(md + slot_scale * 1024 + c), sh = *(const f32x4*)(md + slot_shift * 1024 + c);
            const f32x4 y = v[i] * rs * w * (sc + 1.0f) + sh;
            u32x2 o; o.x = cvt_pk_bf16(y[0], y[1]); o.y = cvt_pk_bf16(y[2], y[3]);
            *(u32x2*)(H + (size_t)m * DM + c) = o; }
#pragma unroll
        for (int i = 0; i < 4; ++i) v[i] = vn[i];
    }
}
__device__ __forceinline__ void phase_final_norm(const Params& P) {
    const int lane = threadIdx.x & 63, gw = blockIdx.x * 8 + (threadIdx.x >> 6), nw = gridDim.x * 8;
    const float* fw = P.in[29];
    f32x4 v[4], vn[4];
    if (gw < MT) { const float* xr = P.out + (size_t)gw * DM;
#pragma unroll
        for (int i = 0; i < 4; ++i) v[i] = *(const f32x4*)(xr + i * 256 + lane * 4); }
    for (int m = gw; m < MT; m += nw) {
        const int mn = m + nw < MT ? m + nw : m;
        { const float* xr = P.out + (size_t)mn * DM;
#pragma unroll
          for (int i = 0; i < 4; ++i) vn[i] = *(const f32x4*)(xr + i * 256 + lane * 4); }
        float ss = 0.f;
#pragma unroll
        for (int i = 0; i < 4; ++i) ss += v[i][0] * v[i][0] + v[i][1] * v[i][1] + v[i][2] * v[i][2] + v[i][3] * v[i][3];
        ss = sum64(ss);
        const float rs = rsqrtf(ss * (1.0f / 1024.0f) + 1e-6f);
        float* xo = P.out + (size_t)m * DM;
#pragma unroll
        for (int i = 0; i < 4; ++i) { const int c = i * 256 + lane * 4; *(f32x4*)(xo + c) = v[i] * rs * *(const f32x4*)(fw + c); }
#pragma unroll
        for (int i = 0; i < 4; ++i) v[i] = vn[i];
    }
}

__device__ __forceinline__ float fsig(float x) { return __builtin_amdgcn_rcpf(1.0f + __expf(-x)); }
struct ScanRegs { u32x2 r[3], k[3], v[3], wd, ad; };
__device__ __forceinline__ void scan_load(ScanRegs& R, const u16* U, int tok0, int T, int t, int h, int d, int cg) {
    const u32x2 z = {0u, 0u};
#pragma unroll
    for (int tap = 0; tap < 3; ++tap) { const int tn = t + tap - 1;
        if (tn >= 0 && tn < T) { const u16* row = U + (size_t)(tok0 + tn) * 1792 + h * 64 + 4 * cg;
            R.r[tap] = *(const u32x2*)row; R.k[tap] = *(const u32x2*)(row + 512); R.v[tap] = *(const u32x2*)(row + 1024); }
        else { R.r[tap] = z; R.k[tap] = z; R.v[tap] = z; } }
    const u16* row = U + (size_t)(tok0 + t) * 1792 + 1536 + d * 64 + 4 * cg;
    R.wd = *(const u32x2*)row; R.ad = *(const u32x2*)(row + 128);
}
__device__ __forceinline__ void unpack4h(const u32x2 q, float (&o)[4]) { o[0] = h2f(q.x & 0xffffu); o[1] = h2f(q.x >> 16); o[2] = h2f(q.y & 0xffffu); o[3] = h2f(q.y >> 16); }

#define LDS_BARRIER() do { asm volatile("s_waitcnt lgkmcnt(0)" ::: "memory"); __builtin_amdgcn_s_barrier(); asm volatile("" ::: "memory"); } while (0)
__device__ __forceinline__ void scan_unit(const Params& P, LAS float* L, int s, int h, int d, int half) {
    typedef float f32x16 __attribute__((ext_vector_type(16)));
    const int tid = threadIdx.x, lane = tid & 63;
    const bool producer = tid >= 256;
    const int T = s < 16 ? 256 : 4096, tok0 = s < 16 ? s * 256 : NPR + (s - 16) * 4096, nchunk = T / 32;
    const u16* U = (const u16*)(P.ws + WS_U16);
    u16* Od = (u16*)(P.ws + WS_H) + (size_t)d * MT * 512;
    float* BS = (float*)(P.ws + WS_BS);
    LAS float* cst = L;            LAS float* xwT = L + 1024;    LAS float* xaT = L + 3072;   LAS float* lora_s = L + 5120;
    LAS float* o_sb = L + 13312;   LAS float* cb = L + 15360;
    if (tid < 64) { const int c = tid, ch = h * 64 + c;
        cst[c] = P.in[16][d * 512 + ch]; cst[64 + c] = P.in[18][d * 512 + ch]; cst[128 + c] = P.in[21][ch]; cst[192 + c] = P.in[22][ch]; cst[256 + c] = P.in[23][ch];
#pragma unroll
        for (int ten = 0; ten < 3; ++ten)
#pragma unroll
            for (int tap = 0; tap < 3; ++tap) cst[(5 + ten * 3 + tap) * 64 + c] = P.in[15][tap * 1536 + ten * 512 + ch]; }
    const int c16 = tid & 15, rp = (tid >> 4) & 15, rA = half * 32 + rp, rB = rA + 16;
    f32x4 SA = {0.f, 0.f, 0.f, 0.f}, SB = {0.f, 0.f, 0.f, 0.f};
    if (!producer && s >= 16) { const float* st = (d ? P.in[3] : P.in[2]) + (size_t)((s - 16) * 8 + h) * 4096;
        SA = *(const f32x4*)(st + rA * 64 + 4 * c16); SB = *(const f32x4*)(st + rB * 64 + 4 * c16); }
    const int pt = tid - 256, pw = (pt >> 6) & 3, nt = pw & 1, kh = pw >> 1, li = lane & 31, lk = lane >> 5;
    float Bw[16], Ba[16];
    if (producer) {
#pragma unroll
        for (int s2 = 0; s2 < 16; ++s2) { const size_t o = (size_t)(d * 64 + kh * 32 + 2 * s2 + lk) * 512 + h * 64 + nt * 32 + li; Bw[s2] = P.in[17][o]; Ba[s2] = P.in[19][o]; }
    } else {
#pragma unroll
        for (int s2 = 0; s2 < 16; ++s2) { Bw[s2] = 0.f; Ba[s2] = 0.f; }
    }
    const int it0 = pt & 255, tt0 = it0 >> 4, cg0 = it0 & 15, tt1 = tt0 + 16, cg1 = cg0;
    ScanRegs R0, R1;
    if (producer) { scan_load(R0, U, tok0, T, d ? T - 1 - tt0 : tt0, h, d, cg0); scan_load(R1, U, tok0, T, d ? T - 1 - tt1 : tt1, h, d, cg1); }
    __syncthreads();
    for (int ci = -1; ci < nchunk; ++ci) {
        const int pc = ci + 1;
        LAS float* pb = cb + (pc & 1) * 12288;
        const LAS float* qb = cb + (ci & 1) * 12288;
        LAS float* o_s = o_sb + (ci & 1) * 1024;
        const bool do_prep = producer && pc < nchunk, do_step = !producer && ci >= 0;
        LAS float* r_s = pb; LAS float* w_s = pb + 2048; LAS float* kd_s = pb + 4096; LAS float* v_s = pb + 6144; LAS float* kk_s = pb + 8192; LAS float* kka_s = pb + 10240;
#define SCAN_STEPS(SEG) if (do_step) { float oAr[8], oBr[8]; float pA = 0.f, pB = 0.f;     \
        _Pragma("unroll") for (int u8 = 0; u8 < 8; ++u8) { const int tt = (SEG) * 8 + u8; \
            const f32x4 w4 = *(const LAS f32x4*)(qb + 2048 + tt * 64 + 4 * c16), kk4 = *(const LAS f32x4*)(qb + 8192 + tt * 64 + 4 * c16), ka4 = *(const LAS f32x4*)(qb + 10240 + tt * 64 + 4 * c16); \
            const f32x4 kd4 = *(const LAS f32x4*)(qb + 4096 + tt * 64 + 4 * c16), r4 = *(const LAS f32x4*)(qb + tt * 64 + 4 * c16); \
            const float vA = qb[6144 + tt * 64 + rA], vB = qb[6144 + tt * 64 + rB]; \
            float saA = SA[0] * kk4[0] + SA[1] * kk4[1] + SA[2] * kk4[2] + SA[3] * kk4[3], saB = SB[0] * kk4[0] + SB[1] * kk4[1] + SB[2] * kk4[2] + SB[3] * kk4[3]; \
            saA = dpp_add<0xB1>(saA); saB = dpp_add<0xB1>(saB); pA = dpp_add<0xB1>(pA); pB = dpp_add<0xB1>(pB); \
            saA = dpp_add<0x4E>(saA); saB = dpp_add<0x4E>(saB); pA = dpp_add<0x4E>(pA); pB = dpp_add<0x4E>(pB); \
            saA = dpp_add<0x141>(saA); saB = dpp_add<0x141>(saB); pA = dpp_add<0x141>(pA); pB = dpp_add<0x141>(pB); \
            saA = dpp_add<0x140>(saA); saB = dpp_add<0x140>(saB); pA = dpp_add<0x140>(pA); pB = dpp_add<0x140>(pB); \
            if (u8 > 0) { oAr[u8 - 1] = pA; oBr[u8 - 1] = pB; } \
            SA = SA * w4 - ka4 * saA + kd4 * vA; SB = SB * w4 - ka4 * saB + kd4 * vB; \
            pA = SA[0] * r4[0] + SA[1] * r4[1] + SA[2] * r4[2] + SA[3] * r4[3]; pB = SB[0] * r4[0] + SB[1] * r4[1] + SB[2] * r4[2] + SB[3] * r4[3]; } \
        pA = dpp_add<0xB1>(pA); pB = dpp_add<0xB1>(pB); pA = dpp_add<0x4E>(pA); pB = dpp_add<0x4E>(pB); pA = dpp_add<0x141>(pA); pB = dpp_add<0x141>(pB); pA = dpp_add<0x140>(pA); pB = dpp_add<0x140>(pB); \
        oAr[7] = pA; oBr[7] = pB; \
        if (c16 == 0) { _Pragma("unroll") for (int u8 = 0; u8 < 8; ++u8) { o_s[((SEG) * 8 + u8) * 32 + rp] = oAr[u8]; o_s[((SEG) * 8 + u8) * 32 + 16 + rp] = oBr[u8]; } } }
        if (do_prep) {
#pragma unroll
            for (int it = 0; it < 2; ++it) { const ScanRegs& R = it ? R1 : R0; const int tt_a = it ? tt1 : tt0, cg = cg0;
                float rv[4] = {0.f, 0.f, 0.f, 0.f}, kv[4] = {0.f, 0.f, 0.f, 0.f}, vv[4] = {0.f, 0.f, 0.f, 0.f};
#pragma unroll
                for (int tap = 0; tap < 3; ++tap) { float a[4], bb[4], c[4]; unpack4h(R.r[tap], a); unpack4h(R.k[tap], bb); unpack4h(R.v[tap], c);
#pragma unroll
                    for (int j = 0; j < 4; ++j) { rv[j] += a[j] * cst[(5 + tap) * 64 + 4 * cg + j]; kv[j] += bb[j] * cst[(8 + tap) * 64 + 4 * cg + j]; vv[j] += c[j] * cst[(11 + tap) * 64 + 4 * cg + j]; } }
                float kkr[4], ss = 0.f;
#pragma unroll
                for (int j = 0; j < 4; ++j) { kkr[j] = kv[j] * cst[128 + 4 * cg + j]; ss += kkr[j] * kkr[j]; }
                ss = sum16(ss);
                const float inv = __builtin_amdgcn_rsqf(fmaxf(ss, 1e-24f));
                float wdv[4], adv[4]; unpack4h(R.wd, wdv); unpack4h(R.ad, adv);
#pragma unroll
                for (int j = 0; j < 4; ++j) { const int o = tt_a * 64 + 4 * cg + j;
                    r_s[o] = rv[j]; v_s[o] = vv[j]; kd_s[o] = kv[j]; kk_s[o] = kkr[j] * inv;
                    xwT[(4 * cg + j) * 32 + tt_a] = 1.0f - 2.0f * __builtin_amdgcn_rcpf(1.0f + __expf(2.0f * wdv[j])); xaT[(4 * cg + j) * 32 + tt_a] = adv[j]; } }
            if (pc + 1 < nchunk) { const int q0 = (pc + 1) * 32 + tt0, q1 = (pc + 1) * 32 + tt1;
                scan_load(R0, U, tok0, T, d ? T - 1 - q0 : q0, h, d, cg0); scan_load(R1, U, tok0, T, d ? T - 1 - q1 : q1, h, d, cg1); }
        }
        SCAN_STEPS(0)
        LDS_BARRIER();
        if (do_prep) {
            f32x16 accw, acca;
#pragma unroll
            for (int i = 0; i < 16; ++i) { accw[i] = 0.f; acca[i] = 0.f; }
#pragma unroll
            for (int s2 = 0; s2 < 16; ++s2) { const int r = kh * 32 + 2 * s2 + lk;
                accw = __builtin_amdgcn_mfma_f32_32x32x2f32(xwT[r * 32 + li], Bw[s2], accw, 0, 0, 0);
                acca = __builtin_amdgcn_mfma_f32_32x32x2f32(xaT[r * 32 + li], Ba[s2], acca, 0, 0, 0); }
#pragma unroll
            for (int reg = 0; reg < 16; ++reg) { const int o = ((reg & 3) + 8 * (reg >> 2) + 4 * lk) * 64 + nt * 32 + li;
                lora_s[(0 * 2 + kh) * 2048 + o] = accw[reg]; lora_s[(1 * 2 + kh) * 2048 + o] = acca[reg]; }
        }
        SCAN_STEPS(1)
        LDS_BARRIER();
        if (do_prep) {
            const int c = pt & 63, tg = pt >> 6;
#pragma unroll
            for (int j = 0; j < 8; ++j) { const int tt = 8 * tg + j, o = tt * 64 + c;
                const float wl = cst[c] + lora_s[o] + lora_s[2048 + o];
                const float w = __expf(-0.6065306597f * fsig(wl));
                const float a = fsig(cst[64 + c] + lora_s[4096 + o] + lora_s[6144 + o]);
                const float k = kd_s[o], kk = kk_s[o];
                const float kd = k * (1.0f + (a - 1.0f) * cst[192 + c]);
                kd_s[o] = kd; kka_s[o] = kk * a; w_s[o] = w;
                const float bsum = sum64(r_s[o] * kd * cst[256 + c]);
                if (lane == 0 && half == 0) { const int q = pc * 32 + tt, t = d ? T - 1 - q : q; BS[(size_t)(tok0 + t) * 16 + h * 2 + d] = bsum; } }
        }
        SCAN_STEPS(2)
        LDS_BARRIER();
        SCAN_STEPS(3)
        LDS_BARRIER();
        if (do_step) { const int tt = tid >> 3, seg = tid & 7, q = ci * 32 + tt, t = d ? T - 1 - q : q;
            u32x2 w2; w2.x = cvt_pk_bf16(o_s[tt * 32 + 4 * seg], o_s[tt * 32 + 4 * seg + 1]); w2.y = cvt_pk_bf16(o_s[tt * 32 + 4 * seg + 2], o_s[tt * 32 + 4 * seg + 3]);
            *(u32x2*)(Od + (size_t)(tok0 + t) * 512 + h * 64 + half * 32 + 4 * seg) = w2; }
#undef SCAN_STEPS
    }
    if (!producer && s < 16) { float* so = P.out + OUT_STATE + (size_t)d * 524288 + (size_t)(s * 8 + h) * 4096;
        *(f32x4*)(so + rA * 64 + 4 * c16) = SA; *(f32x4*)(so + rB * 64 + 4 * c16) = SB; }
    __syncthreads();
}
__device__ __forceinline__ void phase_scan(const Params& P, LAS unsigned char* lds) {
    for (int q = blockIdx.x; q < 768; q += gridDim.x) {
        int s, rem;
        if (q < 256) { s = 16 + (q >> 5); rem = q & 31; } else { const int p = q - 256; s = p >> 5; rem = p & 31; }
        scan_unit(P, (LAS float*)lds, s, rem >> 2, (rem >> 1) & 1, rem & 1);
    }
}

struct PostRaw { unsigned of, ob, v0, v1, v2, sg; float b0, b1; };
__device__ __forceinline__ void post_load(PostRaw& r, int m, int ch, int h, int lane, const u16* OF, const u16* OB, const u16* U, const float* BS, const u16* GT) {
    const int T = m < NPR ? 256 : 4096, t = m < NPR ? (m & 255) : ((m - NPR) & 4095);
    r.of = OF[(size_t)m * 512 + ch]; r.ob = OB[(size_t)m * 512 + ch];
    r.v1 = U[(size_t)m * 1792 + 1024 + ch];
    r.v0 = t > 0 ? U[(size_t)(m - 1) * 1792 + 1024 + ch] : 0u;
    r.v2 = t < T - 1 ? U[(size_t)(m + 1) * 1792 + 1024 + ch] : 0u;
    r.sg = *(const unsigned*)(GT + (size_t)m * GLD + 2048 + 2 * lane);
    r.b0 = BS[(size_t)m * 16 + h * 2]; r.b1 = BS[(size_t)m * 16 + h * 2 + 1];
}
__device__ __forceinline__ void phase_post(const Params& P, LAS unsigned char* lds) {
    const int lane = threadIdx.x & 63, h = threadIdx.x >> 6, ch = h * 64 + lane, G = gridDim.x;
    const u16* OF = (const u16*)(P.ws + WS_H); const u16* OB = OF + (size_t)MT * 512;
    const u16* U = (const u16*)(P.ws + WS_U16); const float* BS = (const float*)(P.ws + WS_BS);
    u16* OPRE = (u16*)(P.ws + WS_OPRE); const u16* GT = (const u16*)(P.ws + WS_R);
    LAS float* sgl = (LAS float*)lds + h * 128;
    float gu[128];
#pragma unroll
    for (int k = 0; k < 128; ++k) gu[k] = P.in[20][(size_t)k * 512 + ch];
    const float lw = P.in[24][ch], lb = P.in[25][ch];
    const float cv0 = P.in[15][0 * 1536 + 1024 + ch], cv1 = P.in[15][1 * 1536 + 1024 + ch], cv2 = P.in[15][2 * 1536 + 1024 + ch];
    PostRaw cur, nxt;
    int m = blockIdx.x;
    post_load(cur, m, ch, h, lane, OF, OB, U, BS, GT);
    for (; m < MT; m += G) {
        const int mn = m + G < MT ? m + G : m;
        post_load(nxt, mn, ch, h, lane, OF, OB, U, BS, GT);
        sgl[2 * lane] = h2f(cur.sg & 0xffffu); sgl[2 * lane + 1] = h2f(cur.sg >> 16);
        const float o = bf2f(cur.of) + bf2f(cur.ob);
        const float mean = sum64(o) * (1.0f / 64.0f), d = o - mean;
        const float rstd = rsqrtf(sum64(d * d) * (1.0f / 64.0f) + 64e-5f);
        const float v = h2f(cur.v0) * cv0 + h2f(cur.v1) * cv1 + h2f(cur.v2) * cv2;
        float g0 = 0.f, g1 = 0.f, g2 = 0.f, g3 = 0.f;
#pragma unroll
        for (int k = 0; k < 128; k += 4) { const f32x4 s4 = *(const LAS f32x4*)(sgl + k);
            g0 += s4[0] * gu[k]; g1 += s4[1] * gu[k + 1]; g2 += s4[2] * gu[k + 2]; g3 += s4[3] * gu[k + 3]; }
        const float y = (d * rstd * lw + lb + (cur.b0 + cur.b1) * v) * ((g0 + g1) + (g2 + g3));
        OPRE[(size_t)m * 512 + ch] = (u16)(cvt_pk_bf16(y, 0.f) & 0xffffu);
        cur = nxt;
    }
}


constexpr size_t WS_BAR = WS_END + 65536;
static_assert(WS_BAR + 4096 <= (size_t)536870912, "barrier words");
__device__ __forceinline__ void fast_grid_sync(unsigned char* ws, unsigned k) {
    asm volatile("s_waitcnt vmcnt(0) lgkmcnt(0)" ::: "memory");
    __builtin_amdgcn_s_barrier();
    if (threadIdx.x == 0) {
        unsigned* bar = (unsigned*)(ws + WS_BAR);
        const unsigned G = gridDim.x, g = blockIdx.x & 7u, gsz = (G - g + 7u) >> 3, ngrp = G < 8u ? G : 8u;
        __builtin_amdgcn_fence(__ATOMIC_RELEASE, "agent");
        asm volatile("s_waitcnt vmcnt(0)" ::: "memory");
        const unsigned old = __hip_atomic_fetch_add(bar + g * 32, 1u, __ATOMIC_RELAXED, __HIP_MEMORY_SCOPE_AGENT);
        if (old + 1u == k * gsz) __hip_atomic_fetch_add(bar + 8 * 32, 1u, __ATOMIC_RELAXED, __HIP_MEMORY_SCOPE_AGENT);
        unsigned spins = 0;
        while (__hip_atomic_load(bar + 8 * 32, __ATOMIC_RELAXED, __HIP_MEMORY_SCOPE_AGENT) < k * ngrp) { if (++spins > (1u << 24)) break; __builtin_amdgcn_s_sleep(1); }
        __builtin_amdgcn_fence(__ATOMIC_ACQUIRE, "agent");
        asm volatile("s_waitcnt vmcnt(0)" ::: "memory");
    }
    __builtin_amdgcn_s_barrier();
    asm volatile("" ::: "memory");
}

__global__ void __launch_bounds__(512, 2) fwd_mega(Params P) {
    extern __shared__ __attribute__((aligned(16))) unsigned char lds_raw[];
    LAS unsigned char* lds = (LAS unsigned char*)lds_raw;
    cg::grid_group grid = cg::this_grid();
    if (threadIdx.x < 32) { const int i = threadIdx.x; const unsigned long long v = i < 30 ? (unsigned long long)P.in[i] : (i == 30 ? (unsigned long long)P.out : (unsigned long long)P.ws);
        *(LAS unsigned long long*)(lds + PTAB_OFF + i * 8) = v; }
    __syncthreads();
unsigned bark_ = 0; unsigned char* P_ws_ = P.ws;
#define PH_BEGIN { const Params Q = get_params(lds); unsigned char* ws = Q.ws; (void)ws;
#define PH_END } asm volatile("s_waitcnt vmcnt(0)" ::: "memory");   grid.sync();
#define PH_ENDF } fast_grid_sync(P_ws_, ++bark_);
    if (blockIdx.x == 0 && threadIdx.x < 9) ((unsigned*)(P.ws + WS_BAR))[threadIdx.x * 32] = 0u;
    PH_BEGIN phase_prep(Q, lds); PH_END
    PH_BEGIN phase_norm(Q, nullptr, 0, 0, 1, (u16*)(ws + WS_H)); PH_ENDF
    PH_BEGIN run_gemm(lds, (const u16*)(ws + WS_H), (const u16*)(ws + WS_W13A), MT, 5632, 1024, EpiSwiglu{(u16*)(ws + WS_BIG)}); PH_ENDF
    PH_BEGIN run_gemm(lds, (const u16*)(ws + WS_BIG), (const u16*)(ws + WS_W2A), MT, 1024, 2816, EpiResid{Q.in[0], Q.in[1], Q.out, (const float*)(ws + WS_MOD), 2, 0.5f}); PH_ENDF
    PH_BEGIN phase_norm(Q, Q.out, 1, 3, 4, (u16*)(ws + WS_H)); PH_ENDF
    PH_BEGIN run_gemm(lds, (const u16*)(ws + WS_WZ), (const u16*)(ws + WS_H), 1024, MT, 1024, EpiZT{(u16*)(ws + WS_ZL)}); PH_ENDF
    PH_BEGIN run_gemm(lds, (const u16*)(ws + WS_T), (const u16*)(ws + WS_ZL), 4096, 4096, 8192, EpiFour{(u16*)(ws + WS_FOUR), 1});
             run_gemm(lds, (const u16*)(ws + WS_T256), (const u16*)(ws + WS_ZP), 256, 8192, 512, EpiFour{(u16*)(ws + WS_FOUR), 0}); PH_ENDF
    PH_BEGIN run_gemm(lds, (const u16*)(ws + WS_H), (const u16*)(ws + WS_WIN), MT, 4096, 1024, EpiU{(u16*)(ws + WS_U16), (u16*)(ws + WS_SG), (u16*)(ws + WS_R), Q.in[14]}); PH_ENDF
    PH_BEGIN phase_scan(Q, lds); PH_ENDF
    PH_BEGIN phase_post(Q, lds); PH_ENDF
    PH_BEGIN run_gemm(lds, (const u16*)(ws + WS_OPRE), (const u16*)(ws + WS_WO), MT, 1024, 512, EpiMul{(u16*)(ws + WS_H), (const u16*)(ws + WS_R), 1}); PH_ENDF
    PH_BEGIN run_gemm(lds, (const u16*)(ws + WS_FOUR), (const u16*)(ws + WS_WF), MT, 1024, 512, EpiMul{(u16*)(ws + WS_H), (const u16*)(ws + WS_R), 2}); PH_ENDF
    PH_BEGIN run_gemm(lds, (const u16*)(ws + WS_H), (const u16*)(ws + WS_WOUT), MT, 1024, 1024, EpiResid{nullptr, nullptr, Q.out, (const float*)(ws + WS_MOD), 5, 1.0f}); PH_ENDF
    PH_BEGIN phase_norm(Q, Q.out, 2, 6, 7, (u16*)(ws + WS_H)); PH_ENDF
    PH_BEGIN run_gemm(lds, (const u16*)(ws + WS_H), (const u16*)(ws + WS_W13B), MT, 5632, 1024, EpiSwiglu{(u16*)(ws + WS_BIG)}); PH_ENDF
    PH_BEGIN run_gemm(lds, (const u16*)(ws + WS_BIG), (const u16*)(ws + WS_W2B), MT, 1024, 2816, EpiResid{nullptr, nullptr, Q.out, (const float*)(ws + WS_MOD), 8, 0.5f}); PH_ENDF
    { const Params Q = get_params(lds); phase_final_norm(Q); }
#undef PH_BEGIN
#undef PH_END
#undef PH_ENDF
}

extern "C" void kernel_launch(void* const* d_in, const int* in_sizes, int n_in, void* d_out, int out_size, void* d_ws, size_t ws_size, hipStream_t stream) {
    static int grid_blocks = 0;
    if (grid_blocks == 0) {
        if (n_in != 30 || ws_size < WS_END) { fprintf(stderr, "kernel_launch: unexpected n_in %d / ws_size %zu (need %zu)\n", n_in, ws_size, (size_t)WS_END); grid_blocks = -1; return; }
        int dev = 0, cus = 0, per_cu = 0;
        (void)hipGetDevice(&dev);
        (void)hipDeviceGetAttribute(&cus, hipDeviceAttributeMultiprocessorCount, dev);
        (void)hipFuncSetAttribute((const void*)fwd_mega, hipFuncAttributeMaxDynamicSharedMemorySize, LDS_BYTES);
        (void)hipOccupancyMaxActiveBlocksPerMultiprocessor(&per_cu, (const void*)fwd_mega, 512, LDS_BYTES);
        if (per_cu < 1) { fprintf(stderr, "kernel_launch: occupancy query reports %d blocks per CU\n", per_cu); per_cu = 1; }
        if (per_cu > 1) per_cu = 1;
        grid_blocks = cus * per_cu;
        (void)hipGetLastError();
    }
    if (grid_blocks < 0) return;
    Params p{};
    for (int i = 0; i < 30; ++i) p.in[i] = (const float*)d_in[i];
    p.out = (float*)d_out; p.ws = (unsigned char*)d_ws;
    void* args[] = {&p};
    hipError_t e = hipLaunchCooperativeKernel((const void*)fwd_mega, dim3(grid_blocks), dim3(512), args, LDS_BYTES, stream);
    if (e != hipSuccess) fprintf(stderr, "cooperative launch failed: %s (grid %d)\n", hipGetErrorString(e), grid_blocks);
}
```

```cpp
#include <hip/hip_runtime.h>
#include <hip/hip_cooperative_groups.h>
#include <cstdio>
namespace cg = cooperative_groups;
namespace pg8 {
#define PG8_LAS __attribute__((address_space(3)))
typedef unsigned short bf16_t;
typedef short bf16x8 __attribute__((ext_vector_type(8)));
typedef float f32x4 __attribute__((ext_vector_type(4)));
typedef unsigned u32x4 __attribute__((ext_vector_type(4)));
constexpr int BM = 256, BK = 64, HALF = 128, HTB = HALF * BK * 2  , STAGE_BYTES = 8 * HTB, NXCD = 8, WGM = 8;

__host__ __device__ __forceinline__ int lds_byte(int r, int c) { const int st = (r >> 4) * 2 + (c >> 5), rr = r & 15, cc = c & 31, ob = rr * 64 + cc * 2; return st * 1024 + (ob ^ (((ob >> 9) & 1) << 5)); }
__host__ __device__ __forceinline__ void stage_rc(int b, int& R, int& C) { const int st = b / 1024, sb = b % 1024, swz = sb ^ (((sb >> 9) & 1) << 5); R = (st >> 1) * 16 + swz / 64; C = (st & 1) * 32 + (swz % 64) / 2; }
__host__ __device__ __forceinline__ int perm32(int rho) { const int n = rho >> 4, i = rho & 15; return 8 * (i >> 2) + 4 * n + (i & 3); }

struct Unit { int pm, pn; };
struct Gemm { const bf16_t* A; const bf16_t* Bt; int M, N, K; };

struct StaticOrder {
    int nM, nN, nwg, G, c;
    __host__ __device__ __forceinline__ void init(int M, int N, int G_, int c_) { nM = M / BM; nN = N / BM; nwg = nM * nN; G = G_; c = c_; }
    __host__ __device__ __forceinline__ bool next(int i, Unit& u) const {
        const long L = (long)i * G + c; if (L >= nwg) return false;
        int wgid = (int)L; { const int q = nwg / NXCD, r = nwg % NXCD, xcd = wgid % NXCD, off = wgid / NXCD; wgid = (xcd < r ? xcd * (q + 1) : r * (q + 1) + (xcd - r) * q) + off; }
        const int nig = WGM * nN, gid = wgid / nig, fm = gid * WGM, gsz = (nM - fm) < WGM ? (nM - fm) : WGM;
        u.pm = fm + ((wgid % nig) % gsz); u.pn = (wgid % nig) / gsz; return true;
    }
    __device__ __forceinline__ void a_ready(const Unit&) const {}
    __device__ __forceinline__ void done(const Unit&) const {}
};
__device__ __forceinline__ unsigned cvt_pk_bf16(float lo, float hi) { unsigned r; asm volatile("v_cvt_pk_bf16_f32 %0, %1, %2" : "=v"(r) : "v"(lo), "v"(hi)); return r; }
template <class Epi, class Sched, bool STAMP = false>
__device__ __forceinline__ void gemm_phase(PG8_LAS unsigned char* lds, const Gemm g, const Sched& S, const Epi& E, unsigned long long* stamps) {
    int tid_ = threadIdx.x; asm volatile("" : "+v"(tid_));
    const int tid = tid_, wid = __builtin_amdgcn_readfirstlane(tid >> 6), lane = tid & 63, wr = wid >> 2, wc = wid & 3, fr = lane & 15, fq = lane >> 4;
    const int K = g.K, nt = K / BK;
    int ts_lo = 0, ts_hi = 0, nts = 0; const unsigned long long rt_entry = STAMP ? (unsigned long long)wall_clock64() : 0ull;
#define PG8_STAMP() do { if (STAMP && wid == 0 && nts < 64) { const unsigned long long _c = (unsigned long long)clock64(); \
        ts_lo = (lane == nts) ? (int)(unsigned)_c : ts_lo; ts_hi = (lane == nts) ? (int)(unsigned)(_c >> 32) : ts_hi; ++nts; } } while (0)
    PG8_STAMP();
    unsigned voffA[2], voffB[2];
#pragma unroll
    for (int i = 0; i < 2; ++i) { int R, C; stage_rc(tid * 16 + i * 8192, R, C); const int Rb = Epi::PERM ? ((R & ~31) + perm32(R & 31)) : R;
        voffA[i] = (unsigned)(R * K + C) * 2u; voffB[i] = (unsigned)(Rb * K + C) * 2u; }
    const size_t kstep = (size_t)(BK * 2);
    const size_t hstep = (size_t)HALF * K * 2;
    const size_t tstep = 2 * hstep;
    const unsigned ldsw = (unsigned)wid * 1024u;
    const int aoff = lds_byte(wr * 64 + fr, fq * 8), boff = lds_byte(wc * 32 + fr, fq * 8);
#define PG8_SA(b, h) (((b) * 2 + (h)) * HTB)
#define PG8_SB(b, h) ((4 + (b) * 2 + (h)) * HTB)
#define PG8_STAGE(bufoff, gbase, voff) do { _Pragma("unroll") for (int _i = 0; _i < 2; ++_i) \
        __builtin_amdgcn_global_load_lds((const unsigned*)((const char*)(gbase) + (voff)[_i]), (PG8_LAS unsigned*)(lds + (bufoff) + ldsw + _i * 8192), 16, 0, 0); } while (0)
#define PG8_LDA(dst, b, h) do { _Pragma("unroll") for (int m = 0; m < 4; ++m) _Pragma("unroll") for (int k = 0; k < 2; ++k) dst[m][k] = *(const PG8_LAS bf16x8*)(lds + PG8_SA(b, h) + aoff + m * 2048 + k * 1024); } while (0)
#define PG8_LDB(dst, b, h) do { _Pragma("unroll") for (int n = 0; n < 2; ++n) _Pragma("unroll") for (int k = 0; k < 2; ++k) dst[n][k] = *(const PG8_LAS bf16x8*)(lds + PG8_SB(b, h) + boff + n * 2048 + k * 1024); } while (0)
#define PG8_MMA(ai, bj, At, Bt) do { __builtin_amdgcn_s_setprio(1); _Pragma("unroll") for (int m = 0; m < 4; ++m) _Pragma("unroll") for (int n = 0; n < 2; ++n) _Pragma("unroll") for (int k = 0; k < 2; ++k) \
        acc[ai][bj][m][n] = __builtin_amdgcn_mfma_f32_16x16x32_bf16(Bt[n][k], At[m][k], acc[ai][bj][m][n], 0, 0, 0); __builtin_amdgcn_s_setprio(0); } while (0)
#define PG8_WAIT_V(n) asm volatile("s_waitcnt vmcnt(" #n ")" ::: "memory")
#define PG8_WAIT_L(n) asm volatile("s_waitcnt lgkmcnt(" #n ")" ::: "memory")
#define PG8_BAR __builtin_amdgcn_s_barrier()
#define PG8_SCHED __builtin_amdgcn_sched_barrier(0)
    Unit cur, nxt; int ui = 0;
    if (!S.next(0, cur)) return;
    f32x4 acc[2][2][4][2];
#pragma unroll
    for (int a = 0; a < 2; ++a)
#pragma unroll
        for (int b = 0; b < 2; ++b)
#pragma unroll
            for (int m = 0; m < 4; ++m)
#pragma unroll
                for (int n = 0; n < 2; ++n) acc[a][b][m][n] = (f32x4){0.f, 0.f, 0.f, 0.f};
    bf16x8 At[4][2], B0[2][2], B1[2][2];
    const char* cA = (const char*)g.A + (size_t)cur.pm * tstep; const char* cB = (const char*)g.Bt + (size_t)cur.pn * tstep;
    S.a_ready(cur);
    PG8_STAGE(PG8_SB(0, 0), cB, voffB); PG8_STAGE(PG8_SA(0, 0), cA, voffA); PG8_STAGE(PG8_SB(0, 1), cB + hstep, voffB); PG8_STAGE(PG8_SA(0, 1), cA + hstep, voffA);
    if (wr == 1) PG8_BAR;
    PG8_WAIT_V(4); PG8_BAR;
    PG8_STAGE(PG8_SB(1, 0), cB + kstep, voffB); PG8_STAGE(PG8_SA(1, 0), cA + kstep, voffA); PG8_STAGE(PG8_SB(1, 1), cB + hstep + kstep, voffB);
    PG8_WAIT_V(6); PG8_BAR;
    PG8_STAMP();
    for (;;) {
        const bool has_next = S.next(ui + 1, nxt);
        const char* nA = has_next ? (const char*)g.A + (size_t)nxt.pm * tstep : cA; const char* nB = has_next ? (const char*)g.Bt + (size_t)nxt.pn * tstep : cB;
        for (int t = 0; t < nt; t += 2) {
            const bool last = (t == nt - 2);
            const char* a1 = cA + (size_t)(t + 1) * kstep;
            const char* a2 = last ? nA : cA + (size_t)(t + 2) * kstep; const char* b2 = last ? nB : cB + (size_t)(t + 2) * kstep;
            const char* a3 = a2 + kstep; const char* b3 = b2 + kstep;
            if (last && has_next) S.a_ready(nxt);
            PG8_LDB(B0, 0, 0); PG8_SCHED; PG8_LDA(At, 0, 0); PG8_STAGE(PG8_SA(1, 1), a1 + hstep, voffA);
            PG8_WAIT_L(8); PG8_BAR; PG8_WAIT_L(0); PG8_MMA(0, 0, At, B0); PG8_BAR; PG8_SCHED;
            PG8_LDB(B1, 0, 1); PG8_STAGE(PG8_SB(0, 0), b2, voffB);
            PG8_BAR; PG8_WAIT_L(0); PG8_MMA(0, 1, At, B1); PG8_BAR;
            PG8_LDA(At, 0, 1); PG8_STAGE(PG8_SA(0, 0), a2, voffA);
            PG8_BAR; PG8_WAIT_L(0); PG8_MMA(1, 0, At, B0); PG8_BAR; PG8_SCHED;
            PG8_STAGE(PG8_SB(0, 1), b2 + hstep, voffB);
            PG8_WAIT_V(6); PG8_BAR; PG8_MMA(1, 1, At, B1); PG8_BAR;
            PG8_LDB(B0, 1, 0); PG8_SCHED; PG8_LDA(At, 1, 0); PG8_STAGE(PG8_SA(0, 1), a2 + hstep, voffA);
            PG8_WAIT_L(8); PG8_BAR; PG8_WAIT_L(0); PG8_MMA(0, 0, At, B0); PG8_BAR; PG8_SCHED;
            PG8_LDB(B1, 1, 1); PG8_STAGE(PG8_SB(1, 0), b3, voffB);
            PG8_BAR; PG8_WAIT_L(0); PG8_MMA(0, 1, At, B1); PG8_BAR;
            PG8_LDA(At, 1, 1); PG8_STAGE(PG8_SA(1, 0), a3, voffA);
            PG8_BAR; PG8_WAIT_L(0); PG8_MMA(1, 0, At, B0); PG8_BAR; PG8_SCHED;
            PG8_STAGE(PG8_SB(1, 1), b3 + hstep, voffB);
            PG8_WAIT_V(6); PG8_BAR; PG8_MMA(1, 1, At, B1); PG8_BAR;
        }
        PG8_STAMP();
        if constexpr (!Epi::AFTER_DRAIN) { E(acc, cur, wr, wc, fr, fq); S.done(cur); }
        PG8_STAMP();
        if (!has_next) break;
#pragma unroll
        for (int a = 0; a < 2; ++a)
#pragma unroll
            for (int b = 0; b < 2; ++b)
#pragma unroll
                for (int m = 0; m < 4; ++m)
#pragma unroll
                    for (int n = 0; n < 2; ++n) acc[a][b][m][n] = (f32x4){0.f, 0.f, 0.f, 0.f};
        cur = nxt; cA = nA; cB = nB; ++ui;
    }
    PG8_WAIT_V(0);
    if (wr == 0) PG8_BAR;
    PG8_BAR;
    if constexpr (Epi::AFTER_DRAIN) { E.fused(acc, cur, wr, wc, fr, fq, lds, wid, lane); S.done(cur); }
    PG8_STAMP();
    if (STAMP && wid == 0) { stamps[lane] = lane < nts ? (((unsigned long long)(unsigned)ts_hi << 32) | (unsigned)ts_lo) : 0ull;
        if (lane == 62) stamps[62] = rt_entry; if (lane == 63) stamps[63] = (unsigned long long)wall_clock64(); }
#undef PG8_STAMP
#undef PG8_SA
#undef PG8_SB
#undef PG8_STAGE
#undef PG8_LDA
#undef PG8_LDB
#undef PG8_MMA
#undef PG8_WAIT_V
#undef PG8_WAIT_L
#undef PG8_BAR
#undef PG8_SCHED
}
}

#define LAS __attribute__((address_space(3)))
typedef unsigned short u16;
typedef float f32x4 __attribute__((ext_vector_type(4)));
typedef unsigned u32x4 __attribute__((ext_vector_type(4)));
typedef unsigned u32x2 __attribute__((ext_vector_type(2)));
using pg8::cvt_pk_bf16;

constexpr int MT = 36864, NPR = 4096, DM = 1024, DFF = 2816;
constexpr int OUT_STATE = MT * DM;
constexpr int LDS_BYTES = 163840, PTAB_OFF = 163840 - 256;

constexpr size_t SZ_W13 = (size_t)5632 * 1024 * 2, SZ_W2 = (size_t)1024 * 2816 * 2;
constexpr size_t WS_W13A = 0, WS_W2A = WS_W13A + SZ_W13, WS_W13B = WS_W2A + SZ_W2, WS_W2B = WS_W13B + SZ_W13;
constexpr size_t WS_WIN = WS_W2B + SZ_W2;
constexpr size_t WS_WZ = WS_WIN + (size_t)4096 * 1024 * 2;
constexpr size_t WS_WO = WS_WZ + (size_t)1024 * 1024 * 2;
constexpr size_t WS_WF = WS_WO + (size_t)1024 * 512 * 2;
constexpr size_t WS_WOUT = WS_WF + (size_t)1024 * 512 * 2;
constexpr size_t WS_GUP = WS_WOUT + (size_t)1024 * 1024 * 2;
constexpr size_t WS_MOD = WS_GUP + (size_t)512 * 256 * 2;
constexpr size_t WS_BS = WS_MOD + (size_t)9 * 9216 * 4;
constexpr size_t WS_SG = WS_BS + (size_t)MT * 16 * 4;
constexpr size_t WS_H = WS_SG + (size_t)MT * 256 * 2;
constexpr size_t WS_BIG = WS_H + (size_t)MT * 1024 * 2;
constexpr size_t WS_U16 = WS_BIG;
constexpr size_t WS_FOUR = WS_U16 + (size_t)MT * 1792 * 2;
constexpr size_t WS_OPRE = WS_FOUR + (size_t)MT * 512 * 2;
constexpr size_t WS_R = WS_BIG + (size_t)MT * 2816 * 2;
constexpr size_t WS_T = WS_R;
constexpr size_t WS_T256 = WS_T + (size_t)4096 * 8192 * 2;
constexpr size_t WS_ZL = WS_T256 + (size_t)256 * 512 * 2;
constexpr size_t WS_ZP = WS_ZL + (size_t)4096 * 8192 * 2;
constexpr int GLD = 2304;
constexpr size_t WS_END = WS_R + (size_t)MT * GLD * 2;
static_assert(WS_ZP + (size_t)8192 * 512 * 2 <= WS_END, "R region");
static_assert(WS_OPRE + (size_t)MT * 512 * 2 <= WS_R, "BIG region");
static_assert(WS_END <= (size_t)536870912, "workspace");
static_assert(WS_ZP == WS_ZL + (size_t)4096 * 8192 * 2, "ZP behind ZL");

struct Params { const float* in[30]; float* out; unsigned char* ws; };
__device__ __forceinline__ unsigned long long ld_ptr(LAS unsigned char* lds, int i) {
    const u32x2 v = *(const LAS u32x2*)(lds + PTAB_OFF + i * 8);
    const unsigned lo = __builtin_amdgcn_readfirstlane(v.x), hi = __builtin_amdgcn_readfirstlane(v.y);
    return ((unsigned long long)hi << 32) | lo;
}
template <class T> __device__ __forceinline__ T* as_global(unsigned long long v) {
    return (T*)(__attribute__((address_space(1))) T*)v;
}
__device__ __forceinline__ Params get_params(LAS unsigned char* lds) {
    Params Q;
#pragma unroll
    for (int i = 0; i < 30; ++i) Q.in[i] = as_global<const float>(ld_ptr(lds, i));
    Q.out = as_global<float>(ld_ptr(lds, 30)); Q.ws = as_global<unsigned char>(ld_ptr(lds, 31));
    return Q;
}
__device__ __forceinline__ float bf2f(unsigned v16) { return __uint_as_float(v16 << 16); }
__device__ __forceinline__ float h2f(unsigned v16) { return (float)__builtin_bit_cast(_Float16, (unsigned short)v16); }
__device__ __forceinline__ unsigned pk_h(float a, float b) {
    const unsigned short ua = __builtin_bit_cast(unsigned short, (_Float16)a), ub = __builtin_bit_cast(unsigned short, (_Float16)b);
    return (unsigned)ua | ((unsigned)ub << 16);
}
__device__ __forceinline__ float sigmoidf_(float x) { return __builtin_amdgcn_rcpf(1.0f + __expf(-x)); }
__device__ __forceinline__ int modidx_pm(int pm) { return pm < 16 ? 8 : ((pm - 16) >> 4); }
__device__ __forceinline__ int modidx_m(int m) { return m < NPR ? 8 : ((m - NPR) >> 12); }

struct EpiSwiglu {
    static constexpr bool PERM = true, AFTER_DRAIN = false;
    u16* G;
    __device__ __forceinline__ void operator()(const f32x4 (&acc)[2][2][4][2], const pg8::Unit& u, int wr, int wc, int fr, int fq) const {
        const int row0 = u.pm * 256 + wr * 64 + fr, col0 = u.pn * 128 + wc * 32 + 8 * fq;
#pragma unroll
        for (int ai = 0; ai < 2; ++ai)
#pragma unroll
            for (int m = 0; m < 4; ++m) {
                float g[8];
#pragma unroll
                for (int n = 0; n < 2; ++n)
#pragma unroll
                    for (int j = 0; j < 4; ++j) { const float a = acc[ai][0][m][n][j], b = acc[ai][1][m][n][j]; g[n * 4 + j] = a * sigmoidf_(a) * b; }
                u32x4 w; w.x = cvt_pk_bf16(g[0], g[1]); w.y = cvt_pk_bf16(g[2], g[3]); w.z = cvt_pk_bf16(g[4], g[5]); w.w = cvt_pk_bf16(g[6], g[7]);
                *(u32x4*)(G + (size_t)(row0 + ai * 128 + m * 16) * DFF + col0) = w;
            }
    }
};
struct EpiResid {
    static constexpr bool PERM = false, AFTER_DRAIN = false;
    const float* xp; const float* xs; float* X; const float* MOD; int slot; float coef;
    __device__ __forceinline__ void operator()(const f32x4 (&acc)[2][2][4][2], const pg8::Unit& u, int wr, int wc, int fr, int fq) const {
        const int row0 = u.pm * 256 + wr * 64 + fr, col0 = u.pn * 256 + wc * 32 + 4 * fq;
        const float* g = MOD + (size_t)modidx_pm(u.pm) * 9216 + slot * 1024 + col0;
        f32x4 gv[2][2];
#pragma unroll
        for (int bj = 0; bj < 2; ++bj)
#pragma unroll
            for (int n = 0; n < 2; ++n) gv[bj][n] = *(const f32x4*)(g + bj * 128 + n * 16) * coef;
#pragma unroll
        for (int ai = 0; ai < 2; ++ai)
#pragma unroll
            for (int m = 0; m < 4; ++m) {
                const int row = row0 + ai * 128 + m * 16;
                const float* src = (xp ? (row < NPR ? xp + (size_t)row * DM : xs + (size_t)(row - NPR) * DM) : X + (size_t)row * DM) + col0;
                float* dst = X + (size_t)row * DM + col0;
#pragma unroll
                for (int bj = 0; bj < 2; ++bj)
#pragma unroll
                    for (int n = 0; n < 2; ++n) *(f32x4*)(dst + bj * 128 + n * 16) = *(const f32x4*)(src + bj * 128 + n * 16) + gv[bj][n] * acc[ai][bj][m][n];
            }
    }
};
struct EpiU {
    static constexpr bool PERM = true, AFTER_DRAIN = false;
    u16* U; u16* SG; u16* GATES; const float* gate_b;
    __device__ __forceinline__ void operator()(const f32x4 (&acc)[2][2][4][2], const pg8::Unit& u, int wr, int wc, int fr, int fq) const {
        const int row0 = u.pm * 256 + wr * 64 + fr, ct = wc * 32 + 8 * fq;
        if (u.pn < 7) {
#pragma unroll
            for (int ai = 0; ai < 2; ++ai)
#pragma unroll
                for (int m = 0; m < 4; ++m)
#pragma unroll
                    for (int bj = 0; bj < 2; ++bj) { const f32x4 v0 = acc[ai][bj][m][0], v1 = acc[ai][bj][m][1];
                        u32x4 w; w.x = pk_h(v0[0], v0[1]); w.y = pk_h(v0[2], v0[3]); w.z = pk_h(v1[0], v1[1]); w.w = pk_h(v1[2], v1[3]);
                        *(u32x4*)(U + (size_t)(row0 + ai * 128 + m * 16) * 1792 + u.pn * 256 + bj * 128 + ct) = w; }
        } else {
            const int gc0 = (u.pn == 7 ? 2048 : (u.pn - 8) * 256) + ct;
#pragma unroll
            for (int bj = 0; bj < 2; ++bj) {
                const int gbi = (u.pn == 7 ? 0 : (u.pn - 8) * 256) + ct; const float bsc = u.pn == 7 ? 0.f : 1.f;
                const f32x4 b0 = *(const f32x4*)(gate_b + gbi + bj * 128) * bsc, b1 = *(const f32x4*)(gate_b + gbi + bj * 128 + 4) * bsc;
#pragma unroll
                for (int ai = 0; ai < 2; ++ai)
#pragma unroll
                    for (int m = 0; m < 4; ++m) { const f32x4 v0 = acc[ai][bj][m][0] + b0, v1 = acc[ai][bj][m][1] + b1;
                        u32x4 w; w.x = pk_h(sigmoidf_(v0[0]), sigmoidf_(v0[1])); w.y = pk_h(sigmoidf_(v0[2]), sigmoidf_(v0[3]));
                        w.z = pk_h(sigmoidf_(v1[0]), sigmoidf_(v1[1])); w.w = pk_h(sigmoidf_(v1[2]), sigmoidf_(v1[3]));
                        *(u32x4*)(GATES + (size_t)(row0 + ai * 128 + m * 16) * GLD + gc0 + bj * 128) = w; }
            }
        }
    }
};
struct EpiZT {
    static constexpr bool PERM = true, AFTER_DRAIN = false;
    u16* ZL;
    __device__ __forceinline__ void operator()(const f32x4 (&acc)[2][2][4][2], const pg8::Unit& u, int wr, int wc, int fr, int fq) const {
#pragma unroll
        for (int bj = 0; bj < 2; ++bj) {
            const int c0 = u.pn * 256 + bj * 128 + wc * 32 + 8 * fq;
#pragma unroll
            for (int ai = 0; ai < 2; ++ai)
#pragma unroll
                for (int m = 0; m < 4; ++m) {
                    const int zr = u.pm * 256 + ai * 128 + wr * 64 + m * 16 + fr, g = zr >> 8, part = (zr >> 7) & 1, kn = zr & 127;
                    size_t off;
                    if (u.pn < 16) off = (size_t)4096 * 8192 + ((size_t)(u.pn * 512 + g * 128 + kn) * 512 + part * 256 + (c0 - u.pn * 256));
                    else { const int tok = c0 - NPR, b = tok >> 12, rc = tok & 4095; off = (size_t)(b * 512 + g * 128 + kn) * 8192 + part * 4096 + rc; }
                    u16* dst = ZL + off;
                    const f32x4 v0 = acc[ai][bj][m][0], v1 = acc[ai][bj][m][1];
                    u32x4 w; w.x = cvt_pk_bf16(v0[0], v0[1]); w.y = cvt_pk_bf16(v0[2], v0[3]); w.z = cvt_pk_bf16(v1[0], v1[1]); w.w = cvt_pk_bf16(v1[2], v1[3]);
                    *(u32x4*)dst = w;
                }
        }
    }
};
struct EpiFour {
    static constexpr bool PERM = true, AFTER_DRAIN = false;
    u16* FOUR; int latent;
    __device__ __forceinline__ void operator()(const f32x4 (&acc)[2][2][4][2], const pg8::Unit& u, int wr, int wc, int fr, int fq) const {
        const int b = u.pn >> 1, ch0 = (u.pn & 1) * 256 + wc * 32 + 8 * fq;
        const int tok0 = (latent ? NPR + b * 4096 : b * 256) + u.pm * 256 + wr * 64 + fr;
#pragma unroll
        for (int ai = 0; ai < 2; ++ai)
#pragma unroll
            for (int m = 0; m < 4; ++m)
#pragma unroll
                for (int bj = 0; bj < 2; ++bj) { const f32x4 v0 = acc[ai][bj][m][0], v1 = acc[ai][bj][m][1];
                    u32x4 w; w.x = cvt_pk_bf16(v0[0], v0[1]); w.y = cvt_pk_bf16(v0[2], v0[3]); w.z = cvt_pk_bf16(v1[0], v1[1]); w.w = cvt_pk_bf16(v1[2], v1[3]);
                    *(u32x4*)(FOUR + (size_t)(tok0 + ai * 128 + m * 16) * 512 + ch0 + bj * 128) = w; }
    }
};
struct EpiMul {
    static constexpr bool PERM = true, AFTER_DRAIN = false;
    u16* O; const u16* GATES; int mode;
    __device__ __forceinline__ void operator()(const f32x4 (&acc)[2][2][4][2], const pg8::Unit& u, int wr, int wc, int fr, int fq) const {
        const int row0 = u.pm * 256 + wr * 64 + fr, col0 = u.pn * 256 + wc * 32 + 8 * fq;
        const int ld = mode == 0 ? 512 : 1024;
#pragma unroll
        for (int ai = 0; ai < 2; ++ai)
#pragma unroll
            for (int m = 0; m < 4; ++m)
#pragma unroll
                for (int bj = 0; bj < 2; ++bj) {
                    const int row = row0 + ai * 128 + m * 16, col = col0 + bj * 128;
                    u16* p = O + (size_t)row * ld + col;
                    float v[8];
#pragma unroll
                    for (int j = 0; j < 4; ++j) { v[j] = acc[ai][bj][m][0][j]; v[4 + j] = acc[ai][bj][m][1][j]; }
                    if (mode == 0) {
                        const u32x4 q = *(const u32x4*)p;
#pragma unroll
                        for (int j = 0; j < 4; ++j) { v[2 * j] *= bf2f(q[j] & 0xffffu); v[2 * j + 1] *= bf2f(q[j] >> 16); }
                    } else {
                        const u32x4 gq = *(const u32x4*)(GATES + (size_t)row * GLD + (mode == 2 ? 1024 : 0) + col);
#pragma unroll
                        for (int j = 0; j < 4; ++j) { v[2 * j] *= h2f(gq[j] & 0xffffu); v[2 * j + 1] *= h2f(gq[j] >> 16); }
                        if (mode == 2) { const u32x4 q = *(const u32x4*)p;
#pragma unroll
                            for (int j = 0; j < 4; ++j) { v[2 * j] += bf2f(q[j] & 0xffffu); v[2 * j + 1] += bf2f(q[j] >> 16); } }
                    }
                    u32x4 w; w.x = cvt_pk_bf16(v[0], v[1]); w.y = cvt_pk_bf16(v[2], v[3]); w.z = cvt_pk_bf16(v[4], v[5]); w.w = cvt_pk_bf16(v[6], v[7]);
                    *(u32x4*)p = w;
                }
    }
};

template <class Epi>
__device__ __forceinline__ void run_gemm(LAS unsigned char* lds, const u16* A, const u16* Bt, int M, int N, int K, const Epi& E) {
    pg8::Gemm g{A, Bt, M, N, K}; pg8::StaticOrder S; S.init(M, N, (int)gridDim.x, (int)blockIdx.x);
    pg8::gemm_phase<Epi, pg8::StaticOrder, false>(lds, g, S, E, nullptr);
}

__device__ __forceinline__ void transpose_tile(const float* src, int ld_src, int col0, int k0, int krows, u16* dst, int n0, int K, LAS float* tile) {
    const int t = threadIdx.x;
#pragma unroll
    for (int i = 0; i < 8; ++i) { const int kk = (t >> 6) + 8 * i, nn = t & 63;
        float v = 0.f; if (col0 >= 0 && k0 + kk < krows) v = src[(size_t)(k0 + kk) * ld_src + col0 + nn];
        tile[kk * 65 + nn] = v; }
    __syncthreads();
    const int nn = t >> 3, ks = (t & 7) * 8;
    float v[8];
#pragma unroll
    for (int j = 0; j < 8; ++j) v[j] = tile[(ks + j) * 65 + nn];
    u32x4 w; w.x = cvt_pk_bf16(v[0], v[1]); w.y = cvt_pk_bf16(v[2], v[3]); w.z = cvt_pk_bf16(v[4], v[5]); w.w = cvt_pk_bf16(v[6], v[7]);
    *(u32x4*)(dst + (size_t)(n0 + nn) * K + k0 + ks) = w;
    __syncthreads();
}

__device__ __forceinline__ void phase_prep(const Params& P, LAS unsigned char* lds) {
    LAS float* L = (LAS float*)lds;
    LAS float* tile = L;
    LAS float* cs128 = L + 4160; LAS float* sn128 = cs128 + 128;
    LAS float* cs64 = sn128 + 128;  LAS float* sn64 = cs64 + 64;
    LAS float* cs256 = sn64 + 64;   LAS float* sn256 = cs256 + 256;
    LAS float* frow = sn256 + 256;
    LAS float* sc = frow + 512;
    LAS float* red = sc + 9216;
    const int tid = threadIdx.x, G = gridDim.x, bid = blockIdx.x;
    unsigned char* ws = P.ws;
    if (tid < 256) { float s, c; sincospif(2.0f * (float)tid / 256.0f, &s, &c); cs256[tid] = c; sn256[tid] = s; }
    if (tid < 128) { float s, c; sincospif(2.0f * (float)tid / 128.0f, &s, &c); cs128[tid] = c; sn128[tid] = s; }
    if (tid < 64)  { float s, c; sincospif(2.0f * (float)tid / 64.0f, &s, &c); cs64[tid] = c; sn64[tid] = s; }
    __syncthreads();

    if (bid < 144) {
        for (int i = tid; i < 9216; i += 512) { const int v = i >> 10, k = i & 1023; const float x = v < 8 ? P.in[4][v * 1024 + k] : P.in[5][k]; sc[i] = x / (1.0f + expf(-x)); }
        __syncthreads();
        const int c = tid & 63, kg = tid >> 6; const float* aw = P.in[6] + bid * 64 + c;
        float a[9];
#pragma unroll
        for (int v = 0; v < 9; ++v) a[v] = 0.f;
        for (int k0 = kg; k0 < 1024; k0 += 64) {
            float w8[8];
#pragma unroll
            for (int u = 0; u < 8; ++u) w8[u] = aw[(size_t)(k0 + 8 * u) * 9216];
#pragma unroll
            for (int u = 0; u < 8; ++u)
#pragma unroll
                for (int v = 0; v < 9; ++v) a[v] += sc[v * 1024 + k0 + 8 * u] * w8[u]; }
#pragma unroll
        for (int v = 0; v < 9; ++v) red[(kg * 9 + v) * 64 + c] = a[v];
        __syncthreads();
        float* MOD = (float*)(ws + WS_MOD);
        for (int i = tid; i < 576; i += 512) { const int v = i >> 6, cc = i & 63; float s = 0.f;
#pragma unroll
            for (int q = 0; q < 8; ++q) s += red[(q * 9 + v) * 64 + cc];
            MOD[v * 9216 + bid * 64 + cc] = s + P.in[7][bid * 64 + cc]; }
        __syncthreads();
    }

    {
        const int total = 5792;
        for (int q = bid; q < total; q += G) {
            int j = 0, r = q, nk = 16;
#define PREP_STEP(JJ, CNT, NKN) if (j == JJ && r >= (CNT)) { r -= (CNT); j = JJ + 1; nk = NKN; }
            PREP_STEP(0, 88 * 16, 44) PREP_STEP(1, 16 * 44, 16) PREP_STEP(2, 88 * 16, 44) PREP_STEP(3, 16 * 44, 16)
            PREP_STEP(4, 64 * 16, 8) PREP_STEP(5, 16 * 8, 8) PREP_STEP(6, 16 * 8, 16) PREP_STEP(7, 16 * 16, 4)
#undef PREP_STEP
            const int tn = r / nk, tk = r % nk, n0 = tn * 64, k0 = tk * 64;
            const float* src; int ld, krows, Kd, col0 = n0; u16* dst;
            if (j == 0 || j == 2) { src = j == 0 ? P.in[9] : P.in[11]; ld = 5632; krows = 1024; Kd = 1024; dst = (u16*)(ws + (j == 0 ? WS_W13A : WS_W13B));
                const int pn = n0 >> 8, rr = n0 & 255; col0 = rr < 128 ? 128 * pn + rr : 2816 + 128 * pn + (rr - 128); }
            else if (j == 1 || j == 3) { src = j == 1 ? P.in[10] : P.in[12]; ld = 1024; krows = 2816; Kd = 2816; dst = (u16*)(ws + (j == 1 ? WS_W2A : WS_W2B)); }
            else if (j == 4) { src = P.in[13]; ld = 4480; krows = 1024; Kd = 1024; dst = (u16*)(ws + WS_WIN);
                col0 = n0 < 1920 ? n0 : (n0 < 2048 ? -1 : 2432 + (n0 - 2048)); }
            else if (j == 5) { src = P.in[26]; ld = 1024; krows = 512; Kd = 512; dst = (u16*)(ws + WS_WO); }
            else if (j == 6) { src = P.in[27]; ld = 1024; krows = 512; Kd = 512; dst = (u16*)(ws + WS_WF); }
            else if (j == 7) { src = P.in[28]; ld = 1024; krows = 1024; Kd = 1024; dst = (u16*)(ws + WS_WOUT); }
            else { src = P.in[20]; ld = 512; krows = 128; Kd = 256; dst = (u16*)(ws + WS_GUP); }
            transpose_tile(src, ld, col0, k0, krows, dst, n0, Kd, tile);
        }
    }

    {
        u16* WZ = (u16*)(ws + WS_WZ);
        for (int k = bid; k < 1024; k += G) {
            frow[tid] = P.in[13][(size_t)k * 4480 + 1920 + tid];
            __syncthreads();
#pragma unroll
            for (int rep = 0; rep < 2; ++rep) { const int zc = tid + rep * 512, g = zc >> 8, part = (zc >> 7) & 1, kn = zc & 127;
                const LAS float* tab = part ? sn128 : cs128; float s = 0.f;
                for (int n = 0; n < 128; ++n) s += frow[g * 128 + n] * tab[(kn * n) & 127];
                s *= 0.08838834764831845f; if (part) s = -s;
                WZ[(size_t)zc * 1024 + k] = (u16)(cvt_pk_bf16(s, 0.f) & 0xffffu); }
            __syncthreads();
        }
    }

    {
        u16* T = (u16*)(ws + WS_T);
        for (size_t vi = (size_t)bid * 512 + tid; vi < (size_t)4096 * 1024; vi += (size_t)G * 512) {
            const int row = (int)(vi >> 10), cv = (int)(vi & 1023) * 8, part = cv >> 12, r = (cv >> 6) & 63, c0 = cv & 63, kr = row >> 6, kc = row & 63;
            const LAS float* tab = part ? sn64 : cs64; const int base = kr * r;
            float v[8];
#pragma unroll
            for (int j = 0; j < 8; ++j) v[j] = tab[(base + kc * (c0 + j)) & 63] * 0.015625f;
            u32x4 w; w.x = cvt_pk_bf16(v[0], v[1]); w.y = cvt_pk_bf16(v[2], v[3]); w.z = cvt_pk_bf16(v[4], v[5]); w.w = cvt_pk_bf16(v[6], v[7]);
            *(u32x4*)(T + vi * 8) = w;
        }
        u16* T2 = (u16*)(ws + WS_T256);
        for (int vi = bid * 512 + tid; vi < 256 * 64; vi += G * 512) {
            const int kt = vi >> 6, cv = (vi & 63) * 8, part = cv >> 8, t0 = cv & 255;
            const LAS float* tab = part ? sn256 : cs256;
            float v[8];
#pragma unroll
            for (int j = 0; j < 8; ++j) v[j] = tab[(kt * (t0 + j)) & 255] * 0.0625f;
            u32x4 w; w.x = cvt_pk_bf16(v[0], v[1]); w.y = cvt_pk_bf16(v[2], v[3]); w.z = cvt_pk_bf16(v[4], v[5]); w.w = cvt_pk_bf16(v[6], v[7]);
            *(u32x4*)(T2 + (size_t)vi * 8) = w;
        }
    }
}

template <int CTRL> __device__ __forceinline__ float dpp_add(float v) {
    return v + __int_as_float(__builtin_amdgcn_update_dpp(0, __float_as_int(v), CTRL, 0xF, 0xF, true));
}
__device__ __forceinline__ float sum16(float v) {
    v = dpp_add<0xB1>(v); v = dpp_add<0x4E>(v); v = dpp_add<0x141>(v); v = dpp_add<0x140>(v); return v;
}
__device__ __forceinline__ float sum64(float v) {
    const float t = sum16(v);
    const int ti = __float_as_int(t);
    return __int_as_float(__builtin_amdgcn_readlane(ti, 0)) + __int_as_float(__builtin_amdgcn_readlane(ti, 16)) + __int_as_float(__builtin_amdgcn_readlane(ti, 32)) + __int_as_float(__builtin_amdgcn_readlane(ti, 48));
}
__device__ __forceinline__ float wave_sum(float v) {
#pragma unroll
    for (int o = 32; o >= 1; o >>= 1) v += __shfl_xor(v, o);
    return v;
}
__device__ __forceinline__ const float* norm_row(const Params& P, const float* X, int m) {
    return X ? X + (size_t)m * DM : (m < NPR ? P.in[0] + (size_t)m * DM : P.in[1] + (size_t)(m - NPR) * DM);
}
__device__ __forceinline__ void phase_norm(const Params& P, const float* X, int nwi, int slot_shift, int slot_scale, u16* H) {
    const int lane = threadIdx.x & 63, gw = blockIdx.x * 8 + (threadIdx.x >> 6), nw = gridDim.x * 8;
    const float* MOD = (const float*)(P.ws + WS_MOD); const float* normw = P.in[8] + nwi * 1024;
    f32x4 v[4], vn[4];
    if (gw < MT) { const float* xr = norm_row(P, X, gw);
#pragma unroll
        for (int i = 0; i < 4; ++i) v[i] = *(const f32x4*)(xr + i * 256 + lane * 4); }
    for (int m = gw; m < MT; m += nw) {
        const int mn = m + nw < MT ? m + nw : m;
        { const float* xr = norm_row(P, X, mn);
#pragma unroll
          for (int i = 0; i < 4; ++i) vn[i] = *(const f32x4*)(xr + i * 256 + lane * 4); }
        float ss = 0.f;
#pragma unroll
        for (int i = 0; i < 4; ++i) ss += v[i][0] * v[i][0] + v[i][1] * v[i][1] + v[i][2] * v[i][2] + v[i][3] * v[i][3];
        ss = sum64(ss);
        const float rs = rsqrtf(ss * (1.0f / 1024.0f) + 1e-6f);
        const float* md = MOD + (size_t)modidx_m(m) * 9216;
#pragma unroll
        for (int i = 0; i < 4; ++i) { const int c = i * 256 + lane * 4;
            const f32x4 w = *(const f32x4*)(normw + c), sc = *(const f32x4*)(md + slot_scale * 1024 + c), sh = *(const f32x4*)(md + slot_shift * 1024 + c);
            const f32x4 y = v[i] * rs * w * (sc + 1.0f) + sh;
            u32x2 o; o.x = cvt_pk_bf16(y[0], y[1]); o.y = cvt_pk_bf16(y[2], y[3]);
            *(u32x2*)(H + (size_t)m * DM + c) = o; }
#pragma unroll
        for (int i = 0; i < 4; ++i) v[i] = vn[i];
    }
}
__device__ __forceinline__ void phase_final_norm(const Params& P) {
    const int lane = threadIdx.x & 63, gw = blockIdx.x * 8 + (threadIdx.x >> 6), nw = gridDim.x * 8;
    const float* fw = P.in[29];
    f32x4 v[4], vn[4];
    if (gw < MT) { const float* xr = P.out + (size_t)gw * DM;
#pragma unroll
        for (int i = 0; i < 4; ++i) v[i] = *(const f32x4*)(xr + i * 256 + lane * 4); }
    for (int m = gw; m < MT; m += nw) {
        const int mn = m + nw < MT ? m + nw : m;
        { const float* xr = P.out + (size_t)mn * DM;
#pragma unroll
          for (int i = 0; i < 4; ++i) vn[i] = *(const f32x4*)(xr + i * 256 + lane * 4); }
        float ss = 0.f;
#pragma unroll
        for (int i = 0; i < 4; ++i) ss += v[i][0] * v[i][0] + v[i][1] * v[i][1] + v[i][2] * v[i][2] + v[i][3] * v[i][3];
        ss = sum64(ss);
        const float rs = rsqrtf(ss * (1.0f / 1024.0f) + 1e-6f);
        float* xo = P.out + (size_t)m * DM;
#pragma unroll
        for (int i = 0; i < 4; ++i) { const int c = i * 256 + lane * 4; *(f32x4*)(xo + c) = v[i] * rs * *(const f32x4*)(fw + c); }
#pragma unroll
        for (int i = 0; i < 4; ++i) v[i] = vn[i];
    }
}

__device__ __forceinline__ float fsig(float x) { return __builtin_amdgcn_rcpf(1.0f + __expf(-x)); }
struct ScanRegs { u32x2 r[3], k[3], v[3], wd, ad; };
__device__ __forceinline__ void scan_load(ScanRegs& R, const u16* U, int tok0, int T, int t, int h, int d, int cg) {
    const u32x2 z = {0u, 0u};
#pragma unroll
    for (int tap = 0; tap < 3; ++tap) { const int tn = t + tap - 1;
        if (tn >= 0 && tn < T) { const u16* row = U + (size_t)(tok0 + tn) * 1792 + h * 64 + 4 * cg;
            R.r[tap] = *(const u32x2*)row; R.k[tap] = *(const u32x2*)(row + 512); R.v[tap] = *(const u32x2*)(row + 1024); }
        else { R.r[tap] = z; R.k[tap] = z; R.v[tap] = z; } }
    const u16* row = U + (size_t)(tok0 + t) * 1792 + 1536 + d * 64 + 4 * cg;
    R.wd = *(const u32x2*)row; R.ad = *(const u32x2*)(row + 128);
}
__device__ __forceinline__ void unpack4h(const u32x2 q, float (&o)[4]) { o[0] = h2f(q.x & 0xffffu); o[1] = h2f(q.x >> 16); o[2] = h2f(q.y & 0xffffu); o[3] = h2f(q.y >> 16); }

#define LDS_BARRIER() do { asm volatile("s_waitcnt lgkmcnt(0)" ::: "memory"); __builtin_amdgcn_s_barrier(); asm volatile("" ::: "memory"); } while (0)
__device__ __forceinline__ void scan_unit(const Params& P, LAS float* L, int s, int h, int d, int half) {
    typedef float f32x16 __attribute__((ext_vector_type(16)));
    const int tid = threadIdx.x, lane = tid & 63;
    const bool producer = tid >= 256;
    const int T = s < 16 ? 256 : 4096, tok0 = s < 16 ? s * 256 : NPR + (s - 16) * 4096, nchunk = T / 32;
    const u16* U = (const u16*)(P.ws + WS_U16);
    u16* Od = (u16*)(P.ws + WS_H) + (size_t)d * MT * 512;
    float* BS = (float*)(P.ws + WS_BS);
    LAS float* cst = L;            LAS float* xwT = L + 1024;    LAS float* xaT = L + 3072;   LAS float* lora_s = L + 5120;
    LAS float* o_sb = L + 13312;   LAS float* cb = L + 15360;
    if (tid < 64) { const int c = tid, ch = h * 64 + c;
        cst[c] = P.in[16][d * 512 + ch]; cst[64 + c] = P.in[18][d * 512 + ch]; cst[128 + c] = P.in[21][ch]; cst[192 + c] = P.in[22][ch]; cst[256 + c] = P.in[23][ch];
#pragma unroll
        for (int ten = 0; ten < 3; ++ten)
#pragma unroll
            for (int tap = 0; tap < 3; ++tap) cst[(5 + ten * 3 + tap) * 64 + c] = P.in[15][tap * 1536 + ten * 512 + ch]; }
    const int c16 = tid & 15, rp = (tid >> 4) & 15, rA = half * 32 + rp, rB = rA + 16;
    f32x4 SA = {0.f, 0.f, 0.f, 0.f}, SB = {0.f, 0.f, 0.f, 0.f};
    if (!producer && s >= 16) { const float* st = (d ? P.in[3] : P.in[2]) + (size_t)((s - 16) * 8 + h) * 4096;
        SA = *(const f32x4*)(st + rA * 64 + 4 * c16); SB = *(const f32x4*)(st + rB * 64 + 4 * c16); }
    const int pt = tid - 256, pw = (pt >> 6) & 3, nt = pw & 1, kh = pw >> 1, li = lane & 31, lk = lane >> 5;
    float Bw[16], Ba[16];
    if (producer) {
#pragma unroll
        for (int s2 = 0; s2 < 16; ++s2) { const size_t o = (size_t)(d * 64 + kh * 32 + 2 * s2 + lk) * 512 + h * 64 + nt * 32 + li; Bw[s2] = P.in[17][o]; Ba[s2] = P.in[19][o]; }
    } else {
#pragma unroll
        for (int s2 = 0; s2 < 16; ++s2) { Bw[s2] = 0.f; Ba[s2] = 0.f; }
    }
    const int it0 = pt & 255, tt0 = it0 >> 4, cg0 = it0 & 15, tt1 = tt0 + 16, cg1 = cg0;
    ScanRegs R0, R1;
    if (producer) { scan_load(R0, U, tok0, T, d ? T - 1 - tt0 : tt0, h, d, cg0); scan_load(R1, U, tok0, T, d ? T - 1 - tt1 : tt1, h, d, cg1); }
    __syncthreads();
    for (int ci = -1; ci < nchunk; ++ci) {
        const int pc = ci + 1;
        LAS float* pb = cb + (pc & 1) * 12288;
        const LAS float* qb = cb + (ci & 1) * 12288;
        LAS float* o_s = o_sb + (ci & 1) * 1024;
        const bool do_prep = producer && pc < nchunk, do_step = !producer && ci >= 0;
        LAS float* r_s = pb; LAS float* w_s = pb + 2048; LAS float* kd_s = pb + 4096; LAS float* v_s = pb + 6144; LAS float* kk_s = pb + 8192; LAS float* kka_s = pb + 10240;
#define SCAN_STEPS(SEG) if (do_step) { float oAr[8], oBr[8]; float pA = 0.f, pB = 0.f;     \
        _Pragma("unroll") for (int u8 = 0; u8 < 8; ++u8) { const int tt = (SEG) * 8 + u8; \
            const f32x4 w4 = *(const LAS f32x4*)(qb + 2048 + tt * 64 + 4 * c16), kk4 = *(const LAS f32x4*)(qb + 8192 + tt * 64 + 4 * c16), ka4 = *(const LAS f32x4*)(qb + 10240 + tt * 64 + 4 * c16); \
            const f32x4 kd4 = *(const LAS f32x4*)(qb + 4096 + tt * 64 + 4 * c16), r4 = *(const LAS f32x4*)(qb + tt * 64 + 4 * c16); \
            const float vA = qb[6144 + tt * 64 + rA], vB = qb[6144 + tt * 64 + rB]; \
            float saA = SA[0] * kk4[0] + SA[1] * kk4[1] + SA[2] * kk4[2] + SA[3] * kk4[3], saB = SB[0] * kk4[0] + SB[1] * kk4[1] + SB[2] * kk4[2] + SB[3] * kk4[3]; \
            saA = dpp_add<0xB1>(saA); saB = dpp_add<0xB1>(saB); pA = dpp_add<0xB1>(pA); pB = dpp_add<0xB1>(pB); \
            saA = dpp_add<0x4E>(saA); saB = dpp_add<0x4E>(saB); pA = dpp_add<0x4E>(pA); pB = dpp_add<0x4E>(pB); \
            saA = dpp_add<0x141>(saA); saB = dpp_add<0x141>(saB); pA = dpp_add<0x141>(pA); pB = dpp_add<0x141>(pB); \
            saA = dpp_add<0x140>(saA); saB = dpp_add<0x140>(saB); pA = dpp_add<0x140>(pA); pB = dpp_add<0x140>(pB); \
            if (u8 > 0) { oAr[u8 - 1] = pA; oBr[u8 - 1] = pB; } \
            SA = SA * w4 - ka4 * saA + kd4 * vA; SB = SB * w4 - ka4 * saB + kd4 * vB; \
            pA = SA[0] * r4[0] + SA[1] * r4[1] + SA[2] * r4[2] + SA[3] * r4[3]; pB = SB[0] * r4[0] + SB[1] * r4[1] + SB[2] * r4[2] + SB[3] * r4[3]; } \
        pA = dpp_add<0xB1>(pA); pB = dpp_add<0xB1>(pB); pA = dpp_add<0x4E>(pA); pB = dpp_add<0x4E>(pB); pA = dpp_add<0x141>(pA); pB = dpp_add<0x141>(pB); pA = dpp_add<0x140>(pA); pB = dpp_add<0x140>(pB); \
        oAr[7] = pA; oBr[7] = pB; \
        if (c16 == 0) { _Pragma("unroll") for (int u8 = 0; u8 < 8; ++u8) { o_s[((SEG) * 8 + u8) * 32 + rp] = oAr[u8]; o_s[((SEG) * 8 + u8) * 32 + 16 + rp] = oBr[u8]; } } }
        if (do_prep) {
#pragma unroll
            for (int it = 0; it < 2; ++it) { const ScanRegs& R = it ? R1 : R0; const int tt_a = it ? tt1 : tt0, cg = cg0;
                float rv[4] = {0.f, 0.f, 0.f, 0.f}, kv[4] = {0.f, 0.f, 0.f, 0.f}, vv[4] = {0.f, 0.f, 0.f, 0.f};
#pragma unroll
                for (int tap = 0; tap < 3; ++tap) { float a[4], bb[4], c[4]; unpack4h(R.r[tap], a); unpack4h(R.k[tap], bb); unpack4h(R.v[tap], c);
#pragma unroll
                    for (int j = 0; j < 4; ++j) { rv[j] += a[j] * cst[(5 + tap) * 64 + 4 * cg + j]; kv[j] += bb[j] * cst[(8 + tap) * 64 + 4 * cg + j]; vv[j] += c[j] * cst[(11 + tap) * 64 + 4 * cg + j]; } }
                float kkr[4], ss = 0.f;
#pragma unroll
                for (int j = 0; j < 4; ++j) { kkr[j] = kv[j] * cst[128 + 4 * cg + j]; ss += kkr[j] * kkr[j]; }
                ss = sum16(ss);
                const float inv = __builtin_amdgcn_rsqf(fmaxf(ss, 1e-24f));
                float wdv[4], adv[4]; unpack4h(R.wd, wdv); unpack4h(R.ad, adv);
#pragma unroll
                for (int j = 0; j < 4; ++j) { const int o = tt_a * 64 + 4 * cg + j;
                    r_s[o] = rv[j]; v_s[o] = vv[j]; kd_s[o] = kv[j]; kk_s[o] = kkr[j] * inv;
                    xwT[(4 * cg + j) * 32 + tt_a] = 1.0f - 2.0f * __builtin_amdgcn_rcpf(1.0f + __expf(2.0f * wdv[j])); xaT[(4 * cg + j) * 32 + tt_a] = adv[j]; } }
            if (pc + 1 < nchunk) { const int q0 = (pc + 1) * 32 + tt0, q1 = (pc + 1) * 32 + tt1;
                scan_load(R0, U, tok0, T, d ? T - 1 - q0 : q0, h, d, cg0); scan_load(R1, U, tok0, T, d ? T - 1 - q1 : q1, h, d, cg1); }
        }
        SCAN_STEPS(0)
        LDS_BARRIER();
        if (do_prep) {
            f32x16 accw, acca;
#pragma unroll
            for (int i = 0; i < 16; ++i) { accw[i] = 0.f; acca[i] = 0.f; }
#pragma unroll
            for (int s2 = 0; s2 < 16; ++s2) { const int r = kh * 32 + 2 * s2 + lk;
                accw = __builtin_amdgcn_mfma_f32_32x32x2f32(xwT[r * 32 + li], Bw[s2], accw, 0, 0, 0);
                acca = __builtin_amdgcn_mfma_f32_32x32x2f32(xaT[r * 32 + li], Ba[s2], acca, 0, 0, 0); }
#pragma unroll
            for (int reg = 0; reg < 16; ++reg) { const int o = ((reg & 3) + 8 * (reg >> 2) + 4 * lk) * 64 + nt * 32 + li;
                lora_s[(0 * 2 + kh) * 2048 + o] = accw[reg]; lora_s[(1 * 2 + kh) * 2048 + o] = acca[reg]; }
        }
        SCAN_STEPS(1)
        LDS_BARRIER();
        if (do_prep) {
            const int c = pt & 63, tg = pt >> 6;
#pragma unroll
            for (int j = 0; j < 8; ++j) { const int tt = 8 * tg + j, o = tt * 64 + c;
                const float wl = cst[c] + lora_s[o] + lora_s[2048 + o];
                const float w = __expf(-0.6065306597f * fsig(wl));
                const float a = fsig(cst[64 + c] + lora_s[4096 + o] + lora_s[6144 + o]);
                const float k = kd_s[o], kk = kk_s[o];
                const float kd = k * (1.0f + (a - 1.0f) * cst[192 + c]);
                kd_s[o] = kd; kka_s[o] = kk * a; w_s[o] = w;
                const float bsum = sum64(r_s[o] * kd * cst[256 + c]);
                if (lane == 0 && half == 0) { const int q = pc * 32 + tt, t = d ? T - 1 - q : q; BS[(size_t)(tok0 + t) * 16 + h * 2 + d] = bsum; } }
        }
        SCAN_STEPS(2)
        LDS_BARRIER();
        SCAN_STEPS(3)
        LDS_BARRIER();
        if (do_step) { const int tt = tid >> 3, seg = tid & 7, q = ci * 32 + tt, t = d ? T - 1 - q : q;
            u32x2 w2; w2.x = cvt_pk_bf16(o_s[tt * 32 + 4 * seg], o_s[tt * 32 + 4 * seg + 1]); w2.y = cvt_pk_bf16(o_s[tt * 32 + 4 * seg + 2], o_s[tt * 32 + 4 * seg + 3]);
            *(u32x2*)(Od + (size_t)(tok0 + t) * 512 + h * 64 + half * 32 + 4 * seg) = w2; }
#undef SCAN_STEPS
    }
    if (!producer && s < 16) { float* so = P.out + OUT_STATE + (size_t)d * 524288 + (size_t)(s * 8 + h) * 4096;
        *(f32x4*)(so + rA * 64 + 4 * c16) = SA; *(f32x4*)(so + rB * 64 + 4 * c16) = SB; }
    __syncthreads();
}
__device__ __forceinline__ void phase_scan(const Params& P, LAS unsigned char* lds) {
    for (int q = blockIdx.x; q < 768; q += gridDim.x) {
        int s, rem;
        if (q < 256) { s = 16 + (q >> 5); rem = q & 31; } else { const int p = q - 256; s = p >> 5; rem = p & 31; }
        scan_unit(P, (LAS float*)lds, s, rem >> 2, (rem >> 1) & 1, rem & 1);
    }
}

struct PostRaw { unsigned of, ob, v0, v1, v2, sg; float b0, b1; };
__device__ __forceinline__ void post_load(PostRaw& r, int m, int ch, int h, int lane, const u16* OF, const u16* OB, const u16* U, const float* BS, const u16* GT) {
    const int T = m < NPR ? 256 : 4096, t = m < NPR ? (m & 255) : ((m - NPR) & 4095);
    r.of = OF[(size_t)m * 512 + ch]; r.ob = OB[(size_t)m * 512 + ch];
    r.v1 = U[(size_t)m * 1792 + 1024 + ch];
    r.v0 = t > 0 ? U[(size_t)(m - 1) * 1792 + 1024 + ch] : 0u;
    r.v2 = t < T - 1 ? U[(size_t)(m + 1) * 1792 + 1024 + ch] : 0u;
    r.sg = *(const unsigned*)(GT + (size_t)m * GLD + 2048 + 2 * lane);
    r.b0 = BS[(size_t)m * 16 + h * 2]; r.b1 = BS[(size_t)m * 16 + h * 2 + 1];
}
__device__ __forceinline__ void phase_post(const Params& P, LAS unsigned char* lds) {
    const int lane = threadIdx.x & 63, h = threadIdx.x >> 6, ch = h * 64 + lane, G = gridDim.x;
    const u16* OF = (const u16*)(P.ws + WS_H); const u16* OB = OF + (size_t)MT * 512;
    const u16* U = (const u16*)(P.ws + WS_U16); const float* BS = (const float*)(P.ws + WS_BS);
    u16* OPRE = (u16*)(P.ws + WS_OPRE); const u16* GT = (const u16*)(P.ws + WS_R);
    LAS float* sgl = (LAS float*)lds + h * 128;
    float gu[128];
#pragma unroll
    for (int k = 0; k < 128; ++k) gu[k] = P.in[20][(size_t)k * 512 + ch];
    const float lw = P.in[24][ch], lb = P.in[25][ch];
    const float cv0 = P.in[15][0 * 1536 + 1024 + ch], cv1 = P.in[15][1 * 1536 + 1024 + ch], cv2 = P.in[15][2 * 1536 + 1024 + ch];
    PostRaw cur, nxt;
    int m = blockIdx.x;
    post_load(cur, m, ch, h, lane, OF, OB, U, BS, GT);
    for (; m < MT; m += G) {
        const int mn = m + G < MT ? m + G : m;
        post_load(nxt, mn, ch, h, lane, OF, OB, U, BS, GT);
        sgl[2 * lane] = h2f(cur.sg & 0xffffu); sgl[2 * lane + 1] = h2f(cur.sg >> 16);
        const float o = bf2f(cur.of) + bf2f(cur.ob);
        const float mean = sum64(o) * (1.0f / 64.0f), d = o - mean;
        const float rstd = rsqrtf(sum64(d * d) * (1.0f / 64.0f) + 64e-5f);
        const float v = h2f(cur.v0) * cv0 + h2f(cur.v1) * cv1 + h2f(cur.v2) * cv2;
        float g0 = 0.f, g1 = 0.f, g2 = 0.f, g3 = 0.f;
#pragma unroll
        for (int k = 0; k < 128; k += 4) { const f32x4 s4 = *(const LAS f32x4*)(sgl + k);
            g0 += s4[0] * gu[k]; g1 += s4[1] * gu[k + 1]; g2 += s4[2] * gu[k + 2]; g3 += s4[3] * gu[k + 3]; }
        const float y = (d * rstd * lw + lb + (cur.b0 + cur.b1) * v) * ((g0 + g1) + (g2 + g3));
        OPRE[(size_t)m * 512 + ch] = (u16)(cvt_pk_bf16(y, 0.f) & 0xffffu);
        cur = nxt;
    }
}


constexpr size_t WS_BAR = WS_END + 65536;
static_assert(WS_BAR + 4096 <= (size_t)536870912, "barrier words");
__device__ __forceinline__ void fast_grid_sync(unsigned char* ws, unsigned k) {
    asm volatile("s_waitcnt vmcnt(0) lgkmcnt(0)" ::: "memory");
    __builtin_amdgcn_s_barrier();
    if (threadIdx.x == 0) {
        unsigned* bar = (unsigned*)(ws + WS_BAR);
        const unsigned G = gridDim.x, g = blockIdx.x & 7u, gsz = (G - g + 7u) >> 3, ngrp = G < 8u ? G : 8u;
        __builtin_amdgcn_fence(__ATOMIC_RELEASE, "agent");
        asm volatile("s_waitcnt vmcnt(0)" ::: "memory");
        const unsigned old = __hip_atomic_fetch_add(bar + g * 32, 1u, __ATOMIC_RELAXED, __HIP_MEMORY_SCOPE_AGENT);
        if (old + 1u == k * gsz) __hip_atomic_fetch_add(bar + 8 * 32, 1u, __ATOMIC_RELAXED, __HIP_MEMORY_SCOPE_AGENT);
        unsigned spins = 0;
        while (__hip_atomic_load(bar + 8 * 32, __ATOMIC_RELAXED, __HIP_MEMORY_SCOPE_AGENT) < k * ngrp) { if (++spins > (1u << 24)) break; __builtin_amdgcn_s_sleep(1); }
        __builtin_amdgcn_fence(__ATOMIC_ACQUIRE, "agent");
        asm volatile("s_waitcnt vmcnt(0)" ::: "memory");
    }
    __builtin_amdgcn_s_barrier();
    asm volatile("" ::: "memory");
}

__global__ void __launch_bounds__(512, 2) fwd_mega(Params P) {
    extern __shared__ __attribute__((aligned(16))) unsigned char lds_raw[];
    LAS unsigned char* lds = (LAS unsigned char*)lds_raw;
    cg::grid_group grid = cg::this_grid();
    if (threadIdx.x < 32) { const int i = threadIdx.x; const unsigned long long v = i < 30 ? (unsigned long long)P.in[i] : (i == 30 ? (unsigned long long)P.out : (unsigned long long)P.ws);
        *(LAS unsigned long long*)(lds + PTAB_OFF + i * 8) = v; }
    __syncthreads();
unsigned bark_ = 0; unsigned char* P_ws_ = P.ws;
#define PH_BEGIN { const Params Q = get_params(lds); unsigned char* ws = Q.ws; (void)ws;
#define PH_END } asm volatile("s_waitcnt vmcnt(0)" ::: "memory");   grid.sync();
#define PH_ENDF } fast_grid_sync(P_ws_, ++bark_);
    if (blockIdx.x == 0 && threadIdx.x < 9) ((unsigned*)(P.ws + WS_BAR))[threadIdx.x * 32] = 0u;
    PH_BEGIN phase_prep(Q, lds); PH_END
    PH_BEGIN phase_norm(Q, nullptr, 0, 0, 1, (u16*)(ws + WS_H)); PH_ENDF
    PH_BEGIN run_gemm(lds, (const u16*)(ws + WS_H), (const u16*)(ws + WS_W13A), MT, 5632, 1024, EpiSwiglu{(u16*)(ws + WS_BIG)}); PH_ENDF
    PH_BEGIN run_gemm(lds, (const u16*)(ws + WS_BIG), (const u16*)(ws + WS_W2A), MT, 1024, 2816, EpiResid{Q.in[0], Q.in[1], Q.out, (const float*)(ws + WS_MOD), 2, 0.5f}); PH_ENDF
    PH_BEGIN phase_norm(Q, Q.out, 1, 3, 4, (u16*)(ws + WS_H)); PH_ENDF
    PH_BEGIN run_gemm(lds, (const u16*)(ws + WS_WZ), (const u16*)(ws + WS_H), 1024, MT, 1024, EpiZT{(u16*)(ws + WS_ZL)}); PH_ENDF
    PH_BEGIN run_gemm(lds, (const u16*)(ws + WS_T), (const u16*)(ws + WS_ZL), 4096, 4096, 8192, EpiFour{(u16*)(ws + WS_FOUR), 1});
             run_gemm(lds, (const u16*)(ws + WS_T256), (const u16*)(ws + WS_ZP), 256, 8192, 512, EpiFour{(u16*)(ws + WS_FOUR), 0}); PH_ENDF
    PH_BEGIN run_gemm(lds, (const u16*)(ws + WS_H), (const u16*)(ws + WS_WIN), MT, 4096, 1024, EpiU{(u16*)(ws + WS_U16), (u16*)(ws + WS_SG), (u16*)(ws + WS_R), Q.in[14]}); PH_ENDF
    PH_BEGIN phase_scan(Q, lds); PH_ENDF
    PH_BEGIN phase_post(Q, lds); PH_ENDF
    PH_BEGIN run_gemm(lds, (const u16*)(ws + WS_OPRE), (const u16*)(ws + WS_WO), MT, 1024, 512, EpiMul{(u16*)(ws + WS_H), (const u16*)(ws + WS_R), 1}); PH_ENDF
    PH_BEGIN run_gemm(lds, (const u16*)(ws + WS_FOUR), (const u16*)(ws + WS_WF), MT, 1024, 512, EpiMul{(u16*)(ws + WS_H), (const u16*)(ws + WS_R), 2}); PH_ENDF
    PH_BEGIN run_gemm(lds, (const u16*)(ws + WS_H), (const u16*)(ws + WS_WOUT), MT, 1024, 1024, EpiResid{nullptr, nullptr, Q.out, (const float*)(ws + WS_MOD), 5, 1.0f}); PH_ENDF
    PH_BEGIN phase_norm(Q, Q.out, 2, 6, 7, (u16*)(ws + WS_H)); PH_ENDF
    PH_BEGIN run_gemm(lds, (const u16*)(ws + WS_H), (const u16*)(ws + WS_W13B), MT, 5632, 1024, EpiSwiglu{(u16*)(ws + WS_BIG)}); PH_ENDF
    PH_BEGIN run_gemm(lds, (const u16*)(ws + WS_BIG), (const u16*)(ws + WS_W2B), MT, 1024, 2816, EpiResid{nullptr, nullptr, Q.out, (const float*)(ws + WS_MOD), 8, 0.5f}); PH_ENDF
    { const Params Q = get_params(lds); phase_final_norm(Q); }
#undef PH_BEGIN
#undef PH_END
#undef PH_ENDF
}

extern "C" void kernel_launch(void* const* d_in, const int* in_sizes, int n_in, void* d_out, int out_size, void* d_ws, size_t ws_size, hipStream_t stream) {
    static int grid_blocks = 0;
    if (grid_blocks == 0) {
        if (n_in != 30 || ws_size < WS_END) { fprintf(stderr, "kernel_launch: unexpected n_in %d / ws_size %zu (need %zu)\n", n_in, ws_size, (size_t)WS_END); grid_blocks = -1; return; }
        int dev = 0, cus = 0, per_cu = 0;
        (void)hipGetDevice(&dev);
        (void)hipDeviceGetAttribute(&cus, hipDeviceAttributeMultiprocessorCount, dev);
        (void)hipFuncSetAttribute((const void*)fwd_mega, hipFuncAttributeMaxDynamicSharedMemorySize, LDS_BYTES);
        (void)hipOccupancyMaxActiveBlocksPerMultiprocessor(&per_cu, (const void*)fwd_mega, 512, LDS_BYTES);
        if (per_cu < 1) { fprintf(stderr, "kernel_launch: occupancy query reports %d blocks per CU\n", per_cu); per_cu = 1; }
        if (per_cu > 1) per_cu = 1;
        grid_blocks = cus * per_cu;
        (void)hipGetLastError();
    }
    if (grid_blocks < 0) return;
    Params p{};
    for (int i = 0; i < 30; ++i) p.in[i] = (const float*)d_in[i];
    p.out = (float*)d_out; p.ws = (unsigned char*)d_ws;
    void* args[] = {&p};
    hipError_t e = hipLaunchCooperativeKernel((const void*)fwd_mega, dim3(grid_blocks), dim3(512), args, LDS_BYTES, stream);
    if (e != hipSuccess) fprintf(stderr, "cooperative launch failed: %s (grid %d)\n", hipGetErrorString(e), grid_blocks);
}
```

```cpp
#include <hip/hip_runtime.h>
#include <hip/hip_cooperative_groups.h>
#include <cstdio>
namespace cg = cooperative_groups;
namespace pg8 {
#define PG8_LAS __attribute__((address_space(3)))
typedef unsigned short bf16_t;
typedef short bf16x8 __attribute__((ext_vector_type(8)));
typedef float f32x4 __attribute__((ext_vector_type(4)));
typedef unsigned u32x4 __attribute__((ext_vector_type(4)));
constexpr int BM = 256, BK = 64, HALF = 128, HTB = HALF * BK * 2  , STAGE_BYTES = 8 * HTB, NXCD = 8, WGM = 8;

__host__ __device__ __forceinline__ int lds_byte(int r, int c) { const int st = (r >> 4) * 2 + (c >> 5), rr = r & 15, cc = c & 31, ob = rr * 64 + cc * 2; return st * 1024 + (ob ^ (((ob >> 9) & 1) << 5)); }
__host__ __device__ __forceinline__ void stage_rc(int b, int& R, int& C) { const int st = b / 1024, sb = b % 1024, swz = sb ^ (((sb >> 9) & 1) << 5); R = (st >> 1) * 16 + swz / 64; C = (st & 1) * 32 + (swz % 64) / 2; }
__host__ __device__ __forceinline__ int perm32(int rho) { const int n = rho >> 4, i = rho & 15; return 8 * (i >> 2) + 4 * n + (i & 3); }

struct Unit { int pm, pn; };
struct Gemm { const bf16_t* A; const bf16_t* Bt; int M, N, K; };

struct StaticOrder {
    int nM, nN, nwg, G, c;
    __host__ __device__ __forceinline__ void init(int M, int N, int G_, int c_) { nM = M / BM; nN = N / BM; nwg = nM * nN; G = G_; c = c_; }
    __host__ __device__ __forceinline__ bool next(int i, Unit& u) const {
        const long L = (long)i * G + c; if (L >= nwg) return false;
        int wgid = (int)L; { const int q = nwg / NXCD, r = nwg % NXCD, xcd = wgid % NXCD, off = wgid / NXCD; wgid = (xcd < r ? xcd * (q + 1) : r * (q + 1) + (xcd - r) * q) + off; }
        const int nig = WGM * nN, gid = wgid / nig, fm = gid * WGM, gsz = (nM - fm) < WGM ? (nM - fm) : WGM;
        u.pm = fm + ((wgid % nig) % gsz); u.pn = (wgid % nig) / gsz; return true;
    }
    __device__ __forceinline__ void a_ready(const Unit&) const {}
    __device__ __forceinline__ void done(const Unit&) const {}
};
__device__ __forceinline__ unsigned cvt_pk_bf16(float lo, float hi) { unsigned r; asm volatile("v_cvt_pk_bf16_f32 %0, %1, %2" : "=v"(r) : "v"(lo), "v"(hi)); return r; }
template <class Epi, class Sched, bool STAMP = false>
__device__ __forceinline__ void gemm_phase(PG8_LAS unsigned char* lds, const Gemm g, const Sched& S, const Epi& E, unsigned long long* stamps) {
    int tid_ = threadIdx.x; asm volatile("" : "+v"(tid_));
    const int tid = tid_, wid = __builtin_amdgcn_readfirstlane(tid >> 6), lane = tid & 63, wr = wid >> 2, wc = wid & 3, fr = lane & 15, fq = lane >> 4;
    const int K = g.K, nt = K / BK;
    int ts_lo = 0, ts_hi = 0, nts = 0; const unsigned long long rt_entry = STAMP ? (unsigned long long)wall_clock64() : 0ull;
#define PG8_STAMP() do { if (STAMP && wid == 0 && nts < 64) { const unsigned long long _c = (unsigned long long)clock64(); \
        ts_lo = (lane == nts) ? (int)(unsigned)_c : ts_lo; ts_hi = (lane == nts) ? (int)(unsigned)(_c >> 32) : ts_hi; ++nts; } } while (0)
    PG8_STAMP();
    unsigned voffA[2], voffB[2];
#pragma unroll
    for (int i = 0; i < 2; ++i) { int R, C; stage_rc(tid * 16 + i * 8192, R, C); const int Rb = Epi::PERM ? ((R & ~31) + perm32(R & 31)) : R;
        voffA[i] = (unsigned)(R * K + C) * 2u; voffB[i] = (unsigned)(Rb * K + C) * 2u; }
    const size_t kstep = (size_t)(BK * 2);
    const size_t hstep = (size_t)HALF * K * 2;
    const size_t tstep = 2 * hstep;
    const unsigned ldsw = (unsigned)wid * 1024u;
    const int aoff = lds_byte(wr * 64 + fr, fq * 8), boff = lds_byte(wc * 32 + fr, fq * 8);
#define PG8_SA(b, h) (((b) * 2 + (h)) * HTB)
#define PG8_SB(b, h) ((4 + (b) * 2 + (h)) * HTB)
#define PG8_STAGE(bufoff, gbase, voff) do { _Pragma("unroll") for (int _i = 0; _i < 2; ++_i) \
        __builtin_amdgcn_global_load_lds((const unsigned*)((const char*)(gbase) + (voff)[_i]), (PG8_LAS unsigned*)(lds + (bufoff) + ldsw + _i * 8192), 16, 0, 0); } while (0)
#define PG8_LDA(dst, b, h) do { _Pragma("unroll") for (int m = 0; m < 4; ++m) _Pragma("unroll") for (int k = 0; k < 2; ++k) dst[m][k] = *(const PG8_LAS bf16x8*)(lds + PG8_SA(b, h) + aoff + m * 2048 + k * 1024); } while (0)
#define PG8_LDB(dst, b, h) do { _Pragma("unroll") for (int n = 0; n < 2; ++n) _Pragma("unroll") for (int k = 0; k < 2; ++k) dst[n][k] = *(const PG8_LAS bf16x8*)(lds + PG8_SB(b, h) + boff + n * 2048 + k * 1024); } while (0)
#define PG8_MMA(ai, bj, At, Bt) do { __builtin_amdgcn_s_setprio(1); _Pragma("unroll") for (int m = 0; m < 4; ++m) _Pragma("unroll") for (int n = 0; n < 2; ++n) _Pragma("unroll") for (int k = 0; k < 2; ++k) \
        acc[ai][bj][m][n] = __builtin_amdgcn_mfma_f32_16x16x32_bf16(Bt[n][k], At[m][k], acc[ai][bj][m][n], 0, 0, 0); __builtin_amdgcn_s_setprio(0); } while (0)
#define PG8_WAIT_V(n) asm volatile("s_waitcnt vmcnt(" #n ")" ::: "memory")
#define PG8_WAIT_L(n) asm volatile("s_waitcnt lgkmcnt(" #n ")" ::: "memory")
#define PG8_BAR __builtin_amdgcn_s_barrier()
#define PG8_SCHED __builtin_amdgcn_sched_barrier(0)
    Unit cur, nxt; int ui = 0;
    if (!S.next(0, cur)) return;
    f32x4 acc[2][2][4][2];
#pragma unroll
    for (int a = 0; a < 2; ++a)
#pragma unroll
        for (int b = 0; b < 2; ++b)
#pragma unroll
            for (int m = 0; m < 4; ++m)
#pragma unroll
                for (int n = 0; n < 2; ++n) acc[a][b][m][n] = (f32x4){0.f, 0.f, 0.f, 0.f};
    bf16x8 At[4][2], B0[2][2], B1[2][2];
    const char* cA = (const char*)g.A + (size_t)cur.pm * tstep; const char* cB = (const char*)g.Bt + (size_t)cur.pn * tstep;
    S.a_ready(cur);
    PG8_STAGE(PG8_SB(0, 0), cB, voffB); PG8_STAGE(PG8_SA(0, 0), cA, voffA); PG8_STAGE(PG8_SB(0, 1), cB + hstep, voffB); PG8_STAGE(PG8_SA(0, 1), cA + hstep, voffA);
    if (wr == 1) PG8_BAR;
    PG8_WAIT_V(4); PG8_BAR;
    PG8_STAGE(PG8_SB(1, 0), cB + kstep, voffB); PG8_STAGE(PG8_SA(1, 0), cA + kstep, voffA); PG8_STAGE(PG8_SB(1, 1), cB + hstep + kstep, voffB);
    PG8_WAIT_V(6); PG8_BAR;
    PG8_STAMP();
    for (;;) {
        const bool has_next = S.next(ui + 1, nxt);
        const char* nA = has_next ? (const char*)g.A + (size_t)nxt.pm * tstep : cA; const char* nB = has_next ? (const char*)g.Bt + (size_t)nxt.pn * tstep : cB;
        for (int t = 0; t < nt; t += 2) {
            const bool last = (t == nt - 2);
            const char* a1 = cA + (size_t)(t + 1) * kstep;
            const char* a2 = last ? nA : cA + (size_t)(t + 2) * kstep; const char* b2 = last ? nB : cB + (size_t)(t + 2) * kstep;
            const char* a3 = a2 + kstep; const char* b3 = b2 + kstep;
            if (last && has_next) S.a_ready(nxt);
            PG8_LDB(B0, 0, 0); PG8_SCHED; PG8_LDA(At, 0, 0); PG8_STAGE(PG8_SA(1, 1), a1 + hstep, voffA);
            PG8_WAIT_L(8); PG8_BAR; PG8_WAIT_L(0); PG8_MMA(0, 0, At, B0); PG8_BAR; PG8_SCHED;
            PG8_LDB(B1, 0, 1); PG8_STAGE(PG8_SB(0, 0), b2, voffB);
            PG8_BAR; PG8_WAIT_L(0); PG8_MMA(0, 1, At, B1); PG8_BAR;
            PG8_LDA(At, 0, 1); PG8_STAGE(PG8_SA(0, 0), a2, voffA);
            PG8_BAR; PG8_WAIT_L(0); PG8_MMA(1, 0, At, B0); PG8_BAR; PG8_SCHED;
            PG8_STAGE(PG8_SB(0, 1), b2 + hstep, voffB);
            PG8_WAIT_V(6); PG8_BAR; PG8_MMA(1, 1, At, B1); PG8_BAR;
            PG8_LDB(B0, 1, 0); PG8_SCHED; PG8_LDA(At, 1, 0); PG8_STAGE(PG8_SA(0, 1), a2 + hstep, voffA);
            PG8_WAIT_L(8); PG8_BAR; PG8_WAIT_L(0); PG8_MMA(0, 0, At, B0); PG8_BAR; PG8_SCHED;
            PG8_LDB(B1, 1, 1); PG8_STAGE(PG8_SB(1, 0), b3, voffB);
            PG8_BAR; PG8_WAIT_L(0); PG8_MMA(0, 1, At, B1); PG8_BAR;
            PG8_LDA(At, 1, 1); PG8_STAGE(PG8_SA(1, 0), a3, voffA);
            PG8_BAR; PG8_WAIT_L(0); PG8_MMA(1, 0, At, B0); PG8_BAR; PG8_SCHED;
            PG8_STAGE(PG8_SB(1, 1), b3 + hstep, voffB);
            PG8_WAIT_V(6); PG8_BAR; PG8_MMA(1, 1, At, B1); PG8_BAR;
        }
        PG8_STAMP();
        if constexpr (!Epi::AFTER_DRAIN) { E(acc, cur, wr, wc, fr, fq); S.done(cur); }
        PG8_STAMP();
        if (!has_next) break;
#pragma unroll
        for (int a = 0; a < 2; ++a)
#pragma unroll
            for (int b = 0; b < 2; ++b)
#pragma unroll
                for (int m = 0; m < 4; ++m)
#pragma unroll
                    for (int n = 0; n < 2; ++n) acc[a][b][m][n] = (f32x4){0.f, 0.f, 0.f, 0.f};
        cur = nxt; cA = nA; cB = nB; ++ui;
    }
    PG8_WAIT_V(0);
    if (wr == 0) PG8_BAR;
    PG8_BAR;
    if constexpr (Epi::AFTER_DRAIN) { E.fused(acc, cur, wr, wc, fr, fq, lds, wid, lane); S.done(cur); }
    PG8_STAMP();
    if (STAMP && wid == 0) { stamps[lane] = lane < nts ? (((unsigned long long)(unsigned)ts_hi << 32) | (unsigned)ts_lo) : 0ull;
        if (lane == 62) stamps[62] = rt_entry; if (lane == 63) stamps[63] = (unsigned long long)wall_clock64(); }
#undef PG8_STAMP
#undef PG8_SA
#undef PG8_SB
#undef PG8_STAGE
#undef PG8_LDA
#undef PG8_LDB
#undef PG8_MMA
#undef PG8_WAIT_V
#undef PG8_WAIT_L
#undef PG8_BAR
#undef PG8_SCHED
}
}

#define LAS __attribute__((address_space(3)))
typedef unsigned short u16;
typedef float f32x4 __attribute__((ext_vector_type(4)));
typedef unsigned u32x4 __attribute__((ext_vector_type(4)));
typedef unsigned u32x2 __attribute__((ext_vector_type(2)));
using pg8::cvt_pk_bf16;

constexpr int MT = 36864, NPR = 4096, DM = 1024, DFF = 2816;
constexpr int OUT_STATE = MT * DM;
constexpr int LDS_BYTES = 163840, PTAB_OFF = 163840 - 256;

constexpr size_t SZ_W13 = (size_t)5632 * 1024 * 2, SZ_W2 = (size_t)1024 * 2816 * 2;
constexpr size_t WS_W13A = 0, WS_W2A = WS_W13A + SZ_W13, WS_W13B = WS_W2A + SZ_W2, WS_W2B = WS_W13B + SZ_W13;
constexpr size_t WS_WIN = WS_W2B + SZ_W2;
constexpr size_t WS_WZ = WS_WIN + (size_t)4096 * 1024 * 2;
constexpr size_t WS_WO = WS_WZ + (size_t)1024 * 1024 * 2;
constexpr size_t WS_WF = WS_WO + (size_t)1024 * 512 * 2;
constexpr size_t WS_WOUT = WS_WF + (size_t)1024 * 512 * 2;
constexpr size_t WS_GUP = WS_WOUT + (size_t)1024 * 1024 * 2;
constexpr size_t WS_MOD = WS_GUP + (size_t)512 * 256 * 2;
constexpr size_t WS_BS = WS_MOD + (size_t)9 * 9216 * 4;
constexpr size_t WS_SG = WS_BS + (size_t)MT * 16 * 4;
constexpr size_t WS_H = WS_SG + (size_t)MT * 256 * 2;
constexpr size_t WS_BIG = WS_H + (size_t)MT * 1024 * 2;
constexpr size_t WS_U16 = WS_BIG;
constexpr size_t WS_FOUR = WS_U16 + (size_t)MT * 1792 * 2;
constexpr size_t WS_OPRE = WS_FOUR + (size_t)MT * 512 * 2;
constexpr size_t WS_R = WS_BIG + (size_t)MT * 2816 * 2;
constexpr size_t WS_T = WS_R;
constexpr size_t WS_T256 = WS_T + (size_t)4096 * 8192 * 2;
constexpr size_t WS_ZL = WS_T256 + (size_t)256 * 512 * 2;
constexpr size_t WS_ZP = WS_ZL + (size_t)4096 * 8192 * 2;
constexpr int GLD = 2304;
constexpr size_t WS_END = WS_R + (size_t)MT * GLD * 2;
static_assert(WS_ZP + (size_t)8192 * 512 * 2 <= WS_END, "R region");
static_assert(WS_OPRE + (size_t)MT * 512 * 2 <= WS_R, "BIG region");
static_assert(WS_END <= (size_t)536870912, "workspace");
static_assert(WS_ZP == WS_ZL + (size_t)4096 * 8192 * 2, "ZP behind ZL");

struct Params { const float* in[30]; float* out; unsigned char* ws; };
__device__ __forceinline__ unsigned long long ld_ptr(LAS unsigned char* lds, int i) {
    const u32x2 v = *(const LAS u32x2*)(lds + PTAB_OFF + i * 8);
    const unsigned lo = __builtin_amdgcn_readfirstlane(v.x), hi = __builtin_amdgcn_readfirstlane(v.y);
    return ((unsigned long long)hi << 32) | lo;
}
template <class T> __device__ __forceinline__ T* as_global(unsigned long long v) {
    return (T*)(__attribute__((address_space(1))) T*)v;
}
__device__ __forceinline__ Params get_params(LAS unsigned char* lds) {
    Params Q;
#pragma unroll
    for (int i = 0; i < 30; ++i) Q.in[i] = as_global<const float>(ld_ptr(lds, i));
    Q.out = as_global<float>(ld_ptr(lds, 30)); Q.ws = as_global<unsigned char>(ld_ptr(lds, 31));
    return Q;
}
__device__ __forceinline__ float bf2f(unsigned v16) { return __uint_as_float(v16 << 16); }
__device__ __forceinline__ float h2f(unsigned v16) { return (float)__builtin_bit_cast(_Float16, (unsigned short)v16); }
__device__ __forceinline__ unsigned pk_h(float a, float b) {
    const unsigned short ua = __builtin_bit_cast(unsigned short, (_Float16)a), ub = __builtin_bit_cast(unsigned short, (_Float16)b);
    return (unsigned)ua | ((unsigned)ub << 16);
}
__device__ __forceinline__ float sigmoidf_(float x) { return __builtin_amdgcn_rcpf(1.0f + __expf(-x)); }
__device__ __forceinline__ int modidx_pm(int pm) { return pm < 16 ? 8 : ((pm - 16) >> 4); }
__device__ __forceinline__ int modidx_m(int m) { return m < NPR ? 8 : ((m - NPR) >> 12); }

struct EpiSwiglu {
    static constexpr bool PERM = true, AFTER_DRAIN = false;
    u16* G;
    __device__ __forceinline__ void operator()(const f32x4 (&acc)[2][2][4][2], const pg8::Unit& u, int wr, int wc, int fr, int fq) const {
        const int row0 = u.pm * 256 + wr * 64 + fr, col0 = u.pn * 128 + wc * 32 + 8 * fq;
#pragma unroll
        for (int ai = 0; ai < 2; ++ai)
#pragma unroll
            for (int m = 0; m < 4; ++m) {
                float g[8];
#pragma unroll
                for (int n = 0; n < 2; ++n)
#pragma unroll
                    for (int j = 0; j < 4; ++j) { const float a = acc[ai][0][m][n][j], b = acc[ai][1][m][n][j]; g[n * 4 + j] = a * sigmoidf_(a) * b; }
                u32x4 w; w.x = cvt_pk_bf16(g[0], g[1]); w.y = cvt_pk_bf16(g[2], g[3]); w.z = cvt_pk_bf16(g[4], g[5]); w.w = cvt_pk_bf16(g[6], g[7]);
                *(u32x4*)(G + (size_t)(row0 + ai * 128 + m * 16) * DFF + col0) = w;
            }
    }
};
struct EpiResid {
    static constexpr bool PERM = false, AFTER_DRAIN = false;
    const float* xp; const float* xs; float* X; const float* MOD; int slot; float coef;
    __device__ __forceinline__ void operator()(const f32x4 (&acc)[2][2][4][2], const pg8::Unit& u, int wr, int wc, int fr, int fq) const {
        const int row0 = u.pm * 256 + wr * 64 + fr, col0 = u.pn * 256 + wc * 32 + 4 * fq;
        const float* g = MOD + (size_t)modidx_pm(u.pm) * 9216 + slot * 1024 + col0;
        f32x4 gv[2][2];
#pragma unroll
        for (int bj = 0; bj < 2; ++bj)
#pragma unroll
            for (int n = 0; n < 2; ++n) gv[bj][n] = *(const f32x4*)(g + bj * 128 + n * 16) * coef;
#pragma unroll
        for (int ai = 0; ai < 2; ++ai)
#pragma unroll
            for (int m = 0; m < 4; ++m) {
                const int row = row0 + ai * 128 + m * 16;
                const float* src = (xp ? (row < NPR ? xp + (size_t)row * DM : xs + (size_t)(row - NPR) * DM) : X + (size_t)row * DM) + col0;
                float* dst = X + (size_t)row * DM + col0;
#pragma unroll
                for (int bj = 0; bj < 2; ++bj)
#pragma unroll
                    for (int n = 0; n < 2; ++n) *(f32x4*)(dst + bj * 128 + n * 16) = *(const f32x4*)(src + bj * 128 + n * 16) + gv[bj][n] * acc[ai][bj][m][n];
            }
    }
};
struct EpiU {
    static constexpr bool PERM = true, AFTER_DRAIN = false;
    u16* U; u16* SG; u16* GATES; const float* gate_b;
    __device__ __forceinline__ void operator()(const f32x4 (&acc)[2][2][4][2], const pg8::Unit& u, int wr, int wc, int fr, int fq) const {
        const int row0 = u.pm * 256 + wr * 64 + fr, ct = wc * 32 + 8 * fq;
        if (u.pn < 7) {
#pragma unroll
            for (int ai = 0; ai < 2; ++ai)
#pragma unroll
                for (int m = 0; m < 4; ++m)
#pragma unroll
                    for (int bj = 0; bj < 2; ++bj) { const f32x4 v0 = acc[ai][bj][m][0], v1 = acc[ai][bj][m][1];
                        u32x4 w; w.x = pk_h(v0[0], v0[1]); w.y = pk_h(v0[2], v0[3]); w.z = pk_h(v1[0], v1[1]); w.w = pk_h(v1[2], v1[3]);
                        *(u32x4*)(U + (size_t)(row0 + ai * 128 + m * 16) * 1792 + u.pn * 256 + bj * 128 + ct) = w; }
        } else {
            const int gc0 = (u.pn == 7 ? 2048 : (u.pn - 8) * 256) + ct;
#pragma unroll
            for (int bj = 0; bj < 2; ++bj) {
                const int gbi = (u.pn == 7 ? 0 : (u.pn - 8) * 256) + ct; const float bsc = u.pn == 7 ? 0.f : 1.f;
                const f32x4 b0 = *(const f32x4*)(gate_b + gbi + bj * 128) * bsc, b1 = *(const f32x4*)(gate_b + gbi + bj * 128 + 4) * bsc;
#pragma unroll
                for (int ai = 0; ai < 2; ++ai)
#pragma unroll
                    for (int m = 0; m < 4; ++m) { const f32x4 v0 = acc[ai][bj][m][0] + b0, v1 = acc[ai][bj][m][1] + b1;
                        u32x4 w; w.x = pk_h(sigmoidf_(v0[0]), sigmoidf_(v0[1])); w.y = pk_h(sigmoidf_(v0[2]), sigmoidf_(v0[3]));
                        w.z = pk_h(sigmoidf_(v1[0]), sigmoidf_(v1[1])); w.w = pk_h(sigmoidf_(v1[2]), sigmoidf_(v1[3]));
                        *(u32x4*)(GATES + (size_t)(row0 + ai * 128 + m * 16) * GLD + gc0 + bj * 128) = w; }
            }
        }
    }
};
struct EpiZT {
    static constexpr bool PERM = true, AFTER_DRAIN = false;
    u16* ZL;
    __device__ __forceinline__ void operator()(const f32x4 (&acc)[2][2][4][2], const pg8::Unit& u, int wr, int wc, int fr, int fq) const {
#pragma unroll
        for (int bj = 0; bj < 2; ++bj) {
            const int c0 = u.pn * 256 + bj * 128 + wc * 32 + 8 * fq;
#pragma unroll
            for (int ai = 0; ai < 2; ++ai)
#pragma unroll
                for (int m = 0; m < 4; ++m) {
                    const int zr = u.pm * 256 + ai * 128 + wr * 64 + m * 16 + fr, g = zr >> 8, part = (zr >> 7) & 1, kn = zr & 127;
                    size_t off;
                    if (u.pn < 16) off = (size_t)4096 * 8192 + ((size_t)(u.pn * 512 + g * 128 + kn) * 512 + part * 256 + (c0 - u.pn * 256));
                    else { const int tok = c0 - NPR, b = tok >> 12, rc = tok & 4095; off = (size_t)(b * 512 + g * 128 + kn) * 8192 + part * 4096 + rc; }
                    u16* dst = ZL + off;
                    const f32x4 v0 = acc[ai][bj][m][0], v1 = acc[ai][bj][m][1];
                    u32x4 w; w.x = cvt_pk_bf16(v0[0], v0[1]); w.y = cvt_pk_bf16(v0[2], v0[3]); w.z = cvt_pk_bf16(v1[0], v1[1]); w.w = cvt_pk_bf16(v1[2], v1[3]);
                    *(u32x4*)dst = w;
                }
        }
    }
};
struct EpiFour {
    static constexpr bool PERM = true, AFTER_DRAIN = false;
    u16* FOUR; int latent;
    __device__ __forceinline__ void operator()(const f32x4 (&acc)[2][2][4][2], const pg8::Unit& u, int wr, int wc, int fr, int fq) const {
        const int b = u.pn >> 1, ch0 = (u.pn & 1) * 256 + wc * 32 + 8 * fq;
        const int tok0 = (latent ? NPR + b * 4096 : b * 256) + u.pm * 256 + wr * 64 + fr;
#pragma unroll
        for (int ai = 0; ai < 2; ++ai)
#pragma unroll
            for (int m = 0; m < 4; ++m)
#pragma unroll
                for (int bj = 0; bj < 2; ++bj) { const f32x4 v0 = acc[ai][bj][m][0], v1 = acc[ai][bj][m][1];
                    u32x4 w; w.x = cvt_pk_bf16(v0[0], v0[1]); w.y = cvt_pk_bf16(v0[2], v0[3]); w.z = cvt_pk_bf16(v1[0], v1[1]); w.w = cvt_pk_bf16(v1[2], v1[3]);
                    *(u32x4*)(FOUR + (size_t)(tok0 + ai * 128 + m * 16) * 512 + ch0 + bj * 128) = w; }
    }
};
struct EpiMul {
    static constexpr bool PERM = true, AFTER_DRAIN = false;
    u16* O; const u16* GATES; int mode;
    __device__ __forceinline__ void operator()(const f32x4 (&acc)[2][2][4][2], const pg8::Unit& u, int wr, int wc, int fr, int fq) const {
        const int row0 = u.pm * 256 + wr * 64 + fr, col0 = u.pn * 256 + wc * 32 + 8 * fq;
        const int ld = mode == 0 ? 512 : 1024;
#pragma unroll
        for (int ai = 0; ai < 2; ++ai)
#pragma unroll
            for (int m = 0; m < 4; ++m)
#pragma unroll
                for (int bj = 0; bj < 2; ++bj) {
                    const int row = row0 + ai * 128 + m * 16, col = col0 + bj * 128;
                    u16* p = O + (size_t)row * ld + col;
                    float v[8];
#pragma unroll
                    for (int j = 0; j < 4; ++j) { v[j] = acc[ai][bj][m][0][j]; v[4 + j] = acc[ai][bj][m][1][j]; }
                    if (mode == 0) {
                        const u32x4 q = *(const u32x4*)p;
#pragma unroll
                        for (int j = 0; j < 4; ++j) { v[2 * j] *= bf2f(q[j] & 0xffffu); v[2 * j + 1] *= bf2f(q[j] >> 16); }
                    } else {
                        const u32x4 gq = *(const u32x4*)(GATES + (size_t)row * GLD + (mode == 2 ? 1024 : 0) + col);
#pragma unroll
                        for (int j = 0; j < 4; ++j) { v[2 * j] *= h2f(gq[j] & 0xffffu); v[2 * j + 1] *= h2f(gq[j] >> 16); }
                        if (mode == 2) { const u32x4 q = *(const u32x4*)p;
#pragma unroll
                            for (int j = 0; j < 4; ++j) { v[2 * j] += bf2f(q[j] & 0xffffu); v[2 * j + 1] += bf2f(q[j] >> 16); } }
                    }
                    u32x4 w; w.x = cvt_pk_bf16(v[0], v[1]); w.y = cvt_pk_bf16(v[2], v[3]); w.z = cvt_pk_bf16(v[4], v[5]); w.w = cvt_pk_bf16(v[6], v[7]);
                    *(u32x4*)p = w;
                }
    }
};

template <class Epi>
__device__ __forceinline__ void run_gemm(LAS unsigned char* lds, const u16* A, const u16* Bt, int M, int N, int K, const Epi& E) {
    pg8::Gemm g{A, Bt, M, N, K}; pg8::StaticOrder S; S.init(M, N, (int)gridDim.x, (int)blockIdx.x);
    pg8::gemm_phase<Epi, pg8::StaticOrder, false>(lds, g, S, E, nullptr);
}

__device__ __forceinline__ void transpose_tile(const float* src, int ld_src, int col0, int k0, int krows, u16* dst, int n0, int K, LAS float* tile) {
    const int t = threadIdx.x;
#pragma unroll
    for (int i = 0; i < 8; ++i) { const int kk = (t >> 6) + 8 * i, nn = t & 63;
        float v = 0.f; if (col0 >= 0 && k0 + kk < krows) v = src[(size_t)(k0 + kk) * ld_src + col0 + nn];
        tile[kk * 65 + nn] = v; }
    __syncthreads();
    const int nn = t >> 3, ks = (t & 7) * 8;
    float v[8];
#pragma unroll
    for (int j = 0; j < 8; ++j) v[j] = tile[(ks + j) * 65 + nn];
    u32x4 w; w.x = cvt_pk_bf16(v[0], v[1]); w.y = cvt_pk_bf16(v[2], v[3]); w.z = cvt_pk_bf16(v[4], v[5]); w.w = cvt_pk_bf16(v[6], v[7]);
    *(u32x4*)(dst + (size_t)(n0 + nn) * K + k0 + ks) = w;
    __syncthreads();
}

__device__ __forceinline__ void phase_prep(const Params& P, LAS unsigned char* lds) {
    LAS float* L = (LAS float*)lds;
    LAS float* tile = L;
    LAS float* cs128 = L + 4160; LAS float* sn128 = cs128 + 128;
    LAS float* cs64 = sn128 + 128;  LAS float* sn64 = cs64 + 64;
    LAS float* cs256 = sn64 + 64;   LAS float* sn256 = cs256 + 256;
    LAS float* frow = sn256 + 256;
    LAS float* sc = frow + 512;
    LAS float* red = sc + 9216;
    const int tid = threadIdx.x, G = gridDim.x, bid = blockIdx.x;
    unsigned char* ws = P.ws;
    if (tid < 256) { float s, c; sincospif(2.0f * (float)tid / 256.0f, &s, &c); cs256[tid] = c; sn256[tid] = s; }
    if (tid < 128) { float s, c; sincospif(2.0f * (float)tid / 128.0f, &s, &c); cs128[tid] = c; sn128[tid] = s; }
    if (tid < 64)  { float s, c; sincospif(2.0f * (float)tid / 64.0f, &s, &c); cs64[tid] = c; sn64[tid] = s; }
    __syncthreads();

    if (bid < 144) {
        for (int i = tid; i < 9216; i += 512) { const int v = i >> 10, k = i & 1023; const float x = v < 8 ? P.in[4][v * 1024 + k] : P.in[5][k]; sc[i] = x / (1.0f + expf(-x)); }
        __syncthreads();
        const int c = tid & 63, kg = tid >> 6; const float* aw = P.in[6] + bid * 64 + c;
        float a[9];
#pragma unroll
        for (int v = 0; v < 9; ++v) a[v] = 0.f;
        for (int k0 = kg; k0 < 1024; k0 += 64) {
            float w8[8];
#pragma unroll
            for (int u = 0; u < 8; ++u) w8[u] = aw[(size_t)(k0 + 8 * u) * 9216];
#pragma unroll
            for (int u = 0; u < 8; ++u)
#pragma unroll
                for (int v = 0; v < 9; ++v) a[v] += sc[v * 1024 + k0 + 8 * u] * w8[u]; }
#pragma unroll
        for (int v = 0; v < 9; ++v) red[(kg * 9 + v) * 64 + c] = a[v];
        __syncthreads();
        float* MOD = (float*)(ws + WS_MOD);
        for (int i = tid; i < 576; i += 512) { const int v = i >> 6, cc = i & 63; float s = 0.f;
#pragma unroll
            for (int q = 0; q < 8; ++q) s += red[(q * 9 + v) * 64 + cc];
            MOD[v * 9216 + bid * 64 + cc] = s + P.in[7][bid * 64 + cc]; }
        __syncthreads();
    }

    {
        const int total = 5792;
#define PREP_DECODE(Q, SRC, LD, KROWS, KD, COL0, N0, K0, DST) { \
            int j = 0, r = (Q), nk = 16; \
            PREP_STEP(0, 88 * 16, 44) PREP_STEP(1, 16 * 44, 16) PREP_STEP(2, 88 * 16, 44) PREP_STEP(3, 16 * 44, 16) \
            PREP_STEP(4, 64 * 16, 8) PREP_STEP(5, 16 * 8, 8) PREP_STEP(6, 16 * 8, 16) PREP_STEP(7, 16 * 16, 4) \
            const int tn = r / nk, tk = r % nk; N0 = tn * 64; K0 = tk * 64; COL0 = N0; \
            if (j == 0 || j == 2) { SRC = j == 0 ? P.in[9] : P.in[11]; LD = 5632; KROWS = 1024; KD = 1024; DST = (u16*)(ws + (j == 0 ? WS_W13A : WS_W13B)); \
                const int pn = N0 >> 8, rr = N0 & 255; COL0 = rr < 128 ? 128 * pn + rr : 2816 + 128 * pn + (rr - 128); } \
            else if (j == 1 || j == 3) { SRC = j == 1 ? P.in[10] : P.in[12]; LD = 1024; KROWS = 2816; KD = 2816; DST = (u16*)(ws + (j == 1 ? WS_W2A : WS_W2B)); } \
            else if (j == 4) { SRC = P.in[13]; LD = 4480; KROWS = 1024; KD = 1024; DST = (u16*)(ws + WS_WIN); \
                COL0 = N0 < 1920 ? N0 : (N0 < 2048 ? -1 : 2432 + (N0 - 2048)); } \
            else if (j == 5) { SRC = P.in[26]; LD = 1024; KROWS = 512; KD = 512; DST = (u16*)(ws + WS_WO); } \
            else if (j == 6) { SRC = P.in[27]; LD = 1024; KROWS = 512; KD = 512; DST = (u16*)(ws + WS_WF); } \
            else if (j == 7) { SRC = P.in[28]; LD = 1024; KROWS = 1024; KD = 1024; DST = (u16*)(ws + WS_WOUT); } \
            else { SRC = P.in[20]; LD = 512; KROWS = 128; KD = 256; DST = (u16*)(ws + WS_GUP); } }
#define PREP_STEP(JJ, CNT, NKN) if (j == JJ && r >= (CNT)) { r -= (CNT); j = JJ + 1; nk = NKN; }
#define PREP_LOAD(V, SRC, LD, KROWS, COL0, K0) { _Pragma("unroll") for (int i = 0; i < 8; ++i) { const int kk = (tid >> 6) + 8 * i, nn = tid & 63; \
            V[i] = ((COL0) >= 0 && (K0) + kk < (KROWS)) ? SRC[(size_t)((K0) + kk) * (LD) + (COL0) + nn] : 0.f; } }
        float cur[8], nxt[8];
        const float* srcc = nullptr; int ldc = 0, krc = 0, kdc = 0, colc = 0, n0c = 0, k0c = 0; u16* dstc = nullptr;
        if (bid < total) { PREP_DECODE(bid, srcc, ldc, krc, kdc, colc, n0c, k0c, dstc) PREP_LOAD(cur, srcc, ldc, krc, colc, k0c) }
        for (int q = bid; q < total; q += G) {
            const float* srcn = srcc; int ldn = ldc, krn = krc, kdn = kdc, coln = colc, n0n = n0c, k0n = k0c; u16* dstn = dstc;
            if (q + G < total) { PREP_DECODE(q + G, srcn, ldn, krn, kdn, coln, n0n, k0n, dstn) PREP_LOAD(nxt, srcn, ldn, krn, coln, k0n) }
#pragma unroll
            for (int i = 0; i < 8; ++i) tile[((tid >> 6) + 8 * i) * 65 + (tid & 63)] = cur[i];
            __syncthreads();
            { const int nn = tid >> 3, ks = (tid & 7) * 8; float v[8];
#pragma unroll
              for (int jj = 0; jj < 8; ++jj) v[jj] = tile[(ks + jj) * 65 + nn];
              u32x4 w; w.x = cvt_pk_bf16(v[0], v[1]); w.y = cvt_pk_bf16(v[2], v[3]); w.z = cvt_pk_bf16(v[4], v[5]); w.w = cvt_pk_bf16(v[6], v[7]);
              *(u32x4*)(dstc + (size_t)(n0c + nn) * kdc + k0c + ks) = w; }
            __syncthreads();
            srcc = srcn; ldc = ldn; krc = krn; kdc = kdn; colc = coln; n0c = n0n; k0c = k0n; dstc = dstn;
#pragma unroll
            for (int i = 0; i < 8; ++i) cur[i] = nxt[i];
        }
#undef PREP_STEP
#undef PREP_DECODE
#undef PREP_LOAD
    }

    {
        u16* WZ = (u16*)(ws + WS_WZ);
        for (int k = bid; k < 1024; k += G) {
            frow[tid] = P.in[13][(size_t)k * 4480 + 1920 + tid];
            __syncthreads();
#pragma unroll
            for (int rep = 0; rep < 2; ++rep) { const int zc = tid + rep * 512, g = zc >> 8, part = (zc >> 7) & 1, kn = zc & 127;
                const LAS float* tab = part ? sn128 : cs128; float s = 0.f;
                for (int n = 0; n < 128; ++n) s += frow[g * 128 + n] * tab[(kn * n) & 127];
                s *= 0.08838834764831845f; if (part) s = -s;
                WZ[(size_t)zc * 1024 + k] = (u16)(cvt_pk_bf16(s, 0.f) & 0xffffu); }
            __syncthreads();
        }
    }

    {
        u16* T = (u16*)(ws + WS_T);
        for (size_t vi = (size_t)bid * 512 + tid; vi < (size_t)4096 * 1024; vi += (size_t)G * 512) {
            const int row = (int)(vi >> 10), cv = (int)(vi & 1023) * 8, part = cv >> 12, r = (cv >> 6) & 63, c0 = cv & 63, kr = row >> 6, kc = row & 63;
            const LAS float* tab = part ? sn64 : cs64; const int base = kr * r;
            float v[8];
#pragma unroll
            for (int j = 0; j < 8; ++j) v[j] = tab[(base + kc * (c0 + j)) & 63] * 0.015625f;
            u32x4 w; w.x = cvt_pk_bf16(v[0], v[1]); w.y = cvt_pk_bf16(v[2], v[3]); w.z = cvt_pk_bf16(v[4], v[5]); w.w = cvt_pk_bf16(v[6], v[7]);
            *(u32x4*)(T + vi * 8) = w;
        }
        u16* T2 = (u16*)(ws + WS_T256);
        for (int vi = bid * 512 + tid; vi < 256 * 64; vi += G * 512) {
            const int kt = vi >> 6, cv = (vi & 63) * 8, part = cv >> 8, t0 = cv & 255;
            const LAS float* tab = part ? sn256 : cs256;
            float v[8];
#pragma unroll
            for (int j = 0; j < 8; ++j) v[j] = tab[(kt * (t0 + j)) & 255] * 0.0625f;
            u32x4 w; w.x = cvt_pk_bf16(v[0], v[1]); w.y = cvt_pk_bf16(v[2], v[3]); w.z = cvt_pk_bf16(v[4], v[5]); w.w = cvt_pk_bf16(v[6], v[7]);
            *(u32x4*)(T2 + (size_t)vi * 8) = w;
        }
    }
}

template <int CTRL> __device__ __forceinline__ float dpp_add(float v) {
    return v + __int_as_float(__builtin_amdgcn_update_dpp(0, __float_as_int(v), CTRL, 0xF, 0xF, true));
}
__device__ __forceinline__ float sum16(float v) {
    v = dpp_add<0xB1>(v); v = dpp_add<0x4E>(v); v = dpp_add<0x141>(v); v = dpp_add<0x140>(v); return v;
}
__device__ __forceinline__ float sum64(float v) {
    const float t = sum16(v);
    const int ti = __float_as_int(t);
    return __int_as_float(__builtin_amdgcn_readlane(ti, 0)) + __int_as_float(__builtin_amdgcn_readlane(ti, 16)) + __int_as_float(__builtin_amdgcn_readlane(ti, 32)) + __int_as_float(__builtin_amdgcn_readlane(ti, 48));
}
__device__ __forceinline__ float wave_sum(float v) {
#pragma unroll
    for (int o = 32; o >= 1; o >>= 1) v += __shfl_xor(v, o);
    return v;
}
__device__ __forceinline__ const float* norm_row(const Params& P, const float* X, int m) {
    return X ? X + (size_t)m * DM : (m < NPR ? P.in[0] + (size_t)m * DM : P.in[1] + (size_t)(m - NPR) * DM);
}
__device__ __forceinline__ void phase_norm(const Params& P, const float* X, int nwi, int slot_shift, int slot_scale, u16* H) {
    const int lane = threadIdx.x & 63, gw = blockIdx.x * 8 + (threadIdx.x >> 6), nw = gridDim.x * 8;
    const float* MOD = (const float*)(P.ws + WS_MOD); const float* normw = P.in[8] + nwi * 1024;
    f32x4 v[4], vn[4];
    if (gw < MT) { const float* xr = norm_row(P, X, gw);
#pragma unroll
        for (int i = 0; i < 4; ++i) v[i] = *(const f32x4*)(xr + i * 256 + lane * 4); }
    for (int m = gw; m < MT; m += nw) {
        const int mn = m + nw < MT ? m + nw : m;
        { const float* xr = norm_row(P, X, mn);
#pragma unroll
          for (int i = 0; i < 4; ++i) vn[i] = *(const f32x4*)(xr + i * 256 + lane * 4); }
        float ss = 0.f;
#pragma unroll
        for (int i = 0; i < 4; ++i) ss += v[i][0] * v[i][0] + v[i][1] * v[i][1] + v[i][2] * v[i][2] + v[i][3] * v[i][3];
        ss = sum64(ss);
        const float rs = rsqrtf(ss * (1.0f / 1024.0f) + 1e-6f);
        const float* md = MOD + (size_t)modidx_m(m) * 9216;
#pragma unroll
        for (int i = 0; i < 4; ++i) { const int c = i * 256 + lane * 4;
            const f32x4 w = *(const f32x4*)(normw + c), sc = *(const f32x4*)(md + slot_scale * 1024 + c), sh = *(const f32x4*)(md + slot_shift * 1024 + c);
            const f32x4 y = v[i] * rs * w * (sc + 1.0f) + sh;
            u32x2 o; o.x = cvt_pk_bf16(y[0], y[1]); o.y = cvt_pk_bf16(y[2], y[3]);
            *(u32x2*)(H + (size_t)m * DM + c) = o; }
#pragma unroll
        for (int i = 0; i < 4; ++i) v[i] = vn[i];
    }
}
__device__ __forceinline__ void phase_final_norm(const Params& P) {
    const int lane = threadIdx.x & 63, gw = blockIdx.x * 8 + (threadIdx.x >> 6), nw = gridDim.x * 8;
    const float* fw = P.in[29];
    f32x4 v[4], vn[4];
    if (gw < MT) { const float* xr = P.out + (size_t)gw * DM;
#pragma unroll
        for (int i = 0; i < 4; ++i) v[i] = *(const f32x4*)(xr + i * 256 + lane * 4); }
    for (int m = gw; m < MT; m += nw) {
        const int mn = m + nw < MT ? m + nw : m;
        { const float* xr = P.out + (size_t)mn * DM;
#pragma unroll
          for (int i = 0; i < 4; ++i) vn[i] = *(const f32x4*)(xr + i * 256 + lane * 4); }
        float ss = 0.f;
#pragma unroll
        for (int i = 0; i < 4; ++i) ss += v[i][0] * v[i][0] + v[i][1] * v[i][1] + v[i][2] * v[i][2] + v[i][3] * v[i][3];
        ss = sum64(ss);
        const float rs = rsqrtf(ss * (1.0f / 1024.0f) + 1e-6f);
        float* xo = P.out + (size_t)m * DM;
#pragma unroll
        for (int i = 0; i < 4; ++i) { const int c = i * 256 + lane * 4; *(f32x4*)(xo + c) = v[i] * rs * *(const f32x4*)(fw + c); }
#pragma unroll
        for (int i = 0; i < 4; ++i) v[i] = vn[i];
    }
}

__device__ __forceinline__ float fsig(float x) { return __builtin_amdgcn_rcpf(1.0f + __expf(-x)); }
struct ScanRegs { u32x2 r[3], k[3], v[3], wd, ad; };
__device__ __forceinline__ void scan_load(ScanRegs& R, const u16* U, int tok0, int T, int t, int h, int d, int cg) {
    const u32x2 z = {0u, 0u};
#pragma unroll
    for (int tap = 0; tap < 3; ++tap) { const int tn = t + tap - 1;
        if (tn >= 0 && tn < T) { const u16* row = U + (size_t)(tok0 + tn) * 1792 + h * 64 + 4 * cg;
            R.r[tap] = *(const u32x2*)row; R.k[tap] = *(const u32x2*)(row + 512); R.v[tap] = *(const u32x2*)(row + 1024); }
        else { R.r[tap] = z; R.k[tap] = z; R.v[tap] = z; } }
    const u16* row = U + (size_t)(tok0 + t) * 1792 + 1536 + d * 64 + 4 * cg;
    R.wd = *(const u32x2*)row; R.ad = *(const u32x2*)(row + 128);
}
__device__ __forceinline__ void unpack4h(const u32x2 q, float (&o)[4]) { o[0] = h2f(q.x & 0xffffu); o[1] = h2f(q.x >> 16); o[2] = h2f(q.y & 0xffffu); o[3] = h2f(q.y >> 16); }

#define LDS_BARRIER() do { asm volatile("s_waitcnt lgkmcnt(0)" ::: "memory"); __builtin_amdgcn_s_barrier(); asm volatile("" ::: "memory"); } while (0)
__device__ __forceinline__ void scan_unit(const Params& P, LAS float* L, int s, int h, int d, int half) {
    typedef float f32x16 __attribute__((ext_vector_type(16)));
    const int tid = threadIdx.x, lane = tid & 63;
    const bool producer = tid >= 256;
    const int T = s < 16 ? 256 : 4096, tok0 = s < 16 ? s * 256 : NPR + (s - 16) * 4096, nchunk = T / 32;
    const u16* U = (const u16*)(P.ws + WS_U16);
    u16* Od = (u16*)(P.ws + WS_H) + (size_t)d * MT * 512;
    float* BS = (float*)(P.ws + WS_BS);
    LAS float* cst = L;            LAS float* xwT = L + 1024;    LAS float* xaT = L + 3072;   LAS float* lora_s = L + 5120;
    LAS float* o_sb = L + 13312;   LAS float* cb = L + 15360;
    if (tid < 64) { const int c = tid, ch = h * 64 + c;
        cst[c] = P.in[16][d * 512 + ch]; cst[64 + c] = P.in[18][d * 512 + ch]; cst[128 + c] = P.in[21][ch]; cst[192 + c] = P.in[22][ch]; cst[256 + c] = P.in[23][ch];
#pragma unroll
        for (int ten = 0; ten < 3; ++ten)
#pragma unroll
            for (int tap = 0; tap < 3; ++tap) cst[(5 + ten * 3 + tap) * 64 + c] = P.in[15][tap * 1536 + ten * 512 + ch]; }
    const int c16 = tid & 15, rp = (tid >> 4) & 15, rA = half * 32 + rp, rB = rA + 16;
    f32x4 SA = {0.f, 0.f, 0.f, 0.f}, SB = {0.f, 0.f, 0.f, 0.f};
    if (!producer && s >= 16) { const float* st = (d ? P.in[3] : P.in[2]) + (size_t)((s - 16) * 8 + h) * 4096;
        SA = *(const f32x4*)(st + rA * 64 + 4 * c16); SB = *(const f32x4*)(st + rB * 64 + 4 * c16); }
    const int pt = tid - 256, pw = (pt >> 6) & 3, nt = pw & 1, kh = pw >> 1, li = lane & 31, lk = lane >> 5;
    float Bw[16], Ba[16];
    if (producer) {
#pragma unroll
        for (int s2 = 0; s2 < 16; ++s2) { const size_t o = (size_t)(d * 64 + kh * 32 + 2 * s2 + lk) * 512 + h * 64 + nt * 32 + li; Bw[s2] = P.in[17][o]; Ba[s2] = P.in[19][o]; }
    } else {
#pragma unroll
        for (int s2 = 0; s2 < 16; ++s2) { Bw[s2] = 0.f; Ba[s2] = 0.f; }
    }
    const int it0 = pt & 255, tt0 = it0 >> 4, cg0 = it0 & 15, tt1 = tt0 + 16, cg1 = cg0;
    ScanRegs R0, R1;
    if (producer) { scan_load(R0, U, tok0, T, d ? T - 1 - tt0 : tt0, h, d, cg0); scan_load(R1, U, tok0, T, d ? T - 1 - tt1 : tt1, h, d, cg1); }
    __syncthreads();
    for (int ci = -1; ci < nchunk; ++ci) {
        const int pc = ci + 1;
        LAS float* pb = cb + (pc & 1) * 12288;
        const LAS float* qb = cb + (ci & 1) * 12288;
        LAS float* o_s = o_sb + (ci & 1) * 1024;
        const bool do_prep = producer && pc < nchunk, do_step = !producer && ci >= 0;
        LAS float* r_s = pb; LAS float* w_s = pb + 2048; LAS float* kd_s = pb + 4096; LAS float* v_s = pb + 6144; LAS float* kk_s = pb + 8192; LAS float* kka_s = pb + 10240;
#define SCAN_STEPS(SEG) if (do_step) { float oAr[8], oBr[8]; float pA = 0.f, pB = 0.f;     \
        _Pragma("unroll") for (int u8 = 0; u8 < 8; ++u8) { const int tt = (SEG) * 8 + u8; \
            const f32x4 w4 = *(const LAS f32x4*)(qb + 2048 + tt * 64 + 4 * c16), kk4 = *(const LAS f32x4*)(qb + 8192 + tt * 64 + 4 * c16), ka4 = *(const LAS f32x4*)(qb + 10240 + tt * 64 + 4 * c16); \
            const f32x4 kd4 = *(const LAS f32x4*)(qb + 4096 + tt * 64 + 4 * c16), r4 = *(const LAS f32x4*)(qb + tt * 64 + 4 * c16); \
            const float vA = qb[6144 + tt * 64 + rA], vB = qb[6144 + tt * 64 + rB]; \
            float saA = SA[0] * kk4[0] + SA[1] * kk4[1] + SA[2] * kk4[2] + SA[3] * kk4[3], saB = SB[0] * kk4[0] + SB[1] * kk4[1] + SB[2] * kk4[2] + SB[3] * kk4[3]; \
            saA = dpp_add<0xB1>(saA); saB = dpp_add<0xB1>(saB); pA = dpp_add<0xB1>(pA); pB = dpp_add<0xB1>(pB); \
            saA = dpp_add<0x4E>(saA); saB = dpp_add<0x4E>(saB); pA = dpp_add<0x4E>(pA); pB = dpp_add<0x4E>(pB); \
            saA = dpp_add<0x141>(saA); saB = dpp_add<0x141>(saB); pA = dpp_add<0x141>(pA); pB = dpp_add<0x141>(pB); \
            saA = dpp_add<0x140>(saA); saB = dpp_add<0x140>(saB); pA = dpp_add<0x140>(pA); pB = dpp_add<0x140>(pB); \
            if (u8 > 0) { oAr[u8 - 1] = pA; oBr[u8 - 1] = pB; } \
            SA = SA * w4 - ka4 * saA + kd4 * vA; SB = SB * w4 - ka4 * saB + kd4 * vB; \
            pA = SA[0] * r4[0] + SA[1] * r4[1] + SA[2] * r4[2] + SA[3] * r4[3]; pB = SB[0] * r4[0] + SB[1] * r4[1] + SB[2] * r4[2] + SB[3] * r4[3]; } \
        pA = dpp_add<0xB1>(pA); pB = dpp_add<0xB1>(pB); pA = dpp_add<0x4E>(pA); pB = dpp_add<0x4E>(pB); pA = dpp_add<0x141>(pA); pB = dpp_add<0x141>(pB); pA = dpp_add<0x140>(pA); pB = dpp_add<0x140>(pB); \
        oAr[7] = pA; oBr[7] = pB; \
        if (c16 == 0) { _Pragma("unroll") for (int u8 = 0; u8 < 8; ++u8) { o_s[((SEG) * 8 + u8) * 32 + rp] = oAr[u8]; o_s[((SEG) * 8 + u8) * 32 + 16 + rp] = oBr[u8]; } } }
        if (do_prep) {
#pragma unroll
            for (int it = 0; it < 2; ++it) { const ScanRegs& R = it ? R1 : R0; const int tt_a = it ? tt1 : tt0, cg = cg0;
                float rv[4] = {0.f, 0.f, 0.f, 0.f}, kv[4] = {0.f, 0.f, 0.f, 0.f}, vv[4] = {0.f, 0.f, 0.f, 0.f};
#pragma unroll
                for (int tap = 0; tap < 3; ++tap) { float a[4], bb[4], c[4]; unpack4h(R.r[tap], a); unpack4h(R.k[tap], bb); unpack4h(R.v[tap], c);
#pragma unroll
                    for (int j = 0; j < 4; ++j) { rv[j] += a[j] * cst[(5 + tap) * 64 + 4 * cg + j]; kv[j] += bb[j] * cst[(8 + tap) * 64 + 4 * cg + j]; vv[j] += c[j] * cst[(11 + tap) * 64 + 4 * cg + j]; } }
                float kkr[4], ss = 0.f;
#pragma unroll
                for (int j = 0; j < 4; ++j) { kkr[j] = kv[j] * cst[128 + 4 * cg + j]; ss += kkr[j] * kkr[j]; }
                ss = sum16(ss);
                const float inv = __builtin_amdgcn_rsqf(fmaxf(ss, 1e-24f));
                float wdv[4], adv[4]; unpack4h(R.wd, wdv); unpack4h(R.ad, adv);
#pragma unroll
                for (int j = 0; j < 4; ++j) { const int o = tt_a * 64 + 4 * cg + j;
                    r_s[o] = rv[j]; v_s[o] = vv[j]; kd_s[o] = kv[j]; kk_s[o] = kkr[j] * inv;
                    xwT[(4 * cg + j) * 32 + tt_a] = 1.0f - 2.0f * __builtin_amdgcn_rcpf(1.0f + __expf(2.0f * wdv[j])); xaT[(4 * cg + j) * 32 + tt_a] = adv[j]; } }
            if (pc + 1 < nchunk) { const int q0 = (pc + 1) * 32 + tt0, q1 = (pc + 1) * 32 + tt1;
                scan_load(R0, U, tok0, T, d ? T - 1 - q0 : q0, h, d, cg0); scan_load(R1, U, tok0, T, d ? T - 1 - q1 : q1, h, d, cg1); }
        }
        SCAN_STEPS(0)
        LDS_BARRIER();
        if (do_prep) {
            f32x16 accw, acca;
#pragma unroll
            for (int i = 0; i < 16; ++i) { accw[i] = 0.f; acca[i] = 0.f; }
#pragma unroll
            for (int s2 = 0; s2 < 16; ++s2) { const int r = kh * 32 + 2 * s2 + lk;
                accw = __builtin_amdgcn_mfma_f32_32x32x2f32(xwT[r * 32 + li], Bw[s2], accw, 0, 0, 0);
                acca = __builtin_amdgcn_mfma_f32_32x32x2f32(xaT[r * 32 + li], Ba[s2], acca, 0, 0, 0); }
#pragma unroll
            for (int reg = 0; reg < 16; ++reg) { const int o = ((reg & 3) + 8 * (reg >> 2) + 4 * lk) * 64 + nt * 32 + li;
                lora_s[(0 * 2 + kh) * 2048 + o] = accw[reg]; lora_s[(1 * 2 + kh) * 2048 + o] = acca[reg]; }
        }
        SCAN_STEPS(1)
        LDS_BARRIER();
        if (do_prep) {
            const int c = pt & 63, tg = pt >> 6;
#pragma unroll
            for (int j = 0; j < 8; ++j) { const int tt = 8 * tg + j, o = tt * 64 + c;
                const float wl = cst[c] + lora_s[o] + lora_s[2048 + o];
                const float w = __expf(-0.6065306597f * fsig(wl));
                const float a = fsig(cst[64 + c] + lora_s[4096 + o] + lora_s[6144 + o]);
                const float k = kd_s[o], kk = kk_s[o];
                const float kd = k * (1.0f + (a - 1.0f) * cst[192 + c]);
                kd_s[o] = kd; kka_s[o] = kk * a; w_s[o] = w;
                const float bsum = sum64(r_s[o] * kd * cst[256 + c]);
                if (lane == 0 && half == 0) { const int q = pc * 32 + tt, t = d ? T - 1 - q : q; BS[(size_t)(tok0 + t) * 16 + h * 2 + d] = bsum; } }
        }
        SCAN_STEPS(2)
        LDS_BARRIER();
        SCAN_STEPS(3)
        LDS_BARRIER();
        if (do_step) { const int tt = tid >> 3, seg = tid & 7, q = ci * 32 + tt, t = d ? T - 1 - q : q;
            u32x2 w2; w2.x = cvt_pk_bf16(o_s[tt * 32 + 4 * seg], o_s[tt * 32 + 4 * seg + 1]); w2.y = cvt_pk_bf16(o_s[tt * 32 + 4 * seg + 2], o_s[tt * 32 + 4 * seg + 3]);
            *(u32x2*)(Od + (size_t)(tok0 + t) * 512 + h * 64 + half * 32 + 4 * seg) = w2; }
#undef SCAN_STEPS
    }
    if (!producer && s < 16) { float* so = P.out + OUT_STATE + (size_t)d * 524288 + (size_t)(s * 8 + h) * 4096;
        *(f32x4*)(so + rA * 64 + 4 * c16) = SA; *(f32x4*)(so + rB * 64 + 4 * c16) = SB; }
    __syncthreads();
}
__device__ __forceinline__ void phase_scan(const Params& P, LAS unsigned char* lds) {
    for (int q = blockIdx.x; q < 768; q += gridDim.x) {
        int s, rem;
        if (q < 256) { s = 16 + (q >> 5); rem = q & 31; } else { const int p = q - 256; s = p >> 5; rem = p & 31; }
        scan_unit(P, (LAS float*)lds, s, rem >> 2, (rem >> 1) & 1, rem & 1);
    }
}

struct PostRaw { unsigned of, ob, v0, v1, v2, sg; float b0, b1; };
__device__ __forceinline__ void post_load(PostRaw& r, int m, int ch, int h, int lane, const u16* OF, const u16* OB, const u16* U, const float* BS, const u16* GT) {
    const int T = m < NPR ? 256 : 4096, t = m < NPR ? (m & 255) : ((m - NPR) & 4095);
    r.of = OF[(size_t)m * 512 + ch]; r.ob = OB[(size_t)m * 512 + ch];
    r.v1 = U[(size_t)m * 1792 + 1024 + ch];
    r.v0 = t > 0 ? U[(size_t)(m - 1) * 1792 + 1024 + ch] : 0u;
    r.v2 = t < T - 1 ? U[(size_t)(m + 1) * 1792 + 1024 + ch] : 0u;
    r.sg = *(const unsigned*)(GT + (size_t)m * GLD + 2048 + 2 * lane);
    r.b0 = BS[(size_t)m * 16 + h * 2]; r.b1 = BS[(size_t)m * 16 + h * 2 + 1];
}
__device__ __forceinline__ void phase_post(const Params& P, LAS unsigned char* lds) {
    const int lane = threadIdx.x & 63, h = threadIdx.x >> 6, ch = h * 64 + lane, G = gridDim.x;
    const u16* OF = (const u16*)(P.ws + WS_H); const u16* OB = OF + (size_t)MT * 512;
    const u16* U = (const u16*)(P.ws + WS_U16); const float* BS = (const float*)(P.ws + WS_BS);
    u16* OPRE = (u16*)(P.ws + WS_OPRE); const u16* GT = (const u16*)(P.ws + WS_R);
    LAS float* sgl = (LAS float*)lds + h * 128;
    float gu[128];
#pragma unroll
    for (int k = 0; k < 128; ++k) gu[k] = P.in[20][(size_t)k * 512 + ch];
    const float lw = P.in[24][ch], lb = P.in[25][ch];
    const float cv0 = P.in[15][0 * 1536 + 1024 + ch], cv1 = P.in[15][1 * 1536 + 1024 + ch], cv2 = P.in[15][2 * 1536 + 1024 + ch];
    PostRaw cur, nxt;
    int m = blockIdx.x;
    post_load(cur, m, ch, h, lane, OF, OB, U, BS, GT);
    for (; m < MT; m += G) {
        const int mn = m + G < MT ? m + G : m;
        post_load(nxt, mn, ch, h, lane, OF, OB, U, BS, GT);
        sgl[2 * lane] = h2f(cur.sg & 0xffffu); sgl[2 * lane + 1] = h2f(cur.sg >> 16);
        const float o = bf2f(cur.of) + bf2f(cur.ob);
        const float mean = sum64(o) * (1.0f / 64.0f), d = o - mean;
        const float rstd = rsqrtf(sum64(d * d) * (1.0f / 64.0f) + 64e-5f);
        const float v = h2f(cur.v0) * cv0 + h2f(cur.v1) * cv1 + h2f(cur.v2) * cv2;
        float g0 = 0.f, g1 = 0.f, g2 = 0.f, g3 = 0.f;
#pragma unroll
        for (int k = 0; k < 128; k += 4) { const f32x4 s4 = *(const LAS f32x4*)(sgl + k);
            g0 += s4[0] * gu[k]; g1 += s4[1] * gu[k + 1]; g2 += s4[2] * gu[k + 2]; g3 += s4[3] * gu[k + 3]; }
        const float y = (d * rstd * lw + lb + (cur.b0 + cur.b1) * v) * ((g0 + g1) + (g2 + g3));
        OPRE[(size_t)m * 512 + ch] = (u16)(cvt_pk_bf16(y, 0.f) & 0xffffu);
        cur = nxt;
    }
}


constexpr size_t WS_BAR = WS_END + 65536;
static_assert(WS_BAR + 4096 <= (size_t)536870912, "barrier words");
__device__ __forceinline__ void fast_grid_sync(unsigned char* ws, unsigned k) {
    asm volatile("s_waitcnt vmcnt(0) lgkmcnt(0)" ::: "memory");
    __builtin_amdgcn_s_barrier();
    if (threadIdx.x == 0) {
        unsigned* bar = (unsigned*)(ws + WS_BAR);
        const unsigned G = gridDim.x, g = blockIdx.x & 7u, gsz = (G - g + 7u) >> 3, ngrp = G < 8u ? G : 8u;
        __builtin_amdgcn_fence(__ATOMIC_RELEASE, "agent");
        asm volatile("s_waitcnt vmcnt(0)" ::: "memory");
        const unsigned old = __hip_atomic_fetch_add(bar + g * 32, 1u, __ATOMIC_RELAXED, __HIP_MEMORY_SCOPE_AGENT);
        if (old + 1u == k * gsz) __hip_atomic_fetch_add(bar + 8 * 32, 1u, __ATOMIC_RELAXED, __HIP_MEMORY_SCOPE_AGENT);
        unsigned spins = 0;
        while (__hip_atomic_load(bar + 8 * 32, __ATOMIC_RELAXED, __HIP_MEMORY_SCOPE_AGENT) < k * ngrp) { if (++spins > (1u << 24)) break; __builtin_amdgcn_s_sleep(1); }
        __builtin_amdgcn_fence(__ATOMIC_ACQUIRE, "agent");
        asm volatile("s_waitcnt vmcnt(0)" ::: "memory");
    }
    __builtin_amdgcn_s_barrier();
    asm volatile("" ::: "memory");
}

__global__ void __launch_bounds__(512, 2) fwd_mega(Params P) {
    extern __shared__ __attribute__((aligned(16))) unsigned char lds_raw[];
    LAS unsigned char* lds = (LAS unsigned char*)lds_raw;
    cg::grid_group grid = cg::this_grid();
    if (threadIdx.x < 32) { const int i = threadIdx.x; const unsigned long long v = i < 30 ? (unsigned long long)P.in[i] : (i == 30 ? (unsigned long long)P.out : (unsigned long long)P.ws);
        *(LAS unsigned long long*)(lds + PTAB_OFF + i * 8) = v; }
    __syncthreads();
unsigned bark_ = 0; unsigned char* P_ws_ = P.ws;
#define PH_BEGIN { const Params Q = get_params(lds); unsigned char* ws = Q.ws; (void)ws;
#define PH_END } asm volatile("s_waitcnt vmcnt(0)" ::: "memory");   grid.sync();
#define PH_ENDF } fast_grid_sync(P_ws_, ++bark_);
    if (blockIdx.x == 0 && threadIdx.x < 9) ((unsigned*)(P.ws + WS_BAR))[threadIdx.x * 32] = 0u;
    PH_BEGIN phase_prep(Q, lds); PH_END
    PH_BEGIN phase_norm(Q, nullptr, 0, 0, 1, (u16*)(ws + WS_H)); PH_ENDF
    PH_BEGIN run_gemm(lds, (const u16*)(ws + WS_H), (const u16*)(ws + WS_W13A), MT, 5632, 1024, EpiSwiglu{(u16*)(ws + WS_BIG)}); PH_ENDF
    PH_BEGIN run_gemm(lds, (const u16*)(ws + WS_BIG), (const u16*)(ws + WS_W2A), MT, 1024, 2816, EpiResid{Q.in[0], Q.in[1], Q.out, (const float*)(ws + WS_MOD), 2, 0.5f}); PH_ENDF
    PH_BEGIN phase_norm(Q, Q.out, 1, 3, 4, (u16*)(ws + WS_H)); PH_ENDF
    PH_BEGIN run_gemm(lds, (const u16*)(ws + WS_WZ), (const u16*)(ws + WS_H), 1024, MT, 1024, EpiZT{(u16*)(ws + WS_ZL)}); PH_ENDF
    PH_BEGIN run_gemm(lds, (const u16*)(ws + WS_T), (const u16*)(ws + WS_ZL), 4096, 4096, 8192, EpiFour{(u16*)(ws + WS_FOUR), 1});
             run_gemm(lds, (const u16*)(ws + WS_T256), (const u16*)(ws + WS_ZP), 256, 8192, 512, EpiFour{(u16*)(ws + WS_FOUR), 0}); PH_ENDF
    PH_BEGIN run_gemm(lds, (const u16*)(ws + WS_H), (const u16*)(ws + WS_WIN), MT, 4096, 1024, EpiU{(u16*)(ws + WS_U16), (u16*)(ws + WS_SG), (u16*)(ws + WS_R), Q.in[14]}); PH_ENDF
    PH_BEGIN phase_scan(Q, lds); PH_ENDF
    PH_BEGIN phase_post(Q, lds); PH_ENDF
    PH_BEGIN run_gemm(lds, (const u16*)(ws + WS_OPRE), (const u16*)(ws + WS_WO), MT, 1024, 512, EpiMul{(u16*)(ws + WS_H), (const u16*)(ws + WS_R), 1}); PH_ENDF
    PH_BEGIN run_gemm(lds, (const u16*)(ws + WS_FOUR), (const u16*)(ws + WS_WF), MT, 1024, 512, EpiMul{(u16*)(ws + WS_H), (const u16*)(ws + WS_R), 2}); PH_ENDF
    PH_BEGIN run_gemm(lds, (const u16*)(ws + WS_H), (const u16*)(ws + WS_WOUT), MT, 1024, 1024, EpiResid{nullptr, nullptr, Q.out, (const float*)(ws + WS_MOD), 5, 1.0f}); PH_ENDF
    PH_BEGIN phase_norm(Q, Q.out, 2, 6, 7, (u16*)(ws + WS_H)); PH_ENDF
    PH_BEGIN run_gemm(lds, (const u16*)(ws + WS_H), (const u16*)(ws + WS_W13B), MT, 5632, 1024, EpiSwiglu{(u16*)(ws + WS_BIG)}); PH_ENDF
    PH_BEGIN run_gemm(lds, (const u16*)(ws + WS_BIG), (const u16*)(ws + WS_W2B), MT, 1024, 2816, EpiResid{nullptr, nullptr, Q.out, (const float*)(ws + WS_MOD), 8, 0.5f}); PH_ENDF
    { const Params Q = get_params(lds); phase_final_norm(Q); }
#undef PH_BEGIN
#undef PH_END
#undef PH_ENDF
}

extern "C" void kernel_launch(void* const* d_in, const int* in_sizes, int n_in, void* d_out, int out_size, void* d_ws, size_t ws_size, hipStream_t stream) {
    static int grid_blocks = 0;
    if (grid_blocks == 0) {
        if (n_in != 30 || ws_size < WS_END) { fprintf(stderr, "kernel_launch: unexpected n_in %d / ws_size %zu (need %zu)\n", n_in, ws_size, (size_t)WS_END); grid_blocks = -1; return; }
        int dev = 0, cus = 0, per_cu = 0;
        (void)hipGetDevice(&dev);
        (void)hipDeviceGetAttribute(&cus, hipDeviceAttributeMultiprocessorCount, dev);
        (void)hipFuncSetAttribute((const void*)fwd_mega, hipFuncAttributeMaxDynamicSharedMemorySize, LDS_BYTES);
        (void)hipOccupancyMaxActiveBlocksPerMultiprocessor(&per_cu, (const void*)fwd_mega, 512, LDS_BYTES);
        if (per_cu < 1) { fprintf(stderr, "kernel_launch: occupancy query reports %d blocks per CU\n", per_cu); per_cu = 1; }
        if (per_cu > 1) per_cu = 1;
        grid_blocks = cus * per_cu;
        (void)hipGetLastError();
    }
    if (grid_blocks < 0) return;
    Params p{};
    for (int i = 0; i < 30; ++i) p.in[i] = (const float*)d_in[i];
    p.out = (float*)d_out; p.ws = (unsigned char*)d_ws;
    void* args[] = {&p};
    hipError_t e = hipLaunchCooperativeKernel((const void*)fwd_mega, dim3(grid_blocks), dim3(512), args, LDS_BYTES, stream);
    if (e != hipSuccess) fprintf(stderr, "cooperative launch failed: %s (grid %d)\n", hipGetErrorString(e), grid_blocks);
}
```

```cpp
#include <hip/hip_runtime.h>
#include <hip/hip_cooperative_groups.h>
#include <cstdio>
namespace cg = cooperative_groups;
namespace pg8 {
#define PG8_LAS __attribute__((address_space(3)))
typedef unsigned short bf16_t;
typedef short bf16x8 __attribute__((ext_vector_type(8)));
typedef float f32x4 __attribute__((ext_vector_type(4)));
typedef unsigned u32x4 __attribute__((ext_vector_type(4)));
constexpr int BM = 256, BK = 64, HALF = 128, HTB = HALF * BK * 2  , STAGE_BYTES = 8 * HTB, NXCD = 8, WGM = 8;

__host__ __device__ __forceinline__ int lds_byte(int r, int c) { const int st = (r >> 4) * 2 + (c >> 5), rr = r & 15, cc = c & 31, ob = rr * 64 + cc * 2; return st * 1024 + (ob ^ (((ob >> 9) & 1) << 5)); }
__host__ __device__ __forceinline__ void stage_rc(int b, int& R, int& C) { const int st = b / 1024, sb = b % 1024, swz = sb ^ (((sb >> 9) & 1) << 5); R = (st >> 1) * 16 + swz / 64; C = (st & 1) * 32 + (swz % 64) / 2; }
__host__ __device__ __forceinline__ int perm32(int rho) { const int n = rho >> 4, i = rho & 15; return 8 * (i >> 2) + 4 * n + (i & 3); }

struct Unit { int pm, pn; };
struct Gemm { const bf16_t* A; const bf16_t* Bt; int M, N, K; };

struct StaticOrder {
    int nM, nN, nwg, G, c;
    __host__ __device__ __forceinline__ void init(int M, int N, int G_, int c_) { nM = M / BM; nN = N / BM; nwg = nM * nN; G = G_; c = c_; }
    __host__ __device__ __forceinline__ bool next(int i, Unit& u) const {
        const long L = (long)i * G + c; if (L >= nwg) return false;
        int wgid = (int)L; { const int q = nwg / NXCD, r = nwg % NXCD, xcd = wgid % NXCD, off = wgid / NXCD; wgid = (xcd < r ? xcd * (q + 1) : r * (q + 1) + (xcd - r) * q) + off; }
        const int nig = WGM * nN, gid = wgid / nig, fm = gid * WGM, gsz = (nM - fm) < WGM ? (nM - fm) : WGM;
        u.pm = fm + ((wgid % nig) % gsz); u.pn = (wgid % nig) / gsz; return true;
    }
    __device__ __forceinline__ void a_ready(const Unit&) const {}
    __device__ __forceinline__ void done(const Unit&) const {}
};
__device__ __forceinline__ unsigned cvt_pk_bf16(float lo, float hi) { unsigned r; asm volatile("v_cvt_pk_bf16_f32 %0, %1, %2" : "=v"(r) : "v"(lo), "v"(hi)); return r; }
template <class Epi, class Sched, bool STAMP = false>
__device__ __forceinline__ void gemm_phase(PG8_LAS unsigned char* lds, const Gemm g, const Sched& S, const Epi& E, unsigned long long* stamps) {
    int tid_ = threadIdx.x; asm volatile("" : "+v"(tid_));
    const int tid = tid_, wid = __builtin_amdgcn_readfirstlane(tid >> 6), lane = tid & 63, wr = wid >> 2, wc = wid & 3, fr = lane & 15, fq = lane >> 4;
    const int K = g.K, nt = K / BK;
    int ts_lo = 0, ts_hi = 0, nts = 0; const unsigned long long rt_entry = STAMP ? (unsigned long long)wall_clock64() : 0ull;
#define PG8_STAMP() do { if (STAMP && wid == 0 && nts < 64) { const unsigned long long _c = (unsigned long long)clock64(); \
        ts_lo = (lane == nts) ? (int)(unsigned)_c : ts_lo; ts_hi = (lane == nts) ? (int)(unsigned)(_c >> 32) : ts_hi; ++nts; } } while (0)
    PG8_STAMP();
    unsigned voffA[2], voffB[2];
#pragma unroll
    for (int i = 0; i < 2; ++i) { int R, C; stage_rc(tid * 16 + i * 8192, R, C); const int Rb = Epi::PERM ? ((R & ~31) + perm32(R & 31)) : R;
        voffA[i] = (unsigned)(R * K + C) * 2u; voffB[i] = (unsigned)(Rb * K + C) * 2u; }
    const size_t kstep = (size_t)(BK * 2);
    const size_t hstep = (size_t)HALF * K * 2;
    const size_t tstep = 2 * hstep;
    const unsigned ldsw = (unsigned)wid * 1024u;
    const int aoff = lds_byte(wr * 64 + fr, fq * 8), boff = lds_byte(wc * 32 + fr, fq * 8);
#define PG8_SA(b, h) (((b) * 2 + (h)) * HTB)
#define PG8_SB(b, h) ((4 + (b) * 2 + (h)) * HTB)
#define PG8_STAGE(bufoff, gbase, voff) do { _Pragma("unroll") for (int _i = 0; _i < 2; ++_i) \
        __builtin_amdgcn_global_load_lds((const unsigned*)((const char*)(gbase) + (voff)[_i]), (PG8_LAS unsigned*)(lds + (bufoff) + ldsw + _i * 8192), 16, 0, 0); } while (0)
#define PG8_LDA(dst, b, h) do { _Pragma("unroll") for (int m = 0; m < 4; ++m) _Pragma("unroll") for (int k = 0; k < 2; ++k) dst[m][k] = *(const PG8_LAS bf16x8*)(lds + PG8_SA(b, h) + aoff + m * 2048 + k * 1024); } while (0)
#define PG8_LDB(dst, b, h) do { _Pragma("unroll") for (int n = 0; n < 2; ++n) _Pragma("unroll") for (int k = 0; k < 2; ++k) dst[n][k] = *(const PG8_LAS bf16x8*)(lds + PG8_SB(b, h) + boff + n * 2048 + k * 1024); } while (0)
#define PG8_MMA(ai, bj, At, Bt) do { __builtin_amdgcn_s_setprio(1); _Pragma("unroll") for (int m = 0; m < 4; ++m) _Pragma("unroll") for (int n = 0; n < 2; ++n) _Pragma("unroll") for (int k = 0; k < 2; ++k) \
        acc[ai][bj][m][n] = __builtin_amdgcn_mfma_f32_16x16x32_bf16(Bt[n][k], At[m][k], acc[ai][bj][m][n], 0, 0, 0); __builtin_amdgcn_s_setprio(0); } while (0)
#define PG8_WAIT_V(n) asm volatile("s_waitcnt vmcnt(" #n ")" ::: "memory")
#define PG8_WAIT_L(n) asm volatile("s_waitcnt lgkmcnt(" #n ")" ::: "memory")
#define PG8_BAR __builtin_amdgcn_s_barrier()
#define PG8_SCHED __builtin_amdgcn_sched_barrier(0)
    Unit cur, nxt; int ui = 0;
    if (!S.next(0, cur)) return;
    f32x4 acc[2][2][4][2];
#pragma unroll
    for (int a = 0; a < 2; ++a)
#pragma unroll
        for (int b = 0; b < 2; ++b)
#pragma unroll
            for (int m = 0; m < 4; ++m)
#pragma unroll
                for (int n = 0; n < 2; ++n) acc[a][b][m][n] = (f32x4){0.f, 0.f, 0.f, 0.f};
    bf16x8 At[4][2], B0[2][2], B1[2][2];
    const char* cA = (const char*)g.A + (size_t)cur.pm * tstep; const char* cB = (const char*)g.Bt + (size_t)cur.pn * tstep;
    S.a_ready(cur);
    PG8_STAGE(PG8_SB(0, 0), cB, voffB); PG8_STAGE(PG8_SA(0, 0), cA, voffA); PG8_STAGE(PG8_SB(0, 1), cB + hstep, voffB); PG8_STAGE(PG8_SA(0, 1), cA + hstep, voffA);
    if (wr == 1) PG8_BAR;
    PG8_WAIT_V(4); PG8_BAR;
    PG8_STAGE(PG8_SB(1, 0), cB + kstep, voffB); PG8_STAGE(PG8_SA(1, 0), cA + kstep, voffA); PG8_STAGE(PG8_SB(1, 1), cB + hstep + kstep, voffB);
    PG8_WAIT_V(6); PG8_BAR;
    PG8_STAMP();
    for (;;) {
        const bool has_next = S.next(ui + 1, nxt);
        const char* nA = has_next ? (const char*)g.A + (size_t)nxt.pm * tstep : cA; const char* nB = has_next ? (const char*)g.Bt + (size_t)nxt.pn * tstep : cB;
        for (int t = 0; t < nt; t += 2) {
            const bool last = (t == nt - 2);
            const char* a1 = cA + (size_t)(t + 1) * kstep;
            const char* a2 = last ? nA : cA + (size_t)(t + 2) * kstep; const char* b2 = last ? nB : cB + (size_t)(t + 2) * kstep;
            const char* a3 = a2 + kstep; const char* b3 = b2 + kstep;
            if (last && has_next) S.a_ready(nxt);
            PG8_LDB(B0, 0, 0); PG8_SCHED; PG8_LDA(At, 0, 0); PG8_STAGE(PG8_SA(1, 1), a1 + hstep, voffA);
            PG8_WAIT_L(8); PG8_BAR; PG8_WAIT_L(0); PG8_MMA(0, 0, At, B0); PG8_BAR; PG8_SCHED;
            PG8_LDB(B1, 0, 1); PG8_STAGE(PG8_SB(0, 0), b2, voffB);
            PG8_BAR; PG8_WAIT_L(0); PG8_MMA(0, 1, At, B1); PG8_BAR;
            PG8_LDA(At, 0, 1); PG8_STAGE(PG8_SA(0, 0), a2, voffA);
            PG8_BAR; PG8_WAIT_L(0); PG8_MMA(1, 0, At, B0); PG8_BAR; PG8_SCHED;
            PG8_STAGE(PG8_SB(0, 1), b2 + hstep, voffB);
            PG8_WAIT_V(6); PG8_BAR; PG8_MMA(1, 1, At, B1); PG8_BAR;
            PG8_LDB(B0, 1, 0); PG8_SCHED; PG8_LDA(At, 1, 0); PG8_STAGE(PG8_SA(0, 1), a2 + hstep, voffA);
            PG8_WAIT_L(8); PG8_BAR; PG8_WAIT_L(0); PG8_MMA(0, 0, At, B0); PG8_BAR; PG8_SCHED;
            PG8_LDB(B1, 1, 1); PG8_STAGE(PG8_SB(1, 0), b3, voffB);
            PG8_BAR; PG8_WAIT_L(0); PG8_MMA(0, 1, At, B1); PG8_BAR;
            PG8_LDA(At, 1, 1); PG8_STAGE(PG8_SA(1, 0), a3, voffA);
            PG8_BAR; PG8_WAIT_L(0); PG8_MMA(1, 0, At, B0); PG8_BAR; PG8_SCHED;
            PG8_STAGE(PG8_SB(1, 1), b3 + hstep, voffB);
            PG8_WAIT_V(6); PG8_BAR; PG8_MMA(1, 1, At, B1); PG8_BAR;
        }
        PG8_STAMP();
        if constexpr (!Epi::AFTER_DRAIN) { E(acc, cur, wr, wc, fr, fq); S.done(cur); }
        PG8_STAMP();
        if (!has_next) break;
#pragma unroll
        for (int a = 0; a < 2; ++a)
#pragma unroll
            for (int b = 0; b < 2; ++b)
#pragma unroll
                for (int m = 0; m < 4; ++m)
#pragma unroll
                    for (int n = 0; n < 2; ++n) acc[a][b][m][n] = (f32x4){0.f, 0.f, 0.f, 0.f};
        cur = nxt; cA = nA; cB = nB; ++ui;
    }
    PG8_WAIT_V(0);
    if (wr == 0) PG8_BAR;
    PG8_BAR;
    if constexpr (Epi::AFTER_DRAIN) { E.fused(acc, cur, wr, wc, fr, fq, lds, wid, lane); S.done(cur); }
    PG8_STAMP();
    if (STAMP && wid == 0) { stamps[lane] = lane < nts ? (((unsigned long long)(unsigned)ts_hi << 32) | (unsigned)ts_lo) : 0ull;
        if (lane == 62) stamps[62] = rt_entry; if (lane == 63) stamps[63] = (unsigned long long)wall_clock64(); }
#undef PG8_STAMP
#undef PG8_SA
#undef PG8_SB
#undef PG8_STAGE
#undef PG8_LDA
#undef PG8_LDB
#undef PG8_MMA
#undef PG8_WAIT_V
#undef PG8_WAIT_L
#undef PG8_BAR
#undef PG8_SCHED
}
}

#define LAS __attribute__((address_space(3)))
typedef unsigned short u16;
typedef float f32x4 __attribute__((ext_vector_type(4)));
typedef unsigned u32x4 __attribute__((ext_vector_type(4)));
typedef unsigned u32x2 __attribute__((ext_vector_type(2)));
using pg8::cvt_pk_bf16;

constexpr int MT = 36864, NPR = 4096, DM = 1024, DFF = 2816;
constexpr int OUT_STATE = MT * DM;
constexpr int LDS_BYTES = 163840, PTAB_OFF = 163840 - 256;

constexpr size_t SZ_W13 = (size_t)5632 * 1024 * 2, SZ_W2 = (size_t)1024 * 2816 * 2;
constexpr size_t WS_W13A = 0, WS_W2A = WS_W13A + SZ_W13, WS_W13B = WS_W2A + SZ_W2, WS_W2B = WS_W13B + SZ_W13;
constexpr size_t WS_WIN = WS_W2B + SZ_W2;
constexpr size_t WS_WZ = WS_WIN + (size_t)4096 * 1024 * 2;
constexpr size_t WS_WO = WS_WZ + (size_t)1024 * 1024 * 2;
constexpr size_t WS_WF = WS_WO + (size_t)1024 * 512 * 2;
constexpr size_t WS_WOUT = WS_WF + (size_t)1024 * 512 * 2;
constexpr size_t WS_GUP = WS_WOUT + (size_t)1024 * 1024 * 2;
constexpr size_t WS_MOD = WS_GUP + (size_t)512 * 256 * 2;
constexpr size_t WS_BS = WS_MOD + (size_t)9 * 9216 * 4;
constexpr size_t WS_SG = WS_BS + (size_t)MT * 16 * 4;
constexpr size_t WS_H = WS_SG + (size_t)MT * 256 * 2;
constexpr size_t WS_BIG = WS_H + (size_t)MT * 1024 * 2;
constexpr size_t WS_U16 = WS_BIG;
constexpr size_t WS_FOUR = WS_U16 + (size_t)MT * 1792 * 2;
constexpr size_t WS_OPRE = WS_FOUR + (size_t)MT * 512 * 2;
constexpr size_t WS_R = WS_BIG + (size_t)MT * 2816 * 2;
constexpr size_t WS_T = WS_R;
constexpr size_t WS_T256 = WS_T + (size_t)4096 * 8192 * 2;
constexpr size_t WS_ZL = WS_T256 + (size_t)256 * 512 * 2;
constexpr size_t WS_ZP = WS_ZL + (size_t)4096 * 8192 * 2;
constexpr int GLD = 2304;
constexpr size_t WS_END = WS_R + (size_t)MT * GLD * 2;
static_assert(WS_ZP + (size_t)8192 * 512 * 2 <= WS_END, "R region");
static_assert(WS_OPRE + (size_t)MT * 512 * 2 <= WS_R, "BIG region");
static_assert(WS_END <= (size_t)536870912, "workspace");
static_assert(WS_ZP == WS_ZL + (size_t)4096 * 8192 * 2, "ZP behind ZL");

struct Params { const float* in[30]; float* out; unsigned char* ws; };
__device__ __forceinline__ unsigned long long ld_ptr(LAS unsigned char* lds, int i) {
    const u32x2 v = *(const LAS u32x2*)(lds + PTAB_OFF + i * 8);
    const unsigned lo = __builtin_amdgcn_readfirstlane(v.x), hi = __builtin_amdgcn_readfirstlane(v.y);
    return ((unsigned long long)hi << 32) | lo;
}
template <class T> __device__ __forceinline__ T* as_global(unsigned long long v) {
    return (T*)(__attribute__((address_space(1))) T*)v;
}
__device__ __forceinline__ Params get_params(LAS unsigned char* lds) {
    Params Q;
#pragma unroll
    for (int i = 0; i < 30; ++i) Q.in[i] = as_global<const float>(ld_ptr(lds, i));
    Q.out = as_global<float>(ld_ptr(lds, 30)); Q.ws = as_global<unsigned char>(ld_ptr(lds, 31));
    return Q;
}
__device__ __forceinline__ float bf2f(unsigned v16) { return __uint_as_float(v16 << 16); }
__device__ __forceinline__ float h2f(unsigned v16) { return (float)__builtin_bit_cast(_Float16, (unsigned short)v16); }
__device__ __forceinline__ unsigned pk_h(float a, float b) {
    const unsigned short ua = __builtin_bit_cast(unsigned short, (_Float16)a), ub = __builtin_bit_cast(unsigned short, (_Float16)b);
    return (unsigned)ua | ((unsigned)ub << 16);
}
__device__ __forceinline__ float sigmoidf_(float x) { return __builtin_amdgcn_rcpf(1.0f + __expf(-x)); }
__device__ __forceinline__ int modidx_pm(int pm) { return pm < 16 ? 8 : ((pm - 16) >> 4); }
__device__ __forceinline__ int modidx_m(int m) { return m < NPR ? 8 : ((m - NPR) >> 12); }

struct EpiSwiglu {
    static constexpr bool PERM = true, AFTER_DRAIN = false;
    u16* G;
    __device__ __forceinline__ void operator()(const f32x4 (&acc)[2][2][4][2], const pg8::Unit& u, int wr, int wc, int fr, int fq) const {
        const int row0 = u.pm * 256 + wr * 64 + fr, col0 = u.pn * 128 + wc * 32 + 8 * fq;
#pragma unroll
        for (int ai = 0; ai < 2; ++ai)
#pragma unroll
            for (int m = 0; m < 4; ++m) {
                float g[8];
#pragma unroll
                for (int n = 0; n < 2; ++n)
#pragma unroll
                    for (int j = 0; j < 4; ++j) { const float a = acc[ai][0][m][n][j], b = acc[ai][1][m][n][j]; g[n * 4 + j] = a * sigmoidf_(a) * b; }
                u32x4 w; w.x = cvt_pk_bf16(g[0], g[1]); w.y = cvt_pk_bf16(g[2], g[3]); w.z = cvt_pk_bf16(g[4], g[5]); w.w = cvt_pk_bf16(g[6], g[7]);
                *(u32x4*)(G + (size_t)(row0 + ai * 128 + m * 16) * DFF + col0) = w;
            }
    }
};
struct EpiResid {
    static constexpr bool PERM = false, AFTER_DRAIN = false;
    const float* xp; const float* xs; float* X; const float* MOD; int slot; float coef;
    __device__ __forceinline__ void operator()(const f32x4 (&acc)[2][2][4][2], const pg8::Unit& u, int wr, int wc, int fr, int fq) const {
        const int row0 = u.pm * 256 + wr * 64 + fr, col0 = u.pn * 256 + wc * 32 + 4 * fq;
        const float* g = MOD + (size_t)modidx_pm(u.pm) * 9216 + slot * 1024 + col0;
        f32x4 gv[2][2];
#pragma unroll
        for (int bj = 0; bj < 2; ++bj)
#pragma unroll
            for (int n = 0; n < 2; ++n) gv[bj][n] = *(const f32x4*)(g + bj * 128 + n * 16) * coef;
#pragma unroll
        for (int ai = 0; ai < 2; ++ai)
#pragma unroll
            for (int m = 0; m < 4; ++m) {
                const int row = row0 + ai * 128 + m * 16;
                const float* src = (xp ? (row < NPR ? xp + (size_t)row * DM : xs + (size_t)(row - NPR) * DM) : X + (size_t)row * DM) + col0;
                float* dst = X + (size_t)row * DM + col0;
#pragma unroll
                for (int bj = 0; bj < 2; ++bj)
#pragma unroll
                    for (int n = 0; n < 2; ++n) *(f32x4*)(dst + bj * 128 + n * 16) = *(const f32x4*)(src + bj * 128 + n * 16) + gv[bj][n] * acc[ai][bj][m][n];
            }
    }
};
struct EpiU {
    static constexpr bool PERM = true, AFTER_DRAIN = false;
    u16* U; u16* SG; u16* GATES; const float* gate_b;
    __device__ __forceinline__ void operator()(const f32x4 (&acc)[2][2][4][2], const pg8::Unit& u, int wr, int wc, int fr, int fq) const {
        const int row0 = u.pm * 256 + wr * 64 + fr, ct = wc * 32 + 8 * fq;
        if (u.pn < 7) {
#pragma unroll
            for (int ai = 0; ai < 2; ++ai)
#pragma unroll
                for (int m = 0; m < 4; ++m)
#pragma unroll
                    for (int bj = 0; bj < 2; ++bj) { const f32x4 v0 = acc[ai][bj][m][0], v1 = acc[ai][bj][m][1];
                        u32x4 w; w.x = pk_h(v0[0], v0[1]); w.y = pk_h(v0[2], v0[3]); w.z = pk_h(v1[0], v1[1]); w.w = pk_h(v1[2], v1[3]);
                        *(u32x4*)(U + (size_t)(row0 + ai * 128 + m * 16) * 1792 + u.pn * 256 + bj * 128 + ct) = w; }
        } else {
            const int gc0 = (u.pn == 7 ? 2048 : (u.pn - 8) * 256) + ct;
#pragma unroll
            for (int bj = 0; bj < 2; ++bj) {
                const int gbi = (u.pn == 7 ? 0 : (u.pn - 8) * 256) + ct; const float bsc = u.pn == 7 ? 0.f : 1.f;
                const f32x4 b0 = *(const f32x4*)(gate_b + gbi + bj * 128) * bsc, b1 = *(const f32x4*)(gate_b + gbi + bj * 128 + 4) * bsc;
#pragma unroll
                for (int ai = 0; ai < 2; ++ai)
#pragma unroll
                    for (int m = 0; m < 4; ++m) { const f32x4 v0 = acc[ai][bj][m][0] + b0, v1 = acc[ai][bj][m][1] + b1;
                        u32x4 w; w.x = pk_h(sigmoidf_(v0[0]), sigmoidf_(v0[1])); w.y = pk_h(sigmoidf_(v0[2]), sigmoidf_(v0[3]));
                        w.z = pk_h(sigmoidf_(v1[0]), sigmoidf_(v1[1])); w.w = pk_h(sigmoidf_(v1[2]), sigmoidf_(v1[3]));
                        *(u32x4*)(GATES + (size_t)(row0 + ai * 128 + m * 16) * GLD + gc0 + bj * 128) = w; }
            }
        }
    }
};
struct EpiZT {
    static constexpr bool PERM = true, AFTER_DRAIN = false;
    u16* ZL;
    __device__ __forceinline__ void operator()(const f32x4 (&acc)[2][2][4][2], const pg8::Unit& u, int wr, int wc, int fr, int fq) const {
#pragma unroll
        for (int bj = 0; bj < 2; ++bj) {
            const int c0 = u.pn * 256 + bj * 128 + wc * 32 + 8 * fq;
#pragma unroll
            for (int ai = 0; ai < 2; ++ai)
#pragma unroll
                for (int m = 0; m < 4; ++m) {
                    const int zr = u.pm * 256 + ai * 128 + wr * 64 + m * 16 + fr, g = zr >> 8, part = (zr >> 7) & 1, kn = zr & 127;
                    size_t off;
                    if (u.pn < 16) off = (size_t)4096 * 8192 + ((size_t)(u.pn * 512 + g * 128 + kn) * 512 + part * 256 + (c0 - u.pn * 256));
                    else { const int tok = c0 - NPR, b = tok >> 12, rc = tok & 4095; off = (size_t)(b * 512 + g * 128 + kn) * 8192 + part * 4096 + rc; }
                    u16* dst = ZL + off;
                    const f32x4 v0 = acc[ai][bj][m][0], v1 = acc[ai][bj][m][1];
                    u32x4 w; w.x = cvt_pk_bf16(v0[0], v0[1]); w.y = cvt_pk_bf16(v0[2], v0[3]); w.z = cvt_pk_bf16(v1[0], v1[1]); w.w = cvt_pk_bf16(v1[2], v1[3]);
                    *(u32x4*)dst = w;
                }
        }
    }
};
struct EpiFour {
    static constexpr bool PERM = true, AFTER_DRAIN = false;
    u16* FOUR; int latent;
    __device__ __forceinline__ void operator()(const f32x4 (&acc)[2][2][4][2], const pg8::Unit& u, int wr, int wc, int fr, int fq) const {
        const int b = u.pn >> 1, ch0 = (u.pn & 1) * 256 + wc * 32 + 8 * fq;
        const int tok0 = (latent ? NPR + b * 4096 : b * 256) + u.pm * 256 + wr * 64 + fr;
#pragma unroll
        for (int ai = 0; ai < 2; ++ai)
#pragma unroll
            for (int m = 0; m < 4; ++m)
#pragma unroll
                for (int bj = 0; bj < 2; ++bj) { const f32x4 v0 = acc[ai][bj][m][0], v1 = acc[ai][bj][m][1];
                    u32x4 w; w.x = cvt_pk_bf16(v0[0], v0[1]); w.y = cvt_pk_bf16(v0[2], v0[3]); w.z = cvt_pk_bf16(v1[0], v1[1]); w.w = cvt_pk_bf16(v1[2], v1[3]);
                    *(u32x4*)(FOUR + (size_t)(tok0 + ai * 128 + m * 16) * 512 + ch0 + bj * 128) = w; }
    }
};
struct EpiMul {
    static constexpr bool PERM = true, AFTER_DRAIN = false;
    u16* O; const u16* GATES; int mode;
    __device__ __forceinline__ void operator()(const f32x4 (&acc)[2][2][4][2], const pg8::Unit& u, int wr, int wc, int fr, int fq) const {
        const int row0 = u.pm * 256 + wr * 64 + fr, col0 = u.pn * 256 + wc * 32 + 8 * fq;
        const int ld = mode == 0 ? 512 : 1024;
#pragma unroll
        for (int ai = 0; ai < 2; ++ai)
#pragma unroll
            for (int m = 0; m < 4; ++m)
#pragma unroll
                for (int bj = 0; bj < 2; ++bj) {
                    const int row = row0 + ai * 128 + m * 16, col = col0 + bj * 128;
                    u16* p = O + (size_t)row * ld + col;
                    float v[8];
#pragma unroll
                    for (int j = 0; j < 4; ++j) { v[j] = acc[ai][bj][m][0][j]; v[4 + j] = acc[ai][bj][m][1][j]; }
                    if (mode == 0) {
                        const u32x4 q = *(const u32x4*)p;
#pragma unroll
                        for (int j = 0; j < 4; ++j) { v[2 * j] *= bf2f(q[j] & 0xffffu); v[2 * j + 1] *= bf2f(q[j] >> 16); }
                    } else {
                        const u32x4 gq = *(const u32x4*)(GATES + (size_t)row * GLD + (mode == 2 ? 1024 : 0) + col);
#pragma unroll
                        for (int j = 0; j < 4; ++j) { v[2 * j] *= h2f(gq[j] & 0xffffu); v[2 * j + 1] *= h2f(gq[j] >> 16); }
                        if (mode == 2) { const u32x4 q = *(const u32x4*)p;
#pragma unroll
                            for (int j = 0; j < 4; ++j) { v[2 * j] += bf2f(q[j] & 0xffffu); v[2 * j + 1] += bf2f(q[j] >> 16); } }
                    }
                    u32x4 w; w.x = cvt_pk_bf16(v[0], v[1]); w.y = cvt_pk_bf16(v[2], v[3]); w.z = cvt_pk_bf16(v[4], v[5]); w.w = cvt_pk_bf16(v[6], v[7]);
                    *(u32x4*)p = w;
                }
    }
};

template <class Epi>
__device__ __forceinline__ void run_gemm(LAS unsigned char* lds, const u16* A, const u16* Bt, int M, int N, int K, const Epi& E) {
    pg8::Gemm g{A, Bt, M, N, K}; pg8::StaticOrder S; S.init(M, N, (int)gridDim.x, (int)blockIdx.x);
    pg8::gemm_phase<Epi, pg8::StaticOrder, false>(lds, g, S, E, nullptr);
}

__device__ __forceinline__ void transpose_tile(const float* src, int ld_src, int col0, int k0, int krows, u16* dst, int n0, int K, LAS float* tile) {
    const int t = threadIdx.x;
#pragma unroll
    for (int i = 0; i < 8; ++i) { const int kk = (t >> 6) + 8 * i, nn = t & 63;
        float v = 0.f; if (col0 >= 0 && k0 + kk < krows) v = src[(size_t)(k0 + kk) * ld_src + col0 + nn];
        tile[kk * 65 + nn] = v; }
    __syncthreads();
    const int nn = t >> 3, ks = (t & 7) * 8;
    float v[8];
#pragma unroll
    for (int j = 0; j < 8; ++j) v[j] = tile[(ks + j) * 65 + nn];
    u32x4 w; w.x = cvt_pk_bf16(v[0], v[1]); w.y = cvt_pk_bf16(v[2], v[3]); w.z = cvt_pk_bf16(v[4], v[5]); w.w = cvt_pk_bf16(v[6], v[7]);
    *(u32x4*)(dst + (size_t)(n0 + nn) * K + k0 + ks) = w;
    __syncthreads();
}

__device__ __forceinline__ void phase_prep(const Params& P, LAS unsigned char* lds) {
    LAS float* L = (LAS float*)lds;
    LAS float* tile = L;
    LAS float* cs128 = L + 4160; LAS float* sn128 = cs128 + 128;
    LAS float* cs64 = sn128 + 128;  LAS float* sn64 = cs64 + 64;
    LAS float* cs256 = sn64 + 64;   LAS float* sn256 = cs256 + 256;
    LAS float* frow = sn256 + 256;
    LAS float* sc = frow + 512;
    LAS float* red = sc + 9216;
    const int tid = threadIdx.x, G = gridDim.x, bid = blockIdx.x;
    unsigned char* ws = P.ws;
    if (tid < 256) { float s, c; sincospif(2.0f * (float)tid / 256.0f, &s, &c); cs256[tid] = c; sn256[tid] = s; }
    if (tid < 128) { float s, c; sincospif(2.0f * (float)tid / 128.0f, &s, &c); cs128[tid] = c; sn128[tid] = s; }
    if (tid < 64)  { float s, c; sincospif(2.0f * (float)tid / 64.0f, &s, &c); cs64[tid] = c; sn64[tid] = s; }
    __syncthreads();

    if (bid < 144) {
        for (int i = tid; i < 9216; i += 512) { const int v = i >> 10, k = i & 1023; const float x = v < 8 ? P.in[4][v * 1024 + k] : P.in[5][k]; sc[i] = x / (1.0f + expf(-x)); }
        __syncthreads();
        const int c = tid & 63, kg = tid >> 6; const float* aw = P.in[6] + bid * 64 + c;
        float a[9];
#pragma unroll
        for (int v = 0; v < 9; ++v) a[v] = 0.f;
        for (int k0 = kg; k0 < 1024; k0 += 64) {
            float w8[8];
#pragma unroll
            for (int u = 0; u < 8; ++u) w8[u] = aw[(size_t)(k0 + 8 * u) * 9216];
#pragma unroll
            for (int u = 0; u < 8; ++u)
#pragma unroll
                for (int v = 0; v < 9; ++v) a[v] += sc[v * 1024 + k0 + 8 * u] * w8[u]; }
#pragma unroll
        for (int v = 0; v < 9; ++v) red[(kg * 9 + v) * 64 + c] = a[v];
        __syncthreads();
        float* MOD = (float*)(ws + WS_MOD);
        for (int i = tid; i < 576; i += 512) { const int v = i >> 6, cc = i & 63; float s = 0.f;
#pragma unroll
            for (int q = 0; q < 8; ++q) s += red[(q * 9 + v) * 64 + cc];
            MOD[v * 9216 + bid * 64 + cc] = s + P.in[7][bid * 64 + cc]; }
        __syncthreads();
    }

    {
        const int total = 5792;
#define PREP_DECODE(Q, SRC, LD, KROWS, KD, COL0, N0, K0, DST) { \
            int j = 0, r = (Q), nk = 16; \
            PREP_STEP(0, 88 * 16, 44) PREP_STEP(1, 16 * 44, 16) PREP_STEP(2, 88 * 16, 44) PREP_STEP(3, 16 * 44, 16) \
            PREP_STEP(4, 64 * 16, 8) PREP_STEP(5, 16 * 8, 8) PREP_STEP(6, 16 * 8, 16) PREP_STEP(7, 16 * 16, 4) \
            const int tn = r / nk, tk = r % nk; N0 = tn * 64; K0 = tk * 64; COL0 = N0; \
            if (j == 0 || j == 2) { SRC = j == 0 ? P.in[9] : P.in[11]; LD = 5632; KROWS = 1024; KD = 1024; DST = (u16*)(ws + (j == 0 ? WS_W13A : WS_W13B)); \
                const int pn = N0 >> 8, rr = N0 & 255; COL0 = rr < 128 ? 128 * pn + rr : 2816 + 128 * pn + (rr - 128); } \
            else if (j == 1 || j == 3) { SRC = j == 1 ? P.in[10] : P.in[12]; LD = 1024; KROWS = 2816; KD = 2816; DST = (u16*)(ws + (j == 1 ? WS_W2A : WS_W2B)); } \
            else if (j == 4) { SRC = P.in[13]; LD = 4480; KROWS = 1024; KD = 1024; DST = (u16*)(ws + WS_WIN); \
                COL0 = N0 < 1920 ? N0 : (N0 < 2048 ? -1 : 2432 + (N0 - 2048)); } \
            else if (j == 5) { SRC = P.in[26]; LD = 1024; KROWS = 512; KD = 512; DST = (u16*)(ws + WS_WO); } \
            else if (j == 6) { SRC = P.in[27]; LD = 1024; KROWS = 512; KD = 512; DST = (u16*)(ws + WS_WF); } \
            else if (j == 7) { SRC = P.in[28]; LD = 1024; KROWS = 1024; KD = 1024; DST = (u16*)(ws + WS_WOUT); } \
            else { SRC = P.in[20]; LD = 512; KROWS = 128; KD = 256; DST = (u16*)(ws + WS_GUP); } }
#define PREP_STEP(JJ, CNT, NKN) if (j == JJ && r >= (CNT)) { r -= (CNT); j = JJ + 1; nk = NKN; }
#define PREP_LOAD(V, SRC, LD, KROWS, COL0, K0) { _Pragma("unroll") for (int i = 0; i < 8; ++i) { const int kk = (tid >> 6) + 8 * i, nn = tid & 63; \
            V[i] = ((COL0) >= 0 && (K0) + kk < (KROWS)) ? SRC[(size_t)((K0) + kk) * (LD) + (COL0) + nn] : 0.f; } }
        float cur[8], nxt[8];
        const float* srcc = nullptr; int ldc = 0, krc = 0, kdc = 0, colc = 0, n0c = 0, k0c = 0; u16* dstc = nullptr;
        if (bid < total) { PREP_DECODE(bid, srcc, ldc, krc, kdc, colc, n0c, k0c, dstc) PREP_LOAD(cur, srcc, ldc, krc, colc, k0c) }
        for (int q = bid; q < total; q += G) {
            const float* srcn = srcc; int ldn = ldc, krn = krc, kdn = kdc, coln = colc, n0n = n0c, k0n = k0c; u16* dstn = dstc;
            if (q + G < total) { PREP_DECODE(q + G, srcn, ldn, krn, kdn, coln, n0n, k0n, dstn) PREP_LOAD(nxt, srcn, ldn, krn, coln, k0n) }
#pragma unroll
            for (int i = 0; i < 8; ++i) tile[((tid >> 6) + 8 * i) * 65 + (tid & 63)] = cur[i];
            __syncthreads();
            { const int nn = tid >> 3, ks = (tid & 7) * 8; float v[8];
#pragma unroll
              for (int jj = 0; jj < 8; ++jj) v[jj] = tile[(ks + jj) * 65 + nn];
              u32x4 w; w.x = cvt_pk_bf16(v[0], v[1]); w.y = cvt_pk_bf16(v[2], v[3]); w.z = cvt_pk_bf16(v[4], v[5]); w.w = cvt_pk_bf16(v[6], v[7]);
              *(u32x4*)(dstc + (size_t)(n0c + nn) * kdc + k0c + ks) = w; }
            __syncthreads();
            srcc = srcn; ldc = ldn; krc = krn; kdc = kdn; colc = coln; n0c = n0n; k0c = k0n; dstc = dstn;
#pragma unroll
            for (int i = 0; i < 8; ++i) cur[i] = nxt[i];
        }
#undef PREP_STEP
#undef PREP_DECODE
#undef PREP_LOAD
    }

    {
        u16* WZ = (u16*)(ws + WS_WZ);
        for (int k = bid; k < 1024; k += G) {
            frow[tid] = P.in[13][(size_t)k * 4480 + 1920 + tid];
            __syncthreads();
#pragma unroll
            for (int rep = 0; rep < 2; ++rep) { const int zc = tid + rep * 512, g = zc >> 8, part = (zc >> 7) & 1, kn = zc & 127;
                const LAS float* tab = part ? sn128 : cs128; float s = 0.f;
                for (int n = 0; n < 128; ++n) s += frow[g * 128 + n] * tab[(kn * n) & 127];
                s *= 0.08838834764831845f; if (part) s = -s;
                WZ[(size_t)zc * 1024 + k] = (u16)(cvt_pk_bf16(s, 0.f) & 0xffffu); }
            __syncthreads();
        }
    }

    {
        u16* T = (u16*)(ws + WS_T);
        for (size_t vi = (size_t)bid * 512 + tid; vi < (size_t)4096 * 1024; vi += (size_t)G * 512) {
            const int row = (int)(vi >> 10), cv = (int)(vi & 1023) * 8, part = cv >> 12, r = (cv >> 6) & 63, c0 = cv & 63, kr = row >> 6, kc = row & 63;
            const LAS float* tab = part ? sn64 : cs64; const int base = kr * r;
            float v[8];
#pragma unroll
            for (int j = 0; j < 8; ++j) v[j] = tab[(base + kc * (c0 + j)) & 63] * 0.015625f;
            u32x4 w; w.x = cvt_pk_bf16(v[0], v[1]); w.y = cvt_pk_bf16(v[2], v[3]); w.z = cvt_pk_bf16(v[4], v[5]); w.w = cvt_pk_bf16(v[6], v[7]);
            *(u32x4*)(T + vi * 8) = w;
        }
        u16* T2 = (u16*)(ws + WS_T256);
        for (int vi = bid * 512 + tid; vi < 256 * 64; vi += G * 512) {
            const int kt = vi >> 6, cv = (vi & 63) * 8, part = cv >> 8, t0 = cv & 255;
            const LAS float* tab = part ? sn256 : cs256;
            float v[8];
#pragma unroll
            for (int j = 0; j < 8; ++j) v[j] = tab[(kt * (t0 + j)) & 255] * 0.0625f;
            u32x4 w; w.x = cvt_pk_bf16(v[0], v[1]); w.y = cvt_pk_bf16(v[2], v[3]); w.z = cvt_pk_bf16(v[4], v[5]); w.w = cvt_pk_bf16(v[6], v[7]);
            *(u32x4*)(T2 + (size_t)vi * 8) = w;
        }
    }
}

template <int CTRL> __device__ __forceinline__ float dpp_add(float v) {
    return v + __int_as_float(__builtin_amdgcn_update_dpp(0, __float_as_int(v), CTRL, 0xF, 0xF, true));
}
__device__ __forceinline__ float sum16(float v) {
    v = dpp_add<0xB1>(v); v = dpp_add<0x4E>(v); v = dpp_add<0x141>(v); v = dpp_add<0x140>(v); return v;
}
__device__ __forceinline__ float sum64(float v) {
    const float t = sum16(v);
    const int ti = __float_as_int(t);
    return __int_as_float(__builtin_amdgcn_readlane(ti, 0)) + __int_as_float(__builtin_amdgcn_readlane(ti, 16)) + __int_as_float(__builtin_amdgcn_readlane(ti, 32)) + __int_as_float(__builtin_amdgcn_readlane(ti, 48));
}
__device__ __forceinline__ float wave_sum(float v) {
#pragma unroll
    for (int o = 32; o >= 1; o >>= 1) v += __shfl_xor(v, o);
    return v;
}
__device__ __forceinline__ const float* norm_row(const Params& P, const float* X, int m) {
    return X ? X + (size_t)m * DM : (m < NPR ? P.in[0] + (size_t)m * DM : P.in[1] + (size_t)(m - NPR) * DM);
}
__device__ __forceinline__ void phase_norm(const Params& P, const float* X, int nwi, int slot_shift, int slot_scale, u16* H) {
    const int lane = threadIdx.x & 63, gw = blockIdx.x * 8 + (threadIdx.x >> 6), nw = gridDim.x * 8;
    const float* MOD = (const float*)(P.ws + WS_MOD); const float* normw = P.in[8] + nwi * 1024;
    f32x4 v[4], vn[4];
    if (gw < MT) { const float* xr = norm_row(P, X, gw);
#pragma unroll
        for (int i = 0; i < 4; ++i) v[i] = *(const f32x4*)(xr + i * 256 + lane * 4); }
    for (int m = gw; m < MT; m += nw) {
        const int mn = m + nw < MT ? m + nw : m;
        { const float* xr = norm_row(P, X, mn);
#pragma unroll
          for (int i = 0; i < 4; ++i) vn[i] = *(const f32x4*)(xr + i * 256 + lane * 4); }
        float ss = 0.f;
#pragma unroll
        for (int i = 0; i < 4; ++i) ss += v[i][0] * v[i][0] + v[i][1] * v[i][1] + v[i][2] * v[i][2] + v[i][3] * v[i][3];
        ss = sum64(ss);
        const float rs = rsqrtf(ss * (1.0f / 1024.0f) + 1e-6f);
        const float* md = MOD + (size_t)modidx_m(m) * 9216;
#pragma unroll
        for (int i = 0; i < 4; ++i) { const int c = i * 256 + lane * 4;
            const f32x4 w = *(const f32x4*)(normw + c), sc = *(const f32x4*)(md + slot_scale * 1024 + c), sh = *(const f32x4*)(md + slot_shift * 1024 + c);
            const f32x4 y = v[i] * rs * w * (sc + 1.0f) + sh;
            u32x2 o; o.x = cvt_pk_bf16(y[0], y[1]); o.y = cvt_pk_bf16(y[2], y[3]);
            *(u32x2*)(H + (size_t)m * DM + c) = o; }
#pragma unroll
        for (int i = 0; i < 4; ++i) v[i] = vn[i];
    }
}
__device__ __forceinline__ void phase_final_norm(const Params& P) {
    const int lane = threadIdx.x & 63, gw = blockIdx.x * 8 + (threadIdx.x >> 6), nw = gridDim.x * 8;
    const float* fw = P.in[29];
    f32x4 v[4], vn[4];
    if (gw < MT) { const float* xr = P.out + (size_t)gw * DM;
#pragma unroll
        for (int i = 0; i < 4; ++i) v[i] = *(const f32x4*)(xr + i * 256 + lane * 4); }
    for (int m = gw; m < MT; m += nw) {
        const int mn = m + nw < MT ? m + nw : m;
        { const float* xr = P.out + (size_t)mn * DM;
#pragma unroll
          for (int i = 0; i < 4; ++i) vn[i] = *(const f32x4*)(xr + i * 256 + lane * 4); }
        float ss = 0.f;
#pragma unroll
        for (int i = 0; i < 4; ++i) ss += v[i][0] * v[i][0] + v[i][1] * v[i][1] + v[i][2] * v[i][2] + v[i][3] * v[i][3];
        ss = sum64(ss);
        const float rs = rsqrtf(ss * (1.0f / 1024.0f) + 1e-6f);
        float* xo = P.out + (size_t)m * DM;
#pragma unroll
        for (int i = 0; i < 4; ++i) { const int c = i * 256 + lane * 4; *(f32x4*)(xo + c) = v[i] * rs * *(const f32x4*)(fw + c); }
#pragma unroll
        for (int i = 0; i < 4; ++i) v[i] = vn[i];
    }
}

__device__ __forceinline__ float dot4(const f32x4 a, const f32x4 b) {
    typedef float f32x2 __attribute__((ext_vector_type(2)));
    f32x2 p = (f32x2){a[0], a[1]} * (f32x2){b[0], b[1]};
    p = (f32x2){a[2], a[3]} * (f32x2){b[2], b[3]} + p;
    return p[0] + p[1];
}
__device__ __forceinline__ float fsig(float x) { return __builtin_amdgcn_rcpf(1.0f + __expf(-x)); }
struct ScanRegs { u32x2 r[3], k[3], v[3], wd, ad; };
__device__ __forceinline__ void scan_load(ScanRegs& R, const u16* U, int tok0, int T, int t, int h, int d, int cg) {
    const u32x2 z = {0u, 0u};
#pragma unroll
    for (int tap = 0; tap < 3; ++tap) { const int tn = t + tap - 1;
        if (tn >= 0 && tn < T) { const u16* row = U + (size_t)(tok0 + tn) * 1792 + h * 64 + 4 * cg;
            R.r[tap] = *(const u32x2*)row; R.k[tap] = *(const u32x2*)(row + 512); R.v[tap] = *(const u32x2*)(row + 1024); }
        else { R.r[tap] = z; R.k[tap] = z; R.v[tap] = z; } }
    const u16* row = U + (size_t)(tok0 + t) * 1792 + 1536 + d * 64 + 4 * cg;
    R.wd = *(const u32x2*)row; R.ad = *(const u32x2*)(row + 128);
}
__device__ __forceinline__ void unpack4h(const u32x2 q, float (&o)[4]) { o[0] = h2f(q.x & 0xffffu); o[1] = h2f(q.x >> 16); o[2] = h2f(q.y & 0xffffu); o[3] = h2f(q.y >> 16); }

#define LDS_BARRIER() do { asm volatile("s_waitcnt lgkmcnt(0)" ::: "memory"); __builtin_amdgcn_s_barrier(); asm volatile("" ::: "memory"); } while (0)
__device__ __forceinline__ void scan_unit(const Params& P, LAS float* L, int s, int h, int d, int half) {
    typedef float f32x16 __attribute__((ext_vector_type(16)));
    const int tid = threadIdx.x, lane = tid & 63;
    const bool producer = tid >= 256;
    const int T = s < 16 ? 256 : 4096, tok0 = s < 16 ? s * 256 : NPR + (s - 16) * 4096, nchunk = T / 32;
    const u16* U = (const u16*)(P.ws + WS_U16);
    u16* Od = (u16*)(P.ws + WS_H) + (size_t)d * MT * 512;
    float* BS = (float*)(P.ws + WS_BS);
    LAS float* cst = L;            LAS float* xwT = L + 1024;    LAS float* xaT = L + 3072;   LAS float* lora_s = L + 5120;
    LAS float* o_sb = L + 13312;   LAS float* cb = L + 15360;
    if (tid < 64) { const int c = tid, ch = h * 64 + c;
        cst[c] = P.in[16][d * 512 + ch]; cst[64 + c] = P.in[18][d * 512 + ch]; cst[128 + c] = P.in[21][ch]; cst[192 + c] = P.in[22][ch]; cst[256 + c] = P.in[23][ch];
#pragma unroll
        for (int ten = 0; ten < 3; ++ten)
#pragma unroll
            for (int tap = 0; tap < 3; ++tap) cst[(5 + ten * 3 + tap) * 64 + c] = P.in[15][tap * 1536 + ten * 512 + ch]; }
    const int c16 = tid & 15, rp = (tid >> 4) & 15, rA = half * 32 + rp, rB = rA + 16;
    f32x4 SA = {0.f, 0.f, 0.f, 0.f}, SB = {0.f, 0.f, 0.f, 0.f};
    if (!producer && s >= 16) { const float* st = (d ? P.in[3] : P.in[2]) + (size_t)((s - 16) * 8 + h) * 4096;
        SA = *(const f32x4*)(st + rA * 64 + 4 * c16); SB = *(const f32x4*)(st + rB * 64 + 4 * c16); }
    const int pt = tid - 256, pw = (pt >> 6) & 3, nt = pw & 1, kh = pw >> 1, li = lane & 31, lk = lane >> 5;
    float Bw[16], Ba[16];
    if (producer) {
#pragma unroll
        for (int s2 = 0; s2 < 16; ++s2) { const size_t o = (size_t)(d * 64 + kh * 32 + 2 * s2 + lk) * 512 + h * 64 + nt * 32 + li; Bw[s2] = P.in[17][o]; Ba[s2] = P.in[19][o]; }
    } else {
#pragma unroll
        for (int s2 = 0; s2 < 16; ++s2) { Bw[s2] = 0.f; Ba[s2] = 0.f; }
    }
    const int it0 = pt & 255, tt0 = it0 >> 4, cg0 = it0 & 15, tt1 = tt0 + 16, cg1 = cg0;
    ScanRegs R0, R1;
    if (producer) { scan_load(R0, U, tok0, T, d ? T - 1 - tt0 : tt0, h, d, cg0); scan_load(R1, U, tok0, T, d ? T - 1 - tt1 : tt1, h, d, cg1); }
    __syncthreads();
    for (int ci = -1; ci < nchunk; ++ci) {
        const int pc = ci + 1;
        LAS float* pb = cb + (pc & 1) * 12288;
        const LAS float* qb = cb + (ci & 1) * 12288;
        LAS float* o_s = o_sb + (ci & 1) * 1024;
        const bool do_prep = producer && pc < nchunk, do_step = !producer && ci >= 0;
        LAS float* r_s = pb; LAS float* w_s = pb + 2048; LAS float* kd_s = pb + 4096; LAS float* v_s = pb + 6144; LAS float* kk_s = pb + 8192; LAS float* kka_s = pb + 10240;
#define SCAN_STEPS(SEG) if (do_step) { float oAr[8], oBr[8]; float pA = 0.f, pB = 0.f;     \
        _Pragma("unroll") for (int u8 = 0; u8 < 8; ++u8) { const int tt = (SEG) * 8 + u8; \
            const f32x4 w4 = *(const LAS f32x4*)(qb + 2048 + tt * 64 + 4 * c16), kk4 = *(const LAS f32x4*)(qb + 8192 + tt * 64 + 4 * c16), ka4 = *(const LAS f32x4*)(qb + 10240 + tt * 64 + 4 * c16); \
            const f32x4 kd4 = *(const LAS f32x4*)(qb + 4096 + tt * 64 + 4 * c16), r4 = *(const LAS f32x4*)(qb + tt * 64 + 4 * c16); \
            const float vA = qb[6144 + tt * 64 + rA], vB = qb[6144 + tt * 64 + rB]; \
            float saA = dot4(SA, kk4), saB = dot4(SB, kk4); \
            saA = dpp_add<0xB1>(saA); saB = dpp_add<0xB1>(saB); pA = dpp_add<0xB1>(pA); pB = dpp_add<0xB1>(pB); \
            saA = dpp_add<0x4E>(saA); saB = dpp_add<0x4E>(saB); pA = dpp_add<0x4E>(pA); pB = dpp_add<0x4E>(pB); \
            saA = dpp_add<0x141>(saA); saB = dpp_add<0x141>(saB); pA = dpp_add<0x141>(pA); pB = dpp_add<0x141>(pB); \
            saA = dpp_add<0x140>(saA); saB = dpp_add<0x140>(saB); pA = dpp_add<0x140>(pA); pB = dpp_add<0x140>(pB); \
            if (u8 > 0) { oAr[u8 - 1] = pA; oBr[u8 - 1] = pB; } \
            SA = SA * w4 - ka4 * saA + kd4 * vA; SB = SB * w4 - ka4 * saB + kd4 * vB; \
            pA = dot4(SA, r4); pB = dot4(SB, r4); } \
        pA = dpp_add<0xB1>(pA); pB = dpp_add<0xB1>(pB); pA = dpp_add<0x4E>(pA); pB = dpp_add<0x4E>(pB); pA = dpp_add<0x141>(pA); pB = dpp_add<0x141>(pB); pA = dpp_add<0x140>(pA); pB = dpp_add<0x140>(pB); \
        oAr[7] = pA; oBr[7] = pB; \
        if (c16 == 0) { _Pragma("unroll") for (int u8 = 0; u8 < 8; ++u8) { o_s[((SEG) * 8 + u8) * 32 + rp] = oAr[u8]; o_s[((SEG) * 8 + u8) * 32 + 16 + rp] = oBr[u8]; } } }
        if (do_prep) {
#pragma unroll
            for (int it = 0; it < 2; ++it) { const ScanRegs& R = it ? R1 : R0; const int tt_a = it ? tt1 : tt0, cg = cg0;
                float rv[4] = {0.f, 0.f, 0.f, 0.f}, kv[4] = {0.f, 0.f, 0.f, 0.f}, vv[4] = {0.f, 0.f, 0.f, 0.f};
#pragma unroll
                for (int tap = 0; tap < 3; ++tap) { float a[4], bb[4], c[4]; unpack4h(R.r[tap], a); unpack4h(R.k[tap], bb); unpack4h(R.v[tap], c);
#pragma unroll
                    for (int j = 0; j < 4; ++j) { rv[j] += a[j] * cst[(5 + tap) * 64 + 4 * cg + j]; kv[j] += bb[j] * cst[(8 + tap) * 64 + 4 * cg + j]; vv[j] += c[j] * cst[(11 + tap) * 64 + 4 * cg + j]; } }
                float kkr[4], ss = 0.f;
#pragma unroll
                for (int j = 0; j < 4; ++j) { kkr[j] = kv[j] * cst[128 + 4 * cg + j]; ss += kkr[j] * kkr[j]; }
                ss = sum16(ss);
                const float inv = __builtin_amdgcn_rsqf(fmaxf(ss, 1e-24f));
                float wdv[4], adv[4]; unpack4h(R.wd, wdv); unpack4h(R.ad, adv);
#pragma unroll
                for (int j = 0; j < 4; ++j) { const int o = tt_a * 64 + 4 * cg + j;
                    r_s[o] = rv[j]; v_s[o] = vv[j]; kd_s[o] = kv[j]; kk_s[o] = kkr[j] * inv;
                    xwT[(4 * cg + j) * 32 + tt_a] = 1.0f - 2.0f * __builtin_amdgcn_rcpf(1.0f + __expf(2.0f * wdv[j])); xaT[(4 * cg + j) * 32 + tt_a] = adv[j]; } }
            if (pc + 1 < nchunk) { const int q0 = (pc + 1) * 32 + tt0, q1 = (pc + 1) * 32 + tt1;
                scan_load(R0, U, tok0, T, d ? T - 1 - q0 : q0, h, d, cg0); scan_load(R1, U, tok0, T, d ? T - 1 - q1 : q1, h, d, cg1); }
        }
        SCAN_STEPS(0)
        LDS_BARRIER();
        if (do_prep) {
            f32x16 accw, acca;
#pragma unroll
            for (int i = 0; i < 16; ++i) { accw[i] = 0.f; acca[i] = 0.f; }
#pragma unroll
            for (int s2 = 0; s2 < 16; ++s2) { const int r = kh * 32 + 2 * s2 + lk;
                accw = __builtin_amdgcn_mfma_f32_32x32x2f32(xwT[r * 32 + li], Bw[s2], accw, 0, 0, 0);
                acca = __builtin_amdgcn_mfma_f32_32x32x2f32(xaT[r * 32 + li], Ba[s2], acca, 0, 0, 0); }
#pragma unroll
            for (int reg = 0; reg < 16; ++reg) { const int o = ((reg & 3) + 8 * (reg >> 2) + 4 * lk) * 64 + nt * 32 + li;
                lora_s[(0 * 2 + kh) * 2048 + o] = accw[reg]; lora_s[(1 * 2 + kh) * 2048 + o] = acca[reg]; }
        }
        SCAN_STEPS(1)
        LDS_BARRIER();
        if (do_prep) {
            const int c = pt & 63, tg = pt >> 6;
#pragma unroll
            for (int j = 0; j < 8; ++j) { const int tt = 8 * tg + j, o = tt * 64 + c;
                const float wl = cst[c] + lora_s[o] + lora_s[2048 + o];
                const float w = __expf(-0.6065306597f * fsig(wl));
                const float a = fsig(cst[64 + c] + lora_s[4096 + o] + lora_s[6144 + o]);
                const float k = kd_s[o], kk = kk_s[o];
                const float kd = k * (1.0f + (a - 1.0f) * cst[192 + c]);
                kd_s[o] = kd; kka_s[o] = kk * a; w_s[o] = w;
                const float bsum = sum64(r_s[o] * kd * cst[256 + c]);
                if (lane == 0 && half == 0) { const int q = pc * 32 + tt, t = d ? T - 1 - q : q; BS[(size_t)(tok0 + t) * 16 + h * 2 + d] = bsum; } }
        }
        SCAN_STEPS(2)
        LDS_BARRIER();
        SCAN_STEPS(3)
        LDS_BARRIER();
        if (do_step) { const int tt = tid >> 3, seg = tid & 7, q = ci * 32 + tt, t = d ? T - 1 - q : q;
            u32x2 w2; w2.x = cvt_pk_bf16(o_s[tt * 32 + 4 * seg], o_s[tt * 32 + 4 * seg + 1]); w2.y = cvt_pk_bf16(o_s[tt * 32 + 4 * seg + 2], o_s[tt * 32 + 4 * seg + 3]);
            *(u32x2*)(Od + (size_t)(tok0 + t) * 512 + h * 64 + half * 32 + 4 * seg) = w2; }
#undef SCAN_STEPS
    }
    if (!producer && s < 16) { float* so = P.out + OUT_STATE + (size_t)d * 524288 + (size_t)(s * 8 + h) * 4096;
        *(f32x4*)(so + rA * 64 + 4 * c16) = SA; *(f32x4*)(so + rB * 64 + 4 * c16) = SB; }
    __syncthreads();
}
__device__ __forceinline__ void phase_scan(const Params& P, LAS unsigned char* lds) {
    for (int q = blockIdx.x; q < 768; q += gridDim.x) {
        int s, rem;
        if (q < 256) { s = 16 + (q >> 5); rem = q & 31; } else { const int p = q - 256; s = p >> 5; rem = p & 31; }
        scan_unit(P, (LAS float*)lds, s, rem >> 2, (rem >> 1) & 1, rem & 1);
    }
}

struct PostRaw { unsigned of, ob, v0, v1, v2, sg; float b0, b1; };
__device__ __forceinline__ void post_load(PostRaw& r, int m, int ch, int h, int lane, const u16* OF, const u16* OB, const u16* U, const float* BS, const u16* GT) {
    const int T = m < NPR ? 256 : 4096, t = m < NPR ? (m & 255) : ((m - NPR) & 4095);
    r.of = OF[(size_t)m * 512 + ch]; r.ob = OB[(size_t)m * 512 + ch];
    r.v1 = U[(size_t)m * 1792 + 1024 + ch];
    r.v0 = t > 0 ? U[(size_t)(m - 1) * 1792 + 1024 + ch] : 0u;
    r.v2 = t < T - 1 ? U[(size_t)(m + 1) * 1792 + 1024 + ch] : 0u;
    r.sg = *(const unsigned*)(GT + (size_t)m * GLD + 2048 + 2 * lane);
    r.b0 = BS[(size_t)m * 16 + h * 2]; r.b1 = BS[(size_t)m * 16 + h * 2 + 1];
}
__device__ __forceinline__ void phase_post(const Params& P, LAS unsigned char* lds) {
    const int lane = threadIdx.x & 63, h = threadIdx.x >> 6, ch = h * 64 + lane, G = gridDim.x;
    const u16* OF = (const u16*)(P.ws + WS_H); const u16* OB = OF + (size_t)MT * 512;
    const u16* U = (const u16*)(P.ws + WS_U16); const float* BS = (const float*)(P.ws + WS_BS);
    u16* OPRE = (u16*)(P.ws + WS_OPRE); const u16* GT = (const u16*)(P.ws + WS_R);
    LAS float* sgl = (LAS float*)lds + h * 128;
    float gu[128];
#pragma unroll
    for (int k = 0; k < 128; ++k) gu[k] = P.in[20][(size_t)k * 512 + ch];
    const float lw = P.in[24][ch], lb = P.in[25][ch];
    const float cv0 = P.in[15][0 * 1536 + 1024 + ch], cv1 = P.in[15][1 * 1536 + 1024 + ch], cv2 = P.in[15][2 * 1536 + 1024 + ch];
    PostRaw cur, nxt;
    int m = blockIdx.x;
    post_load(cur, m, ch, h, lane, OF, OB, U, BS, GT);
    for (; m < MT; m += G) {
        const int mn = m + G < MT ? m + G : m;
        post_load(nxt, mn, ch, h, lane, OF, OB, U, BS, GT);
        sgl[2 * lane] = h2f(cur.sg & 0xffffu); sgl[2 * lane + 1] = h2f(cur.sg >> 16);
        const float o = bf2f(cur.of) + bf2f(cur.ob);
        const float mean = sum64(o) * (1.0f / 64.0f), d = o - mean;
        const float rstd = rsqrtf(sum64(d * d) * (1.0f / 64.0f) + 64e-5f);
        const float v = h2f(cur.v0) * cv0 + h2f(cur.v1) * cv1 + h2f(cur.v2) * cv2;
        float g0 = 0.f, g1 = 0.f, g2 = 0.f, g3 = 0.f;
#pragma unroll
        for (int k = 0; k < 128; k += 4) { const f32x4 s4 = *(const LAS f32x4*)(sgl + k);
            g0 += s4[0] * gu[k]; g1 += s4[1] * gu[k + 1]; g2 += s4[2] * gu[k + 2]; g3 += s4[3] * gu[k + 3]; }
        const float y = (d * rstd * lw + lb + (cur.b0 + cur.b1) * v) * ((g0 + g1) + (g2 + g3));
        OPRE[(size_t)m * 512 + ch] = (u16)(cvt_pk_bf16(y, 0.f) & 0xffffu);
        cur = nxt;
    }
}


constexpr size_t WS_BAR = WS_END + 65536;
static_assert(WS_BAR + 4096 <= (size_t)536870912, "barrier words");
__device__ __forceinline__ void fast_grid_sync(unsigned char* ws, unsigned k) {
    asm volatile("s_waitcnt vmcnt(0) lgkmcnt(0)" ::: "memory");
    __builtin_amdgcn_s_barrier();
    if (threadIdx.x == 0) {
        unsigned* bar = (unsigned*)(ws + WS_BAR);
        const unsigned G = gridDim.x, g = blockIdx.x & 7u, gsz = (G - g + 7u) >> 3, ngrp = G < 8u ? G : 8u;
        __builtin_amdgcn_fence(__ATOMIC_RELEASE, "agent");
        asm volatile("s_waitcnt vmcnt(0)" ::: "memory");
        const unsigned old = __hip_atomic_fetch_add(bar + g * 32, 1u, __ATOMIC_RELAXED, __HIP_MEMORY_SCOPE_AGENT);
        if (old + 1u == k * gsz) __hip_atomic_fetch_add(bar + 8 * 32, 1u, __ATOMIC_RELAXED, __HIP_MEMORY_SCOPE_AGENT);
        unsigned spins = 0;
        while (__hip_atomic_load(bar + 8 * 32, __ATOMIC_RELAXED, __HIP_MEMORY_SCOPE_AGENT) < k * ngrp) { if (++spins > (1u << 24)) break; __builtin_amdgcn_s_sleep(1); }
        __builtin_amdgcn_fence(__ATOMIC_ACQUIRE, "agent");
        asm volatile("s_waitcnt vmcnt(0)" ::: "memory");
    }
    __builtin_amdgcn_s_barrier();
    asm volatile("" ::: "memory");
}

__global__ void __launch_bounds__(512, 2) fwd_mega(Params P) {
    extern __shared__ __attribute__((aligned(16))) unsigned char lds_raw[];
    LAS unsigned char* lds = (LAS unsigned char*)lds_raw;
    cg::grid_group grid = cg::this_grid();
    if (threadIdx.x < 32) { const int i = threadIdx.x; const unsigned long long v = i < 30 ? (unsigned long long)P.in[i] : (i == 30 ? (unsigned long long)P.out : (unsigned long long)P.ws);
        *(LAS unsigned long long*)(lds + PTAB_OFF + i * 8) = v; }
    __syncthreads();
unsigned bark_ = 0; unsigned char* P_ws_ = P.ws;
#define PH_BEGIN { const Params Q = get_params(lds); unsigned char* ws = Q.ws; (void)ws;
#define PH_END } asm volatile("s_waitcnt vmcnt(0)" ::: "memory");   grid.sync();
#define PH_ENDF } fast_grid_sync(P_ws_, ++bark_);
    if (blockIdx.x == 0 && threadIdx.x < 9) ((unsigned*)(P.ws + WS_BAR))[threadIdx.x * 32] = 0u;
    PH_BEGIN phase_prep(Q, lds); PH_END
    PH_BEGIN phase_norm(Q, nullptr, 0, 0, 1, (u16*)(ws + WS_H)); PH_ENDF
    PH_BEGIN run_gemm(lds, (const u16*)(ws + WS_H), (const u16*)(ws + WS_W13A), MT, 5632, 1024, EpiSwiglu{(u16*)(ws + WS_BIG)}); PH_ENDF
    PH_BEGIN run_gemm(lds, (const u16*)(ws + WS_BIG), (const u16*)(ws + WS_W2A), MT, 1024, 2816, EpiResid{Q.in[0], Q.in[1], Q.out, (const float*)(ws + WS_MOD), 2, 0.5f}); PH_ENDF
    PH_BEGIN phase_norm(Q, Q.out, 1, 3, 4, (u16*)(ws + WS_H)); PH_ENDF
    PH_BEGIN run_gemm(lds, (const u16*)(ws + WS_WZ), (const u16*)(ws + WS_H), 1024, MT, 1024, EpiZT{(u16*)(ws + WS_ZL)}); PH_ENDF
    PH_BEGIN run_gemm(lds, (const u16*)(ws + WS_T), (const u16*)(ws + WS_ZL), 4096, 4096, 8192, EpiFour{(u16*)(ws + WS_FOUR), 1});
             run_gemm(lds, (const u16*)(ws + WS_T256), (const u16*)(ws + WS_ZP), 256, 8192, 512, EpiFour{(u16*)(ws + WS_FOUR), 0}); PH_ENDF
    PH_BEGIN run_gemm(lds, (const u16*)(ws + WS_H), (const u16*)(ws + WS_WIN), MT, 4096, 1024, EpiU{(u16*)(ws + WS_U16), (u16*)(ws + WS_SG), (u16*)(ws + WS_R), Q.in[14]}); PH_ENDF
    PH_BEGIN phase_scan(Q, lds); PH_ENDF
    PH_BEGIN phase_post(Q, lds); PH_ENDF
    PH_BEGIN run_gemm(lds, (const u16*)(ws + WS_OPRE), (const u16*)(ws + WS_WO), MT, 1024, 512, EpiMul{(u16*)(ws + WS_H), (const u16*)(ws + WS_R), 1}); PH_ENDF
    PH_BEGIN run_gemm(lds, (const u16*)(ws + WS_FOUR), (const u16*)(ws + WS_WF), MT, 1024, 512, EpiMul{(u16*)(ws + WS_H), (const u16*)(ws + WS_R), 2}); PH_ENDF
    PH_BEGIN run_gemm(lds, (const u16*)(ws + WS_H), (const u16*)(ws + WS_WOUT), MT, 1024, 1024, EpiResid{nullptr, nullptr, Q.out, (const float*)(ws + WS_MOD), 5, 1.0f}); PH_ENDF
    PH_BEGIN phase_norm(Q, Q.out, 2, 6, 7, (u16*)(ws + WS_H)); PH_ENDF
    PH_BEGIN run_gemm(lds, (const u16*)(ws + WS_H), (const u16*)(ws + WS_W13B), MT, 5632, 1024, EpiSwiglu{(u16*)(ws + WS_BIG)}); PH_ENDF
    PH_BEGIN run_gemm(lds, (const u16*)(ws + WS_BIG), (const u16*)(ws + WS_W2B), MT, 1024, 2816, EpiResid{nullptr, nullptr, Q.out, (const float*)(ws + WS_MOD), 8, 0.5f}); PH_ENDF
    { const Params Q = get_params(lds); phase_final_norm(Q); }
#undef PH_BEGIN
#undef PH_END
#undef PH_ENDF
}

extern "C" void kernel_launch(void* const* d_in, const int* in_sizes, int n_in, void* d_out, int out_size, void* d_ws, size_t ws_size, hipStream_t stream) {
    static int grid_blocks = 0;
    if (grid_blocks == 0) {
        if (n_in != 30 || ws_size < WS_END) { fprintf(stderr, "kernel_launch: unexpected n_in %d / ws_size %zu (need %zu)\n", n_in, ws_size, (size_t)WS_END); grid_blocks = -1; return; }
        int dev = 0, cus = 0, per_cu = 0;
        (void)hipGetDevice(&dev);
        (void)hipDeviceGetAttribute(&cus, hipDeviceAttributeMultiprocessorCount, dev);
        (void)hipFuncSetAttribute((const void*)fwd_mega, hipFuncAttributeMaxDynamicSharedMemorySize, LDS_BYTES);
        (void)hipOccupancyMaxActiveBlocksPerMultiprocessor(&per_cu, (const void*)fwd_mega, 512, LDS_BYTES);
        if (per_cu < 1) { fprintf(stderr, "kernel_launch: occupancy query reports %d blocks per CU\n", per_cu); per_cu = 1; }
        if (per_cu > 1) per_cu = 1;
        grid_blocks = cus * per_cu;
        (void)hipGetLastError();
    }
    if (grid_blocks < 0) return;
    Params p{};
    for (int i = 0; i < 30; ++i) p.in[i] = (const float*)d_in[i];
    p.out = (float*)d_out; p.ws = (unsigned char*)d_ws;
    void* args[] = {&p};
    hipError_t e = hipLaunchCooperativeKernel((const void*)fwd_mega, dim3(grid_blocks), dim3(512), args, LDS_BYTES, stream);
    if (e != hipSuccess) fprintf(stderr, "cooperative launch failed: %s (grid %d)\n", hipGetErrorString(e), grid_blocks);
}
```

```cpp
#include <hip/hip_runtime.h>
#include <hip/hip_cooperative_groups.h>
#include <cstdio>
namespace cg = cooperative_groups;
namespace pg8 {
#define PG8_LAS __attribute__((address_space(3)))
typedef unsigned short bf16_t;
typedef short bf16x8 __attribute__((ext_vector_type(8)));
typedef float f32x4 __attribute__((ext_vector_type(4)));
typedef unsigned u32x4 __attribute__((ext_vector_type(4)));
constexpr int BM = 256, BK = 64, HALF = 128, HTB = HALF * BK * 2  , STAGE_BYTES = 8 * HTB, NXCD = 8, WGM = 8;

__host__ __device__ __forceinline__ int lds_byte(int r, int c) { const int st = (r >> 4) * 2 + (c >> 5), rr = r & 15, cc = c & 31, ob = rr * 64 + cc * 2; return st * 1024 + (ob ^ (((ob >> 9) & 1) << 5)); }
__host__ __device__ __forceinline__ void stage_rc(int b, int& R, int& C) { const int st = b / 1024, sb = b % 1024, swz = sb ^ (((sb >> 9) & 1) << 5); R = (st >> 1) * 16 + swz / 64; C = (st & 1) * 32 + (swz % 64) / 2; }
__host__ __device__ __forceinline__ int perm32(int rho) { const int n = rho >> 4, i = rho & 15; return 8 * (i >> 2) + 4 * n + (i & 3); }

struct Unit { int pm, pn; };
struct Gemm { const bf16_t* A; const bf16_t* Bt; int M, N, K; };

struct StaticOrder {
    int nM, nN, nwg, G, c;
    __host__ __device__ __forceinline__ void init(int M, int N, int G_, int c_) { nM = M / BM; nN = N / BM; nwg = nM * nN; G = G_; c = c_; }
    __host__ __device__ __forceinline__ bool next(int i, Unit& u) const {
        const long L = (long)i * G + c; if (L >= nwg) return false;
        int wgid = (int)L; { const int q = nwg / NXCD, r = nwg % NXCD, xcd = wgid % NXCD, off = wgid / NXCD; wgid = (xcd < r ? xcd * (q + 1) : r * (q + 1) + (xcd - r) * q) + off; }
        const int nig = WGM * nN, gid = wgid / nig, fm = gid * WGM, gsz = (nM - fm) < WGM ? (nM - fm) : WGM;
        u.pm = fm + ((wgid % nig) % gsz); u.pn = (wgid % nig) / gsz; return true;
    }
    __device__ __forceinline__ void a_ready(const Unit&) const {}
    __device__ __forceinline__ void done(const Unit&) const {}
};
__device__ __forceinline__ unsigned cvt_pk_bf16(float lo, float hi) { unsigned r; asm volatile("v_cvt_pk_bf16_f32 %0, %1, %2" : "=v"(r) : "v"(lo), "v"(hi)); return r; }
template <class Epi, class Sched, bool STAMP = false>
__device__ __forceinline__ void gemm_phase(PG8_LAS unsigned char* lds, const Gemm g, const Sched& S, const Epi& E, unsigned long long* stamps) {
    int tid_ = threadIdx.x; asm volatile("" : "+v"(tid_));
    const int tid = tid_, wid = __builtin_amdgcn_readfirstlane(tid >> 6), lane = tid & 63, wr = wid >> 2, wc = wid & 3, fr = lane & 15, fq = lane >> 4;
    const int K = g.K, nt = K / BK;
    int ts_lo = 0, ts_hi = 0, nts = 0; const unsigned long long rt_entry = STAMP ? (unsigned long long)wall_clock64() : 0ull;
#define PG8_STAMP() do { if (STAMP && wid == 0 && nts < 64) { const unsigned long long _c = (unsigned long long)clock64(); \
        ts_lo = (lane == nts) ? (int)(unsigned)_c : ts_lo; ts_hi = (lane == nts) ? (int)(unsigned)(_c >> 32) : ts_hi; ++nts; } } while (0)
    PG8_STAMP();
    unsigned voffA[2], voffB[2];
#pragma unroll
    for (int i = 0; i < 2; ++i) { int R, C; stage_rc(tid * 16 + i * 8192, R, C); const int Rb = Epi::PERM ? ((R & ~31) + perm32(R & 31)) : R;
        voffA[i] = (unsigned)(R * K + C) * 2u; voffB[i] = (unsigned)(Rb * K + C) * 2u; }
    const size_t kstep = (size_t)(BK * 2);
    const size_t hstep = (size_t)HALF * K * 2;
    const size_t tstep = 2 * hstep;
    const unsigned ldsw = (unsigned)wid * 1024u;
    const int aoff = lds_byte(wr * 64 + fr, fq * 8), boff = lds_byte(wc * 32 + fr, fq * 8);
#define PG8_SA(b, h) (((b) * 2 + (h)) * HTB)
#define PG8_SB(b, h) ((4 + (b) * 2 + (h)) * HTB)
#define PG8_STAGE(bufoff, gbase, voff) do { _Pragma("unroll") for (int _i = 0; _i < 2; ++_i) \
        __builtin_amdgcn_global_load_lds((const unsigned*)((const char*)(gbase) + (voff)[_i]), (PG8_LAS unsigned*)(lds + (bufoff) + ldsw + _i * 8192), 16, 0, 0); } while (0)
#define PG8_LDA(dst, b, h) do { _Pragma("unroll") for (int m = 0; m < 4; ++m) _Pragma("unroll") for (int k = 0; k < 2; ++k) dst[m][k] = *(const PG8_LAS bf16x8*)(lds + PG8_SA(b, h) + aoff + m * 2048 + k * 1024); } while (0)
#define PG8_LDB(dst, b, h) do { _Pragma("unroll") for (int n = 0; n < 2; ++n) _Pragma("unroll") for (int k = 0; k < 2; ++k) dst[n][k] = *(const PG8_LAS bf16x8*)(lds + PG8_SB(b, h) + boff + n * 2048 + k * 1024); } while (0)
#define PG8_MMA(ai, bj, At, Bt) do { __builtin_amdgcn_s_setprio(1); _Pragma("unroll") for (int m = 0; m < 4; ++m) _Pragma("unroll") for (int n = 0; n < 2; ++n) _Pragma("unroll") for (int k = 0; k < 2; ++k) \
        acc[ai][bj][m][n] = __builtin_amdgcn_mfma_f32_16x16x32_bf16(Bt[n][k], At[m][k], acc[ai][bj][m][n], 0, 0, 0); __builtin_amdgcn_s_setprio(0); } while (0)
#define PG8_WAIT_V(n) asm volatile("s_waitcnt vmcnt(" #n ")" ::: "memory")
#define PG8_WAIT_L(n) asm volatile("s_waitcnt lgkmcnt(" #n ")" ::: "memory")
#define PG8_BAR __builtin_amdgcn_s_barrier()
#define PG8_SCHED __builtin_amdgcn_sched_barrier(0)
    Unit cur, nxt; int ui = 0;
    if (!S.next(0, cur)) return;
    f32x4 acc[2][2][4][2];
#pragma unroll
    for (int a = 0; a < 2; ++a)
#pragma unroll
        for (int b = 0; b < 2; ++b)
#pragma unroll
            for (int m = 0; m < 4; ++m)
#pragma unroll
                for (int n = 0; n < 2; ++n) acc[a][b][m][n] = (f32x4){0.f, 0.f, 0.f, 0.f};
    bf16x8 At[4][2], B0[2][2], B1[2][2];
    const char* cA = (const char*)g.A + (size_t)cur.pm * tstep; const char* cB = (const char*)g.Bt + (size_t)cur.pn * tstep;
    S.a_ready(cur);
    PG8_STAGE(PG8_SB(0, 0), cB, voffB); PG8_STAGE(PG8_SA(0, 0), cA, voffA); PG8_STAGE(PG8_SB(0, 1), cB + hstep, voffB); PG8_STAGE(PG8_SA(0, 1), cA + hstep, voffA);
    if (wr == 1) PG8_BAR;
    PG8_WAIT_V(4); PG8_BAR;
    PG8_STAGE(PG8_SB(1, 0), cB + kstep, voffB); PG8_STAGE(PG8_SA(1, 0), cA + kstep, voffA); PG8_STAGE(PG8_SB(1, 1), cB + hstep + kstep, voffB);
    PG8_WAIT_V(6); PG8_BAR;
    PG8_STAMP();
    for (;;) {
        const bool has_next = S.next(ui + 1, nxt);
        const char* nA = has_next ? (const char*)g.A + (size_t)nxt.pm * tstep : cA; const char* nB = has_next ? (const char*)g.Bt + (size_t)nxt.pn * tstep : cB;
        for (int t = 0; t < nt; t += 2) {
            const bool last = (t == nt - 2);
            const char* a1 = cA + (size_t)(t + 1) * kstep;
            const char* a2 = last ? nA : cA + (size_t)(t + 2) * kstep; const char* b2 = last ? nB : cB + (size_t)(t + 2) * kstep;
            const char* a3 = a2 + kstep; const char* b3 = b2 + kstep;
            if (last && has_next) S.a_ready(nxt);
            PG8_LDB(B0, 0, 0); PG8_SCHED; PG8_LDA(At, 0, 0); PG8_STAGE(PG8_SA(1, 1), a1 + hstep, voffA);
            PG8_WAIT_L(8); PG8_BAR; PG8_WAIT_L(0); PG8_MMA(0, 0, At, B0); PG8_BAR; PG8_SCHED;
            PG8_LDB(B1, 0, 1); PG8_STAGE(PG8_SB(0, 0), b2, voffB);
            PG8_BAR; PG8_WAIT_L(0); PG8_MMA(0, 1, At, B1); PG8_BAR;
            PG8_LDA(At, 0, 1); PG8_STAGE(PG8_SA(0, 0), a2, voffA);
            PG8_BAR; PG8_WAIT_L(0); PG8_MMA(1, 0, At, B0); PG8_BAR; PG8_SCHED;
            PG8_STAGE(PG8_SB(0, 1), b2 + hstep, voffB);
            PG8_WAIT_V(6); PG8_BAR; PG8_MMA(1, 1, At, B1); PG8_BAR;
            PG8_LDB(B0, 1, 0); PG8_SCHED; PG8_LDA(At, 1, 0); PG8_STAGE(PG8_SA(0, 1), a2 + hstep, voffA);
            PG8_WAIT_L(8); PG8_BAR; PG8_WAIT_L(0); PG8_MMA(0, 0, At, B0); PG8_BAR; PG8_SCHED;
            PG8_LDB(B1, 1, 1); PG8_STAGE(PG8_SB(1, 0), b3, voffB);
            PG8_BAR; PG8_WAIT_L(0); PG8_MMA(0, 1, At, B1); PG8_BAR;
            PG8_LDA(At, 1, 1); PG8_STAGE(PG8_SA(1, 0), a3, voffA);
            PG8_BAR; PG8_WAIT_L(0); PG8_MMA(1, 0, At, B0); PG8_BAR; PG8_SCHED;
            PG8_STAGE(PG8_SB(1, 1), b3 + hstep, voffB);
            PG8_WAIT_V(6); PG8_BAR; PG8_MMA(1, 1, At, B1); PG8_BAR;
        }
        PG8_STAMP();
        if constexpr (!Epi::AFTER_DRAIN) { E(acc, cur, wr, wc, fr, fq); S.done(cur); }
        PG8_STAMP();
        if (!has_next) break;
#pragma unroll
        for (int a = 0; a < 2; ++a)
#pragma unroll
            for (int b = 0; b < 2; ++b)
#pragma unroll
                for (int m = 0; m < 4; ++m)
#pragma unroll
                    for (int n = 0; n < 2; ++n) acc[a][b][m][n] = (f32x4){0.f, 0.f, 0.f, 0.f};
        cur = nxt; cA = nA; cB = nB; ++ui;
    }
    PG8_WAIT_V(0);
    if (wr == 0) PG8_BAR;
    PG8_BAR;
    if constexpr (Epi::AFTER_DRAIN) { E.fused(acc, cur, wr, wc, fr, fq, lds, wid, lane); S.done(cur); }
    PG8_STAMP();
    if (STAMP && wid == 0) { stamps[lane] = lane < nts ? (((unsigned long long)(unsigned)ts_hi << 32) | (unsigned)ts_lo) : 0ull;
        if (lane == 62) stamps[62] = rt_entry; if (lane == 63) stamps[63] = (unsigned long long)wall_clock64(); }
#undef PG8_STAMP
#undef PG8_SA
#undef PG8_SB
#undef PG8_STAGE
#undef PG8_LDA
#undef PG8_LDB
#undef PG8_MMA
#undef PG8_WAIT_V
#undef PG8_WAIT_L
#undef PG8_BAR
#undef PG8_SCHED
}
}

#define LAS __attribute__((address_space(3)))
typedef unsigned short u16;
typedef float f32x4 __attribute__((ext_vector_type(4)));
typedef unsigned u32x4 __attribute__((ext_vector_type(4)));
typedef unsigned u32x2 __attribute__((ext_vector_type(2)));
using pg8::cvt_pk_bf16;

constexpr int MT = 36864, NPR = 4096, DM = 1024, DFF = 2816;
constexpr int OUT_STATE = MT * DM;
constexpr int LDS_BYTES = 163840, PTAB_OFF = 163840 - 256;

constexpr size_t SZ_W13 = (size_t)5632 * 1024 * 2, SZ_W2 = (size_t)1024 * 2816 * 2;
constexpr size_t WS_W13A = 0, WS_W2A = WS_W13A + SZ_W13, WS_W13B = WS_W2A + SZ_W2, WS_W2B = WS_W13B + SZ_W13;
constexpr size_t WS_WIN = WS_W2B + SZ_W2;
constexpr size_t WS_WZ = WS_WIN + (size_t)4096 * 1024 * 2;
constexpr size_t WS_WO = WS_WZ + (size_t)1024 * 1024 * 2;
constexpr size_t WS_WF = WS_WO + (size_t)1024 * 512 * 2;
constexpr size_t WS_WOUT = WS_WF + (size_t)1024 * 512 * 2;
constexpr size_t WS_GUP = WS_WOUT + (size_t)1024 * 1024 * 2;
constexpr size_t WS_MOD = WS_GUP + (size_t)512 * 256 * 2;
constexpr size_t WS_BS = WS_MOD + (size_t)9 * 9216 * 4;
constexpr size_t WS_SG = WS_BS + (size_t)MT * 16 * 4;
constexpr size_t WS_H = WS_SG + (size_t)MT * 256 * 2;
constexpr size_t WS_BIG = WS_H + (size_t)MT * 1024 * 2;
constexpr size_t WS_U16 = WS_BIG;
constexpr size_t WS_FOUR = WS_U16 + (size_t)MT * 1792 * 2;
constexpr size_t WS_OPRE = WS_FOUR + (size_t)MT * 512 * 2;
constexpr size_t WS_R = WS_BIG + (size_t)MT * 2816 * 2;
constexpr size_t WS_T = WS_R;
constexpr size_t WS_T256 = WS_T + (size_t)4096 * 8192 * 2;
constexpr size_t WS_ZL = WS_T256 + (size_t)256 * 512 * 2;
constexpr size_t WS_ZP = WS_ZL + (size_t)4096 * 8192 * 2;
constexpr int GLD = 2304;
constexpr size_t WS_END = WS_R + (size_t)MT * GLD * 2;
static_assert(WS_ZP + (size_t)8192 * 512 * 2 <= WS_END, "R region");
static_assert(WS_OPRE + (size_t)MT * 512 * 2 <= WS_R, "BIG region");
static_assert(WS_END <= (size_t)536870912, "workspace");
static_assert(WS_ZP == WS_ZL + (size_t)4096 * 8192 * 2, "ZP behind ZL");

struct Params { const float* in[30]; float* out; unsigned char* ws; };
__device__ __forceinline__ unsigned long long ld_ptr(LAS unsigned char* lds, int i) {
    const u32x2 v = *(const LAS u32x2*)(lds + PTAB_OFF + i * 8);
    const unsigned lo = __builtin_amdgcn_readfirstlane(v.x), hi = __builtin_amdgcn_readfirstlane(v.y);
    return ((unsigned long long)hi << 32) | lo;
}
template <class T> __device__ __forceinline__ T* as_global(unsigned long long v) {
    return (T*)(__attribute__((address_space(1))) T*)v;
}
__device__ __forceinline__ Params get_params(LAS unsigned char* lds) {
    Params Q;
#pragma unroll
    for (int i = 0; i < 30; ++i) Q.in[i] = as_global<const float>(ld_ptr(lds, i));
    Q.out = as_global<float>(ld_ptr(lds, 30)); Q.ws = as_global<unsigned char>(ld_ptr(lds, 31));
    return Q;
}
__device__ __forceinline__ float bf2f(unsigned v16) { return __uint_as_float(v16 << 16); }
__device__ __forceinline__ float h2f(unsigned v16) { return (float)__builtin_bit_cast(_Float16, (unsigned short)v16); }
__device__ __forceinline__ unsigned pk_h(float a, float b) {
    const unsigned short ua = __builtin_bit_cast(unsigned short, (_Float16)a), ub = __builtin_bit_cast(unsigned short, (_Float16)b);
    return (unsigned)ua | ((unsigned)ub << 16);
}
__device__ __forceinline__ float sigmoidf_(float x) { return __builtin_amdgcn_rcpf(1.0f + __expf(-x)); }
__device__ __forceinline__ int modidx_pm(int pm) { return pm < 16 ? 8 : ((pm - 16) >> 4); }
__device__ __forceinline__ int modidx_m(int m) { return m < NPR ? 8 : ((m - NPR) >> 12); }

struct EpiSwiglu {
    static constexpr bool PERM = true, AFTER_DRAIN = false;
    u16* G;
    __device__ __forceinline__ void operator()(const f32x4 (&acc)[2][2][4][2], const pg8::Unit& u, int wr, int wc, int fr, int fq) const {
        const int row0 = u.pm * 256 + wr * 64 + fr, col0 = u.pn * 128 + wc * 32 + 8 * fq;
#pragma unroll
        for (int ai = 0; ai < 2; ++ai)
#pragma unroll
            for (int m = 0; m < 4; ++m) {
                float g[8];
#pragma unroll
                for (int n = 0; n < 2; ++n)
#pragma unroll
                    for (int j = 0; j < 4; ++j) { const float a = acc[ai][0][m][n][j], b = acc[ai][1][m][n][j]; g[n * 4 + j] = a * sigmoidf_(a) * b; }
                u32x4 w; w.x = cvt_pk_bf16(g[0], g[1]); w.y = cvt_pk_bf16(g[2], g[3]); w.z = cvt_pk_bf16(g[4], g[5]); w.w = cvt_pk_bf16(g[6], g[7]);
                *(u32x4*)(G + (size_t)(row0 + ai * 128 + m * 16) * DFF + col0) = w;
            }
    }
};
struct EpiResid {
    static constexpr bool PERM = false, AFTER_DRAIN = false;
    const float* xp; const float* xs; float* X; const float* MOD; int slot; float coef;
    __device__ __forceinline__ void operator()(const f32x4 (&acc)[2][2][4][2], const pg8::Unit& u, int wr, int wc, int fr, int fq) const {
        const int row0 = u.pm * 256 + wr * 64 + fr, col0 = u.pn * 256 + wc * 32 + 4 * fq;
        const float* g = MOD + (size_t)modidx_pm(u.pm) * 9216 + slot * 1024 + col0;
        f32x4 gv[2][2];
#pragma unroll
        for (int bj = 0; bj < 2; ++bj)
#pragma unroll
            for (int n = 0; n < 2; ++n) gv[bj][n] = *(const f32x4*)(g + bj * 128 + n * 16) * coef;
#pragma unroll
        for (int ai = 0; ai < 2; ++ai)
#pragma unroll
            for (int m = 0; m < 4; ++m) {
                const int row = row0 + ai * 128 + m * 16;
                const float* src = (xp ? (row < NPR ? xp + (size_t)row * DM : xs + (size_t)(row - NPR) * DM) : X + (size_t)row * DM) + col0;
                float* dst = X + (size_t)row * DM + col0;
#pragma unroll
                for (int bj = 0; bj < 2; ++bj)
#pragma unroll
                    for (int n = 0; n < 2; ++n) *(f32x4*)(dst + bj * 128 + n * 16) = *(const f32x4*)(src + bj * 128 + n * 16) + gv[bj][n] * acc[ai][bj][m][n];
            }
    }
};
struct EpiU {
    static constexpr bool PERM = true, AFTER_DRAIN = false;
    u16* U; u16* SG; u16* GATES; const float* gate_b;
    __device__ __forceinline__ void operator()(const f32x4 (&acc)[2][2][4][2], const pg8::Unit& u, int wr, int wc, int fr, int fq) const {
        const int row0 = u.pm * 256 + wr * 64 + fr, ct = wc * 32 + 8 * fq;
        if (u.pn < 7) {
#pragma unroll
            for (int ai = 0; ai < 2; ++ai)
#pragma unroll
                for (int m = 0; m < 4; ++m)
#pragma unroll
                    for (int bj = 0; bj < 2; ++bj) { const f32x4 v0 = acc[ai][bj][m][0], v1 = acc[ai][bj][m][1];
                        u32x4 w; w.x = pk_h(v0[0], v0[1]); w.y = pk_h(v0[2], v0[3]); w.z = pk_h(v1[0], v1[1]); w.w = pk_h(v1[2], v1[3]);
                        *(u32x4*)(U + (size_t)(row0 + ai * 128 + m * 16) * 1792 + u.pn * 256 + bj * 128 + ct) = w; }
        } else {
            const int gc0 = (u.pn == 7 ? 2048 : (u.pn - 8) * 256) + ct;
#pragma unroll
            for (int bj = 0; bj < 2; ++bj) {
                const int gbi = (u.pn == 7 ? 0 : (u.pn - 8) * 256) + ct; const float bsc = u.pn == 7 ? 0.f : 1.f;
                const f32x4 b0 = *(const f32x4*)(gate_b + gbi + bj * 128) * bsc, b1 = *(const f32x4*)(gate_b + gbi + bj * 128 + 4) * bsc;
#pragma unroll
                for (int ai = 0; ai < 2; ++ai)
#pragma unroll
                    for (int m = 0; m < 4; ++m) { const f32x4 v0 = acc[ai][bj][m][0] + b0, v1 = acc[ai][bj][m][1] + b1;
                        u32x4 w; w.x = pk_h(sigmoidf_(v0[0]), sigmoidf_(v0[1])); w.y = pk_h(sigmoidf_(v0[2]), sigmoidf_(v0[3]));
                        w.z = pk_h(sigmoidf_(v1[0]), sigmoidf_(v1[1])); w.w = pk_h(sigmoidf_(v1[2]), sigmoidf_(v1[3]));
                        *(u32x4*)(GATES + (size_t)(row0 + ai * 128 + m * 16) * GLD + gc0 + bj * 128) = w; }
            }
        }
    }
};
struct EpiZT {
    static constexpr bool PERM = true, AFTER_DRAIN = false;
    u16* ZL;
    __device__ __forceinline__ void operator()(const f32x4 (&acc)[2][2][4][2], const pg8::Unit& u, int wr, int wc, int fr, int fq) const {
#pragma unroll
        for (int bj = 0; bj < 2; ++bj) {
            const int c0 = u.pn * 256 + bj * 128 + wc * 32 + 8 * fq;
#pragma unroll
            for (int ai = 0; ai < 2; ++ai)
#pragma unroll
                for (int m = 0; m < 4; ++m) {
                    const int zr = u.pm * 256 + ai * 128 + wr * 64 + m * 16 + fr, g = zr >> 8, part = (zr >> 7) & 1, kn = zr & 127;
                    size_t off;
                    if (u.pn < 16) off = (size_t)4096 * 8192 + ((size_t)(u.pn * 512 + g * 128 + kn) * 512 + part * 256 + (c0 - u.pn * 256));
                    else { const int tok = c0 - NPR, b = tok >> 12, rc = tok & 4095; off = (size_t)(b * 512 + g * 128 + kn) * 8192 + part * 4096 + rc; }
                    u16* dst = ZL + off;
                    const f32x4 v0 = acc[ai][bj][m][0], v1 = acc[ai][bj][m][1];
                    u32x4 w; w.x = cvt_pk_bf16(v0[0], v0[1]); w.y = cvt_pk_bf16(v0[2], v0[3]); w.z = cvt_pk_bf16(v1[0], v1[1]); w.w = cvt_pk_bf16(v1[2], v1[3]);
                    *(u32x4*)dst = w;
                }
        }
    }
};
struct EpiFour {
    static constexpr bool PERM = true, AFTER_DRAIN = false;
    u16* FOUR; int latent;
    __device__ __forceinline__ void operator()(const f32x4 (&acc)[2][2][4][2], const pg8::Unit& u, int wr, int wc, int fr, int fq) const {
        const int b = u.pn >> 1, ch0 = (u.pn & 1) * 256 + wc * 32 + 8 * fq;
        const int tok0 = (latent ? NPR + b * 4096 : b * 256) + u.pm * 256 + wr * 64 + fr;
#pragma unroll
        for (int ai = 0; ai < 2; ++ai)
#pragma unroll
            for (int m = 0; m < 4; ++m)
#pragma unroll
                for (int bj = 0; bj < 2; ++bj) { const f32x4 v0 = acc[ai][bj][m][0], v1 = acc[ai][bj][m][1];
                    u32x4 w; w.x = cvt_pk_bf16(v0[0], v0[1]); w.y = cvt_pk_bf16(v0[2], v0[3]); w.z = cvt_pk_bf16(v1[0], v1[1]); w.w = cvt_pk_bf16(v1[2], v1[3]);
                    *(u32x4*)(FOUR + (size_t)(tok0 + ai * 128 + m * 16) * 512 + ch0 + bj * 128) = w; }
    }
};
struct EpiMul {
    static constexpr bool PERM = true, AFTER_DRAIN = false;
    u16* O; const u16* GATES; int mode;
    __device__ __forceinline__ void operator()(const f32x4 (&acc)[2][2][4][2], const pg8::Unit& u, int wr, int wc, int fr, int fq) const {
        const int row0 = u.pm * 256 + wr * 64 + fr, col0 = u.pn * 256 + wc * 32 + 8 * fq;
        const int ld = mode == 0 ? 512 : 1024;
#pragma unroll
        for (int ai = 0; ai < 2; ++ai)
#pragma unroll
            for (int m = 0; m < 4; ++m)
#pragma unroll
                for (int bj = 0; bj < 2; ++bj) {
                    const int row = row0 + ai * 128 + m * 16, col = col0 + bj * 128;
                    u16* p = O + (size_t)row * ld + col;
                    float v[8];
#pragma unroll
                    for (int j = 0; j < 4; ++j) { v[j] = acc[ai][bj][m][0][j]; v[4 + j] = acc[ai][bj][m][1][j]; }
                    if (mode == 0) {
                        const u32x4 q = *(const u32x4*)p;
#pragma unroll
                        for (int j = 0; j < 4; ++j) { v[2 * j] *= bf2f(q[j] & 0xffffu); v[2 * j + 1] *= bf2f(q[j] >> 16); }
                    } else {
                        const u32x4 gq = *(const u32x4*)(GATES + (size_t)row * GLD + (mode == 2 ? 1024 : 0) + col);
#pragma unroll
                        for (int j = 0; j < 4; ++j) { v[2 * j] *= h2f(gq[j] & 0xffffu); v[2 * j + 1] *= h2f(gq[j] >> 16); }
                        if (mode == 2) { const u32x4 q = *(const u32x4*)p;
#pragma unroll
                            for (int j = 0; j < 4; ++j) { v[2 * j] += bf2f(q[j] & 0xffffu); v[2 * j + 1] += bf2f(q[j] >> 16); } }
                    }
                    u32x4 w; w.x = cvt_pk_bf16(v[0], v[1]); w.y = cvt_pk_bf16(v[2], v[3]); w.z = cvt_pk_bf16(v[4], v[5]); w.w = cvt_pk_bf16(v[6], v[7]);
                    *(u32x4*)p = w;
                }
    }
};

template <class Epi>
__device__ __forceinline__ void run_gemm(LAS unsigned char* lds, const u16* A, const u16* Bt, int M, int N, int K, const Epi& E) {
    pg8::Gemm g{A, Bt, M, N, K}; pg8::StaticOrder S; S.init(M, N, (int)gridDim.x, (int)blockIdx.x);
    pg8::gemm_phase<Epi, pg8::StaticOrder, false>(lds, g, S, E, nullptr);
}

__device__ __forceinline__ void transpose_tile(const float* src, int ld_src, int col0, int k0, int krows, u16* dst, int n0, int K, LAS float* tile) {
    const int t = threadIdx.x;
#pragma unroll
    for (int i = 0; i < 8; ++i) { const int kk = (t >> 6) + 8 * i, nn = t & 63;
        float v = 0.f; if (col0 >= 0 && k0 + kk < krows) v = src[(size_t)(k0 + kk) * ld_src + col0 + nn];
        tile[kk * 65 + nn] = v; }
    __syncthreads();
    const int nn = t >> 3, ks = (t & 7) * 8;
    float v[8];
#pragma unroll
    for (int j = 0; j < 8; ++j) v[j] = tile[(ks + j) * 65 + nn];
    u32x4 w; w.x = cvt_pk_bf16(v[0], v[1]); w.y = cvt_pk_bf16(v[2], v[3]); w.z = cvt_pk_bf16(v[4], v[5]); w.w = cvt_pk_bf16(v[6], v[7]);
    *(u32x4*)(dst + (size_t)(n0 + nn) * K + k0 + ks) = w;
    __syncthreads();
}

__device__ __forceinline__ void phase_prep(const Params& P, LAS unsigned char* lds) {
    LAS float* L = (LAS float*)lds;
    LAS float* tile = L;
    LAS float* cs128 = L + 4160; LAS float* sn128 = cs128 + 128;
    LAS float* cs64 = sn128 + 128;  LAS float* sn64 = cs64 + 64;
    LAS float* cs256 = sn64 + 64;   LAS float* sn256 = cs256 + 256;
    LAS float* frow = sn256 + 256;
    LAS float* sc = frow + 512;
    LAS float* red = sc + 9216;
    const int tid = threadIdx.x, G = gridDim.x, bid = blockIdx.x;
    unsigned char* ws = P.ws;
    if (tid < 256) { float s, c; sincospif(2.0f * (float)tid / 256.0f, &s, &c); cs256[tid] = c; sn256[tid] = s; }
    if (tid < 128) { float s, c; sincospif(2.0f * (float)tid / 128.0f, &s, &c); cs128[tid] = c; sn128[tid] = s; }
    if (tid < 64)  { float s, c; sincospif(2.0f * (float)tid / 64.0f, &s, &c); cs64[tid] = c; sn64[tid] = s; }
    __syncthreads();

    if (bid < 144) {
        for (int i = tid; i < 9216; i += 512) { const int v = i >> 10, k = i & 1023; const float x = v < 8 ? P.in[4][v * 1024 + k] : P.in[5][k]; sc[i] = x / (1.0f + expf(-x)); }
        __syncthreads();
        const int c = tid & 63, kg = tid >> 6; const float* aw = P.in[6] + bid * 64 + c;
        float a[9];
#pragma unroll
        for (int v = 0; v < 9; ++v) a[v] = 0.f;
        for (int k0 = kg; k0 < 1024; k0 += 64) {
            float w8[8];
#pragma unroll
            for (int u = 0; u < 8; ++u) w8[u] = aw[(size_t)(k0 + 8 * u) * 9216];
#pragma unroll
            for (int u = 0; u < 8; ++u)
#pragma unroll
                for (int v = 0; v < 9; ++v) a[v] += sc[v * 1024 + k0 + 8 * u] * w8[u]; }
#pragma unroll
        for (int v = 0; v < 9; ++v) red[(kg * 9 + v) * 64 + c] = a[v];
        __syncthreads();
        float* MOD = (float*)(ws + WS_MOD);
        for (int i = tid; i < 576; i += 512) { const int v = i >> 6, cc = i & 63; float s = 0.f;
#pragma unroll
            for (int q = 0; q < 8; ++q) s += red[(q * 9 + v) * 64 + cc];
            MOD[v * 9216 + bid * 64 + cc] = s + P.in[7][bid * 64 + cc]; }
        __syncthreads();
    }

    {
        const int total = 5792;
#define PREP_DECODE(Q, SRC, LD, KROWS, KD, COL0, N0, K0, DST) { \
            int j = 0, r = (Q), nk = 16; \
            PREP_STEP(0, 88 * 16, 44) PREP_STEP(1, 16 * 44, 16) PREP_STEP(2, 88 * 16, 44) PREP_STEP(3, 16 * 44, 16) \
            PREP_STEP(4, 64 * 16, 8) PREP_STEP(5, 16 * 8, 8) PREP_STEP(6, 16 * 8, 16) PREP_STEP(7, 16 * 16, 4) \
            const int tn = r / nk, tk = r % nk; N0 = tn * 64; K0 = tk * 64; COL0 = N0; \
            if (j == 0 || j == 2) { SRC = j == 0 ? P.in[9] : P.in[11]; LD = 5632; KROWS = 1024; KD = 1024; DST = (u16*)(ws + (j == 0 ? WS_W13A : WS_W13B)); \
                const int pn = N0 >> 8, rr = N0 & 255; COL0 = rr < 128 ? 128 * pn + rr : 2816 + 128 * pn + (rr - 128); } \
            else if (j == 1 || j == 3) { SRC = j == 1 ? P.in[10] : P.in[12]; LD = 1024; KROWS = 2816; KD = 2816; DST = (u16*)(ws + (j == 1 ? WS_W2A : WS_W2B)); } \
            else if (j == 4) { SRC = P.in[13]; LD = 4480; KROWS = 1024; KD = 1024; DST = (u16*)(ws + WS_WIN); \
                COL0 = N0 < 1920 ? N0 : (N0 < 2048 ? -1 : 2432 + (N0 - 2048)); } \
            else if (j == 5) { SRC = P.in[26]; LD = 1024; KROWS = 512; KD = 512; DST = (u16*)(ws + WS_WO); } \
            else if (j == 6) { SRC = P.in[27]; LD = 1024; KROWS = 512; KD = 512; DST = (u16*)(ws + WS_WF); } \
            else if (j == 7) { SRC = P.in[28]; LD = 1024; KROWS = 1024; KD = 1024; DST = (u16*)(ws + WS_WOUT); } \
            else { SRC = P.in[20]; LD = 512; KROWS = 128; KD = 256; DST = (u16*)(ws + WS_GUP); } }
#define PREP_STEP(JJ, CNT, NKN) if (j == JJ && r >= (CNT)) { r -= (CNT); j = JJ + 1; nk = NKN; }
#define PREP_LOAD(V, SRC, LD, KROWS, COL0, K0) { _Pragma("unroll") for (int i = 0; i < 8; ++i) { const int kk = (tid >> 6) + 8 * i, nn = tid & 63; \
            V[i] = ((COL0) >= 0 && (K0) + kk < (KROWS)) ? SRC[(size_t)((K0) + kk) * (LD) + (COL0) + nn] : 0.f; } }
        float cur[8], nxt[8];
        const float* srcc = nullptr; int ldc = 0, krc = 0, kdc = 0, colc = 0, n0c = 0, k0c = 0; u16* dstc = nullptr;
        if (bid < total) { PREP_DECODE(bid, srcc, ldc, krc, kdc, colc, n0c, k0c, dstc) PREP_LOAD(cur, srcc, ldc, krc, colc, k0c) }
        for (int q = bid; q < total; q += G) {
            const float* srcn = srcc; int ldn = ldc, krn = krc, kdn = kdc, coln = colc, n0n = n0c, k0n = k0c; u16* dstn = dstc;
            if (q + G < total) { PREP_DECODE(q + G, srcn, ldn, krn, kdn, coln, n0n, k0n, dstn) PREP_LOAD(nxt, srcn, ldn, krn, coln, k0n) }
#pragma unroll
            for (int i = 0; i < 8; ++i) tile[((tid >> 6) + 8 * i) * 65 + (tid & 63)] = cur[i];
            __syncthreads();
            { const int nn = tid >> 3, ks = (tid & 7) * 8; float v[8];
#pragma unroll
              for (int jj = 0; jj < 8; ++jj) v[jj] = tile[(ks + jj) * 65 + nn];
              u32x4 w; w.x = cvt_pk_bf16(v[0], v[1]); w.y = cvt_pk_bf16(v[2], v[3]); w.z = cvt_pk_bf16(v[4], v[5]); w.w = cvt_pk_bf16(v[6], v[7]);
              *(u32x4*)(dstc + (size_t)(n0c + nn) * kdc + k0c + ks) = w; }
            __syncthreads();
            srcc = srcn; ldc = ldn; krc = krn; kdc = kdn; colc = coln; n0c = n0n; k0c = k0n; dstc = dstn;
#pragma unroll
            for (int i = 0; i < 8; ++i) cur[i] = nxt[i];
        }
#undef PREP_STEP
#undef PREP_DECODE
#undef PREP_LOAD
    }

    {
        u16* WZ = (u16*)(ws + WS_WZ);
        for (int k = bid; k < 1024; k += G) {
            frow[tid] = P.in[13][(size_t)k * 4480 + 1920 + tid];
            __syncthreads();
#pragma unroll
            for (int rep = 0; rep < 2; ++rep) { const int zc = tid + rep * 512, g = zc >> 8, part = (zc >> 7) & 1, kn = zc & 127;
                const LAS float* tab = part ? sn128 : cs128; float s = 0.f;
                for (int n = 0; n < 128; ++n) s += frow[g * 128 + n] * tab[(kn * n) & 127];
                s *= 0.08838834764831845f; if (part) s = -s;
                WZ[(size_t)zc * 1024 + k] = (u16)(cvt_pk_bf16(s, 0.f) & 0xffffu); }
            __syncthreads();
        }
    }

    {
        u16* T = (u16*)(ws + WS_T);
        for (size_t vi = (size_t)bid * 512 + tid; vi < (size_t)4096 * 1024; vi += (size_t)G * 512) {
            const int row = (int)(vi >> 10), cv = (int)(vi & 1023) * 8, part = cv >> 12, r = (cv >> 6) & 63, c0 = cv & 63, kr = row >> 6, kc = row & 63;
            const LAS float* tab = part ? sn64 : cs64; const int base = kr * r;
            float v[8];
#pragma unroll
            for (int j = 0; j < 8; ++j) v[j] = tab[(base + kc * (c0 + j)) & 63] * 0.015625f;
            u32x4 w; w.x = cvt_pk_bf16(v[0], v[1]); w.y = cvt_pk_bf16(v[2], v[3]); w.z = cvt_pk_bf16(v[4], v[5]); w.w = cvt_pk_bf16(v[6], v[7]);
            *(u32x4*)(T + vi * 8) = w;
        }
        u16* T2 = (u16*)(ws + WS_T256);
        for (int vi = bid * 512 + tid; vi < 256 * 64; vi += G * 512) {
            const int kt = vi >> 6, cv = (vi & 63) * 8, part = cv >> 8, t0 = cv & 255;
            const LAS float* tab = part ? sn256 : cs256;
            float v[8];
#pragma unroll
            for (int j = 0; j < 8; ++j) v[j] = tab[(kt * (t0 + j)) & 255] * 0.0625f;
            u32x4 w; w.x = cvt_pk_bf16(v[0], v[1]); w.y = cvt_pk_bf16(v[2], v[3]); w.z = cvt_pk_bf16(v[4], v[5]); w.w = cvt_pk_bf16(v[6], v[7]);
            *(u32x4*)(T2 + (size_t)vi * 8) = w;
        }
    }
}

template <int CTRL> __device__ __forceinline__ float dpp_add(float v) {
    return v + __int_as_float(__builtin_amdgcn_update_dpp(0, __float_as_int(v), CTRL, 0xF, 0xF, true));
}
__device__ __forceinline__ float sum16(float v) {
    v = dpp_add<0xB1>(v); v = dpp_add<0x4E>(v); v = dpp_add<0x141>(v); v = dpp_add<0x140>(v); return v;
}
__device__ __forceinline__ float sum64(float v) {
    const float t = sum16(v);
    const int ti = __float_as_int(t);
    return __int_as_float(__builtin_amdgcn_readlane(ti, 0)) + __int_as_float(__builtin_amdgcn_readlane(ti, 16)) + __int_as_float(__builtin_amdgcn_readlane(ti, 32)) + __int_as_float(__builtin_amdgcn_readlane(ti, 48));
}
__device__ __forceinline__ float wave_sum(float v) {
#pragma unroll
    for (int o = 32; o >= 1; o >>= 1) v += __shfl_xor(v, o);
    return v;
}
__device__ __forceinline__ const float* norm_row(const Params& P, const float* X, int m) {
    return X ? X + (size_t)m * DM : (m < NPR ? P.in[0] + (size_t)m * DM : P.in[1] + (size_t)(m - NPR) * DM);
}
__device__ __forceinline__ void phase_norm(const Params& P, const float* X, int nwi, int slot_shift, int slot_scale, u16* H) {
    const int lane = threadIdx.x & 63, gw = blockIdx.x * 8 + (threadIdx.x >> 6), nw = gridDim.x * 8;
    const float* MOD = (const float*)(P.ws + WS_MOD); const float* normw = P.in[8] + nwi * 1024;
    f32x4 v[4], vn[4];
    if (gw < MT) { const float* xr = norm_row(P, X, gw);
#pragma unroll
        for (int i = 0; i < 4; ++i) v[i] = *(const f32x4*)(xr + i * 256 + lane * 4); }
    for (int m = gw; m < MT; m += nw) {
        const int mn = m + nw < MT ? m + nw : m;
        { const float* xr = norm_row(P, X, mn);
#pragma unroll
          for (int i = 0; i < 4; ++i) vn[i] = *(const f32x4*)(xr + i * 256 + lane * 4); }
        float ss = 0.f;
#pragma unroll
        for (int i = 0; i < 4; ++i) ss += v[i][0] * v[i][0] + v[i][1] * v[i][1] + v[i][2] * v[i][2] + v[i][3] * v[i][3];
        ss = sum64(ss);
        const float rs = rsqrtf(ss * (1.0f / 1024.0f) + 1e-6f);
        const float* md = MOD + (size_t)modidx_m(m) * 9216;
#pragma unroll
        for (int i = 0; i < 4; ++i) { const int c = i * 256 + lane * 4;
            const f32x4 w = *(const f32x4*)(normw + c), sc = *(const f32x4*)(md + slot_scale * 1024 + c), sh = *(const f32x4*)(md + slot_shift * 1024 + c);
            const f32x4 y = v[i] * rs * w * (sc + 1.0f) + sh;
            u32x2 o; o.x = cvt_pk_bf16(y[0], y[1]); o.y = cvt_pk_bf16(y[2], y[3]);
            *(u32x2*)(H + (size_t)m * DM + c) = o; }
#pragma unroll
        for (int i = 0; i < 4; ++i) v[i] = vn[i];
    }
}
__device__ __forceinline__ void phase_final_norm(const Params& P) {
    const int lane = threadIdx.x & 63, gw = blockIdx.x * 8 + (threadIdx.x >> 6), nw = gridDim.x * 8;
    const float* fw = P.in[29];
    f32x4 v[4], vn[4];
    if (gw < MT) { const float* xr = P.out + (size_t)gw * DM;
#pragma unroll
        for (int i = 0; i < 4; ++i) v[i] = *(const f32x4*)(xr + i * 256 + lane * 4); }
    for (int m = gw; m < MT; m += nw) {
        const int mn = m + nw < MT ? m + nw : m;
        { const float* xr = P.out + (size_t)mn * DM;
#pragma unroll
          for (int i = 0; i < 4; ++i) vn[i] = *(const f32x4*)(xr + i * 256 + lane * 4); }
        float ss = 0.f;
#pragma unroll
        for (int i = 0; i < 4; ++i) ss += v[i][0] * v[i][0] + v[i][1] * v[i][1] + v[i][2] * v[i][2] + v[i][3] * v[i][3];
        ss = sum64(ss);
        const float rs = rsqrtf(ss * (1.0f / 1024.0f) + 1e-6f);
        float* xo = P.out + (size_t)m * DM;
#pragma unroll
        for (int i = 0; i < 4; ++i) { const int c = i * 256 + lane * 4; *(f32x4*)(xo + c) = v[i] * rs * *(const f32x4*)(fw + c); }
#pragma unroll
        for (int i = 0; i < 4; ++i) v[i] = vn[i];
    }
}

__device__ __forceinline__ float dot4(const f32x4 a, const f32x4 b) {
    typedef float f32x2 __attribute__((ext_vector_type(2)));
    f32x2 p = (f32x2){a[0], a[1]} * (f32x2){b[0], b[1]};
    p = (f32x2){a[2], a[3]} * (f32x2){b[2], b[3]} + p;
    return p[0] + p[1];
}
__device__ __forceinline__ float fsig(float x) { return __builtin_amdgcn_rcpf(1.0f + __expf(-x)); }
struct ScanRegs { u32x2 r[3], k[3], v[3], wd, ad; };
__device__ __forceinline__ void scan_load(ScanRegs& R, const u16* U, int tok0, int T, int t, int h, int d, int cg) {
    const u32x2 z = {0u, 0u};
#pragma unroll
    for (int tap = 0; tap < 3; ++tap) { const int tn = t + tap - 1;
        if (tn >= 0 && tn < T) { const u16* row = U + (size_t)(tok0 + tn) * 1792 + h * 64 + 4 * cg;
            R.r[tap] = *(const u32x2*)row; R.k[tap] = *(const u32x2*)(row + 512); R.v[tap] = *(const u32x2*)(row + 1024); }
        else { R.r[tap] = z; R.k[tap] = z; R.v[tap] = z; } }
    const u16* row = U + (size_t)(tok0 + t) * 1792 + 1536 + d * 64 + 4 * cg;
    R.wd = *(const u32x2*)row; R.ad = *(const u32x2*)(row + 128);
}
__device__ __forceinline__ void unpack4h(const u32x2 q, float (&o)[4]) { o[0] = h2f(q.x & 0xffffu); o[1] = h2f(q.x >> 16); o[2] = h2f(q.y & 0xffffu); o[3] = h2f(q.y >> 16); }

#define LDS_BARRIER() do { asm volatile("s_waitcnt lgkmcnt(0)" ::: "memory"); __builtin_amdgcn_s_barrier(); asm volatile("" ::: "memory"); } while (0)
__device__ __forceinline__ void scan_unit(const Params& P, LAS float* L, int s, int h, int d, int half) {
    typedef float f32x16 __attribute__((ext_vector_type(16)));
    const int tid = threadIdx.x, lane = tid & 63;
    const bool producer = tid >= 256;
    const int T = s < 16 ? 256 : 4096, tok0 = s < 16 ? s * 256 : NPR + (s - 16) * 4096, nchunk = T / 32;
    const u16* U = (const u16*)(P.ws + WS_U16);
    u16* Od = (u16*)(P.ws + WS_H) + (size_t)d * MT * 512;
    float* BS = (float*)(P.ws + WS_BS);
    LAS float* cst = L;            LAS float* xwT = L + 1024;    LAS float* xaT = L + 3136;   LAS float* lora_s = L + 5248;
    LAS float* o_sb = L + 13440;   LAS float* cb = L + 15488;
    if (tid < 64) { const int c = tid, ch = h * 64 + c;
        cst[c] = P.in[16][d * 512 + ch]; cst[64 + c] = P.in[18][d * 512 + ch]; cst[128 + c] = P.in[21][ch]; cst[192 + c] = P.in[22][ch]; cst[256 + c] = P.in[23][ch];
#pragma unroll
        for (int ten = 0; ten < 3; ++ten)
#pragma unroll
            for (int tap = 0; tap < 3; ++tap) cst[(5 + ten * 3 + tap) * 64 + c] = P.in[15][tap * 1536 + ten * 512 + ch]; }
    const int c16 = tid & 15, rp = (tid >> 4) & 15, rA = half * 32 + rp, rB = rA + 16;
    f32x4 SA = {0.f, 0.f, 0.f, 0.f}, SB = {0.f, 0.f, 0.f, 0.f};
    if (!producer && s >= 16) { const float* st = (d ? P.in[3] : P.in[2]) + (size_t)((s - 16) * 8 + h) * 4096;
        SA = *(const f32x4*)(st + rA * 64 + 4 * c16); SB = *(const f32x4*)(st + rB * 64 + 4 * c16); }
    const int pt = tid - 256, pw = (pt >> 6) & 3, nt = pw & 1, kh = pw >> 1, li = lane & 31, lk = lane >> 5;
    float Bw[16], Ba[16];
    if (producer) {
#pragma unroll
        for (int s2 = 0; s2 < 16; ++s2) { const size_t o = (size_t)(d * 64 + kh * 32 + 2 * s2 + lk) * 512 + h * 64 + nt * 32 + li; Bw[s2] = P.in[17][o]; Ba[s2] = P.in[19][o]; }
    } else {
#pragma unroll
        for (int s2 = 0; s2 < 16; ++s2) { Bw[s2] = 0.f; Ba[s2] = 0.f; }
    }
    const int it0 = pt & 255, tt0 = it0 >> 4, cg0 = it0 & 15, tt1 = tt0 + 16, cg1 = cg0;
    ScanRegs R0, R1;
    if (producer) { scan_load(R0, U, tok0, T, d ? T - 1 - tt0 : tt0, h, d, cg0); scan_load(R1, U, tok0, T, d ? T - 1 - tt1 : tt1, h, d, cg1); }
    __syncthreads();
    for (int ci = -1; ci < nchunk; ++ci) {
        const int pc = ci + 1;
        LAS float* pb = cb + (pc & 1) * 12288;
        const LAS float* qb = cb + (ci & 1) * 12288;
        LAS float* o_s = o_sb + (ci & 1) * 1024;
        const bool do_prep = producer && pc < nchunk, do_step = !producer && ci >= 0;
        LAS float* r_s = pb; LAS float* w_s = pb + 2048; LAS float* kd_s = pb + 4096; LAS float* v_s = pb + 6144; LAS float* kk_s = pb + 8192; LAS float* kka_s = pb + 10240;
#define SCAN_STEPS(SEG) if (do_step) { float oAr[8], oBr[8]; float pA = 0.f, pB = 0.f;     \
        _Pragma("unroll") for (int u8 = 0; u8 < 8; ++u8) { const int tt = (SEG) * 8 + u8; \
            const f32x4 w4 = *(const LAS f32x4*)(qb + 2048 + tt * 64 + 4 * c16), kk4 = *(const LAS f32x4*)(qb + 8192 + tt * 64 + 4 * c16), ka4 = *(const LAS f32x4*)(qb + 10240 + tt * 64 + 4 * c16); \
            const f32x4 kd4 = *(const LAS f32x4*)(qb + 4096 + tt * 64 + 4 * c16), r4 = *(const LAS f32x4*)(qb + tt * 64 + 4 * c16); \
            const float vA = qb[6144 + tt * 64 + rA], vB = qb[6144 + tt * 64 + rB]; \
            float saA = dot4(SA, kk4), saB = dot4(SB, kk4); \
            saA = dpp_add<0xB1>(saA); saB = dpp_add<0xB1>(saB); pA = dpp_add<0xB1>(pA); pB = dpp_add<0xB1>(pB); \
            saA = dpp_add<0x4E>(saA); saB = dpp_add<0x4E>(saB); pA = dpp_add<0x4E>(pA); pB = dpp_add<0x4E>(pB); \
            saA = dpp_add<0x141>(saA); saB = dpp_add<0x141>(saB); pA = dpp_add<0x141>(pA); pB = dpp_add<0x141>(pB); \
            saA = dpp_add<0x140>(saA); saB = dpp_add<0x140>(saB); pA = dpp_add<0x140>(pA); pB = dpp_add<0x140>(pB); \
            if (u8 > 0) { oAr[u8 - 1] = pA; oBr[u8 - 1] = pB; } \
            SA = SA * w4 - ka4 * saA + kd4 * vA; SB = SB * w4 - ka4 * saB + kd4 * vB; \
            pA = dot4(SA, r4); pB = dot4(SB, r4); } \
        pA = dpp_add<0xB1>(pA); pB = dpp_add<0xB1>(pB); pA = dpp_add<0x4E>(pA); pB = dpp_add<0x4E>(pB); pA = dpp_add<0x141>(pA); pB = dpp_add<0x141>(pB); pA = dpp_add<0x140>(pA); pB = dpp_add<0x140>(pB); \
        oAr[7] = pA; oBr[7] = pB; \
        if (c16 == 0) { _Pragma("unroll") for (int u8 = 0; u8 < 8; ++u8) { o_s[((SEG) * 8 + u8) * 32 + rp] = oAr[u8]; o_s[((SEG) * 8 + u8) * 32 + 16 + rp] = oBr[u8]; } } }
        if (do_prep) {
#pragma unroll
            for (int it = 0; it < 2; ++it) { const ScanRegs& R = it ? R1 : R0; const int tt_a = it ? tt1 : tt0, cg = cg0;
                float rv[4] = {0.f, 0.f, 0.f, 0.f}, kv[4] = {0.f, 0.f, 0.f, 0.f}, vv[4] = {0.f, 0.f, 0.f, 0.f};
#pragma unroll
                for (int tap = 0; tap < 3; ++tap) { float a[4], bb[4], c[4]; unpack4h(R.r[tap], a); unpack4h(R.k[tap], bb); unpack4h(R.v[tap], c);
#pragma unroll
                    for (int j = 0; j < 4; ++j) { rv[j] += a[j] * cst[(5 + tap) * 64 + 4 * cg + j]; kv[j] += bb[j] * cst[(8 + tap) * 64 + 4 * cg + j]; vv[j] += c[j] * cst[(11 + tap) * 64 + 4 * cg + j]; } }
                float kkr[4], ss = 0.f;
#pragma unroll
                for (int j = 0; j < 4; ++j) { kkr[j] = kv[j] * cst[128 + 4 * cg + j]; ss += kkr[j] * kkr[j]; }
                ss = sum16(ss);
                const float inv = __builtin_amdgcn_rsqf(fmaxf(ss, 1e-24f));
                float wdv[4], adv[4]; unpack4h(R.wd, wdv); unpack4h(R.ad, adv);
#pragma unroll
                for (int j = 0; j < 4; ++j) { const int o = tt_a * 64 + 4 * cg + j;
                    r_s[o] = rv[j]; v_s[o] = vv[j]; kd_s[o] = kv[j]; kk_s[o] = kkr[j] * inv;
                    xwT[(4 * cg + j) * 33 + tt_a] = 1.0f - 2.0f * __builtin_amdgcn_rcpf(1.0f + __expf(2.0f * wdv[j])); xaT[(4 * cg + j) * 33 + tt_a] = adv[j]; } }
            if (pc + 1 < nchunk) { const int q0 = (pc + 1) * 32 + tt0, q1 = (pc + 1) * 32 + tt1;
                scan_load(R0, U, tok0, T, d ? T - 1 - q0 : q0, h, d, cg0); scan_load(R1, U, tok0, T, d ? T - 1 - q1 : q1, h, d, cg1); }
        }
        SCAN_STEPS(0)
        LDS_BARRIER();
        if (do_prep) {
            f32x16 accw, acca;
#pragma unroll
            for (int i = 0; i < 16; ++i) { accw[i] = 0.f; acca[i] = 0.f; }
#pragma unroll
            for (int s2 = 0; s2 < 16; ++s2) { const int r = kh * 32 + 2 * s2 + lk;
                accw = __builtin_amdgcn_mfma_f32_32x32x2f32(xwT[r * 33 + li], Bw[s2], accw, 0, 0, 0);
                acca = __builtin_amdgcn_mfma_f32_32x32x2f32(xaT[r * 33 + li], Ba[s2], acca, 0, 0, 0); }
#pragma unroll
            for (int reg = 0; reg < 16; ++reg) { const int o = ((reg & 3) + 8 * (reg >> 2) + 4 * lk) * 64 + nt * 32 + li;
                lora_s[(0 * 2 + kh) * 2048 + o] = accw[reg]; lora_s[(1 * 2 + kh) * 2048 + o] = acca[reg]; }
        }
        SCAN_STEPS(1)
        LDS_BARRIER();
        if (do_prep) {
            const int c = pt & 63, tg = pt >> 6;
#pragma unroll
            for (int j = 0; j < 8; ++j) { const int tt = 8 * tg + j, o = tt * 64 + c;
                const float wl = cst[c] + lora_s[o] + lora_s[2048 + o];
                const float w = __expf(-0.6065306597f * fsig(wl));
                const float a = fsig(cst[64 + c] + lora_s[4096 + o] + lora_s[6144 + o]);
                const float k = kd_s[o], kk = kk_s[o];
                const float kd = k * (1.0f + (a - 1.0f) * cst[192 + c]);
                kd_s[o] = kd; kka_s[o] = kk * a; w_s[o] = w;
                const float bsum = sum64(r_s[o] * kd * cst[256 + c]);
                if (lane == 0 && half == 0) { const int q = pc * 32 + tt, t = d ? T - 1 - q : q; BS[(size_t)(tok0 + t) * 16 + h * 2 + d] = bsum; } }
        }
        SCAN_STEPS(2)
        LDS_BARRIER();
        SCAN_STEPS(3)
        LDS_BARRIER();
        if (do_step) { const int tt = tid >> 3, seg = tid & 7, q = ci * 32 + tt, t = d ? T - 1 - q : q;
            u32x2 w2; w2.x = cvt_pk_bf16(o_s[tt * 32 + 4 * seg], o_s[tt * 32 + 4 * seg + 1]); w2.y = cvt_pk_bf16(o_s[tt * 32 + 4 * seg + 2], o_s[tt * 32 + 4 * seg + 3]);
            *(u32x2*)(Od + (size_t)(tok0 + t) * 512 + h * 64 + half * 32 + 4 * seg) = w2; }
#undef SCAN_STEPS
    }
    if (!producer && s < 16) { float* so = P.out + OUT_STATE + (size_t)d * 524288 + (size_t)(s * 8 + h) * 4096;
        *(f32x4*)(so + rA * 64 + 4 * c16) = SA; *(f32x4*)(so + rB * 64 + 4 * c16) = SB; }
    __syncthreads();
}
__device__ __forceinline__ void phase_scan(const Params& P, LAS unsigned char* lds) {
    for (int q = blockIdx.x; q < 768; q += gridDim.x) {
        int s, rem;
        if (q < 256) { s = 16 + (q >> 5); rem = q & 31; } else { const int p = q - 256; s = p >> 5; rem = p & 31; }
        scan_unit(P, (LAS float*)lds, s, rem >> 2, (rem >> 1) & 1, rem & 1);
    }
}

struct PostRaw { unsigned of, ob, v0, v1, v2, sg; float b0, b1; };
__device__ __forceinline__ void post_load(PostRaw& r, int m, int ch, int h, int lane, const u16* OF, const u16* OB, const u16* U, const float* BS, const u16* GT) {
    const int T = m < NPR ? 256 : 4096, t = m < NPR ? (m & 255) : ((m - NPR) & 4095);
    r.of = OF[(size_t)m * 512 + ch]; r.ob = OB[(size_t)m * 512 + ch];
    r.v1 = U[(size_t)m * 1792 + 1024 + ch];
    r.v0 = t > 0 ? U[(size_t)(m - 1) * 1792 + 1024 + ch] : 0u;
    r.v2 = t < T - 1 ? U[(size_t)(m + 1) * 1792 + 1024 + ch] : 0u;
    r.sg = *(const unsigned*)(GT + (size_t)m * GLD + 2048 + 2 * lane);
    r.b0 = BS[(size_t)m * 16 + h * 2]; r.b1 = BS[(size_t)m * 16 + h * 2 + 1];
}
__device__ __forceinline__ void phase_post(const Params& P, LAS unsigned char* lds) {
    const int lane = threadIdx.x & 63, h = threadIdx.x >> 6, ch = h * 64 + lane, G = gridDim.x;
    const u16* OF = (const u16*)(P.ws + WS_H); const u16* OB = OF + (size_t)MT * 512;
    const u16* U = (const u16*)(P.ws + WS_U16); const float* BS = (const float*)(P.ws + WS_BS);
    u16* OPRE = (u16*)(P.ws + WS_OPRE); const u16* GT = (const u16*)(P.ws + WS_R);
    LAS float* sgl = (LAS float*)lds + h * 128;
    float gu[128];
#pragma unroll
    for (int k = 0; k < 128; ++k) gu[k] = P.in[20][(size_t)k * 512 + ch];
    const float lw = P.in[24][ch], lb = P.in[25][ch];
    const float cv0 = P.in[15][0 * 1536 + 1024 + ch], cv1 = P.in[15][1 * 1536 + 1024 + ch], cv2 = P.in[15][2 * 1536 + 1024 + ch];
    PostRaw cur, nxt;
    int m = blockIdx.x;
    post_load(cur, m, ch, h, lane, OF, OB, U, BS, GT);
    for (; m < MT; m += G) {
        const int mn = m + G < MT ? m + G : m;
        post_load(nxt, mn, ch, h, lane, OF, OB, U, BS, GT);
        sgl[2 * lane] = h2f(cur.sg & 0xffffu); sgl[2 * lane + 1] = h2f(cur.sg >> 16);
        const float o = bf2f(cur.of) + bf2f(cur.ob);
        const float mean = sum64(o) * (1.0f / 64.0f), d = o - mean;
        const float rstd = rsqrtf(sum64(d * d) * (1.0f / 64.0f) + 64e-5f);
        const float v = h2f(cur.v0) * cv0 + h2f(cur.v1) * cv1 + h2f(cur.v2) * cv2;
        float g0 = 0.f, g1 = 0.f, g2 = 0.f, g3 = 0.f;
#pragma unroll
        for (int k = 0; k < 128; k += 4) { const f32x4 s4 = *(const LAS f32x4*)(sgl + k);
            g0 += s4[0] * gu[k]; g1 += s4[1] * gu[k + 1]; g2 += s4[2] * gu[k + 2]; g3 += s4[3] * gu[k + 3]; }
        const float y = (d * rstd * lw + lb + (cur.b0 + cur.b1) * v) * ((g0 + g1) + (g2 + g3));
        OPRE[(size_t)m * 512 + ch] = (u16)(cvt_pk_bf16(y, 0.f) & 0xffffu);
        cur = nxt;
    }
}


constexpr size_t WS_BAR = WS_END + 65536;
static_assert(WS_BAR + 4096 <= (size_t)536870912, "barrier words");
__device__ __forceinline__ void fast_grid_sync(unsigned char* ws, unsigned k) {
    asm volatile("s_waitcnt vmcnt(0) lgkmcnt(0)" ::: "memory");
    __builtin_amdgcn_s_barrier();
    if (threadIdx.x == 0) {
        unsigned* bar = (unsigned*)(ws + WS_BAR);
        const unsigned G = gridDim.x, g = blockIdx.x & 7u, gsz = (G - g + 7u) >> 3, ngrp = G < 8u ? G : 8u;
        __builtin_amdgcn_fence(__ATOMIC_RELEASE, "agent");
        asm volatile("s_waitcnt vmcnt(0)" ::: "memory");
        const unsigned old = __hip_atomic_fetch_add(bar + g * 32, 1u, __ATOMIC_RELAXED, __HIP_MEMORY_SCOPE_AGENT);
        if (old + 1u == k * gsz) __hip_atomic_fetch_add(bar + 8 * 32, 1u, __ATOMIC_RELAXED, __HIP_MEMORY_SCOPE_AGENT);
        unsigned spins = 0;
        while (__hip_atomic_load(bar + 8 * 32, __ATOMIC_RELAXED, __HIP_MEMORY_SCOPE_AGENT) < k * ngrp) { if (++spins > (1u << 24)) break; __builtin_amdgcn_s_sleep(1); }
        __builtin_amdgcn_fence(__ATOMIC_ACQUIRE, "agent");
        asm volatile("s_waitcnt vmcnt(0)" ::: "memory");
    }
    __builtin_amdgcn_s_barrier();
    asm volatile("" ::: "memory");
}

__global__ void __launch_bounds__(512, 2) fwd_mega(Params P) {
    extern __shared__ __attribute__((aligned(16))) unsigned char lds_raw[];
    LAS unsigned char* lds = (LAS unsigned char*)lds_raw;
    cg::grid_group grid = cg::this_grid();
    if (threadIdx.x < 32) { const int i = threadIdx.x; const unsigned long long v = i < 30 ? (unsigned long long)P.in[i] : (i == 30 ? (unsigned long long)P.out : (unsigned long long)P.ws);
        *(LAS unsigned long long*)(lds + PTAB_OFF + i * 8) = v; }
    __syncthreads();
unsigned bark_ = 0; unsigned char* P_ws_ = P.ws;
#define PH_BEGIN { const Params Q = get_params(lds); unsigned char* ws = Q.ws; (void)ws;
#define PH_END } asm volatile("s_waitcnt vmcnt(0)" ::: "memory");   grid.sync();
#define PH_ENDF } fast_grid_sync(P_ws_, ++bark_);
    if (blockIdx.x == 0 && threadIdx.x < 9) ((unsigned*)(P.ws + WS_BAR))[threadIdx.x * 32] = 0u;
    PH_BEGIN phase_prep(Q, lds); PH_END
    PH_BEGIN phase_norm(Q, nullptr, 0, 0, 1, (u16*)(ws + WS_H)); PH_ENDF
    PH_BEGIN run_gemm(lds, (const u16*)(ws + WS_H), (const u16*)(ws + WS_W13A), MT, 5632, 1024, EpiSwiglu{(u16*)(ws + WS_BIG)}); PH_ENDF
    PH_BEGIN run_gemm(lds, (const u16*)(ws + WS_BIG), (const u16*)(ws + WS_W2A), MT, 1024, 2816, EpiResid{Q.in[0], Q.in[1], Q.out, (const float*)(ws + WS_MOD), 2, 0.5f}); PH_ENDF
    PH_BEGIN phase_norm(Q, Q.out, 1, 3, 4, (u16*)(ws + WS_H)); PH_ENDF
    PH_BEGIN run_gemm(lds, (const u16*)(ws + WS_WZ), (const u16*)(ws + WS_H), 1024, MT, 1024, EpiZT{(u16*)(ws + WS_ZL)}); PH_ENDF
    PH_BEGIN run_gemm(lds, (const u16*)(ws + WS_T), (const u16*)(ws + WS_ZL), 4096, 4096, 8192, EpiFour{(u16*)(ws + WS_FOUR), 1});
             run_gemm(lds, (const u16*)(ws + WS_T256), (const u16*)(ws + WS_ZP), 256, 8192, 512, EpiFour{(u16*)(ws + WS_FOUR), 0}); PH_ENDF
    PH_BEGIN run_gemm(lds, (const u16*)(ws + WS_H), (const u16*)(ws + WS_WIN), MT, 4096, 1024, EpiU{(u16*)(ws + WS_U16), (u16*)(ws + WS_SG), (u16*)(ws + WS_R), Q.in[14]}); PH_ENDF
    PH_BEGIN phase_scan(Q, lds); PH_ENDF
    PH_BEGIN phase_post(Q, lds); PH_ENDF
    PH_BEGIN run_gemm(lds, (const u16*)(ws + WS_OPRE), (const u16*)(ws + WS_WO), MT, 1024, 512, EpiMul{(u16*)(ws + WS_H), (const u16*)(ws + WS_R), 1}); PH_ENDF
    PH_BEGIN run_gemm(lds, (const u16*)(ws + WS_FOUR), (const u16*)(ws + WS_WF), MT, 1024, 512, EpiMul{(u16*)(ws + WS_H), (const u16*)(ws + WS_R), 2}); PH_ENDF
    PH_BEGIN run_gemm(lds, (const u16*)(ws + WS_H), (const u16*)(ws + WS_WOUT), MT, 1024, 1024, EpiResid{nullptr, nullptr, Q.out, (const float*)(ws + WS_MOD), 5, 1.0f}); PH_ENDF
    PH_BEGIN phase_norm(Q, Q.out, 2, 6, 7, (u16*)(ws + WS_H)); PH_ENDF
    PH_BEGIN run_gemm(lds, (const u16*)(ws + WS_H), (const u16*)(ws + WS_W13B), MT, 5632, 1024, EpiSwiglu{(u16*)(ws + WS_BIG)}); PH_ENDF
    PH_BEGIN run_gemm(lds, (const u16*)(ws + WS_BIG), (const u16*)(ws + WS_W2B), MT, 1024, 2816, EpiResid{nullptr, nullptr, Q.out, (const float*)(ws + WS_MOD), 8, 0.5f}); PH_ENDF
    { const Params Q = get_params(lds); phase_final_norm(Q); }
#undef PH_BEGIN
#undef PH_END
#undef PH_ENDF
}

extern "C" void kernel_launch(void* const* d_in, const int* in_sizes, int n_in, void* d_out, int out_size, void* d_ws, size_t ws_size, hipStream_t stream) {
    static int grid_blocks = 0;
    if (grid_blocks == 0) {
        if (n_in != 30 || ws_size < WS_END) { fprintf(stderr, "kernel_launch: unexpected n_in %d / ws_size %zu (need %zu)\n", n_in, ws_size, (size_t)WS_END); grid_blocks = -1; return; }
        int dev = 0, cus = 0, per_cu = 0;
        (void)hipGetDevice(&dev);
        (void)hipDeviceGetAttribute(&cus, hipDeviceAttributeMultiprocessorCount, dev);
        (void)hipFuncSetAttribute((const void*)fwd_mega, hipFuncAttributeMaxDynamicSharedMemorySize, LDS_BYTES);
        (void)hipOccupancyMaxActiveBlocksPerMultiprocessor(&per_cu, (const void*)fwd_mega, 512, LDS_BYTES);
        if (per_cu < 1) { fprintf(stderr, "kernel_launch: occupancy query reports %d blocks per CU\n", per_cu); per_cu = 1; }
        if (per_cu > 1) per_cu = 1;
        grid_blocks = cus * per_cu;
        (void)hipGetLastError();
    }
    if (grid_blocks < 0) return;
    Params p{};
    for (int i = 0; i < 30; ++i) p.in[i] = (const float*)d_in[i];
    p.out = (float*)d_out; p.ws = (unsigned char*)d_ws;
    void* args[] = {&p};
    hipError_t e = hipLaunchCooperativeKernel((const void*)fwd_mega, dim3(grid_blocks), dim3(512), args, LDS_BYTES, stream);
    if (e != hipSuccess) fprintf(stderr, "cooperative launch failed: %s (grid %d)\n", hipGetErrorString(e), grid_blocks);
}
```

```cpp
#include <hip/hip_runtime.h>
#include <hip/hip_cooperative_groups.h>
#include <cstdio>
namespace cg = cooperative_groups;
namespace pg8 {
#define PG8_LAS __attribute__((address_space(3)))
typedef unsigned short bf16_t;
typedef short bf16x8 __attribute__((ext_vector_type(8)));
typedef float f32x4 __attribute__((ext_vector_type(4)));
typedef unsigned u32x4 __attribute__((ext_vector_type(4)));
constexpr int BM = 256, BK = 64, HALF = 128, HTB = HALF * BK * 2  , STAGE_BYTES = 8 * HTB, NXCD = 8, WGM = 8;

__host__ __device__ __forceinline__ int lds_byte(int r, int c) { const int st = (r >> 4) * 2 + (c >> 5), rr = r & 15, cc = c & 31, ob = rr * 64 + cc * 2; return st * 1024 + (ob ^ (((ob >> 9) & 1) << 5)); }
__host__ __device__ __forceinline__ void stage_rc(int b, int& R, int& C) { const int st = b / 1024, sb = b % 1024, swz = sb ^ (((sb >> 9) & 1) << 5); R = (st >> 1) * 16 + swz / 64; C = (st & 1) * 32 + (swz % 64) / 2; }
__host__ __device__ __forceinline__ int perm32(int rho) { const int n = rho >> 4, i = rho & 15; return 8 * (i >> 2) + 4 * n + (i & 3); }

struct Unit { int pm, pn; };
struct Gemm { const bf16_t* A; const bf16_t* Bt; int M, N, K; };

struct StaticOrder {
    int nM, nN, nwg, G, c;
    __host__ __device__ __forceinline__ void init(int M, int N, int G_, int c_) { nM = M / BM; nN = N / BM; nwg = nM * nN; G = G_; c = c_; }
    __host__ __device__ __forceinline__ bool next(int i, Unit& u) const {
        const long L = (long)i * G + c; if (L >= nwg) return false;
        int wgid = (int)L; { const int q = nwg / NXCD, r = nwg % NXCD, xcd = wgid % NXCD, off = wgid / NXCD; wgid = (xcd < r ? xcd * (q + 1) : r * (q + 1) + (xcd - r) * q) + off; }
        const int nig = WGM * nN, gid = wgid / nig, fm = gid * WGM, gsz = (nM - fm) < WGM ? (nM - fm) : WGM;
        u.pm = fm + ((wgid % nig) % gsz); u.pn = (wgid % nig) / gsz; return true;
    }
    __device__ __forceinline__ void a_ready(const Unit&) const {}
    __device__ __forceinline__ void done(const Unit&) const {}
};
__device__ __forceinline__ unsigned cvt_pk_bf16(float lo, float hi) { unsigned r; asm volatile("v_cvt_pk_bf16_f32 %0, %1, %2" : "=v"(r) : "v"(lo), "v"(hi)); return r; }
template <class Epi, class Sched, bool STAMP = false>
__device__ __forceinline__ void gemm_phase(PG8_LAS unsigned char* lds, const Gemm g, const Sched& S, const Epi& E, unsigned long long* stamps) {
    int tid_ = threadIdx.x; asm volatile("" : "+v"(tid_));
    const int tid = tid_, wid = __builtin_amdgcn_readfirstlane(tid >> 6), lane = tid & 63, wr = wid >> 2, wc = wid & 3, fr = lane & 15, fq = lane >> 4;
    const int K = g.K, nt = K / BK;
    int ts_lo = 0, ts_hi = 0, nts = 0; const unsigned long long rt_entry = STAMP ? (unsigned long long)wall_clock64() : 0ull;
#define PG8_STAMP() do { if (STAMP && wid == 0 && nts < 64) { const unsigned long long _c = (unsigned long long)clock64(); \
        ts_lo = (lane == nts) ? (int)(unsigned)_c : ts_lo; ts_hi = (lane == nts) ? (int)(unsigned)(_c >> 32) : ts_hi; ++nts; } } while (0)
    PG8_STAMP();
    unsigned voffA[2], voffB[2];
#pragma unroll
    for (int i = 0; i < 2; ++i) { int R, C; stage_rc(tid * 16 + i * 8192, R, C); const int Rb = Epi::PERM ? ((R & ~31) + perm32(R & 31)) : R;
        voffA[i] = (unsigned)(R * K + C) * 2u; voffB[i] = (unsigned)(Rb * K + C) * 2u; }
    const size_t kstep = (size_t)(BK * 2);
    const size_t hstep = (size_t)HALF * K * 2;
    const size_t tstep = 2 * hstep;
    const unsigned ldsw = (unsigned)wid * 1024u;
    const int aoff = lds_byte(wr * 64 + fr, fq * 8), boff = lds_byte(wc * 32 + fr, fq * 8);
#define PG8_SA(b, h) (((b) * 2 + (h)) * HTB)
#define PG8_SB(b, h) ((4 + (b) * 2 + (h)) * HTB)
#define PG8_STAGE(bufoff, gbase, voff) do { _Pragma("unroll") for (int _i = 0; _i < 2; ++_i) \
        __builtin_amdgcn_global_load_lds((const unsigned*)((const char*)(gbase) + (voff)[_i]), (PG8_LAS unsigned*)(lds + (bufoff) + ldsw + _i * 8192), 16, 0, 0); } while (0)
#define PG8_LDA(dst, b, h) do { _Pragma("unroll") for (int m = 0; m < 4; ++m) _Pragma("unroll") for (int k = 0; k < 2; ++k) dst[m][k] = *(const PG8_LAS bf16x8*)(lds + PG8_SA(b, h) + aoff + m * 2048 + k * 1024); } while (0)
#define PG8_LDB(dst, b, h) do { _Pragma("unroll") for (int n = 0; n < 2; ++n) _Pragma("unroll") for (int k = 0; k < 2; ++k) dst[n][k] = *(const PG8_LAS bf16x8*)(lds + PG8_SB(b, h) + boff + n * 2048 + k * 1024); } while (0)
#define PG8_MMA(ai, bj, At, Bt) do { __builtin_amdgcn_s_setprio(1); _Pragma("unroll") for (int m = 0; m < 4; ++m) _Pragma("unroll") for (int n = 0; n < 2; ++n) _Pragma("unroll") for (int k = 0; k < 2; ++k) \
        acc[ai][bj][m][n] = __builtin_amdgcn_mfma_f32_16x16x32_bf16(Bt[n][k], At[m][k], acc[ai][bj][m][n], 0, 0, 0); __builtin_amdgcn_s_setprio(0); } while (0)
#define PG8_WAIT_V(n) asm volatile("s_waitcnt vmcnt(" #n ")" ::: "memory")
#define PG8_WAIT_L(n) asm volatile("s_waitcnt lgkmcnt(" #n ")" ::: "memory")
#define PG8_BAR __builtin_amdgcn_s_barrier()
#define PG8_SCHED __builtin_amdgcn_sched_barrier(0)
    Unit cur, nxt; int ui = 0;
    if (!S.next(0, cur)) return;
    f32x4 acc[2][2][4][2];
#pragma unroll
    for (int a = 0; a < 2; ++a)
#pragma unroll
        for (int b = 0; b < 2; ++b)
#pragma unroll
            for (int m = 0; m < 4; ++m)
#pragma unroll
                for (int n = 0; n < 2; ++n) acc[a][b][m][n] = (f32x4){0.f, 0.f, 0.f, 0.f};
    bf16x8 At[4][2], B0[2][2], B1[2][2];
    const char* cA = (const char*)g.A + (size_t)cur.pm * tstep; const char* cB = (const char*)g.Bt + (size_t)cur.pn * tstep;
    S.a_ready(cur);
    PG8_STAGE(PG8_SB(0, 0), cB, voffB); PG8_STAGE(PG8_SA(0, 0), cA, voffA); PG8_STAGE(PG8_SB(0, 1), cB + hstep, voffB); PG8_STAGE(PG8_SA(0, 1), cA + hstep, voffA);
    if (wr == 1) PG8_BAR;
    PG8_WAIT_V(4); PG8_BAR;
    PG8_STAGE(PG8_SB(1, 0), cB + kstep, voffB); PG8_STAGE(PG8_SA(1, 0), cA + kstep, voffA); PG8_STAGE(PG8_SB(1, 1), cB + hstep + kstep, voffB);
    PG8_WAIT_V(6); PG8_BAR;
    PG8_STAMP();
    for (;;) {
        const bool has_next = S.next(ui + 1, nxt);
        const char* nA = has_next ? (const char*)g.A + (size_t)nxt.pm * tstep : cA; const char* nB = has_next ? (const char*)g.Bt + (size_t)nxt.pn * tstep : cB;
        for (int t = 0; t < nt; t += 2) {
            const bool last = (t == nt - 2);
            const char* a1 = cA + (size_t)(t + 1) * kstep;
            const char* a2 = last ? nA : cA + (size_t)(t + 2) * kstep; const char* b2 = last ? nB : cB + (size_t)(t + 2) * kstep;
            const char* a3 = a2 + kstep; const char* b3 = b2 + kstep;
            if (last && has_next) S.a_ready(nxt);
            PG8_LDB(B0, 0, 0); PG8_SCHED; PG8_LDA(At, 0, 0); PG8_STAGE(PG8_SA(1, 1), a1 + hstep, voffA);
            PG8_WAIT_L(8); PG8_BAR; PG8_WAIT_L(0); PG8_MMA(0, 0, At, B0); PG8_BAR; PG8_SCHED;
            PG8_LDB(B1, 0, 1); PG8_STAGE(PG8_SB(0, 0), b2, voffB);
            PG8_BAR; PG8_WAIT_L(0); PG8_MMA(0, 1, At, B1); PG8_BAR;
            PG8_LDA(At, 0, 1); PG8_STAGE(PG8_SA(0, 0), a2, voffA);
            PG8_BAR; PG8_WAIT_L(0); PG8_MMA(1, 0, At, B0); PG8_BAR; PG8_SCHED;
            PG8_STAGE(PG8_SB(0, 1), b2 + hstep, voffB);
            PG8_WAIT_V(6); PG8_BAR; PG8_MMA(1, 1, At, B1); PG8_BAR;
            PG8_LDB(B0, 1, 0); PG8_SCHED; PG8_LDA(At, 1, 0); PG8_STAGE(PG8_SA(0, 1), a2 + hstep, voffA);
            PG8_WAIT_L(8); PG8_BAR; PG8_WAIT_L(0); PG8_MMA(0, 0, At, B0); PG8_BAR; PG8_SCHED;
            PG8_LDB(B1, 1, 1); PG8_STAGE(PG8_SB(1, 0), b3, voffB);
            PG8_BAR; PG8_WAIT_L(0); PG8_MMA(0, 1, At, B1); PG8_BAR;
            PG8_LDA(At, 1, 1); PG8_STAGE(PG8_SA(1, 0), a3, voffA);
            PG8_BAR; PG8_WAIT_L(0); PG8_MMA(1, 0, At, B0); PG8_BAR; PG8_SCHED;
            PG8_STAGE(PG8_SB(1, 1), b3 + hstep, voffB);
            PG8_WAIT_V(6); PG8_BAR; PG8_MMA(1, 1, At, B1); PG8_BAR;
        }
        PG8_STAMP();
        if constexpr (!Epi::AFTER_DRAIN) { E(acc, cur, wr, wc, fr, fq); S.done(cur); }
        PG8_STAMP();
        if (!has_next) break;
#pragma unroll
        for (int a = 0; a < 2; ++a)
#pragma unroll
            for (int b = 0; b < 2; ++b)
#pragma unroll
                for (int m = 0; m < 4; ++m)
#pragma unroll
                    for (int n = 0; n < 2; ++n) acc[a][b][m][n] = (f32x4){0.f, 0.f, 0.f, 0.f};
        cur = nxt; cA = nA; cB = nB; ++ui;
    }
    PG8_WAIT_V(0);
    if (wr == 0) PG8_BAR;
    PG8_BAR;
    if constexpr (Epi::AFTER_DRAIN) { E.fused(acc, cur, wr, wc, fr, fq, lds, wid, lane); S.done(cur); }
    PG8_STAMP();
    if (STAMP && wid == 0) { stamps[lane] = lane < nts ? (((unsigned long long)(unsigned)ts_hi << 32) | (unsigned)ts_lo) : 0ull;
        if (lane == 62) stamps[62] = rt_entry; if (lane == 63) stamps[63] = (unsigned long long)wall_clock64(); }
#undef PG8_STAMP
#undef PG8_SA
#undef PG8_SB
#undef PG8_STAGE
#undef PG8_LDA
#undef PG8_LDB
#undef PG8_MMA
#undef PG8_WAIT_V
#undef PG8_WAIT_L
#undef PG8_BAR
#undef PG8_SCHED
}
}

#define LAS __attribute__((address_space(3)))
typedef unsigned short u16;
typedef float f32x4 __attribute__((ext_vector_type(4)));
typedef unsigned u32x4 __attribute__((ext_vector_type(4)));
typedef unsigned u32x2 __attribute__((ext_vector_type(2)));
using pg8::cvt_pk_bf16;

constexpr int MT = 36864, NPR = 4096, DM = 1024, DFF = 2816;
constexpr int OUT_STATE = MT * DM;
constexpr int LDS_BYTES = 163840, PTAB_OFF = 163840 - 256;

constexpr size_t SZ_W13 = (size_t)5632 * 1024 * 2, SZ_W2 = (size_t)1024 * 2816 * 2;
constexpr size_t WS_W13A = 0, WS_W2A = WS_W13A + SZ_W13, WS_W13B = WS_W2A + SZ_W2, WS_W2B = WS_W13B + SZ_W13;
constexpr size_t WS_WIN = WS_W2B + SZ_W2;
constexpr size_t WS_WZ = WS_WIN + (size_t)4096 * 1024 * 2;
constexpr size_t WS_WO = WS_WZ + (size_t)1024 * 1024 * 2;
constexpr size_t WS_WF = WS_WO + (size_t)1024 * 512 * 2;
constexpr size_t WS_WOUT = WS_WF + (size_t)1024 * 512 * 2;
constexpr size_t WS_GUP = WS_WOUT + (size_t)1024 * 1024 * 2;
constexpr size_t WS_MOD = WS_GUP + (size_t)512 * 256 * 2;
constexpr size_t WS_BS = WS_MOD + (size_t)9 * 9216 * 4;
constexpr size_t WS_SG = WS_BS + (size_t)MT * 16 * 4;
constexpr size_t WS_H = WS_SG + (size_t)MT * 256 * 2;
constexpr size_t WS_BIG = WS_H + (size_t)MT * 1024 * 2;
constexpr size_t WS_U16 = WS_BIG;
constexpr size_t WS_FOUR = WS_U16 + (size_t)MT * 1792 * 2;
constexpr size_t WS_OPRE = WS_FOUR + (size_t)MT * 512 * 2;
constexpr size_t WS_R = WS_BIG + (size_t)MT * 2816 * 2;
constexpr size_t WS_T = WS_R;
constexpr size_t WS_T256 = WS_T + (size_t)4096 * 8192 * 2;
constexpr size_t WS_ZL = WS_T256 + (size_t)256 * 512 * 2;
constexpr size_t WS_ZP = WS_ZL + (size_t)4096 * 8192 * 2;
constexpr int GLD = 2304;
constexpr size_t WS_END = WS_R + (size_t)MT * GLD * 2;
static_assert(WS_ZP + (size_t)8192 * 512 * 2 <= WS_END, "R region");
static_assert(WS_OPRE + (size_t)MT * 512 * 2 <= WS_R, "BIG region");
static_assert(WS_END <= (size_t)536870912, "workspace");
static_assert(WS_ZP == WS_ZL + (size_t)4096 * 8192 * 2, "ZP behind ZL");

struct Params { const float* in[30]; float* out; unsigned char* ws; };
__device__ __forceinline__ unsigned long long ld_ptr(LAS unsigned char* lds, int i) {
    const u32x2 v = *(const LAS u32x2*)(lds + PTAB_OFF + i * 8);
    const unsigned lo = __builtin_amdgcn_readfirstlane(v.x), hi = __builtin_amdgcn_readfirstlane(v.y);
    return ((unsigned long long)hi << 32) | lo;
}
template <class T> __device__ __forceinline__ T* as_global(unsigned long long v) {
    return (T*)(__attribute__((address_space(1))) T*)v;
}
__device__ __forceinline__ Params get_params(LAS unsigned char* lds) {
    Params Q;
#pragma unroll
    for (int i = 0; i < 30; ++i) Q.in[i] = as_global<const float>(ld_ptr(lds, i));
    Q.out = as_global<float>(ld_ptr(lds, 30)); Q.ws = as_global<unsigned char>(ld_ptr(lds, 31));
    return Q;
}
__device__ __forceinline__ float bf2f(unsigned v16) { return __uint_as_float(v16 << 16); }
__device__ __forceinline__ float h2f(unsigned v16) { return (float)__builtin_bit_cast(_Float16, (unsigned short)v16); }
__device__ __forceinline__ unsigned pk_h(float a, float b) {
    const unsigned short ua = __builtin_bit_cast(unsigned short, (_Float16)a), ub = __builtin_bit_cast(unsigned short, (_Float16)b);
    return (unsigned)ua | ((unsigned)ub << 16);
}
__device__ __forceinline__ float sigmoidf_(float x) { return __builtin_amdgcn_rcpf(1.0f + __expf(-x)); }
__device__ __forceinline__ int modidx_pm(int pm) { return pm < 16 ? 8 : ((pm - 16) >> 4); }
__device__ __forceinline__ int modidx_m(int m) { return m < NPR ? 8 : ((m - NPR) >> 12); }

struct EpiSwiglu {
    static constexpr bool PERM = true, AFTER_DRAIN = false;
    u16* G;
    __device__ __forceinline__ void operator()(const f32x4 (&acc)[2][2][4][2], const pg8::Unit& u, int wr, int wc, int fr, int fq) const {
        const int row0 = u.pm * 256 + wr * 64 + fr, col0 = u.pn * 128 + wc * 32 + 8 * fq;
#pragma unroll
        for (int ai = 0; ai < 2; ++ai)
#pragma unroll
            for (int m = 0; m < 4; ++m) {
                float g[8];
#pragma unroll
                for (int n = 0; n < 2; ++n)
#pragma unroll
                    for (int j = 0; j < 4; ++j) { const float a = acc[ai][0][m][n][j], b = acc[ai][1][m][n][j]; g[n * 4 + j] = a * sigmoidf_(a) * b; }
                u32x4 w; w.x = cvt_pk_bf16(g[0], g[1]); w.y = cvt_pk_bf16(g[2], g[3]); w.z = cvt_pk_bf16(g[4], g[5]); w.w = cvt_pk_bf16(g[6], g[7]);
                *(u32x4*)(G + (size_t)(row0 + ai * 128 + m * 16) * DFF + col0) = w;
            }
    }
};
struct EpiResid {
    static constexpr bool PERM = false, AFTER_DRAIN = false;
    const float* xp; const float* xs; float* X; const float* MOD; int slot; float coef;
    __device__ __forceinline__ void operator()(const f32x4 (&acc)[2][2][4][2], const pg8::Unit& u, int wr, int wc, int fr, int fq) const {
        const int row0 = u.pm * 256 + wr * 64 + fr, col0 = u.pn * 256 + wc * 32 + 4 * fq;
        const float* g = MOD + (size_t)modidx_pm(u.pm) * 9216 + slot * 1024 + col0;
        f32x4 gv[2][2];
#pragma unroll
        for (int bj = 0; bj < 2; ++bj)
#pragma unroll
            for (int n = 0; n < 2; ++n) gv[bj][n] = *(const f32x4*)(g + bj * 128 + n * 16) * coef;
#pragma unroll
        for (int ai = 0; ai < 2; ++ai)
#pragma unroll
            for (int m = 0; m < 4; ++m) {
                const int row = row0 + ai * 128 + m * 16;
                const float* src = (xp ? (row < NPR ? xp + (size_t)row * DM : xs + (size_t)(row - NPR) * DM) : X + (size_t)row * DM) + col0;
                float* dst = X + (size_t)row * DM + col0;
#pragma unroll
                for (int bj = 0; bj < 2; ++bj)
#pragma unroll
                    for (int n = 0; n < 2; ++n) *(f32x4*)(dst + bj * 128 + n * 16) = *(const f32x4*)(src + bj * 128 + n * 16) + gv[bj][n] * acc[ai][bj][m][n];
            }
    }
};
struct EpiU {
    static constexpr bool PERM = true, AFTER_DRAIN = false;
    u16* U; u16* SG; u16* GATES; const float* gate_b;
    __device__ __forceinline__ void operator()(const f32x4 (&acc)[2][2][4][2], const pg8::Unit& u, int wr, int wc, int fr, int fq) const {
        const int row0 = u.pm * 256 + wr * 64 + fr, ct = wc * 32 + 8 * fq;
        if (u.pn < 7) {
#pragma unroll
            for (int ai = 0; ai < 2; ++ai)
#pragma unroll
                for (int m = 0; m < 4; ++m)
#pragma unroll
                    for (int bj = 0; bj < 2; ++bj) { const f32x4 v0 = acc[ai][bj][m][0], v1 = acc[ai][bj][m][1];
                        u32x4 w; w.x = pk_h(v0[0], v0[1]); w.y = pk_h(v0[2], v0[3]); w.z = pk_h(v1[0], v1[1]); w.w = pk_h(v1[2], v1[3]);
                        *(u32x4*)(U + (size_t)(row0 + ai * 128 + m * 16) * 1792 + u.pn * 256 + bj * 128 + ct) = w; }
        } else {
            const int gc0 = (u.pn == 7 ? 2048 : (u.pn - 8) * 256) + ct;
#pragma unroll
            for (int bj = 0; bj < 2; ++bj) {
                const int gbi = (u.pn == 7 ? 0 : (u.pn - 8) * 256) + ct; const float bsc = u.pn == 7 ? 0.f : 1.f;
                const f32x4 b0 = *(const f32x4*)(gate_b + gbi + bj * 128) * bsc, b1 = *(const f32x4*)(gate_b + gbi + bj * 128 + 4) * bsc;
#pragma unroll
                for (int ai = 0; ai < 2; ++ai)
#pragma unroll
                    for (int m = 0; m < 4; ++m) { const f32x4 v0 = acc[ai][bj][m][0] + b0, v1 = acc[ai][bj][m][1] + b1;
                        u32x4 w; w.x = pk_h(sigmoidf_(v0[0]), sigmoidf_(v0[1])); w.y = pk_h(sigmoidf_(v0[2]), sigmoidf_(v0[3]));
                        w.z = pk_h(sigmoidf_(v1[0]), sigmoidf_(v1[1])); w.w = pk_h(sigmoidf_(v1[2]), sigmoidf_(v1[3]));
                        *(u32x4*)(GATES + (size_t)(row0 + ai * 128 + m * 16) * GLD + gc0 + bj * 128) = w; }
            }
        }
    }
};
struct EpiZT {
    static constexpr bool PERM = true, AFTER_DRAIN = false;
    u16* ZL;
    __device__ __forceinline__ void operator()(const f32x4 (&acc)[2][2][4][2], const pg8::Unit& u, int wr, int wc, int fr, int fq) const {
#pragma unroll
        for (int bj = 0; bj < 2; ++bj) {
            const int c0 = u.pn * 256 + bj * 128 + wc * 32 + 8 * fq;
#pragma unroll
            for (int ai = 0; ai < 2; ++ai)
#pragma unroll
                for (int m = 0; m < 4; ++m) {
                    const int zr = u.pm * 256 + ai * 128 + wr * 64 + m * 16 + fr, g = zr >> 8, part = (zr >> 7) & 1, kn = zr & 127;
                    size_t off;
                    if (u.pn < 16) off = (size_t)4096 * 8192 + ((size_t)(u.pn * 512 + g * 128 + kn) * 512 + part * 256 + (c0 - u.pn * 256));
                    else { const int tok = c0 - NPR, b = tok >> 12, rc = tok & 4095; off = (size_t)(b * 512 + g * 128 + kn) * 8192 + part * 4096 + rc; }
                    u16* dst = ZL + off;
                    const f32x4 v0 = acc[ai][bj][m][0], v1 = acc[ai][bj][m][1];
                    u32x4 w; w.x = cvt_pk_bf16(v0[0], v0[1]); w.y = cvt_pk_bf16(v0[2], v0[3]); w.z = cvt_pk_bf16(v1[0], v1[1]); w.w = cvt_pk_bf16(v1[2], v1[3]);
                    *(u32x4*)dst = w;
                }
        }
    }
};
struct EpiFour {
    static constexpr bool PERM = true, AFTER_DRAIN = false;
    u16* FOUR; int latent;
    __device__ __forceinline__ void operator()(const f32x4 (&acc)[2][2][4][2], const pg8::Unit& u, int wr, int wc, int fr, int fq) const {
        const int b = u.pn >> 1, ch0 = (u.pn & 1) * 256 + wc * 32 + 8 * fq;
        const int tok0 = (latent ? NPR + b * 4096 : b * 256) + u.pm * 256 + wr * 64 + fr;
#pragma unroll
        for (int ai = 0; ai < 2; ++ai)
#pragma unroll
            for (int m = 0; m < 4; ++m)
#pragma unroll
                for (int bj = 0; bj < 2; ++bj) { const f32x4 v0 = acc[ai][bj][m][0], v1 = acc[ai][bj][m][1];
                    u32x4 w; w.x = cvt_pk_bf16(v0[0], v0[1]); w.y = cvt_pk_bf16(v0[2], v0[3]); w.z = cvt_pk_bf16(v1[0], v1[1]); w.w = cvt_pk_bf16(v1[2], v1[3]);
                    *(u32x4*)(FOUR + (size_t)(tok0 + ai * 128 + m * 16) * 512 + ch0 + bj * 128) = w; }
    }
};
struct EpiMul {
    static constexpr bool PERM = true, AFTER_DRAIN = false;
    u16* O; const u16* GATES; int mode;
    __device__ __forceinline__ void operator()(const f32x4 (&acc)[2][2][4][2], const pg8::Unit& u, int wr, int wc, int fr, int fq) const {
        const int row0 = u.pm * 256 + wr * 64 + fr, col0 = u.pn * 256 + wc * 32 + 8 * fq;
        const int ld = mode == 0 ? 512 : 1024;
#pragma unroll
        for (int ai = 0; ai < 2; ++ai)
#pragma unroll
            for (int m = 0; m < 4; ++m)
#pragma unroll
                for (int bj = 0; bj < 2; ++bj) {
                    const int row = row0 + ai * 128 + m * 16, col = col0 + bj * 128;
                    u16* p = O + (size_t)row * ld + col;
                    float v[8];
#pragma unroll
                    for (int j = 0; j < 4; ++j) { v[j] = acc[ai][bj][m][0][j]; v[4 + j] = acc[ai][bj][m][1][j]; }
                    if (mode == 0) {
                        const u32x4 q = *(const u32x4*)p;
#pragma unroll
                        for (int j = 0; j < 4; ++j) { v[2 * j] *= bf2f(q[j] & 0xffffu); v[2 * j + 1] *= bf2f(q[j] >> 16); }
                    } else {
                        const u32x4 gq = *(const u32x4*)(GATES + (size_t)row * GLD + (mode == 2 ? 1024 : 0) + col);
#pragma unroll
                        for (int j = 0; j < 4; ++j) { v[2 * j] *= h2f(gq[j] & 0xffffu); v[2 * j + 1] *= h2f(gq[j] >> 16); }
                        if (mode == 2) { const u32x4 q = *(const u32x4*)p;
#pragma unroll
                            for (int j = 0; j < 4; ++j) { v[2 * j] += bf2f(q[j] & 0xffffu); v[2 * j + 1] += bf2f(q[j] >> 16); } }
                    }
                    u32x4 w; w.x = cvt_pk_bf16(v[0], v[1]); w.y = cvt_pk_bf16(v[2], v[3]); w.z = cvt_pk_bf16(v[4], v[5]); w.w = cvt_pk_bf16(v[6], v[7]);
                    *(u32x4*)p = w;
                }
    }
};

template <class Epi>
__device__ __forceinline__ void run_gemm(LAS unsigned char* lds, const u16* A, const u16* Bt, int M, int N, int K, const Epi& E) {
    pg8::Gemm g{A, Bt, M, N, K}; pg8::StaticOrder S; S.init(M, N, (int)gridDim.x, (int)blockIdx.x);
    pg8::gemm_phase<Epi, pg8::StaticOrder, false>(lds, g, S, E, nullptr);
}

__device__ __forceinline__ void transpose_tile(const float* src, int ld_src, int col0, int k0, int krows, u16* dst, int n0, int K, LAS float* tile) {
    const int t = threadIdx.x;
#pragma unroll
    for (int i = 0; i < 8; ++i) { const int kk = (t >> 6) + 8 * i, nn = t & 63;
        float v = 0.f; if (col0 >= 0 && k0 + kk < krows) v = src[(size_t)(k0 + kk) * ld_src + col0 + nn];
        tile[kk * 65 + nn] = v; }
    __syncthreads();
    const int nn = t >> 3, ks = (t & 7) * 8;
    float v[8];
#pragma unroll
    for (int j = 0; j < 8; ++j) v[j] = tile[(ks + j) * 65 + nn];
    u32x4 w; w.x = cvt_pk_bf16(v[0], v[1]); w.y = cvt_pk_bf16(v[2], v[3]); w.z = cvt_pk_bf16(v[4], v[5]); w.w = cvt_pk_bf16(v[6], v[7]);
    *(u32x4*)(dst + (size_t)(n0 + nn) * K + k0 + ks) = w;
    __syncthreads();
}

__device__ __forceinline__ void phase_prep(const Params& P, LAS unsigned char* lds) {
    LAS float* L = (LAS float*)lds;
    LAS float* tile = L;
    LAS float* cs128 = L + 4160; LAS float* sn128 = cs128 + 128;
    LAS float* cs64 = sn128 + 128;  LAS float* sn64 = cs64 + 64;
    LAS float* cs256 = sn64 + 64;   LAS float* sn256 = cs256 + 256;
    LAS float* frow = sn256 + 256;
    LAS float* sc = frow + 512;
    LAS float* red = sc + 9216;
    const int tid = threadIdx.x, G = gridDim.x, bid = blockIdx.x;
    unsigned char* ws = P.ws;
    if (tid < 256) { float s, c; sincospif(2.0f * (float)tid / 256.0f, &s, &c); cs256[tid] = c; sn256[tid] = s; }
    if (tid < 128) { float s, c; sincospif(2.0f * (float)tid / 128.0f, &s, &c); cs128[tid] = c; sn128[tid] = s; }
    if (tid < 64)  { float s, c; sincospif(2.0f * (float)tid / 64.0f, &s, &c); cs64[tid] = c; sn64[tid] = s; }
    __syncthreads();

    if (bid < 144) {
        for (int i = tid; i < 9216; i += 512) { const int v = i >> 10, k = i & 1023; const float x = v < 8 ? P.in[4][v * 1024 + k] : P.in[5][k]; sc[i] = x / (1.0f + expf(-x)); }
        __syncthreads();
        const int c = tid & 63, kg = tid >> 6; const float* aw = P.in[6] + bid * 64 + c;
        float a[9];
#pragma unroll
        for (int v = 0; v < 9; ++v) a[v] = 0.f;
        for (int k0 = kg; k0 < 1024; k0 += 64) {
            float w8[8];
#pragma unroll
            for (int u = 0; u < 8; ++u) w8[u] = aw[(size_t)(k0 + 8 * u) * 9216];
#pragma unroll
            for (int u = 0; u < 8; ++u)
#pragma unroll
                for (int v = 0; v < 9; ++v) a[v] += sc[v * 1024 + k0 + 8 * u] * w8[u]; }
#pragma unroll
        for (int v = 0; v < 9; ++v) red[(kg * 9 + v) * 64 + c] = a[v];
        __syncthreads();
        float* MOD = (float*)(ws + WS_MOD);
        for (int i = tid; i < 576; i += 512) { const int v = i >> 6, cc = i & 63; float s = 0.f;
#pragma unroll
            for (int q = 0; q < 8; ++q) s += red[(q * 9 + v) * 64 + cc];
            MOD[v * 9216 + bid * 64 + cc] = s + P.in[7][bid * 64 + cc]; }
        __syncthreads();
    }

    {
        const int total = 5792;
#define PREP_DECODE(Q, SRC, LD, KROWS, KD, COL0, N0, K0, DST) { \
            int j = 0, r = (Q), nk = 16; \
            PREP_STEP(0, 88 * 16, 44) PREP_STEP(1, 16 * 44, 16) PREP_STEP(2, 88 * 16, 44) PREP_STEP(3, 16 * 44, 16) \
            PREP_STEP(4, 64 * 16, 8) PREP_STEP(5, 16 * 8, 8) PREP_STEP(6, 16 * 8, 16) PREP_STEP(7, 16 * 16, 4) \
            const int tn = r / nk, tk = r % nk; N0 = tn * 64; K0 = tk * 64; COL0 = N0; \
            if (j == 0 || j == 2) { SRC = j == 0 ? P.in[9] : P.in[11]; LD = 5632; KROWS = 1024; KD = 1024; DST = (u16*)(ws + (j == 0 ? WS_W13A : WS_W13B)); \
                const int pn = N0 >> 8, rr = N0 & 255; COL0 = rr < 128 ? 128 * pn + rr : 2816 + 128 * pn + (rr - 128); } \
            else if (j == 1 || j == 3) { SRC = j == 1 ? P.in[10] : P.in[12]; LD = 1024; KROWS = 2816; KD = 2816; DST = (u16*)(ws + (j == 1 ? WS_W2A : WS_W2B)); } \
            else if (j == 4) { SRC = P.in[13]; LD = 4480; KROWS = 1024; KD = 1024; DST = (u16*)(ws + WS_WIN); \
                COL0 = N0 < 1920 ? N0 : (N0 < 2048 ? -1 : 2432 + (N0 - 2048)); } \
            else if (j == 5) { SRC = P.in[26]; LD = 1024; KROWS = 512; KD = 512; DST = (u16*)(ws + WS_WO); } \
            else if (j == 6) { SRC = P.in[27]; LD = 1024; KROWS = 512; KD = 512; DST = (u16*)(ws + WS_WF); } \
            else if (j == 7) { SRC = P.in[28]; LD = 1024; KROWS = 1024; KD = 1024; DST = (u16*)(ws + WS_WOUT); } \
            else { SRC = P.in[20]; LD = 512; KROWS = 128; KD = 256; DST = (u16*)(ws + WS_GUP); } }
#define PREP_STEP(JJ, CNT, NKN) if (j == JJ && r >= (CNT)) { r -= (CNT); j = JJ + 1; nk = NKN; }
#define PREP_LOAD(V, SRC, LD, KROWS, COL0, K0) { _Pragma("unroll") for (int i = 0; i < 8; ++i) { const int kk = (tid >> 6) + 8 * i, nn = tid & 63; \
            V[i] = ((COL0) >= 0 && (K0) + kk < (KROWS)) ? SRC[(size_t)((K0) + kk) * (LD) + (COL0) + nn] : 0.f; } }
        float cur[8], nxt[8];
        const float* srcc = nullptr; int ldc = 0, krc = 0, kdc = 0, colc = 0, n0c = 0, k0c = 0; u16* dstc = nullptr;
        if (bid < total) { PREP_DECODE(bid, srcc, ldc, krc, kdc, colc, n0c, k0c, dstc) PREP_LOAD(cur, srcc, ldc, krc, colc, k0c) }
        for (int q = bid; q < total; q += G) {
            const float* srcn = srcc; int ldn = ldc, krn = krc, kdn = kdc, coln = colc, n0n = n0c, k0n = k0c; u16* dstn = dstc;
            if (q + G < total) { PREP_DECODE(q + G, srcn, ldn, krn, kdn, coln, n0n, k0n, dstn) PREP_LOAD(nxt, srcn, ldn, krn, coln, k0n) }
#pragma unroll
            for (int i = 0; i < 8; ++i) tile[((tid >> 6) + 8 * i) * 65 + (tid & 63)] = cur[i];
            __syncthreads();
            { const int nn = tid >> 3, ks = (tid & 7) * 8; float v[8];
#pragma unroll
              for (int jj = 0; jj < 8; ++jj) v[jj] = tile[(ks + jj) * 65 + nn];
              u32x4 w; w.x = cvt_pk_bf16(v[0], v[1]); w.y = cvt_pk_bf16(v[2], v[3]); w.z = cvt_pk_bf16(v[4], v[5]); w.w = cvt_pk_bf16(v[6], v[7]);
              *(u32x4*)(dstc + (size_t)(n0c + nn) * kdc + k0c + ks) = w; }
            __syncthreads();
            srcc = srcn; ldc = ldn; krc = krn; kdc = kdn; colc = coln; n0c = n0n; k0c = k0n; dstc = dstn;
#pragma unroll
            for (int i = 0; i < 8; ++i) cur[i] = nxt[i];
        }
#undef PREP_STEP
#undef PREP_DECODE
#undef PREP_LOAD
    }

    {
        u16* WZ = (u16*)(ws + WS_WZ);
        for (int k = bid; k < 1024; k += G) {
            frow[tid] = P.in[13][(size_t)k * 4480 + 1920 + tid];
            __syncthreads();
#pragma unroll
            for (int rep = 0; rep < 2; ++rep) { const int zc = tid + rep * 512, g = zc >> 8, part = (zc >> 7) & 1, kn = zc & 127;
                const LAS float* tab = part ? sn128 : cs128; float s = 0.f;
                for (int n = 0; n < 128; ++n) s += frow[g * 128 + n] * tab[(kn * n) & 127];
                s *= 0.08838834764831845f; if (part) s = -s;
                WZ[(size_t)zc * 1024 + k] = (u16)(cvt_pk_bf16(s, 0.f) & 0xffffu); }
            __syncthreads();
        }
    }

    {
        u16* T = (u16*)(ws + WS_T);
        for (size_t vi = (size_t)bid * 512 + tid; vi < (size_t)4096 * 1024; vi += (size_t)G * 512) {
            const int row = (int)(vi >> 10), cv = (int)(vi & 1023) * 8, part = cv >> 12, r = (cv >> 6) & 63, c0 = cv & 63, kr = row >> 6, kc = row & 63;
            const LAS float* tab = part ? sn64 : cs64; const int base = kr * r;
            float v[8];
#pragma unroll
            for (int j = 0; j < 8; ++j) v[j] = tab[(base + kc * (c0 + j)) & 63] * 0.015625f;
            u32x4 w; w.x = cvt_pk_bf16(v[0], v[1]); w.y = cvt_pk_bf16(v[2], v[3]); w.z = cvt_pk_bf16(v[4], v[5]); w.w = cvt_pk_bf16(v[6], v[7]);
            *(u32x4*)(T + vi * 8) = w;
        }
        u16* T2 = (u16*)(ws + WS_T256);
        for (int vi = bid * 512 + tid; vi < 256 * 64; vi += G * 512) {
            const int kt = vi >> 6, cv = (vi & 63) * 8, part = cv >> 8, t0 = cv & 255;
            const LAS float* tab = part ? sn256 : cs256;
            float v[8];
#pragma unroll
            for (int j = 0; j < 8; ++j) v[j] = tab[(kt * (t0 + j)) & 255] * 0.0625f;
            u32x4 w; w.x = cvt_pk_bf16(v[0], v[1]); w.y = cvt_pk_bf16(v[2], v[3]); w.z = cvt_pk_bf16(v[4], v[5]); w.w = cvt_pk_bf16(v[6], v[7]);
            *(u32x4*)(T2 + (size_t)vi * 8) = w;
        }
    }
}

template <int CTRL> __device__ __forceinline__ float dpp_add(float v) {
    return v + __int_as_float(__builtin_amdgcn_update_dpp(0, __float_as_int(v), CTRL, 0xF, 0xF, true));
}
__device__ __forceinline__ float sum16(float v) {
    v = dpp_add<0xB1>(v); v = dpp_add<0x4E>(v); v = dpp_add<0x141>(v); v = dpp_add<0x140>(v); return v;
}
__device__ __forceinline__ float sum64(float v) {
    const float t = sum16(v);
    const int ti = __float_as_int(t);
    return __int_as_float(__builtin_amdgcn_readlane(ti, 0)) + __int_as_float(__builtin_amdgcn_readlane(ti, 16)) + __int_as_float(__builtin_amdgcn_readlane(ti, 32)) + __int_as_float(__builtin_amdgcn_readlane(ti, 48));
}
__device__ __forceinline__ float wave_sum(float v) {
#pragma unroll
    for (int o = 32; o >= 1; o >>= 1) v += __shfl_xor(v, o);
    return v;
}
__device__ __forceinline__ const float* norm_row(const Params& P, const float* X, int m) {
    return X ? X + (size_t)m * DM : (m < NPR ? P.in[0] + (size_t)m * DM : P.in[1] + (size_t)(m - NPR) * DM);
}
__device__ __forceinline__ void phase_norm(const Params& P, const float* X, int nwi, int slot_shift, int slot_scale, u16* H) {
    const int lane = threadIdx.x & 63, gw = blockIdx.x * 8 + (threadIdx.x >> 6), nw = gridDim.x * 8;
    const float* MOD = (const float*)(P.ws + WS_MOD); const float* normw = P.in[8] + nwi * 1024;
    f32x4 v[4], vn[4];
    if (gw < MT) { const float* xr = norm_row(P, X, gw);
#pragma unroll
        for (int i = 0; i < 4; ++i) v[i] = *(const f32x4*)(xr + i * 256 + lane * 4); }
    for (int m = gw; m < MT; m += nw) {
        const int mn = m + nw < MT ? m + nw : m;
        { const float* xr = norm_row(P, X, mn);
#pragma unroll
          for (int i = 0; i < 4; ++i) vn[i] = *(const f32x4*)(xr + i * 256 + lane * 4); }
        float ss = 0.f;
#pragma unroll
        for (int i = 0; i < 4; ++i) ss += v[i][0] * v[i][0] + v[i][1] * v[i][1] + v[i][2] * v[i][2] + v[i][3] * v[i][3];
        ss = sum64(ss);
        const float rs = rsqrtf(ss * (1.0f / 1024.0f) + 1e-6f);
        const float* md = MOD + (size_t)modidx_m(m) * 9216;
#pragma unroll
        for (int i = 0; i < 4; ++i) { const int c = i * 256 + lane * 4;
            const f32x4 w = *(const f32x4*)(normw + c), sc = *(const f32x4*)(md + slot_scale * 1024 + c), sh = *(const f32x4*)(md + slot_shift * 1024 + c);
            const f32x4 y = v[i] * rs * w * (sc + 1.0f) + sh;
            u32x2 o; o.x = cvt_pk_bf16(y[0], y[1]); o.y = cvt_pk_bf16(y[2], y[3]);
            *(u32x2*)(H + (size_t)m * DM + c) = o; }
#pragma unroll
        for (int i = 0; i < 4; ++i) v[i] = vn[i];
    }
}
__device__ __forceinline__ void phase_final_norm(const Params& P) {
    const int lane = threadIdx.x & 63, gw = blockIdx.x * 8 + (threadIdx.x >> 6), nw = gridDim.x * 8;
    const float* fw = P.in[29];
    f32x4 v[4], vn[4];
    if (gw < MT) { const float* xr = P.out + (size_t)gw * DM;
#pragma unroll
        for (int i = 0; i < 4; ++i) v[i] = *(const f32x4*)(xr + i * 256 + lane * 4); }
    for (int m = gw; m < MT; m += nw) {
        const int mn = m + nw < MT ? m + nw : m;
        { const float* xr = P.out + (size_t)mn * DM;
#pragma unroll
          for (int i = 0; i < 4; ++i) vn[i] = *(const f32x4*)(xr + i * 256 + lane * 4); }
        float ss = 0.f;
#pragma unroll
        for (int i = 0; i < 4; ++i) ss += v[i][0] * v[i][0] + v[i][1] * v[i][1] + v[i][2] * v[i][2] + v[i][3] * v[i][3];
        ss = sum64(ss);
        const float rs = rsqrtf(ss * (1.0f / 1024.0f) + 1e-6f);
        float* xo = P.out + (size_t)m * DM;
#pragma unroll
        for (int i = 0; i < 4; ++i) { const int c = i * 256 + lane * 4; *(f32x4*)(xo + c) = v[i] * rs * *(const f32x4*)(fw + c); }
#pragma unroll
        for (int i = 0; i < 4; ++i) v[i] = vn[i];
    }
}

__device__ __forceinline__ float dot4(const f32x4 a, const f32x4 b) {
    typedef float f32x2 __attribute__((ext_vector_type(2)));
    f32x2 p = (f32x2){a[0], a[1]} * (f32x2){b[0], b[1]};
    p = (f32x2){a[2], a[3]} * (f32x2){b[2], b[3]} + p;
    return p[0] + p[1];
}
__device__ __forceinline__ float fsig(float x) { return __builtin_amdgcn_rcpf(1.0f + __expf(-x)); }
struct ScanRegs { u32x2 r[3], k[3], v[3], wd, ad; };
__device__ __forceinline__ void scan_load(ScanRegs& R, const u16* U, int tok0, int T, int t, int h, int d, int cg) {
    const u32x2 z = {0u, 0u};
#pragma unroll
    for (int tap = 0; tap < 3; ++tap) { const int tn = t + tap - 1;
        if (tn >= 0 && tn < T) { const u16* row = U + (size_t)(tok0 + tn) * 1792 + h * 64 + 4 * cg;
            R.r[tap] = *(const u32x2*)row; R.k[tap] = *(const u32x2*)(row + 512); R.v[tap] = *(const u32x2*)(row + 1024); }
        else { R.r[tap] = z; R.k[tap] = z; R.v[tap] = z; } }
    const u16* row = U + (size_t)(tok0 + t) * 1792 + 1536 + d * 64 + 4 * cg;
    R.wd = *(const u32x2*)row; R.ad = *(const u32x2*)(row + 128);
}
__device__ __forceinline__ void unpack4h(const u32x2 q, float (&o)[4]) { o[0] = h2f(q.x & 0xffffu); o[1] = h2f(q.x >> 16); o[2] = h2f(q.y & 0xffffu); o[3] = h2f(q.y >> 16); }

#define LDS_BARRIER() do { asm volatile("s_waitcnt lgkmcnt(0)" ::: "memory"); __builtin_amdgcn_s_barrier(); asm volatile("" ::: "memory"); } while (0)
__device__ __forceinline__ void scan_unit(const Params& P, LAS float* L, int s, int h, int d, int half) {
    typedef float f32x16 __attribute__((ext_vector_type(16)));
    const int tid = threadIdx.x, lane = tid & 63;
    const bool producer = tid >= 256;
    const int T = s < 16 ? 256 : 4096, tok0 = s < 16 ? s * 256 : NPR + (s - 16) * 4096, nchunk = T / 32;
    const u16* U = (const u16*)(P.ws + WS_U16);
    u16* Od = (u16*)(P.ws + WS_H) + (size_t)d * MT * 512;
    float* BS = (float*)(P.ws + WS_BS);
    LAS float* cst = L;            LAS float* xwT = L + 1024;    LAS float* xaT = L + 3136;   LAS float* lora_s = L + 5248;
    LAS float* o_sb = L + 13440;   LAS float* cb = L + 15488;
    if (tid < 64) { const int c = tid, ch = h * 64 + c;
        cst[c] = P.in[16][d * 512 + ch]; cst[64 + c] = P.in[18][d * 512 + ch]; cst[128 + c] = P.in[21][ch]; cst[192 + c] = P.in[22][ch]; cst[256 + c] = P.in[23][ch];
#pragma unroll
        for (int ten = 0; ten < 3; ++ten)
#pragma unroll
            for (int tap = 0; tap < 3; ++tap) cst[(5 + ten * 3 + tap) * 64 + c] = P.in[15][tap * 1536 + ten * 512 + ch]; }
    const int c16 = tid & 15, rp = (tid >> 4) & 15, rA = half * 32 + rp, rB = rA + 16;
    f32x4 SA = {0.f, 0.f, 0.f, 0.f}, SB = {0.f, 0.f, 0.f, 0.f};
    if (!producer && s >= 16) { const float* st = (d ? P.in[3] : P.in[2]) + (size_t)((s - 16) * 8 + h) * 4096;
        SA = *(const f32x4*)(st + rA * 64 + 4 * c16); SB = *(const f32x4*)(st + rB * 64 + 4 * c16); }
    const int pt = tid - 256, pw = (pt >> 6) & 3, nt = pw & 1, kh = pw >> 1, li = lane & 31, lk = lane >> 5;
    float Bw[16], Ba[16];
    if (producer) {
#pragma unroll
        for (int s2 = 0; s2 < 16; ++s2) { const size_t o = (size_t)(d * 64 + kh * 32 + 2 * s2 + lk) * 512 + h * 64 + nt * 32 + li; Bw[s2] = P.in[17][o]; Ba[s2] = P.in[19][o]; }
    } else {
#pragma unroll
        for (int s2 = 0; s2 < 16; ++s2) { Bw[s2] = 0.f; Ba[s2] = 0.f; }
    }
    const int it0 = pt & 255, tt0 = it0 >> 4, cg0 = it0 & 15, tt1 = tt0 + 16, cg1 = cg0;
    ScanRegs R0, R1;
    if (producer) { scan_load(R0, U, tok0, T, d ? T - 1 - tt0 : tt0, h, d, cg0); scan_load(R1, U, tok0, T, d ? T - 1 - tt1 : tt1, h, d, cg1); }
    __syncthreads();
    float tpr[3][4], tpk[3][4], tpv[3][4], kkc4[4];
#pragma unroll
    for (int tap = 0; tap < 3; ++tap)
#pragma unroll
        for (int j = 0; j < 4; ++j) { tpr[tap][j] = cst[(5 + tap) * 64 + 4 * cg0 + j]; tpk[tap][j] = cst[(8 + tap) * 64 + 4 * cg0 + j]; tpv[tap][j] = cst[(11 + tap) * 64 + 4 * cg0 + j]; }
#pragma unroll
    for (int j = 0; j < 4; ++j) kkc4[j] = cst[128 + 4 * cg0 + j];
    const float w0c = cst[pt & 63], a0c = cst[64 + (pt & 63)], kac = cst[192 + (pt & 63)], rkc = cst[256 + (pt & 63)];
    for (int ci = -1; ci < nchunk; ++ci) {
        const int pc = ci + 1;
        LAS float* pb = cb + (pc & 1) * 12288;
        const LAS float* qb = cb + (ci & 1) * 12288;
        LAS float* o_s = o_sb + (ci & 1) * 1024;
        const bool do_prep = producer && pc < nchunk, do_step = !producer && ci >= 0;
        LAS float* r_s = pb; LAS float* w_s = pb + 2048; LAS float* kd_s = pb + 4096; LAS float* v_s = pb + 6144; LAS float* kk_s = pb + 8192; LAS float* kka_s = pb + 10240;
#define SCAN_STEPS(SEG) if (do_step) { float oAr[8], oBr[8]; float pA = 0.f, pB = 0.f;     \
        _Pragma("unroll") for (int u8 = 0; u8 < 8; ++u8) { const int tt = (SEG) * 8 + u8; \
            const f32x4 w4 = *(const LAS f32x4*)(qb + 2048 + tt * 64 + 4 * c16), kk4 = *(const LAS f32x4*)(qb + 8192 + tt * 64 + 4 * c16), ka4 = *(const LAS f32x4*)(qb + 10240 + tt * 64 + 4 * c16); \
            const f32x4 kd4 = *(const LAS f32x4*)(qb + 4096 + tt * 64 + 4 * c16), r4 = *(const LAS f32x4*)(qb + tt * 64 + 4 * c16); \
            const float vA = qb[6144 + tt * 64 + rA], vB = qb[6144 + tt * 64 + rB]; \
            float saA = dot4(SA, kk4), saB = dot4(SB, kk4); \
            saA = dpp_add<0xB1>(saA); saB = dpp_add<0xB1>(saB); pA = dpp_add<0xB1>(pA); pB = dpp_add<0xB1>(pB); \
            saA = dpp_add<0x4E>(saA); saB = dpp_add<0x4E>(saB); pA = dpp_add<0x4E>(pA); pB = dpp_add<0x4E>(pB); \
            saA = dpp_add<0x141>(saA); saB = dpp_add<0x141>(saB); pA = dpp_add<0x141>(pA); pB = dpp_add<0x141>(pB); \
            saA = dpp_add<0x140>(saA); saB = dpp_add<0x140>(saB); pA = dpp_add<0x140>(pA); pB = dpp_add<0x140>(pB); \
            if (u8 > 0) { oAr[u8 - 1] = pA; oBr[u8 - 1] = pB; } \
            SA = SA * w4 - ka4 * saA + kd4 * vA; SB = SB * w4 - ka4 * saB + kd4 * vB; \
            pA = dot4(SA, r4); pB = dot4(SB, r4); } \
        pA = dpp_add<0xB1>(pA); pB = dpp_add<0xB1>(pB); pA = dpp_add<0x4E>(pA); pB = dpp_add<0x4E>(pB); pA = dpp_add<0x141>(pA); pB = dpp_add<0x141>(pB); pA = dpp_add<0x140>(pA); pB = dpp_add<0x140>(pB); \
        oAr[7] = pA; oBr[7] = pB; \
        if (c16 == 0) { _Pragma("unroll") for (int u8 = 0; u8 < 8; ++u8) { o_s[((SEG) * 8 + u8) * 32 + rp] = oAr[u8]; o_s[((SEG) * 8 + u8) * 32 + 16 + rp] = oBr[u8]; } } }
        if (do_prep) {
#pragma unroll
            for (int it = 0; it < 2; ++it) { const ScanRegs& R = it ? R1 : R0; const int tt_a = it ? tt1 : tt0, cg = cg0;
                float rv[4] = {0.f, 0.f, 0.f, 0.f}, kv[4] = {0.f, 0.f, 0.f, 0.f}, vv[4] = {0.f, 0.f, 0.f, 0.f};
#pragma unroll
                for (int tap = 0; tap < 3; ++tap) { float a[4], bb[4], c[4]; unpack4h(R.r[tap], a); unpack4h(R.k[tap], bb); unpack4h(R.v[tap], c);
#pragma unroll
                    for (int j = 0; j < 4; ++j) { rv[j] += a[j] * tpr[tap][j]; kv[j] += bb[j] * tpk[tap][j]; vv[j] += c[j] * tpv[tap][j]; } }
                float kkr[4], ss = 0.f;
#pragma unroll
                for (int j = 0; j < 4; ++j) { kkr[j] = kv[j] * kkc4[j]; ss += kkr[j] * kkr[j]; }
                ss = sum16(ss);
                const float inv = __builtin_amdgcn_rsqf(fmaxf(ss, 1e-24f));
                float wdv[4], adv[4]; unpack4h(R.wd, wdv); unpack4h(R.ad, adv);
#pragma unroll
                for (int j = 0; j < 4; ++j) { const int o = tt_a * 64 + 4 * cg + j;
                    r_s[o] = rv[j]; v_s[o] = vv[j]; kd_s[o] = kv[j]; kk_s[o] = kkr[j] * inv;
                    xwT[(4 * cg + j) * 33 + tt_a] = 1.0f - 2.0f * __builtin_amdgcn_rcpf(1.0f + __expf(2.0f * wdv[j])); xaT[(4 * cg + j) * 33 + tt_a] = adv[j]; } }
            if (pc + 1 < nchunk) { const int q0 = (pc + 1) * 32 + tt0, q1 = (pc + 1) * 32 + tt1;
                scan_load(R0, U, tok0, T, d ? T - 1 - q0 : q0, h, d, cg0); scan_load(R1, U, tok0, T, d ? T - 1 - q1 : q1, h, d, cg1); }
        }
        SCAN_STEPS(0)
        LDS_BARRIER();
        if (do_prep) {
            f32x16 accw, acca;
#pragma unroll
            for (int i = 0; i < 16; ++i) { accw[i] = 0.f; acca[i] = 0.f; }
#pragma unroll
            for (int s2 = 0; s2 < 16; ++s2) { const int r = kh * 32 + 2 * s2 + lk;
                accw = __builtin_amdgcn_mfma_f32_32x32x2f32(xwT[r * 33 + li], Bw[s2], accw, 0, 0, 0);
                acca = __builtin_amdgcn_mfma_f32_32x32x2f32(xaT[r * 33 + li], Ba[s2], acca, 0, 0, 0); }
#pragma unroll
            for (int reg = 0; reg < 16; ++reg) { const int o = ((reg & 3) + 8 * (reg >> 2) + 4 * lk) * 64 + nt * 32 + li;
                lora_s[(0 * 2 + kh) * 2048 + o] = accw[reg]; lora_s[(1 * 2 + kh) * 2048 + o] = acca[reg]; }
        }
        SCAN_STEPS(1)
        LDS_BARRIER();
        if (do_prep) {
            const int c = pt & 63, tg = pt >> 6;
#pragma unroll
            for (int j = 0; j < 8; ++j) { const int tt = 8 * tg + j, o = tt * 64 + c;
                const float wl = w0c + lora_s[o] + lora_s[2048 + o];
                const float w = __expf(-0.6065306597f * fsig(wl));
                const float a = fsig(a0c + lora_s[4096 + o] + lora_s[6144 + o]);
                const float k = kd_s[o], kk = kk_s[o];
                const float kd = k * (1.0f + (a - 1.0f) * kac);
                kd_s[o] = kd; kka_s[o] = kk * a; w_s[o] = w;
                const float bsum = sum64(r_s[o] * kd * rkc);
                if (lane == 0 && half == 0) { const int q = pc * 32 + tt, t = d ? T - 1 - q : q; BS[(size_t)(tok0 + t) * 16 + h * 2 + d] = bsum; } }
        }
        SCAN_STEPS(2)
        LDS_BARRIER();
        SCAN_STEPS(3)
        LDS_BARRIER();
        if (do_step) { const int tt = tid >> 3, seg = tid & 7, q = ci * 32 + tt, t = d ? T - 1 - q : q;
            u32x2 w2; w2.x = cvt_pk_bf16(o_s[tt * 32 + 4 * seg], o_s[tt * 32 + 4 * seg + 1]); w2.y = cvt_pk_bf16(o_s[tt * 32 + 4 * seg + 2], o_s[tt * 32 + 4 * seg + 3]);
            *(u32x2*)(Od + (size_t)(tok0 + t) * 512 + h * 64 + half * 32 + 4 * seg) = w2; }
#undef SCAN_STEPS
    }
    if (!producer && s < 16) { float* so = P.out + OUT_STATE + (size_t)d * 524288 + (size_t)(s * 8 + h) * 4096;
        *(f32x4*)(so + rA * 64 + 4 * c16) = SA; *(f32x4*)(so + rB * 64 + 4 * c16) = SB; }
    __syncthreads();
}
__device__ __forceinline__ void phase_scan(const Params& P, LAS unsigned char* lds) {
    for (int q = blockIdx.x; q < 768; q += gridDim.x) {
        int s, rem;
        if (q < 256) { s = 16 + (q >> 5); rem = q & 31; } else { const int p = q - 256; s = p >> 5; rem = p & 31; }
        scan_unit(P, (LAS float*)lds, s, rem >> 2, (rem >> 1) & 1, rem & 1);
    }
}

struct PostRaw { unsigned of, ob, v0, v1, v2, sg; float b0, b1; };
__device__ __forceinline__ void post_load(PostRaw& r, int m, int ch, int h, int lane, const u16* OF, const u16* OB, const u16* U, const float* BS, const u16* GT) {
    const int T = m < NPR ? 256 : 4096, t = m < NPR ? (m & 255) : ((m - NPR) & 4095);
    r.of = OF[(size_t)m * 512 + ch]; r.ob = OB[(size_t)m * 512 + ch];
    r.v1 = U[(size_t)m * 1792 + 1024 + ch];
    r.v0 = t > 0 ? U[(size_t)(m - 1) * 1792 + 1024 + ch] : 0u;
    r.v2 = t < T - 1 ? U[(size_t)(m + 1) * 1792 + 1024 + ch] : 0u;
    r.sg = *(const unsigned*)(GT + (size_t)m * GLD + 2048 + 2 * lane);
    r.b0 = BS[(size_t)m * 16 + h * 2]; r.b1 = BS[(size_t)m * 16 + h * 2 + 1];
}
__device__ __forceinline__ void phase_post(const Params& P, LAS unsigned char* lds) {
    const int lane = threadIdx.x & 63, h = threadIdx.x >> 6, ch = h * 64 + lane, G = gridDim.x;
    const u16* OF = (const u16*)(P.ws + WS_H); const u16* OB = OF + (size_t)MT * 512;
    const u16* U = (const u16*)(P.ws + WS_U16); const float* BS = (const float*)(P.ws + WS_BS);
    u16* OPRE = (u16*)(P.ws + WS_OPRE); const u16* GT = (const u16*)(P.ws + WS_R);
    LAS float* sgl = (LAS float*)lds + h * 128;
    float gu[128];
#pragma unroll
    for (int k = 0; k < 128; ++k) gu[k] = P.in[20][(size_t)k * 512 + ch];
    const float lw = P.in[24][ch], lb = P.in[25][ch];
    const float cv0 = P.in[15][0 * 1536 + 1024 + ch], cv1 = P.in[15][1 * 1536 + 1024 + ch], cv2 = P.in[15][2 * 1536 + 1024 + ch];
    PostRaw cur, nxt;
    int m = blockIdx.x;
    post_load(cur, m, ch, h, lane, OF, OB, U, BS, GT);
    for (; m < MT; m += G) {
        const int mn = m + G < MT ? m + G : m;
        post_load(nxt, mn, ch, h, lane, OF, OB, U, BS, GT);
        sgl[2 * lane] = h2f(cur.sg & 0xffffu); sgl[2 * lane + 1] = h2f(cur.sg >> 16);
        const float o = bf2f(cur.of) + bf2f(cur.ob);
        const float mean = sum64(o) * (1.0f / 64.0f), d = o - mean;
        const float rstd = rsqrtf(sum64(d * d) * (1.0f / 64.0f) + 64e-5f);
        const float v = h2f(cur.v0) * cv0 + h2f(cur.v1) * cv1 + h2f(cur.v2) * cv2;
        float g0 = 0.f, g1 = 0.f, g2 = 0.f, g3 = 0.f;
#pragma unroll
        for (int k = 0; k < 128; k += 4) { const f32x4 s4 = *(const LAS f32x4*)(sgl + k);
            g0 += s4[0] * gu[k]; g1 += s4[1] * gu[k + 1]; g2 += s4[2] * gu[k + 2]; g3 += s4[3] * gu[k + 3]; }
        const float y = (d * rstd * lw + lb + (cur.b0 + cur.b1) * v) * ((g0 + g1) + (g2 + g3));
        OPRE[(size_t)m * 512 + ch] = (u16)(cvt_pk_bf16(y, 0.f) & 0xffffu);
        cur = nxt;
    }
}


constexpr size_t WS_BAR = WS_END + 65536;
static_assert(WS_BAR + 4096 <= (size_t)536870912, "barrier words");
__device__ __forceinline__ void fast_grid_sync(unsigned char* ws, unsigned k) {
    asm volatile("s_waitcnt vmcnt(0) lgkmcnt(0)" ::: "memory");
    __builtin_amdgcn_s_barrier();
    if (threadIdx.x == 0) {
        unsigned* bar = (unsigned*)(ws + WS_BAR);
        const unsigned G = gridDim.x, g = blockIdx.x & 7u, gsz = (G - g + 7u) >> 3, ngrp = G < 8u ? G : 8u;
        __builtin_amdgcn_fence(__ATOMIC_RELEASE, "agent");
        asm volatile("s_waitcnt vmcnt(0)" ::: "memory");
        const unsigned old = __hip_atomic_fetch_add(bar + g * 32, 1u, __ATOMIC_RELAXED, __HIP_MEMORY_SCOPE_AGENT);
        if (old + 1u == k * gsz) __hip_atomic_fetch_add(bar + 8 * 32, 1u, __ATOMIC_RELAXED, __HIP_MEMORY_SCOPE_AGENT);
        unsigned spins = 0;
        while (__hip_atomic_load(bar + 8 * 32, __ATOMIC_RELAXED, __HIP_MEMORY_SCOPE_AGENT) < k * ngrp) { if (++spins > (1u << 24)) break; __builtin_amdgcn_s_sleep(1); }
        __builtin_amdgcn_fence(__ATOMIC_ACQUIRE, "agent");
        asm volatile("s_waitcnt vmcnt(0)" ::: "memory");
    }
    __builtin_amdgcn_s_barrier();
    asm volatile("" ::: "memory");
}

__global__ void __launch_bounds__(512, 2) fwd_mega(Params P) {
    extern __shared__ __attribute__((aligned(16))) unsigned char lds_raw[];
    LAS unsigned char* lds = (LAS unsigned char*)lds_raw;
    cg::grid_group grid = cg::this_grid();
    if (threadIdx.x < 32) { const int i = threadIdx.x; const unsigned long long v = i < 30 ? (unsigned long long)P.in[i] : (i == 30 ? (unsigned long long)P.out : (unsigned long long)P.ws);
        *(LAS unsigned long long*)(lds + PTAB_OFF + i * 8) = v; }
    __syncthreads();
unsigned bark_ = 0; unsigned char* P_ws_ = P.ws;
#define PH_BEGIN { const Params Q = get_params(lds); unsigned char* ws = Q.ws; (void)ws;
#define PH_END } asm volatile("s_waitcnt vmcnt(0)" ::: "memory");   grid.sync();
#define PH_ENDF } fast_grid_sync(P_ws_, ++bark_);
    if (blockIdx.x == 0 && threadIdx.x < 9) ((unsigned*)(P.ws + WS_BAR))[threadIdx.x * 32] = 0u;
    PH_BEGIN phase_prep(Q, lds); PH_END
    PH_BEGIN phase_norm(Q, nullptr, 0, 0, 1, (u16*)(ws + WS_H)); PH_ENDF
    PH_BEGIN run_gemm(lds, (const u16*)(ws + WS_H), (const u16*)(ws + WS_W13A), MT, 5632, 1024, EpiSwiglu{(u16*)(ws + WS_BIG)}); PH_ENDF
    PH_BEGIN run_gemm(lds, (const u16*)(ws + WS_BIG), (const u16*)(ws + WS_W2A), MT, 1024, 2816, EpiResid{Q.in[0], Q.in[1], Q.out, (const float*)(ws + WS_MOD), 2, 0.5f}); PH_ENDF
    PH_BEGIN phase_norm(Q, Q.out, 1, 3, 4, (u16*)(ws + WS_H)); PH_ENDF
    PH_BEGIN run_gemm(lds, (const u16*)(ws + WS_WZ), (const u16*)(ws + WS_H), 1024, MT, 1024, EpiZT{(u16*)(ws + WS_ZL)}); PH_ENDF
    PH_BEGIN run_gemm(lds, (const u16*)(ws + WS_T), (const u16*)(ws + WS_ZL), 4096, 4096, 8192, EpiFour{(u16*)(ws + WS_FOUR), 1});
             run_gemm(lds, (const u16*)(ws + WS_T256), (const u16*)(ws + WS_ZP), 256, 8192, 512, EpiFour{(u16*)(ws + WS_FOUR), 0}); PH_ENDF
    PH_BEGIN run_gemm(lds, (const u16*)(ws + WS_H), (const u16*)(ws + WS_WIN), MT, 4096, 1024, EpiU{(u16*)(ws + WS_U16), (u16*)(ws + WS_SG), (u16*)(ws + WS_R), Q.in[14]}); PH_ENDF
    PH_BEGIN phase_scan(Q, lds); PH_ENDF
    PH_BEGIN phase_post(Q, lds); PH_ENDF
    PH_BEGIN run_gemm(lds, (const u16*)(ws + WS_OPRE), (const u16*)(ws + WS_WO), MT, 1024, 512, EpiMul{(u16*)(ws + WS_H), (const u16*)(ws + WS_R), 1}); PH_ENDF
    PH_BEGIN run_gemm(lds, (const u16*)(ws + WS_FOUR), (const u16*)(ws + WS_WF), MT, 1024, 512, EpiMul{(u16*)(ws + WS_H), (const u16*)(ws + WS_R), 2}); PH_ENDF
    PH_BEGIN run_gemm(lds, (const u16*)(ws + WS_H), (const u16*)(ws + WS_WOUT), MT, 1024, 1024, EpiResid{nullptr, nullptr, Q.out, (const float*)(ws + WS_MOD), 5, 1.0f}); PH_ENDF
    PH_BEGIN phase_norm(Q, Q.out, 2, 6, 7, (u16*)(ws + WS_H)); PH_ENDF
    PH_BEGIN run_gemm(lds, (const u16*)(ws + WS_H), (const u16*)(ws + WS_W13B), MT, 5632, 1024, EpiSwiglu{(u16*)(ws + WS_BIG)}); PH_ENDF
    PH_BEGIN run_gemm(lds, (const u16*)(ws + WS_BIG), (const u16*)(ws + WS_W2B), MT, 1024, 2816, EpiResid{nullptr, nullptr, Q.out, (const float*)(ws + WS_MOD), 8, 0.5f}); PH_ENDF
    { const Params Q = get_params(lds); phase_final_norm(Q); }
#undef PH_BEGIN
#undef PH_END
#undef PH_ENDF
}

extern "C" void kernel_launch(void* const* d_in, const int* in_sizes, int n_in, void* d_out, int out_size, void* d_ws, size_t ws_size, hipStream_t stream) {
    static int grid_blocks = 0;
    if (grid_blocks == 0) {
        if (n_in != 30 || ws_size < WS_END) { fprintf(stderr, "kernel_launch: unexpected n_in %d / ws_size %zu (need %zu)\n", n_in, ws_size, (size_t)WS_END); grid_blocks = -1; return; }
        int dev = 0, cus = 0, per_cu = 0;
        (void)hipGetDevice(&dev);
        (void)hipDeviceGetAttribute(&cus, hipDeviceAttributeMultiprocessorCount, dev);
        (void)hipFuncSetAttribute((const void*)fwd_mega, hipFuncAttributeMaxDynamicSharedMemorySize, LDS_BYTES);
        (void)hipOccupancyMaxActiveBlocksPerMultiprocessor(&per_cu, (const void*)fwd_mega, 512, LDS_BYTES);
        if (per_cu < 1) { fprintf(stderr, "kernel_launch: occupancy query reports %d blocks per CU\n", per_cu); per_cu = 1; }
        if (per_cu > 1) per_cu = 1;
        grid_blocks = cus * per_cu;
        (void)hipGetLastError();
    }
    if (grid_blocks < 0) return;
    Params p{};
    for (int i = 0; i < 30; ++i) p.in[i] = (const float*)d_in[i];
    p.out = (float*)d_out; p.ws = (unsigned char*)d_ws;
    void* args[] = {&p};
    hipError_t e = hipLaunchCooperativeKernel((const void*)fwd_mega, dim3(grid_blocks), dim3(512), args, LDS_BYTES, stream);
    if (e != hipSuccess) fprintf(stderr, "cooperative launch failed: %s (grid %d)\n", hipGetErrorString(e), grid_blocks);
}
```

```cpp
#include <hip/hip_runtime.h>
#include <hip/hip_cooperative_groups.h>
#include <cstdio>
namespace cg = cooperative_groups;
namespace pg8 {
#define PG8_LAS __attribute__((address_space(3)))
typedef unsigned short bf16_t;
typedef short bf16x8 __attribute__((ext_vector_type(8)));
typedef float f32x4 __attribute__((ext_vector_type(4)));
typedef unsigned u32x4 __attribute__((ext_vector_type(4)));
constexpr int BM = 256, BK = 64, HALF = 128, HTB = HALF * BK * 2  , STAGE_BYTES = 8 * HTB, NXCD = 8, WGM = 8;

__host__ __device__ __forceinline__ int lds_byte(int r, int c) { const int st = (r >> 4) * 2 + (c >> 5), rr = r & 15, cc = c & 31, ob = rr * 64 + cc * 2; return st * 1024 + (ob ^ (((ob >> 9) & 1) << 5)); }
__host__ __device__ __forceinline__ void stage_rc(int b, int& R, int& C) { const int st = b / 1024, sb = b % 1024, swz = sb ^ (((sb >> 9) & 1) << 5); R = (st >> 1) * 16 + swz / 64; C = (st & 1) * 32 + (swz % 64) / 2; }
__host__ __device__ __forceinline__ int perm32(int rho) { const int n = rho >> 4, i = rho & 15; return 8 * (i >> 2) + 4 * n + (i & 3); }

struct Unit { int pm, pn; };
struct Gemm { const bf16_t* A; const bf16_t* Bt; int M, N, K; };

struct StaticOrder {
    int nM, nN, nwg, G, c;
    __host__ __device__ __forceinline__ void init(int M, int N, int G_, int c_) { nM = M / BM; nN = N / BM; nwg = nM * nN; G = G_; c = c_; }
    __host__ __device__ __forceinline__ bool next(int i, Unit& u) const {
        const long L = (long)i * G + c; if (L >= nwg) return false;
        int wgid = (int)L; { const int q = nwg / NXCD, r = nwg % NXCD, xcd = wgid % NXCD, off = wgid / NXCD; wgid = (xcd < r ? xcd * (q + 1) : r * (q + 1) + (xcd - r) * q) + off; }
        const int nig = WGM * nN, gid = wgid / nig, fm = gid * WGM, gsz = (nM - fm) < WGM ? (nM - fm) : WGM;
        u.pm = fm + ((wgid % nig) % gsz); u.pn = (wgid % nig) / gsz; return true;
    }
    __device__ __forceinline__ void a_ready(const Unit&) const {}
    __device__ __forceinline__ void done(const Unit&) const {}
};
__device__ __forceinline__ unsigned cvt_pk_bf16(float lo, float hi) { unsigned r; asm volatile("v_cvt_pk_bf16_f32 %0, %1, %2" : "=v"(r) : "v"(lo), "v"(hi)); return r; }
template <class Epi, class Sched, bool STAMP = false>
__device__ __forceinline__ void gemm_phase(PG8_LAS unsigned char* lds, const Gemm g, const Sched& S, const Epi& E, unsigned long long* stamps) {
    int tid_ = threadIdx.x; asm volatile("" : "+v"(tid_));
    const int tid = tid_, wid = __builtin_amdgcn_readfirstlane(tid >> 6), lane = tid & 63, wr = wid >> 2, wc = wid & 3, fr = lane & 15, fq = lane >> 4;
    const int K = g.K, nt = K / BK;
    int ts_lo = 0, ts_hi = 0, nts = 0; const unsigned long long rt_entry = STAMP ? (unsigned long long)wall_clock64() : 0ull;
#define PG8_STAMP() do { if (STAMP && wid == 0 && nts < 64) { const unsigned long long _c = (unsigned long long)clock64(); \
        ts_lo = (lane == nts) ? (int)(unsigned)_c : ts_lo; ts_hi = (lane == nts) ? (int)(unsigned)(_c >> 32) : ts_hi; ++nts; } } while (0)
    PG8_STAMP();
    unsigned voffA[2], voffB[2];
#pragma unroll
    for (int i = 0; i < 2; ++i) { int R, C; stage_rc(tid * 16 + i * 8192, R, C); const int Rb = Epi::PERM ? ((R & ~31) + perm32(R & 31)) : R;
        voffA[i] = (unsigned)(R * K + C) * 2u; voffB[i] = (unsigned)(Rb * K + C) * 2u; }
    const size_t kstep = (size_t)(BK * 2);
    const size_t hstep = (size_t)HALF * K * 2;
    const size_t tstep = 2 * hstep;
    const unsigned ldsw = (unsigned)wid * 1024u;
    const int aoff = lds_byte(wr * 64 + fr, fq * 8), boff = lds_byte(wc * 32 + fr, fq * 8);
#define PG8_SA(b, h) (((b) * 2 + (h)) * HTB)
#define PG8_SB(b, h) ((4 + (b) * 2 + (h)) * HTB)
#define PG8_STAGE(bufoff, gbase, voff) do { _Pragma("unroll") for (int _i = 0; _i < 2; ++_i) \
        __builtin_amdgcn_global_load_lds((const unsigned*)((const char*)(gbase) + (voff)[_i]), (PG8_LAS unsigned*)(lds + (bufoff) + ldsw + _i * 8192), 16, 0, 0); } while (0)
#define PG8_LDA(dst, b, h) do { _Pragma("unroll") for (int m = 0; m < 4; ++m) _Pragma("unroll") for (int k = 0; k < 2; ++k) dst[m][k] = *(const PG8_LAS bf16x8*)(lds + PG8_SA(b, h) + aoff + m * 2048 + k * 1024); } while (0)
#define PG8_LDB(dst, b, h) do { _Pragma("unroll") for (int n = 0; n < 2; ++n) _Pragma("unroll") for (int k = 0; k < 2; ++k) dst[n][k] = *(const PG8_LAS bf16x8*)(lds + PG8_SB(b, h) + boff + n * 2048 + k * 1024); } while (0)
#define PG8_MMA(ai, bj, At, Bt) do { __builtin_amdgcn_s_setprio(1); _Pragma("unroll") for (int m = 0; m < 4; ++m) _Pragma("unroll") for (int n = 0; n < 2; ++n) _Pragma("unroll") for (int k = 0; k < 2; ++k) \
        acc[ai][bj][m][n] = __builtin_amdgcn_mfma_f32_16x16x32_bf16(Bt[n][k], At[m][k], acc[ai][bj][m][n], 0, 0, 0); __builtin_amdgcn_s_setprio(0); } while (0)
#define PG8_WAIT_V(n) asm volatile("s_waitcnt vmcnt(" #n ")" ::: "memory")
#define PG8_WAIT_L(n) asm volatile("s_waitcnt lgkmcnt(" #n ")" ::: "memory")
#define PG8_BAR __builtin_amdgcn_s_barrier()
#define PG8_SCHED __builtin_amdgcn_sched_barrier(0)
    Unit cur, nxt; int ui = 0;
    if (!S.next(0, cur)) return;
    f32x4 acc[2][2][4][2];
#pragma unroll
    for (int a = 0; a < 2; ++a)
#pragma unroll
        for (int b = 0; b < 2; ++b)
#pragma unroll
            for (int m = 0; m < 4; ++m)
#pragma unroll
                for (int n = 0; n < 2; ++n) acc[a][b][m][n] = (f32x4){0.f, 0.f, 0.f, 0.f};
    bf16x8 At[4][2], B0[2][2], B1[2][2];
    const char* cA = (const char*)g.A + (size_t)cur.pm * tstep; const char* cB = (const char*)g.Bt + (size_t)cur.pn * tstep;
    S.a_ready(cur);
    PG8_STAGE(PG8_SB(0, 0), cB, voffB); PG8_STAGE(PG8_SA(0, 0), cA, voffA); PG8_STAGE(PG8_SB(0, 1), cB + hstep, voffB); PG8_STAGE(PG8_SA(0, 1), cA + hstep, voffA);
    if (wr == 1) PG8_BAR;
    PG8_WAIT_V(4); PG8_BAR;
    PG8_STAGE(PG8_SB(1, 0), cB + kstep, voffB); PG8_STAGE(PG8_SA(1, 0), cA + kstep, voffA); PG8_STAGE(PG8_SB(1, 1), cB + hstep + kstep, voffB);
    PG8_WAIT_V(6); PG8_BAR;
    PG8_STAMP();
    for (;;) {
        const bool has_next = S.next(ui + 1, nxt);
        const char* nA = has_next ? (const char*)g.A + (size_t)nxt.pm * tstep : cA; const char* nB = has_next ? (const char*)g.Bt + (size_t)nxt.pn * tstep : cB;
        for (int t = 0; t < nt; t += 2) {
            const bool last = (t == nt - 2);
            const char* a1 = cA + (size_t)(t + 1) * kstep;
            const char* a2 = last ? nA : cA + (size_t)(t + 2) * kstep; const char* b2 = last ? nB : cB + (size_t)(t + 2) * kstep;
            const char* a3 = a2 + kstep; const char* b3 = b2 + kstep;
            if (last && has_next) S.a_ready(nxt);
            PG8_LDB(B0, 0, 0); PG8_SCHED; PG8_LDA(At, 0, 0); PG8_STAGE(PG8_SA(1, 1), a1 + hstep, voffA);
            PG8_WAIT_L(8); PG8_BAR; PG8_WAIT_L(0); PG8_MMA(0, 0, At, B0); PG8_BAR; PG8_SCHED;
            PG8_LDB(B1, 0, 1); PG8_STAGE(PG8_SB(0, 0), b2, voffB);
            PG8_BAR; PG8_WAIT_L(0); PG8_MMA(0, 1, At, B1); PG8_BAR;
            PG8_LDA(At, 0, 1); PG8_STAGE(PG8_SA(0, 0), a2, voffA);
            PG8_BAR; PG8_WAIT_L(0); PG8_MMA(1, 0, At, B0); PG8_BAR; PG8_SCHED;
            PG8_STAGE(PG8_SB(0, 1), b2 + hstep, voffB);
            PG8_WAIT_V(6); PG8_BAR; PG8_MMA(1, 1, At, B1); PG8_BAR;
            PG8_LDB(B0, 1, 0); PG8_SCHED; PG8_LDA(At, 1, 0); PG8_STAGE(PG8_SA(0, 1), a2 + hstep, voffA);
            PG8_WAIT_L(8); PG8_BAR; PG8_WAIT_L(0); PG8_MMA(0, 0, At, B0); PG8_BAR; PG8_SCHED;
            PG8_LDB(B1, 1, 1); PG8_STAGE(PG8_SB(1, 0), b3, voffB);
            PG8_BAR; PG8_WAIT_L(0); PG8_MMA(0, 1, At, B1); PG8_BAR;
            PG8_LDA(At, 1, 1); PG8_STAGE(PG8_SA(1, 0), a3, voffA);
            PG8_BAR; PG8_WAIT_L(0); PG8_MMA(1, 0, At, B0); PG8_BAR; PG8_SCHED;
            PG8_STAGE(PG8_SB(1, 1), b3 + hstep, voffB);
            PG8_WAIT_V(6); PG8_BAR; PG8_MMA(1, 1, At, B1); PG8_BAR;
        }
        PG8_STAMP();
        if constexpr (!Epi::AFTER_DRAIN) { E(acc, cur, wr, wc, fr, fq); S.done(cur); }
        PG8_STAMP();
        if (!has_next) break;
#pragma unroll
        for (int a = 0; a < 2; ++a)
#pragma unroll
            for (int b = 0; b < 2; ++b)
#pragma unroll
                for (int m = 0; m < 4; ++m)
#pragma unroll
                    for (int n = 0; n < 2; ++n) acc[a][b][m][n] = (f32x4){0.f, 0.f, 0.f, 0.f};
        cur = nxt; cA = nA; cB = nB; ++ui;
    }
    PG8_WAIT_V(0);
    if (wr == 0) PG8_BAR;
    PG8_BAR;
    if constexpr (Epi::AFTER_DRAIN) { E.fused(acc, cur, wr, wc, fr, fq, lds, wid, lane); S.done(cur); }
    PG8_STAMP();
    if (STAMP && wid == 0) { stamps[lane] = lane < nts ? (((unsigned long long)(unsigned)ts_hi << 32) | (unsigned)ts_lo) : 0ull;
        if (lane == 62) stamps[62] = rt_entry; if (lane == 63) stamps[63] = (unsigned long long)wall_clock64(); }
#undef PG8_STAMP
#undef PG8_SA
#undef PG8_SB
#undef PG8_STAGE
#undef PG8_LDA
#undef PG8_LDB
#undef PG8_MMA
#undef PG8_WAIT_V
#undef PG8_WAIT_L
#undef PG8_BAR
#undef PG8_SCHED
}
}

#define LAS __attribute__((address_space(3)))
typedef unsigned short u16;
typedef float f32x4 __attribute__((ext_vector_type(4)));
typedef unsigned u32x4 __attribute__((ext_vector_type(4)));
typedef unsigned u32x2 __attribute__((ext_vector_type(2)));
using pg8::cvt_pk_bf16;

constexpr int MT = 36864, NPR = 4096, DM = 1024, DFF = 2816;
constexpr int OUT_STATE = MT * DM;
constexpr int LDS_BYTES = 163840, PTAB_OFF = 163840 - 256;

constexpr size_t SZ_W13 = (size_t)5632 * 1024 * 2, SZ_W2 = (size_t)1024 * 2816 * 2;
constexpr size_t WS_W13A = 0, WS_W2A = WS_W13A + SZ_W13, WS_W13B = WS_W2A + SZ_W2, WS_W2B = WS_W13B + SZ_W13;
constexpr size_t WS_WIN = WS_W2B + SZ_W2;
constexpr size_t WS_WZ = WS_WIN + (size_t)4096 * 1024 * 2;
constexpr size_t WS_WO = WS_WZ + (size_t)1024 * 1024 * 2;
constexpr size_t WS_WF = WS_WO + (size_t)1024 * 512 * 2;
constexpr size_t WS_WOUT = WS_WF + (size_t)1024 * 512 * 2;
constexpr size_t WS_GUP = WS_WOUT + (size_t)1024 * 1024 * 2;
constexpr size_t WS_MOD = WS_GUP + (size_t)512 * 256 * 2;
constexpr size_t WS_BS = WS_MOD + (size_t)9 * 9216 * 4;
constexpr size_t WS_SG = WS_BS + (size_t)MT * 16 * 4;
constexpr size_t WS_H = WS_SG + (size_t)MT * 256 * 2;
constexpr size_t WS_BIG = WS_H + (size_t)MT * 1024 * 2;
constexpr size_t WS_U16 = WS_BIG;
constexpr size_t WS_FOUR = WS_U16 + (size_t)MT * 1792 * 2;
constexpr size_t WS_OPRE = WS_FOUR + (size_t)MT * 512 * 2;
constexpr size_t WS_R = WS_BIG + (size_t)MT * 2816 * 2;
constexpr size_t WS_T = WS_R;
constexpr size_t WS_T256 = WS_T + (size_t)4096 * 8192 * 2;
constexpr size_t WS_ZL = WS_T256 + (size_t)256 * 512 * 2;
constexpr size_t WS_ZP = WS_ZL + (size_t)4096 * 8192 * 2;
constexpr int GLD = 2304;
constexpr size_t WS_END = WS_R + (size_t)MT * GLD * 2;
static_assert(WS_ZP + (size_t)8192 * 512 * 2 <= WS_END, "R region");
static_assert(WS_OPRE + (size_t)MT * 512 * 2 <= WS_R, "BIG region");
static_assert(WS_END <= (size_t)536870912, "workspace");
static_assert(WS_ZP == WS_ZL + (size_t)4096 * 8192 * 2, "ZP behind ZL");

struct Params { const float* in[30]; float* out; unsigned char* ws; };
__device__ __forceinline__ unsigned long long ld_ptr(LAS unsigned char* lds, int i) {
    const u32x2 v = *(const LAS u32x2*)(lds + PTAB_OFF + i * 8);
    const unsigned lo = __builtin_amdgcn_readfirstlane(v.x), hi = __builtin_amdgcn_readfirstlane(v.y);
    return ((unsigned long long)hi << 32) | lo;
}
template <class T> __device__ __forceinline__ T* as_global(unsigned long long v) {
    return (T*)(__attribute__((address_space(1))) T*)v;
}
__device__ __forceinline__ Params get_params(LAS unsigned char* lds) {
    Params Q;
#pragma unroll
    for (int i = 0; i < 30; ++i) Q.in[i] = as_global<const float>(ld_ptr(lds, i));
    Q.out = as_global<float>(ld_ptr(lds, 30)); Q.ws = as_global<unsigned char>(ld_ptr(lds, 31));
    return Q;
}
__device__ __forceinline__ float bf2f(unsigned v16) { return __uint_as_float(v16 << 16); }
__device__ __forceinline__ float h2f(unsigned v16) { return (float)__builtin_bit_cast(_Float16, (unsigned short)v16); }
__device__ __forceinline__ unsigned pk_h(float a, float b) {
    const unsigned short ua = __builtin_bit_cast(unsigned short, (_Float16)a), ub = __builtin_bit_cast(unsigned short, (_Float16)b);
    return (unsigned)ua | ((unsigned)ub << 16);
}
__device__ __forceinline__ float sigmoidf_(float x) { return __builtin_amdgcn_rcpf(1.0f + __expf(-x)); }
__device__ __forceinline__ int modidx_pm(int pm) { return pm < 16 ? 8 : ((pm - 16) >> 4); }
__device__ __forceinline__ int modidx_m(int m) { return m < NPR ? 8 : ((m - NPR) >> 12); }

struct EpiSwiglu {
    static constexpr bool PERM = true, AFTER_DRAIN = false;
    u16* G;
    __device__ __forceinline__ void operator()(const f32x4 (&acc)[2][2][4][2], const pg8::Unit& u, int wr, int wc, int fr, int fq) const {
        const int row0 = u.pm * 256 + wr * 64 + fr, col0 = u.pn * 128 + wc * 32 + 8 * fq;
#pragma unroll
        for (int ai = 0; ai < 2; ++ai)
#pragma unroll
            for (int m = 0; m < 4; ++m) {
                float g[8];
#pragma unroll
                for (int n = 0; n < 2; ++n)
#pragma unroll
                    for (int j = 0; j < 4; ++j) { const float a = acc[ai][0][m][n][j], b = acc[ai][1][m][n][j]; g[n * 4 + j] = a * sigmoidf_(a) * b; }
                u32x4 w; w.x = cvt_pk_bf16(g[0], g[1]); w.y = cvt_pk_bf16(g[2], g[3]); w.z = cvt_pk_bf16(g[4], g[5]); w.w = cvt_pk_bf16(g[6], g[7]);
                *(u32x4*)(G + (size_t)(row0 + ai * 128 + m * 16) * DFF + col0) = w;
            }
    }
};
struct EpiResid {
    static constexpr bool PERM = false, AFTER_DRAIN = false;
    const float* xp; const float* xs; float* X; const float* MOD; int slot; float coef;
    __device__ __forceinline__ void operator()(const f32x4 (&acc)[2][2][4][2], const pg8::Unit& u, int wr, int wc, int fr, int fq) const {
        const int row0 = u.pm * 256 + wr * 64 + fr, col0 = u.pn * 256 + wc * 32 + 4 * fq;
        const float* g = MOD + (size_t)modidx_pm(u.pm) * 9216 + slot * 1024 + col0;
        f32x4 gv[2][2];
#pragma unroll
        for (int bj = 0; bj < 2; ++bj)
#pragma unroll
            for (int n = 0; n < 2; ++n) gv[bj][n] = *(const f32x4*)(g + bj * 128 + n * 16) * coef;
#pragma unroll
        for (int ai = 0; ai < 2; ++ai)
#pragma unroll
            for (int m = 0; m < 4; ++m) {
                const int row = row0 + ai * 128 + m * 16;
                const float* src = (xp ? (row < NPR ? xp + (size_t)row * DM : xs + (size_t)(row - NPR) * DM) : X + (size_t)row * DM) + col0;
                float* dst = X + (size_t)row * DM + col0;
#pragma unroll
                for (int bj = 0; bj < 2; ++bj)
#pragma unroll
                    for (int n = 0; n < 2; ++n) *(f32x4*)(dst + bj * 128 + n * 16) = *(const f32x4*)(src + bj * 128 + n * 16) + gv[bj][n] * acc[ai][bj][m][n];
            }
    }
};
struct EpiU {
    static constexpr bool PERM = true, AFTER_DRAIN = false;
    u16* U; u16* SG; u16* GATES; const float* gate_b;
    __device__ __forceinline__ void operator()(const f32x4 (&acc)[2][2][4][2], const pg8::Unit& u, int wr, int wc, int fr, int fq) const {
        const int row0 = u.pm * 256 + wr * 64 + fr, ct = wc * 32 + 8 * fq;
        if (u.pn < 7) {
#pragma unroll
            for (int ai = 0; ai < 2; ++ai)
#pragma unroll
                for (int m = 0; m < 4; ++m)
#pragma unroll
                    for (int bj = 0; bj < 2; ++bj) { const f32x4 v0 = acc[ai][bj][m][0], v1 = acc[ai][bj][m][1];
                        u32x4 w; w.x = pk_h(v0[0], v0[1]); w.y = pk_h(v0[2], v0[3]); w.z = pk_h(v1[0], v1[1]); w.w = pk_h(v1[2], v1[3]);
                        *(u32x4*)(U + (size_t)(row0 + ai * 128 + m * 16) * 1792 + u.pn * 256 + bj * 128 + ct) = w; }
        } else {
            const int gc0 = (u.pn == 7 ? 2048 : (u.pn - 8) * 256) + ct;
#pragma unroll
            for (int bj = 0; bj < 2; ++bj) {
                const int gbi = (u.pn == 7 ? 0 : (u.pn - 8) * 256) + ct; const float bsc = u.pn == 7 ? 0.f : 1.f;
                const f32x4 b0 = *(const f32x4*)(gate_b + gbi + bj * 128) * bsc, b1 = *(const f32x4*)(gate_b + gbi + bj * 128 + 4) * bsc;
#pragma unroll
                for (int ai = 0; ai < 2; ++ai)
#pragma unroll
                    for (int m = 0; m < 4; ++m) { const f32x4 v0 = acc[ai][bj][m][0] + b0, v1 = acc[ai][bj][m][1] + b1;
                        u32x4 w; w.x = pk_h(sigmoidf_(v0[0]), sigmoidf_(v0[1])); w.y = pk_h(sigmoidf_(v0[2]), sigmoidf_(v0[3]));
                        w.z = pk_h(sigmoidf_(v1[0]), sigmoidf_(v1[1])); w.w = pk_h(sigmoidf_(v1[2]), sigmoidf_(v1[3]));
                        *(u32x4*)(GATES + (size_t)(row0 + ai * 128 + m * 16) * GLD + gc0 + bj * 128) = w; }
            }
        }
    }
};
struct EpiZT {
    static constexpr bool PERM = true, AFTER_DRAIN = false;
    u16* ZL;
    __device__ __forceinline__ void operator()(const f32x4 (&acc)[2][2][4][2], const pg8::Unit& u, int wr, int wc, int fr, int fq) const {
#pragma unroll
        for (int bj = 0; bj < 2; ++bj) {
            const int c0 = u.pn * 256 + bj * 128 + wc * 32 + 8 * fq;
#pragma unroll
            for (int ai = 0; ai < 2; ++ai)
#pragma unroll
                for (int m = 0; m < 4; ++m) {
                    const int zr = u.pm * 256 + ai * 128 + wr * 64 + m * 16 + fr, g = zr >> 8, part = (zr >> 7) & 1, kn = zr & 127;
                    size_t off;
                    if (u.pn < 16) off = (size_t)4096 * 8192 + ((size_t)(u.pn * 512 + g * 128 + kn) * 512 + part * 256 + (c0 - u.pn * 256));
                    else { const int tok = c0 - NPR, b = tok >> 12, rc = tok & 4095; off = (size_t)(b * 512 + g * 128 + kn) * 8192 + part * 4096 + rc; }
                    u16* dst = ZL + off;
                    const f32x4 v0 = acc[ai][bj][m][0], v1 = acc[ai][bj][m][1];
                    u32x4 w; w.x = cvt_pk_bf16(v0[0], v0[1]); w.y = cvt_pk_bf16(v0[2], v0[3]); w.z = cvt_pk_bf16(v1[0], v1[1]); w.w = cvt_pk_bf16(v1[2], v1[3]);
                    *(u32x4*)dst = w;
                }
        }
    }
};
struct EpiFour {
    static constexpr bool PERM = true, AFTER_DRAIN = false;
    u16* FOUR; int latent;
    __device__ __forceinline__ void operator()(const f32x4 (&acc)[2][2][4][2], const pg8::Unit& u, int wr, int wc, int fr, int fq) const {
        const int b = u.pn >> 1, ch0 = (u.pn & 1) * 256 + wc * 32 + 8 * fq;
        const int tok0 = (latent ? NPR + b * 4096 : b * 256) + u.pm * 256 + wr * 64 + fr;
#pragma unroll
        for (int ai = 0; ai < 2; ++ai)
#pragma unroll
            for (int m = 0; m < 4; ++m)
#pragma unroll
                for (int bj = 0; bj < 2; ++bj) { const f32x4 v0 = acc[ai][bj][m][0], v1 = acc[ai][bj][m][1];
                    u32x4 w; w.x = cvt_pk_bf16(v0[0], v0[1]); w.y = cvt_pk_bf16(v0[2], v0[3]); w.z = cvt_pk_bf16(v1[0], v1[1]); w.w = cvt_pk_bf16(v1[2], v1[3]);
                    *(u32x4*)(FOUR + (size_t)(tok0 + ai * 128 + m * 16) * 512 + ch0 + bj * 128) = w; }
    }
};
struct EpiMul {
    static constexpr bool PERM = true, AFTER_DRAIN = false;
    u16* O; const u16* GATES; int mode;
    __device__ __forceinline__ void operator()(const f32x4 (&acc)[2][2][4][2], const pg8::Unit& u, int wr, int wc, int fr, int fq) const {
        const int row0 = u.pm * 256 + wr * 64 + fr, col0 = u.pn * 256 + wc * 32 + 8 * fq;
        const int ld = mode == 0 ? 512 : 1024;
#pragma unroll
        for (int ai = 0; ai < 2; ++ai)
#pragma unroll
            for (int m = 0; m < 4; ++m)
#pragma unroll
                for (int bj = 0; bj < 2; ++bj) {
                    const int row = row0 + ai * 128 + m * 16, col = col0 + bj * 128;
                    u16* p = O + (size_t)row * ld + col;
                    float v[8];
#pragma unroll
                    for (int j = 0; j < 4; ++j) { v[j] = acc[ai][bj][m][0][j]; v[4 + j] = acc[ai][bj][m][1][j]; }
                    if (mode == 0) {
                        const u32x4 q = *(const u32x4*)p;
#pragma unroll
                        for (int j = 0; j < 4; ++j) { v[2 * j] *= bf2f(q[j] & 0xffffu); v[2 * j + 1] *= bf2f(q[j] >> 16); }
                    } else {
                        const u32x4 gq = *(const u32x4*)(GATES + (size_t)row * GLD + (mode == 2 ? 1024 : 0) + col);
#pragma unroll
                        for (int j = 0; j < 4; ++j) { v[2 * j] *= h2f(gq[j] & 0xffffu); v[2 * j + 1] *= h2f(gq[j] >> 16); }
                        if (mode == 2) { const u32x4 q = *(const u32x4*)p;
#pragma unroll
                            for (int j = 0; j < 4; ++j) { v[2 * j] += bf2f(q[j] & 0xffffu); v[2 * j + 1] += bf2f(q[j] >> 16); } }
                    }
                    u32x4 w; w.x = cvt_pk_bf16(v[0], v[1]); w.y = cvt_pk_bf16(v[2], v[3]); w.z = cvt_pk_bf16(v[4], v[5]); w.w = cvt_pk_bf16(v[6], v[7]);
                    *(u32x4*)p = w;
                }
    }
};

template <class Epi>
__device__ __forceinline__ void run_gemm(LAS unsigned char* lds, const u16* A, const u16* Bt, int M, int N, int K, const Epi& E) {
    pg8::Gemm g{A, Bt, M, N, K}; pg8::StaticOrder S; S.init(M, N, (int)gridDim.x, (int)blockIdx.x);
    pg8::gemm_phase<Epi, pg8::StaticOrder, false>(lds, g, S, E, nullptr);
}

__device__ __forceinline__ void transpose_tile(const float* src, int ld_src, int col0, int k0, int krows, u16* dst, int n0, int K, LAS float* tile) {
    const int t = threadIdx.x;
#pragma unroll
    for (int i = 0; i < 8; ++i) { const int kk = (t >> 6) + 8 * i, nn = t & 63;
        float v = 0.f; if (col0 >= 0 && k0 + kk < krows) v = src[(size_t)(k0 + kk) * ld_src + col0 + nn];
        tile[kk * 65 + nn] = v; }
    __syncthreads();
    const int nn = t >> 3, ks = (t & 7) * 8;
    float v[8];
#pragma unroll
    for (int j = 0; j < 8; ++j) v[j] = tile[(ks + j) * 65 + nn];
    u32x4 w; w.x = cvt_pk_bf16(v[0], v[1]); w.y = cvt_pk_bf16(v[2], v[3]); w.z = cvt_pk_bf16(v[4], v[5]); w.w = cvt_pk_bf16(v[6], v[7]);
    *(u32x4*)(dst + (size_t)(n0 + nn) * K + k0 + ks) = w;
    __syncthreads();
}

__device__ __forceinline__ void phase_prep(const Params& P, LAS unsigned char* lds) {
    LAS float* L = (LAS float*)lds;
    LAS float* tile = L;
    LAS float* cs128 = L + 4160; LAS float* sn128 = cs128 + 128;
    LAS float* cs64 = sn128 + 128;  LAS float* sn64 = cs64 + 64;
    LAS float* cs256 = sn64 + 64;   LAS float* sn256 = cs256 + 256;
    LAS float* frow = sn256 + 256;
    LAS float* sc = frow + 512;
    LAS float* red = sc + 9216;
    const int tid = threadIdx.x, G = gridDim.x, bid = blockIdx.x;
    unsigned char* ws = P.ws;
    if (tid < 256) { float s, c; sincospif(2.0f * (float)tid / 256.0f, &s, &c); cs256[tid] = c; sn256[tid] = s; }
    if (tid < 128) { float s, c; sincospif(2.0f * (float)tid / 128.0f, &s, &c); cs128[tid] = c; sn128[tid] = s; }
    if (tid < 64)  { float s, c; sincospif(2.0f * (float)tid / 64.0f, &s, &c); cs64[tid] = c; sn64[tid] = s; }
    __syncthreads();

    if (bid < 144) {
        for (int i = tid; i < 9216; i += 512) { const int v = i >> 10, k = i & 1023; const float x = v < 8 ? P.in[4][v * 1024 + k] : P.in[5][k]; sc[i] = x / (1.0f + expf(-x)); }
        __syncthreads();
        const int c = tid & 63, kg = tid >> 6; const float* aw = P.in[6] + bid * 64 + c;
        float a[9];
#pragma unroll
        for (int v = 0; v < 9; ++v) a[v] = 0.f;
        for (int k0 = kg; k0 < 1024; k0 += 64) {
            float w8[8];
#pragma unroll
            for (int u = 0; u < 8; ++u) w8[u] = aw[(size_t)(k0 + 8 * u) * 9216];
#pragma unroll
            for (int u = 0; u < 8; ++u)
#pragma unroll
                for (int v = 0; v < 9; ++v) a[v] += sc[v * 1024 + k0 + 8 * u] * w8[u]; }
#pragma unroll
        for (int v = 0; v < 9; ++v) red[(kg * 9 + v) * 64 + c] = a[v];
        __syncthreads();
        float* MOD = (float*)(ws + WS_MOD);
        for (int i = tid; i < 576; i += 512) { const int v = i >> 6, cc = i & 63; float s = 0.f;
#pragma unroll
            for (int q = 0; q < 8; ++q) s += red[(q * 9 + v) * 64 + cc];
            MOD[v * 9216 + bid * 64 + cc] = s + P.in[7][bid * 64 + cc]; }
        __syncthreads();
    }

    {
        const int total = 5792;
#define PREP_DECODE(Q, SRC, LD, KROWS, KD, COL0, N0, K0, DST) { \
            int j = 0, r = (Q), nk = 16; \
            PREP_STEP(0, 88 * 16, 44) PREP_STEP(1, 16 * 44, 16) PREP_STEP(2, 88 * 16, 44) PREP_STEP(3, 16 * 44, 16) \
            PREP_STEP(4, 64 * 16, 8) PREP_STEP(5, 16 * 8, 8) PREP_STEP(6, 16 * 8, 16) PREP_STEP(7, 16 * 16, 4) \
            const int tn = r / nk, tk = r % nk; N0 = tn * 64; K0 = tk * 64; COL0 = N0; \
            if (j == 0 || j == 2) { SRC = j == 0 ? P.in[9] : P.in[11]; LD = 5632; KROWS = 1024; KD = 1024; DST = (u16*)(ws + (j == 0 ? WS_W13A : WS_W13B)); \
                const int pn = N0 >> 8, rr = N0 & 255; COL0 = rr < 128 ? 128 * pn + rr : 2816 + 128 * pn + (rr - 128); } \
            else if (j == 1 || j == 3) { SRC = j == 1 ? P.in[10] : P.in[12]; LD = 1024; KROWS = 2816; KD = 2816; DST = (u16*)(ws + (j == 1 ? WS_W2A : WS_W2B)); } \
            else if (j == 4) { SRC = P.in[13]; LD = 4480; KROWS = 1024; KD = 1024; DST = (u16*)(ws + WS_WIN); \
                COL0 = N0 < 1920 ? N0 : (N0 < 2048 ? -1 : 2432 + (N0 - 2048)); } \
            else if (j == 5) { SRC = P.in[26]; LD = 1024; KROWS = 512; KD = 512; DST = (u16*)(ws + WS_WO); } \
            else if (j == 6) { SRC = P.in[27]; LD = 1024; KROWS = 512; KD = 512; DST = (u16*)(ws + WS_WF); } \
            else if (j == 7) { SRC = P.in[28]; LD = 1024; KROWS = 1024; KD = 1024; DST = (u16*)(ws + WS_WOUT); } \
            else { SRC = P.in[20]; LD = 512; KROWS = 128; KD = 256; DST = (u16*)(ws + WS_GUP); } }
#define PREP_STEP(JJ, CNT, NKN) if (j == JJ && r >= (CNT)) { r -= (CNT); j = JJ + 1; nk = NKN; }
#define PREP_LOAD(V, SRC, LD, KROWS, COL0, K0) { _Pragma("unroll") for (int i = 0; i < 8; ++i) { const int kk = (tid >> 6) + 8 * i, nn = tid & 63; \
            V[i] = ((COL0) >= 0 && (K0) + kk < (KROWS)) ? SRC[(size_t)((K0) + kk) * (LD) + (COL0) + nn] : 0.f; } }
        float cur[8], nxt[8];
        const float* srcc = nullptr; int ldc = 0, krc = 0, kdc = 0, colc = 0, n0c = 0, k0c = 0; u16* dstc = nullptr;
        if (bid < total) { PREP_DECODE(bid, srcc, ldc, krc, kdc, colc, n0c, k0c, dstc) PREP_LOAD(cur, srcc, ldc, krc, colc, k0c) }
        for (int q = bid; q < total; q += G) {
            const float* srcn = srcc; int ldn = ldc, krn = krc, kdn = kdc, coln = colc, n0n = n0c, k0n = k0c; u16* dstn = dstc;
            if (q + G < total) { PREP_DECODE(q + G, srcn, ldn, krn, kdn, coln, n0n, k0n, dstn) PREP_LOAD(nxt, srcn, ldn, krn, coln, k0n) }
#pragma unroll
            for (int i = 0; i < 8; ++i) tile[((tid >> 6) + 8 * i) * 65 + (tid & 63)] = cur[i];
            __syncthreads();
            { const int nn = tid >> 3, ks = (tid & 7) * 8; float v[8];
#pragma unroll
              for (int jj = 0; jj < 8; ++jj) v[jj] = tile[(ks + jj) * 65 + nn];
              u32x4 w; w.x = cvt_pk_bf16(v[0], v[1]); w.y = cvt_pk_bf16(v[2], v[3]); w.z = cvt_pk_bf16(v[4], v[5]); w.w = cvt_pk_bf16(v[6], v[7]);
              *(u32x4*)(dstc + (size_t)(n0c + nn) * kdc + k0c + ks) = w; }
            __syncthreads();
            srcc = srcn; ldc = ldn; krc = krn; kdc = kdn; colc = coln; n0c = n0n; k0c = k0n; dstc = dstn;
#pragma unroll
            for (int i = 0; i < 8; ++i) cur[i] = nxt[i];
        }
#undef PREP_STEP
#undef PREP_DECODE
#undef PREP_LOAD
    }

    {
        u16* WZ = (u16*)(ws + WS_WZ);
        for (int k = bid; k < 1024; k += G) {
            frow[tid] = P.in[13][(size_t)k * 4480 + 1920 + tid];
            __syncthreads();
#pragma unroll
            for (int rep = 0; rep < 2; ++rep) { const int zc = tid + rep * 512, g = zc >> 8, part = (zc >> 7) & 1, kn = zc & 127;
                const LAS float* tab = part ? sn128 : cs128; float s = 0.f;
                for (int n = 0; n < 128; ++n) s += frow[g * 128 + n] * tab[(kn * n) & 127];
                s *= 0.08838834764831845f; if (part) s = -s;
                WZ[(size_t)zc * 1024 + k] = (u16)(cvt_pk_bf16(s, 0.f) & 0xffffu); }
            __syncthreads();
        }
    }

    {
        u16* T = (u16*)(ws + WS_T);
        for (size_t vi = (size_t)bid * 512 + tid; vi < (size_t)4096 * 1024; vi += (size_t)G * 512) {
            const int row = (int)(vi >> 10), cv = (int)(vi & 1023) * 8, part = cv >> 12, r = (cv >> 6) & 63, c0 = cv & 63, kr = row >> 6, kc = row & 63;
            const LAS float* tab = part ? sn64 : cs64; const int base = kr * r;
            float v[8];
#pragma unroll
            for (int j = 0; j < 8; ++j) v[j] = tab[(base + kc * (c0 + j)) & 63] * 0.015625f;
            u32x4 w; w.x = cvt_pk_bf16(v[0], v[1]); w.y = cvt_pk_bf16(v[2], v[3]); w.z = cvt_pk_bf16(v[4], v[5]); w.w = cvt_pk_bf16(v[6], v[7]);
            *(u32x4*)(T + vi * 8) = w;
        }
        u16* T2 = (u16*)(ws + WS_T256);
        for (int vi = bid * 512 + tid; vi < 256 * 64; vi += G * 512) {
            const int kt = vi >> 6, cv = (vi & 63) * 8, part = cv >> 8, t0 = cv & 255;
            const LAS float* tab = part ? sn256 : cs256;
            float v[8];
#pragma unroll
            for (int j = 0; j < 8; ++j) v[j] = tab[(kt * (t0 + j)) & 255] * 0.0625f;
            u32x4 w; w.x = cvt_pk_bf16(v[0], v[1]); w.y = cvt_pk_bf16(v[2], v[3]); w.z = cvt_pk_bf16(v[4], v[5]); w.w = cvt_pk_bf16(v[6], v[7]);
            *(u32x4*)(T2 + (size_t)vi * 8) = w;
        }
    }
}

template <int CTRL> __device__ __forceinline__ float dpp_add(float v) {
    return v + __int_as_float(__builtin_amdgcn_update_dpp(0, __float_as_int(v), CTRL, 0xF, 0xF, true));
}
__device__ __forceinline__ float sum16(float v) {
    v = dpp_add<0xB1>(v); v = dpp_add<0x4E>(v); v = dpp_add<0x141>(v); v = dpp_add<0x140>(v); return v;
}
__device__ __forceinline__ float sum64(float v) {
    const float t = sum16(v);
    const int ti = __float_as_int(t);
    return __int_as_float(__builtin_amdgcn_readlane(ti, 0)) + __int_as_float(__builtin_amdgcn_readlane(ti, 16)) + __int_as_float(__builtin_amdgcn_readlane(ti, 32)) + __int_as_float(__builtin_amdgcn_readlane(ti, 48));
}
__device__ __forceinline__ float wave_sum(float v) {
#pragma unroll
    for (int o = 32; o >= 1; o >>= 1) v += __shfl_xor(v, o);
    return v;
}
__device__ __forceinline__ const float* norm_row(const Params& P, const float* X, int m) {
    return X ? X + (size_t)m * DM : (m < NPR ? P.in[0] + (size_t)m * DM : P.in[1] + (size_t)(m - NPR) * DM);
}
__device__ __forceinline__ void phase_norm(const Params& P, const float* X, int nwi, int slot_shift, int slot_scale, u16* H) {
    const int lane = threadIdx.x & 63, gw = blockIdx.x * 8 + (threadIdx.x >> 6), nw = gridDim.x * 8;
    const float* MOD = (const float*)(P.ws + WS_MOD); const float* normw = P.in[8] + nwi * 1024;
    f32x4 v[4], vn[4];
    if (gw < MT) { const float* xr = norm_row(P, X, gw);
#pragma unroll
        for (int i = 0; i < 4; ++i) v[i] = *(const f32x4*)(xr + i * 256 + lane * 4); }
    for (int m = gw; m < MT; m += nw) {
        const int mn = m + nw < MT ? m + nw : m;
        { const float* xr = norm_row(P, X, mn);
#pragma unroll
          for (int i = 0; i < 4; ++i) vn[i] = *(const f32x4*)(xr + i * 256 + lane * 4); }
        float ss = 0.f;
#pragma unroll
        for (int i = 0; i < 4; ++i) ss += v[i][0] * v[i][0] + v[i][1] * v[i][1] + v[i][2] * v[i][2] + v[i][3] * v[i][3];
        ss = sum64(ss);
        const float rs = rsqrtf(ss * (1.0f / 1024.0f) + 1e-6f);
        const float* md = MOD + (size_t)modidx_m(m) * 9216;
#pragma unroll
        for (int i = 0; i < 4; ++i) { const int c = i * 256 + lane * 4;
            const f32x4 w = *(const f32x4*)(normw + c), sc = *(const f32x4*)(md + slot_scale * 1024 + c), sh = *(const f32x4*)(md + slot_shift * 1024 + c);
            const f32x4 y = v[i] * rs * w * (sc + 1.0f) + sh;
            u32x2 o; o.x = cvt_pk_bf16(y[0], y[1]); o.y = cvt_pk_bf16(y[2], y[3]);
            *(u32x2*)(H + (size_t)m * DM + c) = o; }
#pragma unroll
        for (int i = 0; i < 4; ++i) v[i] = vn[i];
    }
}
__device__ __forceinline__ void phase_final_norm(const Params& P) {
    const int lane = threadIdx.x & 63, gw = blockIdx.x * 8 + (threadIdx.x >> 6), nw = gridDim.x * 8;
    const float* fw = P.in[29];
    f32x4 v[4], vn[4];
    if (gw < MT) { const float* xr = P.out + (size_t)gw * DM;
#pragma unroll
        for (int i = 0; i < 4; ++i) v[i] = *(const f32x4*)(xr + i * 256 + lane * 4); }
    for (int m = gw; m < MT; m += nw) {
        const int mn = m + nw < MT ? m + nw : m;
        { const float* xr = P.out + (size_t)mn * DM;
#pragma unroll
          for (int i = 0; i < 4; ++i) vn[i] = *(const f32x4*)(xr + i * 256 + lane * 4); }
        float ss = 0.f;
#pragma unroll
        for (int i = 0; i < 4; ++i) ss += v[i][0] * v[i][0] + v[i][1] * v[i][1] + v[i][2] * v[i][2] + v[i][3] * v[i][3];
        ss = sum64(ss);
        const float rs = rsqrtf(ss * (1.0f / 1024.0f) + 1e-6f);
        float* xo = P.out + (size_t)m * DM;
#pragma unroll
        for (int i = 0; i < 4; ++i) { const int c = i * 256 + lane * 4; *(f32x4*)(xo + c) = v[i] * rs * *(const f32x4*)(fw + c); }
#pragma unroll
        for (int i = 0; i < 4; ++i) v[i] = vn[i];
    }
}

__device__ __forceinline__ float dot4(const f32x4 a, const f32x4 b) {
    typedef float f32x2 __attribute__((ext_vector_type(2)));
    f32x2 p = (f32x2){a[0], a[1]} * (f32x2){b[0], b[1]};
    p = (f32x2){a[2], a[3]} * (f32x2){b[2], b[3]} + p;
    return p[0] + p[1];
}
__device__ __forceinline__ float fsig(float x) { return __builtin_amdgcn_rcpf(1.0f + __expf(-x)); }
struct ScanRegs { u32x2 r[3], k[3], v[3], wd, ad; };
__device__ __forceinline__ void scan_load(ScanRegs& R, const u16* U, int tok0, int T, int t, int h, int d, int cg) {
    const u32x2 z = {0u, 0u};
#pragma unroll
    for (int tap = 0; tap < 3; ++tap) { const int tn = t + tap - 1;
        if (tn >= 0 && tn < T) { const u16* row = U + (size_t)(tok0 + tn) * 1792 + h * 64 + 4 * cg;
            R.r[tap] = *(const u32x2*)row; R.k[tap] = *(const u32x2*)(row + 512); R.v[tap] = *(const u32x2*)(row + 1024); }
        else { R.r[tap] = z; R.k[tap] = z; R.v[tap] = z; } }
    const u16* row = U + (size_t)(tok0 + t) * 1792 + 1536 + d * 64 + 4 * cg;
    R.wd = *(const u32x2*)row; R.ad = *(const u32x2*)(row + 128);
}
__device__ __forceinline__ void unpack4h(const u32x2 q, float (&o)[4]) { o[0] = h2f(q.x & 0xffffu); o[1] = h2f(q.x >> 16); o[2] = h2f(q.y & 0xffffu); o[3] = h2f(q.y >> 16); }

#define LDS_BARRIER() do { asm volatile("s_waitcnt lgkmcnt(0)" ::: "memory"); __builtin_amdgcn_s_barrier(); asm volatile("" ::: "memory"); } while (0)
__device__ __forceinline__ void scan_unit(const Params& P, LAS float* L, int s, int h, int d, int half) {
    typedef float f32x16 __attribute__((ext_vector_type(16)));
    const int tid = threadIdx.x, lane = tid & 63;
    const bool producer = tid >= 256;
    const int T = s < 16 ? 256 : 4096, tok0 = s < 16 ? s * 256 : NPR + (s - 16) * 4096, nchunk = T / 32;
    const u16* U = (const u16*)(P.ws + WS_U16);
    u16* Od = (u16*)(P.ws + WS_H) + (size_t)d * MT * 512;
    float* BS = (float*)(P.ws + WS_BS);
    LAS float* cst = L;            LAS float* xwT = L + 1024;    LAS float* xaT = L + 3136;   LAS float* lora_s = L + 5248;
    LAS float* o_sb = L + 13440;   LAS float* cb = L + 15488;
    if (tid < 64) { const int c = tid, ch = h * 64 + c;
        cst[c] = P.in[16][d * 512 + ch]; cst[64 + c] = P.in[18][d * 512 + ch]; cst[128 + c] = P.in[21][ch]; cst[192 + c] = P.in[22][ch]; cst[256 + c] = P.in[23][ch];
#pragma unroll
        for (int ten = 0; ten < 3; ++ten)
#pragma unroll
            for (int tap = 0; tap < 3; ++tap) cst[(5 + ten * 3 + tap) * 64 + c] = P.in[15][tap * 1536 + ten * 512 + ch]; }
    const int c16 = tid & 15, rp = (tid >> 4) & 15, rA = half * 32 + rp, rB = rA + 16;
    f32x4 SA = {0.f, 0.f, 0.f, 0.f}, SB = {0.f, 0.f, 0.f, 0.f};
    if (!producer && s >= 16) { const float* st = (d ? P.in[3] : P.in[2]) + (size_t)((s - 16) * 8 + h) * 4096;
        SA = *(const f32x4*)(st + rA * 64 + 4 * c16); SB = *(const f32x4*)(st + rB * 64 + 4 * c16); }
    const int pt = tid - 256, pw = (pt >> 6) & 3, nt = pw & 1, kh = pw >> 1, li = lane & 31, lk = lane >> 5;
    float Bw[16], Ba[16];
    if (producer) {
#pragma unroll
        for (int s2 = 0; s2 < 16; ++s2) { const size_t o = (size_t)(d * 64 + kh * 32 + 2 * s2 + lk) * 512 + h * 64 + nt * 32 + li; Bw[s2] = P.in[17][o]; Ba[s2] = P.in[19][o]; }
    } else {
#pragma unroll
        for (int s2 = 0; s2 < 16; ++s2) { Bw[s2] = 0.f; Ba[s2] = 0.f; }
    }
    const int it0 = pt & 255, tt0 = it0 >> 4, cg0 = it0 & 15, tt1 = tt0 + 16, cg1 = cg0;
    ScanRegs R0, R1;
    if (producer) { scan_load(R0, U, tok0, T, d ? T - 1 - tt0 : tt0, h, d, cg0); scan_load(R1, U, tok0, T, d ? T - 1 - tt1 : tt1, h, d, cg1); }
    __syncthreads();
    float tpr[3][4], tpk[3][4], tpv[3][4], kkc4[4];
#pragma unroll
    for (int tap = 0; tap < 3; ++tap)
#pragma unroll
        for (int j = 0; j < 4; ++j) { tpr[tap][j] = cst[(5 + tap) * 64 + 4 * cg0 + j]; tpk[tap][j] = cst[(8 + tap) * 64 + 4 * cg0 + j]; tpv[tap][j] = cst[(11 + tap) * 64 + 4 * cg0 + j]; }
#pragma unroll
    for (int j = 0; j < 4; ++j) kkc4[j] = cst[128 + 4 * cg0 + j];
    for (int ci = -1; ci < nchunk; ++ci) {
        const int pc = ci + 1;
        LAS float* pb = cb + (pc & 1) * 12288;
        const LAS float* qb = cb + (ci & 1) * 12288;
        LAS float* o_s = o_sb + (ci & 1) * 1024;
        const bool do_prep = producer && pc < nchunk, do_step = !producer && ci >= 0;
        LAS float* r_s = pb; LAS float* w_s = pb + 2048; LAS float* kd_s = pb + 4096; LAS float* v_s = pb + 6144; LAS float* kk_s = pb + 8192; LAS float* kka_s = pb + 10240;
#define SCAN_STEPS(SEG) if (do_step) { float oAr[8], oBr[8]; float pA = 0.f, pB = 0.f;     \
        _Pragma("unroll") for (int u8 = 0; u8 < 8; ++u8) { const int tt = (SEG) * 8 + u8; \
            const f32x4 w4 = *(const LAS f32x4*)(qb + 2048 + tt * 64 + 4 * c16), kk4 = *(const LAS f32x4*)(qb + 8192 + tt * 64 + 4 * c16), ka4 = *(const LAS f32x4*)(qb + 10240 + tt * 64 + 4 * c16); \
            const f32x4 kd4 = *(const LAS f32x4*)(qb + 4096 + tt * 64 + 4 * c16), r4 = *(const LAS f32x4*)(qb + tt * 64 + 4 * c16); \
            const float vA = qb[6144 + tt * 64 + rA], vB = qb[6144 + tt * 64 + rB]; \
            float saA = dot4(SA, kk4), saB = dot4(SB, kk4); \
            saA = dpp_add<0xB1>(saA); saB = dpp_add<0xB1>(saB); pA = dpp_add<0xB1>(pA); pB = dpp_add<0xB1>(pB); \
            saA = dpp_add<0x4E>(saA); saB = dpp_add<0x4E>(saB); pA = dpp_add<0x4E>(pA); pB = dpp_add<0x4E>(pB); \
            saA = dpp_add<0x141>(saA); saB = dpp_add<0x141>(saB); pA = dpp_add<0x141>(pA); pB = dpp_add<0x141>(pB); \
            saA = dpp_add<0x140>(saA); saB = dpp_add<0x140>(saB); pA = dpp_add<0x140>(pA); pB = dpp_add<0x140>(pB); \
            if (u8 > 0) { oAr[u8 - 1] = pA; oBr[u8 - 1] = pB; } \
            SA = SA * w4 - ka4 * saA + kd4 * vA; SB = SB * w4 - ka4 * saB + kd4 * vB; \
            pA = dot4(SA, r4); pB = dot4(SB, r4); } \
        pA = dpp_add<0xB1>(pA); pB = dpp_add<0xB1>(pB); pA = dpp_add<0x4E>(pA); pB = dpp_add<0x4E>(pB); pA = dpp_add<0x141>(pA); pB = dpp_add<0x141>(pB); pA = dpp_add<0x140>(pA); pB = dpp_add<0x140>(pB); \
        oAr[7] = pA; oBr[7] = pB; \
        if (c16 == 0) { _Pragma("unroll") for (int u8 = 0; u8 < 8; ++u8) { o_s[((SEG) * 8 + u8) * 32 + rp] = oAr[u8]; o_s[((SEG) * 8 + u8) * 32 + 16 + rp] = oBr[u8]; } } }
        if (do_prep) {
#pragma unroll
            for (int it = 0; it < 2; ++it) { const ScanRegs& R = it ? R1 : R0; const int tt_a = it ? tt1 : tt0, cg = cg0;
                float rv[4] = {0.f, 0.f, 0.f, 0.f}, kv[4] = {0.f, 0.f, 0.f, 0.f}, vv[4] = {0.f, 0.f, 0.f, 0.f};
#pragma unroll
                for (int tap = 0; tap < 3; ++tap) { float a[4], bb[4], c[4]; unpack4h(R.r[tap], a); unpack4h(R.k[tap], bb); unpack4h(R.v[tap], c);
#pragma unroll
                    for (int j = 0; j < 4; ++j) { rv[j] += a[j] * tpr[tap][j]; kv[j] += bb[j] * tpk[tap][j]; vv[j] += c[j] * tpv[tap][j]; } }
                float kkr[4], ss = 0.f;
#pragma unroll
                for (int j = 0; j < 4; ++j) { kkr[j] = kv[j] * kkc4[j]; ss += kkr[j] * kkr[j]; }
                ss = sum16(ss);
                const float inv = __builtin_amdgcn_rsqf(fmaxf(ss, 1e-24f));
                float wdv[4], adv[4]; unpack4h(R.wd, wdv); unpack4h(R.ad, adv);
#pragma unroll
                for (int j = 0; j < 4; ++j) { const int o = tt_a * 64 + 4 * cg + j;
                    r_s[o] = rv[j]; v_s[o] = vv[j]; kd_s[o] = kv[j]; kk_s[o] = kkr[j] * inv;
                    xwT[(4 * cg + j) * 33 + tt_a] = 1.0f - 2.0f * __builtin_amdgcn_rcpf(1.0f + __expf(2.0f * wdv[j])); xaT[(4 * cg + j) * 33 + tt_a] = adv[j]; } }
            if (pc + 1 < nchunk) { const int q0 = (pc + 1) * 32 + tt0, q1 = (pc + 1) * 32 + tt1;
                scan_load(R0, U, tok0, T, d ? T - 1 - q0 : q0, h, d, cg0); scan_load(R1, U, tok0, T, d ? T - 1 - q1 : q1, h, d, cg1); }
        }
        SCAN_STEPS(0)
        LDS_BARRIER();
        if (do_prep) {
            f32x16 accw, acca;
#pragma unroll
            for (int i = 0; i < 16; ++i) { accw[i] = 0.f; acca[i] = 0.f; }
#pragma unroll
            for (int s2 = 0; s2 < 16; ++s2) { const int r = kh * 32 + 2 * s2 + lk;
                accw = __builtin_amdgcn_mfma_f32_32x32x2f32(xwT[r * 33 + li], Bw[s2], accw, 0, 0, 0);
                acca = __builtin_amdgcn_mfma_f32_32x32x2f32(xaT[r * 33 + li], Ba[s2], acca, 0, 0, 0); }
#pragma unroll
            for (int reg = 0; reg < 16; ++reg) { const int o = ((reg & 3) + 8 * (reg >> 2) + 4 * lk) * 64 + nt * 32 + li;
                lora_s[(0 * 2 + kh) * 2048 + o] = accw[reg]; lora_s[(1 * 2 + kh) * 2048 + o] = acca[reg]; }
        }
        SCAN_STEPS(1)
        LDS_BARRIER();
        if (do_prep) {
            const f32x4 w0c4 = *(const LAS f32x4*)(cst + 4 * cg0), a0c4 = *(const LAS f32x4*)(cst + 64 + 4 * cg0), kac4 = *(const LAS f32x4*)(cst + 192 + 4 * cg0), rkc4 = *(const LAS f32x4*)(cst + 256 + 4 * cg0);
#pragma unroll
            for (int it = 0; it < 2; ++it) { const int tt = it ? tt1 : tt0, o = tt * 64 + 4 * cg0;
                const f32x4 l0 = *(const LAS f32x4*)(lora_s + o), l1 = *(const LAS f32x4*)(lora_s + 2048 + o), l2 = *(const LAS f32x4*)(lora_s + 4096 + o), l3 = *(const LAS f32x4*)(lora_s + 6144 + o);
                const f32x4 k4 = *(const LAS f32x4*)(kd_s + o), kkv = *(const LAS f32x4*)(kk_s + o), r4v = *(const LAS f32x4*)(r_s + o);
                f32x4 wo, kdo, kao; float bs = 0.f;
#pragma unroll
                for (int j = 0; j < 4; ++j) {
                    const float w = __expf(-0.6065306597f * fsig(w0c4[j] + l0[j] + l1[j]));
                    const float a = fsig(a0c4[j] + l2[j] + l3[j]);
                    const float kd = k4[j] * (1.0f + (a - 1.0f) * kac4[j]);
                    wo[j] = w; kdo[j] = kd; kao[j] = kkv[j] * a; bs += r4v[j] * kd * rkc4[j]; }
                *(LAS f32x4*)(w_s + o) = wo; *(LAS f32x4*)(kd_s + o) = kdo; *(LAS f32x4*)(kka_s + o) = kao;
                bs = sum16(bs);
                if (cg0 == 0 && half == 0) { const int q = pc * 32 + tt, t = d ? T - 1 - q : q; BS[(size_t)(tok0 + t) * 16 + h * 2 + d] = bs; } }
        }
        SCAN_STEPS(2)
        LDS_BARRIER();
        SCAN_STEPS(3)
        LDS_BARRIER();
        if (do_step) { const int tt = tid >> 3, seg = tid & 7, q = ci * 32 + tt, t = d ? T - 1 - q : q;
            u32x2 w2; w2.x = cvt_pk_bf16(o_s[tt * 32 + 4 * seg], o_s[tt * 32 + 4 * seg + 1]); w2.y = cvt_pk_bf16(o_s[tt * 32 + 4 * seg + 2], o_s[tt * 32 + 4 * seg + 3]);
            *(u32x2*)(Od + (size_t)(tok0 + t) * 512 + h * 64 + half * 32 + 4 * seg) = w2; }
#undef SCAN_STEPS
    }
    if (!producer && s < 16) { float* so = P.out + OUT_STATE + (size_t)d * 524288 + (size_t)(s * 8 + h) * 4096;
        *(f32x4*)(so + rA * 64 + 4 * c16) = SA; *(f32x4*)(so + rB * 64 + 4 * c16) = SB; }
    __syncthreads();
}
__device__ __forceinline__ void phase_scan(const Params& P, LAS unsigned char* lds) {
    for (int q = blockIdx.x; q < 768; q += gridDim.x) {
        int s, rem;
        if (q < 256) { s = 16 + (q >> 5); rem = q & 31; } else { const int p = q - 256; s = p >> 5; rem = p & 31; }
        scan_unit(P, (LAS float*)lds, s, rem >> 2, (rem >> 1) & 1, rem & 1);
    }
}

struct PostRaw { unsigned of, ob, v0, v1, v2, sg; float b0, b1; };
__device__ __forceinline__ void post_load(PostRaw& r, int m, int ch, int h, int lane, const u16* OF, const u16* OB, const u16* U, const float* BS, const u16* GT) {
    const int T = m < NPR ? 256 : 4096, t = m < NPR ? (m & 255) : ((m - NPR) & 4095);
    r.of = OF[(size_t)m * 512 + ch]; r.ob = OB[(size_t)m * 512 + ch];
    r.v1 = U[(size_t)m * 1792 + 1024 + ch];
    r.v0 = t > 0 ? U[(size_t)(m - 1) * 1792 + 1024 + ch] : 0u;
    r.v2 = t < T - 1 ? U[(size_t)(m + 1) * 1792 + 1024 + ch] : 0u;
    r.sg = *(const unsigned*)(GT + (size_t)m * GLD + 2048 + 2 * lane);
    r.b0 = BS[(size_t)m * 16 + h * 2]; r.b1 = BS[(size_t)m * 16 + h * 2 + 1];
}
__device__ __forceinline__ void phase_post(const Params& P, LAS unsigned char* lds) {
    const int lane = threadIdx.x & 63, h = threadIdx.x >> 6, ch = h * 64 + lane, G = gridDim.x;
    const u16* OF = (const u16*)(P.ws + WS_H); const u16* OB = OF + (size_t)MT * 512;
    const u16* U = (const u16*)(P.ws + WS_U16); const float* BS = (const float*)(P.ws + WS_BS);
    u16* OPRE = (u16*)(P.ws + WS_OPRE); const u16* GT = (const u16*)(P.ws + WS_R);
    LAS float* sgl = (LAS float*)lds + h * 128;
    float gu[128];
#pragma unroll
    for (int k = 0; k < 128; ++k) gu[k] = P.in[20][(size_t)k * 512 + ch];
    const float lw = P.in[24][ch], lb = P.in[25][ch];
    const float cv0 = P.in[15][0 * 1536 + 1024 + ch], cv1 = P.in[15][1 * 1536 + 1024 + ch], cv2 = P.in[15][2 * 1536 + 1024 + ch];
    PostRaw cur, nxt;
    int m = blockIdx.x;
    post_load(cur, m, ch, h, lane, OF, OB, U, BS, GT);
    for (; m < MT; m += G) {
        const int mn = m + G < MT ? m + G : m;
        post_load(nxt, mn, ch, h, lane, OF, OB, U, BS, GT);
        sgl[2 * lane] = h2f(cur.sg & 0xffffu); sgl[2 * lane + 1] = h2f(cur.sg >> 16);
        const float o = bf2f(cur.of) + bf2f(cur.ob);
        const float mean = sum64(o) * (1.0f / 64.0f), d = o - mean;
        const float rstd = rsqrtf(sum64(d * d) * (1.0f / 64.0f) + 64e-5f);
        const float v = h2f(cur.v0) * cv0 + h2f(cur.v1) * cv1 + h2f(cur.v2) * cv2;
        float g0 = 0.f, g1 = 0.f, g2 = 0.f, g3 = 0.f;
#pragma unroll
        for (int k = 0; k < 128; k += 4) { const f32x4 s4 = *(const LAS f32x4*)(sgl + k);
            g0 += s4[0] * gu[k]; g1 += s4[1] * gu[k + 1]; g2 += s4[2] * gu[k + 2]; g3 += s4[3] * gu[k + 3]; }
        const float y = (d * rstd * lw + lb + (cur.b0 + cur.b1) * v) * ((g0 + g1) + (g2 + g3));
        OPRE[(size_t)m * 512 + ch] = (u16)(cvt_pk_bf16(y, 0.f) & 0xffffu);
        cur = nxt;
    }
}


constexpr size_t WS_BAR = WS_END + 65536;
static_assert(WS_BAR + 4096 <= (size_t)536870912, "barrier words");
__device__ __forceinline__ void fast_grid_sync(unsigned char* ws, unsigned k) {
    asm volatile("s_waitcnt vmcnt(0) lgkmcnt(0)" ::: "memory");
    __builtin_amdgcn_s_barrier();
    if (threadIdx.x == 0) {
        unsigned* bar = (unsigned*)(ws + WS_BAR);
        const unsigned G = gridDim.x, g = blockIdx.x & 7u, gsz = (G - g + 7u) >> 3, ngrp = G < 8u ? G : 8u;
        __builtin_amdgcn_fence(__ATOMIC_RELEASE, "agent");
        asm volatile("s_waitcnt vmcnt(0)" ::: "memory");
        const unsigned old = __hip_atomic_fetch_add(bar + g * 32, 1u, __ATOMIC_RELAXED, __HIP_MEMORY_SCOPE_AGENT);
        if (old + 1u == k * gsz) __hip_atomic_fetch_add(bar + 8 * 32, 1u, __ATOMIC_RELAXED, __HIP_MEMORY_SCOPE_AGENT);
        unsigned spins = 0;
        while (__hip_atomic_load(bar + 8 * 32, __ATOMIC_RELAXED, __HIP_MEMORY_SCOPE_AGENT) < k * ngrp) { if (++spins > (1u << 24)) break; __builtin_amdgcn_s_sleep(1); }
        __builtin_amdgcn_fence(__ATOMIC_ACQUIRE, "agent");
        asm volatile("s_waitcnt vmcnt(0)" ::: "memory");
    }
    __builtin_amdgcn_s_barrier();
    asm volatile("" ::: "memory");
}

__global__ void __launch_bounds__(512, 2) fwd_mega(Params P) {
    extern __shared__ __attribute__((aligned(16))) unsigned char lds_raw[];
    LAS unsigned char* lds = (LAS unsigned char*)lds_raw;
    cg::grid_group grid = cg::this_grid();
    if (threadIdx.x < 32) { const int i = threadIdx.x; const unsigned long long v = i < 30 ? (unsigned long long)P.in[i] : (i == 30 ? (unsigned long long)P.out : (unsigned long long)P.ws);
        *(LAS unsigned long long*)(lds + PTAB_OFF + i * 8) = v; }
    __syncthreads();
unsigned bark_ = 0; unsigned char* P_ws_ = P.ws;
#define PH_BEGIN { const Params Q = get_params(lds); unsigned char* ws = Q.ws; (void)ws;
#define PH_END } asm volatile("s_waitcnt vmcnt(0)" ::: "memory");   grid.sync();
#define PH_ENDF } fast_grid_sync(P_ws_, ++bark_);
    if (blockIdx.x == 0 && threadIdx.x < 9) ((unsigned*)(P.ws + WS_BAR))[threadIdx.x * 32] = 0u;
    PH_BEGIN phase_prep(Q, lds); PH_END
    PH_BEGIN phase_norm(Q, nullptr, 0, 0, 1, (u16*)(ws + WS_H)); PH_ENDF
    PH_BEGIN run_gemm(lds, (const u16*)(ws + WS_H), (const u16*)(ws + WS_W13A), MT, 5632, 1024, EpiSwiglu{(u16*)(ws + WS_BIG)}); PH_ENDF
    PH_BEGIN run_gemm(lds, (const u16*)(ws + WS_BIG), (const u16*)(ws + WS_W2A), MT, 1024, 2816, EpiResid{Q.in[0], Q.in[1], Q.out, (const float*)(ws + WS_MOD), 2, 0.5f}); PH_ENDF
    PH_BEGIN phase_norm(Q, Q.out, 1, 3, 4, (u16*)(ws + WS_H)); PH_ENDF
    PH_BEGIN run_gemm(lds, (const u16*)(ws + WS_WZ), (const u16*)(ws + WS_H), 1024, MT, 1024, EpiZT{(u16*)(ws + WS_ZL)}); PH_ENDF
    PH_BEGIN run_gemm(lds, (const u16*)(ws + WS_T), (const u16*)(ws + WS_ZL), 4096, 4096, 8192, EpiFour{(u16*)(ws + WS_FOUR), 1});
             run_gemm(lds, (const u16*)(ws + WS_T256), (const u16*)(ws + WS_ZP), 256, 8192, 512, EpiFour{(u16*)(ws + WS_FOUR), 0}); PH_ENDF
    PH_BEGIN run_gemm(lds, (const u16*)(ws + WS_H), (const u16*)(ws + WS_WIN), MT, 4096, 1024, EpiU{(u16*)(ws + WS_U16), (u16*)(ws + WS_SG), (u16*)(ws + WS_R), Q.in[14]}); PH_ENDF
    PH_BEGIN phase_scan(Q, lds); PH_ENDF
    PH_BEGIN phase_post(Q, lds); PH_ENDF
    PH_BEGIN run_gemm(lds, (const u16*)(ws + WS_OPRE), (const u16*)(ws + WS_WO), MT, 1024, 512, EpiMul{(u16*)(ws + WS_H), (const u16*)(ws + WS_R), 1}); PH_ENDF
    PH_BEGIN run_gemm(lds, (const u16*)(ws + WS_FOUR), (const u16*)(ws + WS_WF), MT, 1024, 512, EpiMul{(u16*)(ws + WS_H), (const u16*)(ws + WS_R), 2}); PH_ENDF
    PH_BEGIN run_gemm(lds, (const u16*)(ws + WS_H), (const u16*)(ws + WS_WOUT), MT, 1024, 1024, EpiResid{nullptr, nullptr, Q.out, (const float*)(ws + WS_MOD), 5, 1.0f}); PH_ENDF
    PH_BEGIN phase_norm(Q, Q.out, 2, 6, 7, (u16*)(ws + WS_H)); PH_ENDF
    PH_BEGIN run_gemm(lds, (const u16*)(ws + WS_H), (const u16*)(ws + WS_W13B), MT, 5632, 1024, EpiSwiglu{(u16*)(ws + WS_BIG)}); PH_ENDF
    PH_BEGIN run_gemm(lds, (const u16*)(ws + WS_BIG), (const u16*)(ws + WS_W2B), MT, 1024, 2816, EpiResid{nullptr, nullptr, Q.out, (const float*)(ws + WS_MOD), 8, 0.5f}); PH_ENDF
    { const Params Q = get_params(lds); phase_final_norm(Q); }
#undef PH_BEGIN
#undef PH_END
#undef PH_ENDF
}

extern "C" void kernel_launch(void* const* d_in, const int* in_sizes, int n_in, void* d_out, int out_size, void* d_ws, size_t ws_size, hipStream_t stream) {
    static int grid_blocks = 0;
    if (grid_blocks == 0) {
        if (n_in != 30 || ws_size < WS_END) { fprintf(stderr, "kernel_launch: unexpected n_in %d / ws_size %zu (need %zu)\n", n_in, ws_size, (size_t)WS_END); grid_blocks = -1; return; }
        int dev = 0, cus = 0, per_cu = 0;
        (void)hipGetDevice(&dev);
        (void)hipDeviceGetAttribute(&cus, hipDeviceAttributeMultiprocessorCount, dev);
        (void)hipFuncSetAttribute((const void*)fwd_mega, hipFuncAttributeMaxDynamicSharedMemorySize, LDS_BYTES);
        (void)hipOccupancyMaxActiveBlocksPerMultiprocessor(&per_cu, (const void*)fwd_mega, 512, LDS_BYTES);
        if (per_cu < 1) { fprintf(stderr, "kernel_launch: occupancy query reports %d blocks per CU\n", per_cu); per_cu = 1; }
        if (per_cu > 1) per_cu = 1;
        grid_blocks = cus * per_cu;
        (void)hipGetLastError();
    }
    if (grid_blocks < 0) return;
    Params p{};
    for (int i = 0; i < 30; ++i) p.in[i] = (const float*)d_in[i];
    p.out = (float*)d_out; p.ws = (unsigned char*)d_ws;
    void* args[] = {&p};
    hipError_t e = hipLaunchCooperativeKernel((const void*)fwd_mega, dim3(grid_blocks), dim3(512), args, LDS_BYTES, stream);
    if (e != hipSuccess) fprintf(stderr, "cooperative launch failed: %s (grid %d)\n", hipGetErrorString(e), grid_blocks);
}
```

```cpp
#include <hip/hip_runtime.h>
#include <hip/hip_cooperative_groups.h>
#include <cstdio>
namespace cg = cooperative_groups;
namespace pg8 {
#define PG8_LAS __attribute__((address_space(3)))
typedef unsigned short bf16_t;
typedef short bf16x8 __attribute__((ext_vector_type(8)));
typedef float f32x4 __attribute__((ext_vector_type(4)));
typedef unsigned u32x4 __attribute__((ext_vector_type(4)));
constexpr int BM = 256, BK = 64, HALF = 128, HTB = HALF * BK * 2  , STAGE_BYTES = 8 * HTB, NXCD = 8, WGM = 8;

__host__ __device__ __forceinline__ int lds_byte(int r, int c) { const int st = (r >> 4) * 2 + (c >> 5), rr = r & 15, cc = c & 31, ob = rr * 64 + cc * 2; return st * 1024 + (ob ^ (((ob >> 9) & 1) << 5)); }
__host__ __device__ __forceinline__ void stage_rc(int b, int& R, int& C) { const int st = b / 1024, sb = b % 1024, swz = sb ^ (((sb >> 9) & 1) << 5); R = (st >> 1) * 16 + swz / 64; C = (st & 1) * 32 + (swz % 64) / 2; }
__host__ __device__ __forceinline__ int perm32(int rho) { const int n = rho >> 4, i = rho & 15; return 8 * (i >> 2) + 4 * n + (i & 3); }

struct Unit { int pm, pn; };
struct Gemm { const bf16_t* A; const bf16_t* Bt; int M, N, K; };

struct StaticOrder {
    int nM, nN, nwg, G, c;
    __host__ __device__ __forceinline__ void init(int M, int N, int G_, int c_) { nM = M / BM; nN = N / BM; nwg = nM * nN; G = G_; c = c_; }
    __host__ __device__ __forceinline__ bool next(int i, Unit& u) const {
        const long L = (long)i * G + c; if (L >= nwg) return false;
        int wgid = (int)L; { const int q = nwg / NXCD, r = nwg % NXCD, xcd = wgid % NXCD, off = wgid / NXCD; wgid = (xcd < r ? xcd * (q + 1) : r * (q + 1) + (xcd - r) * q) + off; }
        const int nig = WGM * nN, gid = wgid / nig, fm = gid * WGM, gsz = (nM - fm) < WGM ? (nM - fm) : WGM;
        u.pm = fm + ((wgid % nig) % gsz); u.pn = (wgid % nig) / gsz; return true;
    }
    __device__ __forceinline__ void a_ready(const Unit&) const {}
    __device__ __forceinline__ void done(const Unit&) const {}
};
__device__ __forceinline__ unsigned cvt_pk_bf16(float lo, float hi) { unsigned r; asm volatile("v_cvt_pk_bf16_f32 %0, %1, %2" : "=v"(r) : "v"(lo), "v"(hi)); return r; }
template <class Epi, class Sched, bool STAMP = false>
__device__ __forceinline__ void gemm_phase(PG8_LAS unsigned char* lds, const Gemm g, const Sched& S, const Epi& E, unsigned long long* stamps) {
    int tid_ = threadIdx.x; asm volatile("" : "+v"(tid_));
    const int tid = tid_, wid = __builtin_amdgcn_readfirstlane(tid >> 6), lane = tid & 63, wr = wid >> 2, wc = wid & 3, fr = lane & 15, fq = lane >> 4;
    const int K = g.K, nt = K / BK;
    int ts_lo = 0, ts_hi = 0, nts = 0; const unsigned long long rt_entry = STAMP ? (unsigned long long)wall_clock64() : 0ull;
#define PG8_STAMP() do { if (STAMP && wid == 0 && nts < 64) { const unsigned long long _c = (unsigned long long)clock64(); \
        ts_lo = (lane == nts) ? (int)(unsigned)_c : ts_lo; ts_hi = (lane == nts) ? (int)(unsigned)(_c >> 32) : ts_hi; ++nts; } } while (0)
    PG8_STAMP();
    unsigned voffA[2], voffB[2];
#pragma unroll
    for (int i = 0; i < 2; ++i) { int R, C; stage_rc(tid * 16 + i * 8192, R, C); const int Rb = Epi::PERM ? ((R & ~31) + perm32(R & 31)) : R;
        voffA[i] = (unsigned)(R * K + C) * 2u; voffB[i] = (unsigned)(Rb * K + C) * 2u; }
    const size_t kstep = (size_t)(BK * 2);
    const size_t hstep = (size_t)HALF * K * 2;
    const size_t tstep = 2 * hstep;
    const unsigned ldsw = (unsigned)wid * 1024u;
    const int aoff = lds_byte(wr * 64 + fr, fq * 8), boff = lds_byte(wc * 32 + fr, fq * 8);
#define PG8_SA(b, h) (((b) * 2 + (h)) * HTB)
#define PG8_SB(b, h) ((4 + (b) * 2 + (h)) * HTB)
#define PG8_STAGE(bufoff, gbase, voff) do { _Pragma("unroll") for (int _i = 0; _i < 2; ++_i) \
        __builtin_amdgcn_global_load_lds((const unsigned*)((const char*)(gbase) + (voff)[_i]), (PG8_LAS unsigned*)(lds + (bufoff) + ldsw + _i * 8192), 16, 0, 0); } while (0)
#define PG8_LDA(dst, b, h) do { _Pragma("unroll") for (int m = 0; m < 4; ++m) _Pragma("unroll") for (int k = 0; k < 2; ++k) dst[m][k] = *(const PG8_LAS bf16x8*)(lds + PG8_SA(b, h) + aoff + m * 2048 + k * 1024); } while (0)
#define PG8_LDB(dst, b, h) do { _Pragma("unroll") for (int n = 0; n < 2; ++n) _Pragma("unroll") for (int k = 0; k < 2; ++k) dst[n][k] = *(const PG8_LAS bf16x8*)(lds + PG8_SB(b, h) + boff + n * 2048 + k * 1024); } while (0)
#define PG8_MMA(ai, bj, At, Bt) do { __builtin_amdgcn_s_setprio(1); _Pragma("unroll") for (int m = 0; m < 4; ++m) _Pragma("unroll") for (int n = 0; n < 2; ++n) _Pragma("unroll") for (int k = 0; k < 2; ++k) \
        acc[ai][bj][m][n] = __builtin_amdgcn_mfma_f32_16x16x32_bf16(Bt[n][k], At[m][k], acc[ai][bj][m][n], 0, 0, 0); __builtin_amdgcn_s_setprio(0); } while (0)
#define PG8_WAIT_V(n) asm volatile("s_waitcnt vmcnt(" #n ")" ::: "memory")
#define PG8_WAIT_L(n) asm volatile("s_waitcnt lgkmcnt(" #n ")" ::: "memory")
#define PG8_BAR __builtin_amdgcn_s_barrier()
#define PG8_SCHED __builtin_amdgcn_sched_barrier(0)
    Unit cur, nxt; int ui = 0;
    if (!S.next(0, cur)) return;
    f32x4 acc[2][2][4][2];
#pragma unroll
    for (int a = 0; a < 2; ++a)
#pragma unroll
        for (int b = 0; b < 2; ++b)
#pragma unroll
            for (int m = 0; m < 4; ++m)
#pragma unroll
                for (int n = 0; n < 2; ++n) acc[a][b][m][n] = (f32x4){0.f, 0.f, 0.f, 0.f};
    bf16x8 At[4][2], B0[2][2], B1[2][2];
    const char* cA = (const char*)g.A + (size_t)cur.pm * tstep; const char* cB = (const char*)g.Bt + (size_t)cur.pn * tstep;
    S.a_ready(cur);
    PG8_STAGE(PG8_SB(0, 0), cB, voffB); PG8_STAGE(PG8_SA(0, 0), cA, voffA); PG8_STAGE(PG8_SB(0, 1), cB + hstep, voffB); PG8_STAGE(PG8_SA(0, 1), cA + hstep, voffA);
    if (wr == 1) PG8_BAR;
    PG8_WAIT_V(4); PG8_BAR;
    PG8_STAGE(PG8_SB(1, 0), cB + kstep, voffB); PG8_STAGE(PG8_SA(1, 0), cA + kstep, voffA); PG8_STAGE(PG8_SB(1, 1), cB + hstep + kstep, voffB);
    PG8_WAIT_V(6); PG8_BAR;
    PG8_STAMP();
    for (;;) {
        const bool has_next = S.next(ui + 1, nxt);
        const char* nA = has_next ? (const char*)g.A + (size_t)nxt.pm * tstep : cA; const char* nB = has_next ? (const char*)g.Bt + (size_t)nxt.pn * tstep : cB;
        for (int t = 0; t < nt; t += 2) {
            const bool last = (t == nt - 2);
            const char* a1 = cA + (size_t)(t + 1) * kstep;
            const char* a2 = last ? nA : cA + (size_t)(t + 2) * kstep; const char* b2 = last ? nB : cB + (size_t)(t + 2) * kstep;
            const char* a3 = a2 + kstep; const char* b3 = b2 + kstep;
            if (last && has_next) S.a_ready(nxt);
            PG8_LDB(B0, 0, 0); PG8_SCHED; PG8_LDA(At, 0, 0); PG8_STAGE(PG8_SA(1, 1), a1 + hstep, voffA);
            PG8_WAIT_L(8); PG8_BAR; PG8_WAIT_L(0); PG8_MMA(0, 0, At, B0); PG8_BAR; PG8_SCHED;
            PG8_LDB(B1, 0, 1); PG8_STAGE(PG8_SB(0, 0), b2, voffB);
            PG8_BAR; PG8_WAIT_L(0); PG8_MMA(0, 1, At, B1); PG8_BAR;
            PG8_LDA(At, 0, 1); PG8_STAGE(PG8_SA(0, 0), a2, voffA);
            PG8_BAR; PG8_WAIT_L(0); PG8_MMA(1, 0, At, B0); PG8_BAR; PG8_SCHED;
            PG8_STAGE(PG8_SB(0, 1), b2 + hstep, voffB);
            PG8_WAIT_V(6); PG8_BAR; PG8_MMA(1, 1, At, B1); PG8_BAR;
            PG8_LDB(B0, 1, 0); PG8_SCHED; PG8_LDA(At, 1, 0); PG8_STAGE(PG8_SA(0, 1), a2 + hstep, voffA);
            PG8_WAIT_L(8); PG8_BAR; PG8_WAIT_L(0); PG8_MMA(0, 0, At, B0); PG8_BAR; PG8_SCHED;
            PG8_LDB(B1, 1, 1); PG8_STAGE(PG8_SB(1, 0), b3, voffB);
            PG8_BAR; PG8_WAIT_L(0); PG8_MMA(0, 1, At, B1); PG8_BAR;
            PG8_LDA(At, 1, 1); PG8_STAGE(PG8_SA(1, 0), a3, voffA);
            PG8_BAR; PG8_WAIT_L(0); PG8_MMA(1, 0, At, B0); PG8_BAR; PG8_SCHED;
            PG8_STAGE(PG8_SB(1, 1), b3 + hstep, voffB);
            PG8_WAIT_V(6); PG8_BAR; PG8_MMA(1, 1, At, B1); PG8_BAR;
        }
        PG8_STAMP();
        if constexpr (!Epi::AFTER_DRAIN) { E(acc, cur, wr, wc, fr, fq); S.done(cur); }
        PG8_STAMP();
        if (!has_next) break;
#pragma unroll
        for (int a = 0; a < 2; ++a)
#pragma unroll
            for (int b = 0; b < 2; ++b)
#pragma unroll
                for (int m = 0; m < 4; ++m)
#pragma unroll
                    for (int n = 0; n < 2; ++n) acc[a][b][m][n] = (f32x4){0.f, 0.f, 0.f, 0.f};
        cur = nxt; cA = nA; cB = nB; ++ui;
    }
    PG8_WAIT_V(0);
    if (wr == 0) PG8_BAR;
    PG8_BAR;
    if constexpr (Epi::AFTER_DRAIN) { E.fused(acc, cur, wr, wc, fr, fq, lds, wid, lane); S.done(cur); }
    PG8_STAMP();
    if (STAMP && wid == 0) { stamps[lane] = lane < nts ? (((unsigned long long)(unsigned)ts_hi << 32) | (unsigned)ts_lo) : 0ull;
        if (lane == 62) stamps[62] = rt_entry; if (lane == 63) stamps[63] = (unsigned long long)wall_clock64(); }
#undef PG8_STAMP
#undef PG8_SA
#undef PG8_SB
#undef PG8_STAGE
#undef PG8_LDA
#undef PG8_LDB
#undef PG8_MMA
#undef PG8_WAIT_V
#undef PG8_WAIT_L
#undef PG8_BAR
#undef PG8_SCHED
}
}

#define LAS __attribute__((address_space(3)))
typedef unsigned short u16;
typedef float f32x4 __attribute__((ext_vector_type(4)));
typedef unsigned u32x4 __attribute__((ext_vector_type(4)));
typedef unsigned u32x2 __attribute__((ext_vector_type(2)));
using pg8::cvt_pk_bf16;

constexpr int MT = 36864, NPR = 4096, DM = 1024, DFF = 2816;
constexpr int OUT_STATE = MT * DM;
constexpr int LDS_BYTES = 163840, PTAB_OFF = 163840 - 256;

constexpr size_t SZ_W13 = (size_t)5632 * 1024 * 2, SZ_W2 = (size_t)1024 * 2816 * 2;
constexpr size_t WS_W13A = 0, WS_W2A = WS_W13A + SZ_W13, WS_W13B = WS_W2A + SZ_W2, WS_W2B = WS_W13B + SZ_W13;
constexpr size_t WS_WIN = WS_W2B + SZ_W2;
constexpr size_t WS_WZ = WS_WIN + (size_t)4096 * 1024 * 2;
constexpr size_t WS_WO = WS_WZ + (size_t)1024 * 1024 * 2;
constexpr size_t WS_WF = WS_WO + (size_t)1024 * 512 * 2;
constexpr size_t WS_WOUT = WS_WF + (size_t)1024 * 512 * 2;
constexpr size_t WS_GUP = WS_WOUT + (size_t)1024 * 1024 * 2;
constexpr size_t WS_MOD = WS_GUP + (size_t)512 * 256 * 2;
constexpr size_t WS_BS = WS_MOD + (size_t)9 * 9216 * 4;
constexpr size_t WS_SG = WS_BS + (size_t)MT * 16 * 4;
constexpr size_t WS_H = WS_SG + (size_t)MT * 256 * 2;
constexpr size_t WS_BIG = WS_H + (size_t)MT * 1024 * 2;
constexpr size_t WS_U16 = WS_BIG;
constexpr size_t WS_FOUR = WS_U16 + (size_t)MT * 1792 * 2;
constexpr size_t WS_OPRE = WS_FOUR + (size_t)MT * 512 * 2;
constexpr size_t WS_R = WS_BIG + (size_t)MT * 2816 * 2;
constexpr size_t WS_T = WS_R;
constexpr size_t WS_T256 = WS_T + (size_t)4096 * 8192 * 2;
constexpr size_t WS_ZL = WS_T256 + (size_t)256 * 512 * 2;
constexpr size_t WS_ZP = WS_ZL + (size_t)4096 * 8192 * 2;
constexpr int GLD = 2304;
constexpr size_t WS_END = WS_R + (size_t)MT * GLD * 2;
static_assert(WS_ZP + (size_t)8192 * 512 * 2 <= WS_END, "R region");
static_assert(WS_OPRE + (size_t)MT * 512 * 2 <= WS_R, "BIG region");
static_assert(WS_END <= (size_t)536870912, "workspace");
static_assert(WS_ZP == WS_ZL + (size_t)4096 * 8192 * 2, "ZP behind ZL");

struct Params { const float* in[30]; float* out; unsigned char* ws; };
__device__ __forceinline__ unsigned long long ld_ptr(LAS unsigned char* lds, int i) {
    const u32x2 v = *(const LAS u32x2*)(lds + PTAB_OFF + i * 8);
    const unsigned lo = __builtin_amdgcn_readfirstlane(v.x), hi = __builtin_amdgcn_readfirstlane(v.y);
    return ((unsigned long long)hi << 32) | lo;
}
template <class T> __device__ __forceinline__ T* as_global(unsigned long long v) {
    return (T*)(__attribute__((address_space(1))) T*)v;
}
__device__ __forceinline__ Params get_params(LAS unsigned char* lds) {
    Params Q;
#pragma unroll
    for (int i = 0; i < 30; ++i) Q.in[i] = as_global<const float>(ld_ptr(lds, i));
    Q.out = as_global<float>(ld_ptr(lds, 30)); Q.ws = as_global<unsigned char>(ld_ptr(lds, 31));
    return Q;
}
__device__ __forceinline__ float bf2f(unsigned v16) { return __uint_as_float(v16 << 16); }
__device__ __forceinline__ float h2f(unsigned v16) { return (float)__builtin_bit_cast(_Float16, (unsigned short)v16); }
__device__ __forceinline__ unsigned pk_h(float a, float b) {
    const unsigned short ua = __builtin_bit_cast(unsigned short, (_Float16)a), ub = __builtin_bit_cast(unsigned short, (_Float16)b);
    return (unsigned)ua | ((unsigned)ub << 16);
}
__device__ __forceinline__ float sigmoidf_(float x) { return __builtin_amdgcn_rcpf(1.0f + __expf(-x)); }
__device__ __forceinline__ int modidx_pm(int pm) { return pm < 16 ? 8 : ((pm - 16) >> 4); }
__device__ __forceinline__ int modidx_m(int m) { return m < NPR ? 8 : ((m - NPR) >> 12); }

struct EpiSwiglu {
    static constexpr bool PERM = true, AFTER_DRAIN = false;
    u16* G;
    __device__ __forceinline__ void operator()(const f32x4 (&acc)[2][2][4][2], const pg8::Unit& u, int wr, int wc, int fr, int fq) const {
        const int row0 = u.pm * 256 + wr * 64 + fr, col0 = u.pn * 128 + wc * 32 + 8 * fq;
#pragma unroll
        for (int ai = 0; ai < 2; ++ai)
#pragma unroll
            for (int m = 0; m < 4; ++m) {
                float g[8];
#pragma unroll
                for (int n = 0; n < 2; ++n)
#pragma unroll
                    for (int j = 0; j < 4; ++j) { const float a = acc[ai][0][m][n][j], b = acc[ai][1][m][n][j]; g[n * 4 + j] = a * sigmoidf_(a) * b; }
                u32x4 w; w.x = cvt_pk_bf16(g[0], g[1]); w.y = cvt_pk_bf16(g[2], g[3]); w.z = cvt_pk_bf16(g[4], g[5]); w.w = cvt_pk_bf16(g[6], g[7]);
                *(u32x4*)(G + (size_t)(row0 + ai * 128 + m * 16) * DFF + col0) = w;
            }
    }
};
struct EpiResid {
    static constexpr bool PERM = false, AFTER_DRAIN = false;
    const float* xp; const float* xs; float* X; const float* MOD; int slot; float coef;
    __device__ __forceinline__ void operator()(const f32x4 (&acc)[2][2][4][2], const pg8::Unit& u, int wr, int wc, int fr, int fq) const {
        const int row0 = u.pm * 256 + wr * 64 + fr, col0 = u.pn * 256 + wc * 32 + 4 * fq;
        const float* g = MOD + (size_t)modidx_pm(u.pm) * 9216 + slot * 1024 + col0;
        f32x4 gv[2][2];
#pragma unroll
        for (int bj = 0; bj < 2; ++bj)
#pragma unroll
            for (int n = 0; n < 2; ++n) gv[bj][n] = *(const f32x4*)(g + bj * 128 + n * 16) * coef;
#pragma unroll
        for (int ai = 0; ai < 2; ++ai)
#pragma unroll
            for (int m = 0; m < 4; ++m) {
                const int row = row0 + ai * 128 + m * 16;
                const float* src = (xp ? (row < NPR ? xp + (size_t)row * DM : xs + (size_t)(row - NPR) * DM) : X + (size_t)row * DM) + col0;
                float* dst = X + (size_t)row * DM + col0;
#pragma unroll
                for (int bj = 0; bj < 2; ++bj)
#pragma unroll
                    for (int n = 0; n < 2; ++n) *(f32x4*)(dst + bj * 128 + n * 16) = *(const f32x4*)(src + bj * 128 + n * 16) + gv[bj][n] * acc[ai][bj][m][n];
            }
    }
};
struct EpiU {
    static constexpr bool PERM = true, AFTER_DRAIN = false;
    u16* U; u16* SG; u16* GATES; const float* gate_b;
    __device__ __forceinline__ void operator()(const f32x4 (&acc)[2][2][4][2], const pg8::Unit& u, int wr, int wc, int fr, int fq) const {
        const int row0 = u.pm * 256 + wr * 64 + fr, ct = wc * 32 + 8 * fq;
        if (u.pn < 7) {
#pragma unroll
            for (int ai = 0; ai < 2; ++ai)
#pragma unroll
                for (int m = 0; m < 4; ++m)
#pragma unroll
                    for (int bj = 0; bj < 2; ++bj) { const f32x4 v0 = acc[ai][bj][m][0], v1 = acc[ai][bj][m][1];
                        u32x4 w; w.x = pk_h(v0[0], v0[1]); w.y = pk_h(v0[2], v0[3]); w.z = pk_h(v1[0], v1[1]); w.w = pk_h(v1[2], v1[3]);
                        *(u32x4*)(U + (size_t)(row0 + ai * 128 + m * 16) * 1792 + u.pn * 256 + bj * 128 + ct) = w; }
        } else {
            const int gc0 = (u.pn == 7 ? 2048 : (u.pn - 8) * 256) + ct;
#pragma unroll
            for (int bj = 0; bj < 2; ++bj) {
                const int gbi = (u.pn == 7 ? 0 : (u.pn - 8) * 256) + ct; const float bsc = u.pn == 7 ? 0.f : 1.f;
                const f32x4 b0 = *(const f32x4*)(gate_b + gbi + bj * 128) * bsc, b1 = *(const f32x4*)(gate_b + gbi + bj * 128 + 4) * bsc;
#pragma unroll
                for (int ai = 0; ai < 2; ++ai)
#pragma unroll
                    for (int m = 0; m < 4; ++m) { const f32x4 v0 = acc[ai][bj][m][0] + b0, v1 = acc[ai][bj][m][1] + b1;
                        u32x4 w; w.x = pk_h(sigmoidf_(v0[0]), sigmoidf_(v0[1])); w.y = pk_h(sigmoidf_(v0[2]), sigmoidf_(v0[3]));
                        w.z = pk_h(sigmoidf_(v1[0]), sigmoidf_(v1[1])); w.w = pk_h(sigmoidf_(v1[2]), sigmoidf_(v1[3]));
                        *(u32x4*)(GATES + (size_t)(row0 + ai * 128 + m * 16) * GLD + gc0 + bj * 128) = w; }
            }
        }
    }
};
struct EpiZT {
    static constexpr bool PERM = true, AFTER_DRAIN = false;
    u16* ZL;
    __device__ __forceinline__ void operator()(const f32x4 (&acc)[2][2][4][2], const pg8::Unit& u, int wr, int wc, int fr, int fq) const {
#pragma unroll
        for (int bj = 0; bj < 2; ++bj) {
            const int c0 = u.pn * 256 + bj * 128 + wc * 32 + 8 * fq;
#pragma unroll
            for (int ai = 0; ai < 2; ++ai)
#pragma unroll
                for (int m = 0; m < 4; ++m) {
                    const int zr = u.pm * 256 + ai * 128 + wr * 64 + m * 16 + fr, g = zr >> 8, part = (zr >> 7) & 1, kn = zr & 127;
                    size_t off;
                    if (u.pn < 16) off = (size_t)4096 * 8192 + ((size_t)(u.pn * 512 + g * 128 + kn) * 512 + part * 256 + (c0 - u.pn * 256));
                    else { const int tok = c0 - NPR, b = tok >> 12, rc = tok & 4095; off = (size_t)(b * 512 + g * 128 + kn) * 8192 + part * 4096 + rc; }
                    u16* dst = ZL + off;
                    const f32x4 v0 = acc[ai][bj][m][0], v1 = acc[ai][bj][m][1];
                    u32x4 w; w.x = cvt_pk_bf16(v0[0], v0[1]); w.y = cvt_pk_bf16(v0[2], v0[3]); w.z = cvt_pk_bf16(v1[0], v1[1]); w.w = cvt_pk_bf16(v1[2], v1[3]);
                    *(u32x4*)dst = w;
                }
        }
    }
};
struct EpiFour {
    static constexpr bool PERM = true, AFTER_DRAIN = false;
    u16* FOUR; int latent;
    __device__ __forceinline__ void operator()(const f32x4 (&acc)[2][2][4][2], const pg8::Unit& u, int wr, int wc, int fr, int fq) const {
        const int b = u.pn >> 1, ch0 = (u.pn & 1) * 256 + wc * 32 + 8 * fq;
        const int tok0 = (latent ? NPR + b * 4096 : b * 256) + u.pm * 256 + wr * 64 + fr;
#pragma unroll
        for (int ai = 0; ai < 2; ++ai)
#pragma unroll
            for (int m = 0; m < 4; ++m)
#pragma unroll
                for (int bj = 0; bj < 2; ++bj) { const f32x4 v0 = acc[ai][bj][m][0], v1 = acc[ai][bj][m][1];
                    u32x4 w; w.x = cvt_pk_bf16(v0[0], v0[1]); w.y = cvt_pk_bf16(v0[2], v0[3]); w.z = cvt_pk_bf16(v1[0], v1[1]); w.w = cvt_pk_bf16(v1[2], v1[3]);
                    *(u32x4*)(FOUR + (size_t)(tok0 + ai * 128 + m * 16) * 512 + ch0 + bj * 128) = w; }
    }
};
struct EpiMul {
    static constexpr bool PERM = true, AFTER_DRAIN = false;
    u16* O; const u16* GATES; int mode;
    __device__ __forceinline__ void operator()(const f32x4 (&acc)[2][2][4][2], const pg8::Unit& u, int wr, int wc, int fr, int fq) const {
        const int row0 = u.pm * 256 + wr * 64 + fr, col0 = u.pn * 256 + wc * 32 + 8 * fq;
        const int ld = mode == 0 ? 512 : 1024;
#pragma unroll
        for (int ai = 0; ai < 2; ++ai)
#pragma unroll
            for (int m = 0; m < 4; ++m)
#pragma unroll
                for (int bj = 0; bj < 2; ++bj) {
                    const int row = row0 + ai * 128 + m * 16, col = col0 + bj * 128;
                    u16* p = O + (size_t)row * ld + col;
                    float v[8];
#pragma unroll
                    for (int j = 0; j < 4; ++j) { v[j] = acc[ai][bj][m][0][j]; v[4 + j] = acc[ai][bj][m][1][j]; }
                    if (mode == 0) {
                        const u32x4 q = *(const u32x4*)p;
#pragma unroll
                        for (int j = 0; j < 4; ++j) { v[2 * j] *= bf2f(q[j] & 0xffffu); v[2 * j + 1] *= bf2f(q[j] >> 16); }
                    } else {
                        const u32x4 gq = *(const u32x4*)(GATES + (size_t)row * GLD + (mode == 2 ? 1024 : 0) + col);
#pragma unroll
                        for (int j = 0; j < 4; ++j) { v[2 * j] *= h2f(gq[j] & 0xffffu); v[2 * j + 1] *= h2f(gq[j] >> 16); }
                        if (mode == 2) { const u32x4 q = *(const u32x4*)p;
#pragma unroll
                            for (int j = 0; j < 4; ++j) { v[2 * j] += bf2f(q[j] & 0xffffu); v[2 * j + 1] += bf2f(q[j] >> 16); } }
                    }
                    u32x4 w; w.x = cvt_pk_bf16(v[0], v[1]); w.y = cvt_pk_bf16(v[2], v[3]); w.z = cvt_pk_bf16(v[4], v[5]); w.w = cvt_pk_bf16(v[6], v[7]);
                    *(u32x4*)p = w;
                }
    }
};

template <class Epi>
__device__ __forceinline__ void run_gemm(LAS unsigned char* lds, const u16* A, const u16* Bt, int M, int N, int K, const Epi& E) {
    pg8::Gemm g{A, Bt, M, N, K}; pg8::StaticOrder S; S.init(M, N, (int)gridDim.x, (int)blockIdx.x);
    pg8::gemm_phase<Epi, pg8::StaticOrder, false>(lds, g, S, E, nullptr);
}

__device__ __forceinline__ void transpose_tile(const float* src, int ld_src, int col0, int k0, int krows, u16* dst, int n0, int K, LAS float* tile) {
    const int t = threadIdx.x;
#pragma unroll
    for (int i = 0; i < 8; ++i) { const int kk = (t >> 6) + 8 * i, nn = t & 63;
        float v = 0.f; if (col0 >= 0 && k0 + kk < krows) v = src[(size_t)(k0 + kk) * ld_src + col0 + nn];
        tile[kk * 65 + nn] = v; }
    __syncthreads();
    const int nn = t >> 3, ks = (t & 7) * 8;
    float v[8];
#pragma unroll
    for (int j = 0; j < 8; ++j) v[j] = tile[(ks + j) * 65 + nn];
    u32x4 w; w.x = cvt_pk_bf16(v[0], v[1]); w.y = cvt_pk_bf16(v[2], v[3]); w.z = cvt_pk_bf16(v[4], v[5]); w.w = cvt_pk_bf16(v[6], v[7]);
    *(u32x4*)(dst + (size_t)(n0 + nn) * K + k0 + ks) = w;
    __syncthreads();
}

__device__ __forceinline__ void phase_prep(const Params& P, LAS unsigned char* lds) {
    LAS float* L = (LAS float*)lds;
    LAS float* tile = L;
    LAS float* cs128 = L + 4160; LAS float* sn128 = cs128 + 128;
    LAS float* cs64 = sn128 + 128;  LAS float* sn64 = cs64 + 64;
    LAS float* cs256 = sn64 + 64;   LAS float* sn256 = cs256 + 256;
    LAS float* frow = sn256 + 256;
    LAS float* sc = frow + 512;
    LAS float* red = sc + 9216;
    const int tid = threadIdx.x, G = gridDim.x, bid = blockIdx.x;
    unsigned char* ws = P.ws;
    if (tid < 256) { float s, c; sincospif(2.0f * (float)tid / 256.0f, &s, &c); cs256[tid] = c; sn256[tid] = s; }
    if (tid < 128) { float s, c; sincospif(2.0f * (float)tid / 128.0f, &s, &c); cs128[tid] = c; sn128[tid] = s; }
    if (tid < 64)  { float s, c; sincospif(2.0f * (float)tid / 64.0f, &s, &c); cs64[tid] = c; sn64[tid] = s; }
    __syncthreads();

    if (bid < 144) {
        for (int i = tid; i < 9216; i += 512) { const int v = i >> 10, k = i & 1023; const float x = v < 8 ? P.in[4][v * 1024 + k] : P.in[5][k]; sc[i] = x / (1.0f + expf(-x)); }
        __syncthreads();
        const int c = tid & 63, kg = tid >> 6; const float* aw = P.in[6] + bid * 64 + c;
        float a[9];
#pragma unroll
        for (int v = 0; v < 9; ++v) a[v] = 0.f;
        for (int k0 = kg; k0 < 1024; k0 += 64) {
            float w8[8];
#pragma unroll
            for (int u = 0; u < 8; ++u) w8[u] = aw[(size_t)(k0 + 8 * u) * 9216];
#pragma unroll
            for (int u = 0; u < 8; ++u)
#pragma unroll
                for (int v = 0; v < 9; ++v) a[v] += sc[v * 1024 + k0 + 8 * u] * w8[u]; }
#pragma unroll
        for (int v = 0; v < 9; ++v) red[(kg * 9 + v) * 64 + c] = a[v];
        __syncthreads();
        float* MOD = (float*)(ws + WS_MOD);
        for (int i = tid; i < 576; i += 512) { const int v = i >> 6, cc = i & 63; float s = 0.f;
#pragma unroll
            for (int q = 0; q < 8; ++q) s += red[(q * 9 + v) * 64 + cc];
            MOD[v * 9216 + bid * 64 + cc] = s + P.in[7][bid * 64 + cc]; }
        __syncthreads();
    }

    {
        const int total = 5792;
#define PREP_DECODE(Q, SRC, LD, KROWS, KD, COL0, N0, K0, DST) { \
            int j = 0, r = (Q), nk = 16; \
            PREP_STEP(0, 88 * 16, 44) PREP_STEP(1, 16 * 44, 16) PREP_STEP(2, 88 * 16, 44) PREP_STEP(3, 16 * 44, 16) \
            PREP_STEP(4, 64 * 16, 8) PREP_STEP(5, 16 * 8, 8) PREP_STEP(6, 16 * 8, 16) PREP_STEP(7, 16 * 16, 4) \
            const int tn = r / nk, tk = r % nk; N0 = tn * 64; K0 = tk * 64; COL0 = N0; \
            if (j == 0 || j == 2) { SRC = j == 0 ? P.in[9] : P.in[11]; LD = 5632; KROWS = 1024; KD = 1024; DST = (u16*)(ws + (j == 0 ? WS_W13A : WS_W13B)); \
                const int pn = N0 >> 8, rr = N0 & 255; COL0 = rr < 128 ? 128 * pn + rr : 2816 + 128 * pn + (rr - 128); } \
            else if (j == 1 || j == 3) { SRC = j == 1 ? P.in[10] : P.in[12]; LD = 1024; KROWS = 2816; KD = 2816; DST = (u16*)(ws + (j == 1 ? WS_W2A : WS_W2B)); } \
            else if (j == 4) { SRC = P.in[13]; LD = 4480; KROWS = 1024; KD = 1024; DST = (u16*)(ws + WS_WIN); \
                COL0 = N0 < 1920 ? N0 : (N0 < 2048 ? -1 : 2432 + (N0 - 2048)); } \
            else if (j == 5) { SRC = P.in[26]; LD = 1024; KROWS = 512; KD = 512; DST = (u16*)(ws + WS_WO); } \
            else if (j == 6) { SRC = P.in[27]; LD = 1024; KROWS = 512; KD = 512; DST = (u16*)(ws + WS_WF); } \
            else if (j == 7) { SRC = P.in[28]; LD = 1024; KROWS = 1024; KD = 1024; DST = (u16*)(ws + WS_WOUT); } \
            else { SRC = P.in[20]; LD = 512; KROWS = 128; KD = 256; DST = (u16*)(ws + WS_GUP); } }
#define PREP_STEP(JJ, CNT, NKN) if (j == JJ && r >= (CNT)) { r -= (CNT); j = JJ + 1; nk = NKN; }
#define PREP_LOAD(V, SRC, LD, KROWS, COL0, K0) { _Pragma("unroll") for (int i = 0; i < 8; ++i) { const int kk = (tid >> 6) + 8 * i, nn = tid & 63; \
            V[i] = ((COL0) >= 0 && (K0) + kk < (KROWS)) ? SRC[(size_t)((K0) + kk) * (LD) + (COL0) + nn] : 0.f; } }
        float cur[8], nxt[8];
        const float* srcc = nullptr; int ldc = 0, krc = 0, kdc = 0, colc = 0, n0c = 0, k0c = 0; u16* dstc = nullptr;
        if (bid < total) { PREP_DECODE(bid, srcc, ldc, krc, kdc, colc, n0c, k0c, dstc) PREP_LOAD(cur, srcc, ldc, krc, colc, k0c) }
        for (int q = bid; q < total; q += G) {
            const float* srcn = srcc; int ldn = ldc, krn = krc, kdn = kdc, coln = colc, n0n = n0c, k0n = k0c; u16* dstn = dstc;
            if (q + G < total) { PREP_DECODE(q + G, srcn, ldn, krn, kdn, coln, n0n, k0n, dstn) PREP_LOAD(nxt, srcn, ldn, krn, coln, k0n) }
#pragma unroll
            for (int i = 0; i < 8; ++i) tile[((tid >> 6) + 8 * i) * 65 + (tid & 63)] = cur[i];
            __syncthreads();
            { const int nn = tid >> 3, ks = (tid & 7) * 8; float v[8];
#pragma unroll
              for (int jj = 0; jj < 8; ++jj) v[jj] = tile[(ks + jj) * 65 + nn];
              u32x4 w; w.x = cvt_pk_bf16(v[0], v[1]); w.y = cvt_pk_bf16(v[2], v[3]); w.z = cvt_pk_bf16(v[4], v[5]); w.w = cvt_pk_bf16(v[6], v[7]);
              *(u32x4*)(dstc + (size_t)(n0c + nn) * kdc + k0c + ks) = w; }
            __syncthreads();
            srcc = srcn; ldc = ldn; krc = krn; kdc = kdn; colc = coln; n0c = n0n; k0c = k0n; dstc = dstn;
#pragma unroll
            for (int i = 0; i < 8; ++i) cur[i] = nxt[i];
        }
#undef PREP_STEP
#undef PREP_DECODE
#undef PREP_LOAD
    }

    {
        u16* WZ = (u16*)(ws + WS_WZ);
        for (int k = bid; k < 1024; k += G) {
            frow[tid] = P.in[13][(size_t)k * 4480 + 1920 + tid];
            __syncthreads();
#pragma unroll
            for (int rep = 0; rep < 2; ++rep) { const int zc = tid + rep * 512, g = zc >> 8, part = (zc >> 7) & 1, kn = zc & 127;
                const LAS float* tab = part ? sn128 : cs128; float s = 0.f;
                for (int n = 0; n < 128; ++n) s += frow[g * 128 + n] * tab[(kn * n) & 127];
                s *= 0.08838834764831845f; if (part) s = -s;
                WZ[(size_t)zc * 1024 + k] = (u16)(cvt_pk_bf16(s, 0.f) & 0xffffu); }
            __syncthreads();
        }
    }

    {
        u16* T = (u16*)(ws + WS_T);
        for (size_t vi = (size_t)bid * 512 + tid; vi < (size_t)4096 * 1024; vi += (size_t)G * 512) {
            const int row = (int)(vi >> 10), cv = (int)(vi & 1023) * 8, part = cv >> 12, r = (cv >> 6) & 63, c0 = cv & 63, kr = row >> 6, kc = row & 63;
            const LAS float* tab = part ? sn64 : cs64; const int base = kr * r;
            float v[8];
#pragma unroll
            for (int j = 0; j < 8; ++j) v[j] = tab[(base + kc * (c0 + j)) & 63] * 0.015625f;
            u32x4 w; w.x = cvt_pk_bf16(v[0], v[1]); w.y = cvt_pk_bf16(v[2], v[3]); w.z = cvt_pk_bf16(v[4], v[5]); w.w = cvt_pk_bf16(v[6], v[7]);
            *(u32x4*)(T + vi * 8) = w;
        }
        u16* T2 = (u16*)(ws + WS_T256);
        for (int vi = bid * 512 + tid; vi < 256 * 64; vi += G * 512) {
            const int kt = vi >> 6, cv = (vi & 63) * 8, part = cv >> 8, t0 = cv & 255;
            const LAS float* tab = part ? sn256 : cs256;
            float v[8];
#pragma unroll
            for (int j = 0; j < 8; ++j) v[j] = tab[(kt * (t0 + j)) & 255] * 0.0625f;
            u32x4 w; w.x = cvt_pk_bf16(v[0], v[1]); w.y = cvt_pk_bf16(v[2], v[3]); w.z = cvt_pk_bf16(v[4], v[5]); w.w = cvt_pk_bf16(v[6], v[7]);
            *(u32x4*)(T2 + (size_t)vi * 8) = w;
        }
    }
}

template <int CTRL> __device__ __forceinline__ float dpp_add(float v) {
    return v + __int_as_float(__builtin_amdgcn_update_dpp(0, __float_as_int(v), CTRL, 0xF, 0xF, true));
}
__device__ __forceinline__ float sum16(float v) {
    v = dpp_add<0xB1>(v); v = dpp_add<0x4E>(v); v = dpp_add<0x141>(v); v = dpp_add<0x140>(v); return v;
}
__device__ __forceinline__ float sum64(float v) {
    const float t = sum16(v);
    const int ti = __float_as_int(t);
    return __int_as_float(__builtin_amdgcn_readlane(ti, 0)) + __int_as_float(__builtin_amdgcn_readlane(ti, 16)) + __int_as_float(__builtin_amdgcn_readlane(ti, 32)) + __int_as_float(__builtin_amdgcn_readlane(ti, 48));
}
__device__ __forceinline__ float wave_sum(float v) {
#pragma unroll
    for (int o = 32; o >= 1; o >>= 1) v += __shfl_xor(v, o);
    return v;
}
__device__ __forceinline__ const float* norm_row(const Params& P, const float* X, int m) {
    return X ? X + (size_t)m * DM : (m < NPR ? P.in[0] + (size_t)m * DM : P.in[1] + (size_t)(m - NPR) * DM);
}
__device__ __forceinline__ void phase_norm(const Params& P, const float* X, int nwi, int slot_shift, int slot_scale, u16* H) {
    const int lane = threadIdx.x & 63, gw = blockIdx.x * 8 + (threadIdx.x >> 6), nw = gridDim.x * 8;
    const float* MOD = (const float*)(P.ws + WS_MOD); const float* normw = P.in[8] + nwi * 1024;
    f32x4 v[4], vn[4];
    if (gw < MT) { const float* xr = norm_row(P, X, gw);
#pragma unroll
        for (int i = 0; i < 4; ++i) v[i] = *(const f32x4*)(xr + i * 256 + lane * 4); }
    for (int m = gw; m < MT; m += nw) {
        const int mn = m + nw < MT ? m + nw : m;
        { const float* xr = norm_row(P, X, mn);
#pragma unroll
          for (int i = 0; i < 4; ++i) vn[i] = *(const f32x4*)(xr + i * 256 + lane * 4); }
        float ss = 0.f;
#pragma unroll
        for (int i = 0; i < 4; ++i) ss += v[i][0] * v[i][0] + v[i][1] * v[i][1] + v[i][2] * v[i][2] + v[i][3] * v[i][3];
        ss = sum64(ss);
        const float rs = rsqrtf(ss * (1.0f / 1024.0f) + 1e-6f);
        const float* md = MOD + (size_t)modidx_m(m) * 9216;
#pragma unroll
        for (int i = 0; i < 4; ++i) { const int c = i * 256 + lane * 4;
            const f32x4 w = *(const f32x4*)(normw + c), sc = *(const f32x4*)(md + slot_scale * 1024 + c), sh = *(const f32x4*)(md + slot_shift * 1024 + c);
            const f32x4 y = v[i] * rs * w * (sc + 1.0f) + sh;
            u32x2 o; o.x = cvt_pk_bf16(y[0], y[1]); o.y = cvt_pk_bf16(y[2], y[3]);
            *(u32x2*)(H + (size_t)m * DM + c) = o; }
#pragma unroll
        for (int i = 0; i < 4; ++i) v[i] = vn[i];
    }
}
__device__ __forceinline__ void phase_final_norm(const Params& P) {
    const int lane = threadIdx.x & 63, gw = blockIdx.x * 8 + (threadIdx.x >> 6), nw = gridDim.x * 8;
    const float* fw = P.in[29];
    f32x4 v[4], vn[4];
    if (gw < MT) { const float* xr = P.out + (size_t)gw * DM;
#pragma unroll
        for (int i = 0; i < 4; ++i) v[i] = *(const f32x4*)(xr + i * 256 + lane * 4); }
    for (int m = gw; m < MT; m += nw) {
        const int mn = m + nw < MT ? m + nw : m;
        { const float* xr = P.out + (size_t)mn * DM;
#pragma unroll
          for (int i = 0; i < 4; ++i) vn[i] = *(const f32x4*)(xr + i * 256 + lane * 4); }
        float ss = 0.f;
#pragma unroll
        for (int i = 0; i < 4; ++i) ss += v[i][0] * v[i][0] + v[i][1] * v[i][1] + v[i][2] * v[i][2] + v[i][3] * v[i][3];
        ss = sum64(ss);
        const float rs = rsqrtf(ss * (1.0f / 1024.0f) + 1e-6f);
        float* xo = P.out + (size_t)m * DM;
#pragma unroll
        for (int i = 0; i < 4; ++i) { const int c = i * 256 + lane * 4; *(f32x4*)(xo + c) = v[i] * rs * *(const f32x4*)(fw + c); }
#pragma unroll
        for (int i = 0; i < 4; ++i) v[i] = vn[i];
    }
}

__device__ __forceinline__ float dot4(const f32x4 a, const f32x4 b) {
    typedef float f32x2 __attribute__((ext_vector_type(2)));
    f32x2 p = (f32x2){a[0], a[1]} * (f32x2){b[0], b[1]};
    p = (f32x2){a[2], a[3]} * (f32x2){b[2], b[3]} + p;
    return p[0] + p[1];
}
__device__ __forceinline__ float fsig(float x) { return __builtin_amdgcn_rcpf(1.0f + __expf(-x)); }
struct ScanRegs { u32x2 r[3], k[3], v[3], wd, ad; };
__device__ __forceinline__ void scan_load(ScanRegs& R, const u16* U, int tok0, int T, int t, int h, int d, int cg) {
    const u32x2 z = {0u, 0u};
#pragma unroll
    for (int tap = 0; tap < 3; ++tap) { const int tn = t + tap - 1;
        if (tn >= 0 && tn < T) { const u16* row = U + (size_t)(tok0 + tn) * 1792 + h * 64 + 4 * cg;
            R.r[tap] = *(const u32x2*)row; R.k[tap] = *(const u32x2*)(row + 512); R.v[tap] = *(const u32x2*)(row + 1024); }
        else { R.r[tap] = z; R.k[tap] = z; R.v[tap] = z; } }
    const u16* row = U + (size_t)(tok0 + t) * 1792 + 1536 + d * 64 + 4 * cg;
    R.wd = *(const u32x2*)row; R.ad = *(const u32x2*)(row + 128);
}
__device__ __forceinline__ void unpack4h(const u32x2 q, float (&o)[4]) { o[0] = h2f(q.x & 0xffffu); o[1] = h2f(q.x >> 16); o[2] = h2f(q.y & 0xffffu); o[3] = h2f(q.y >> 16); }

#define LDS_BARRIER() do { asm volatile("s_waitcnt lgkmcnt(0)" ::: "memory"); __builtin_amdgcn_s_barrier(); asm volatile("" ::: "memory"); } while (0)
__device__ __forceinline__ void scan_unit(const Params& P, LAS float* L, int s, int h, int d, int half) {
    typedef float f32x16 __attribute__((ext_vector_type(16)));
    const int tid = threadIdx.x, lane = tid & 63;
    const bool producer = tid >= 256;
    const int T = s < 16 ? 256 : 4096, tok0 = s < 16 ? s * 256 : NPR + (s - 16) * 4096, nchunk = T / 32;
    const u16* U = (const u16*)(P.ws + WS_U16);
    u16* Od = (u16*)(P.ws + WS_H) + (size_t)d * MT * 512;
    float* BS = (float*)(P.ws + WS_BS);
    LAS float* cst = L;            LAS float* xwT = L + 1024;    LAS float* xaT = L + 3136;   LAS float* lora_s = L + 5248;
    LAS float* o_sb = L + 13440;   LAS float* cb = L + 15488;
    if (tid < 64) { const int c = tid, ch = h * 64 + c;
        cst[c] = P.in[16][d * 512 + ch]; cst[64 + c] = P.in[18][d * 512 + ch]; cst[128 + c] = P.in[21][ch]; cst[192 + c] = P.in[22][ch]; cst[256 + c] = P.in[23][ch];
#pragma unroll
        for (int ten = 0; ten < 3; ++ten)
#pragma unroll
            for (int tap = 0; tap < 3; ++tap) cst[(5 + ten * 3 + tap) * 64 + c] = P.in[15][tap * 1536 + ten * 512 + ch]; }
    const int c16 = tid & 15, rp = (tid >> 4) & 15, rA = half * 32 + rp, rB = rA + 16;
    f32x4 SA = {0.f, 0.f, 0.f, 0.f}, SB = {0.f, 0.f, 0.f, 0.f};
    if (!producer && s >= 16) { const float* st = (d ? P.in[3] : P.in[2]) + (size_t)((s - 16) * 8 + h) * 4096;
        SA = *(const f32x4*)(st + rA * 64 + 4 * c16); SB = *(const f32x4*)(st + rB * 64 + 4 * c16); }
    const int pt = tid - 256, pw = (pt >> 6) & 3, nt = pw & 1, kh = pw >> 1, li = lane & 31, lk = lane >> 5;
    float Bw[16], Ba[16];
    if (producer) {
#pragma unroll
        for (int s2 = 0; s2 < 16; ++s2) { const size_t o = (size_t)(d * 64 + kh * 32 + 2 * s2 + lk) * 512 + h * 64 + nt * 32 + li; Bw[s2] = P.in[17][o]; Ba[s2] = P.in[19][o]; }
    } else {
#pragma unroll
        for (int s2 = 0; s2 < 16; ++s2) { Bw[s2] = 0.f; Ba[s2] = 0.f; }
    }
    const int it0 = pt & 255, tt0 = it0 >> 4, cg0 = it0 & 15, tt1 = tt0 + 16, cg1 = cg0;
    ScanRegs R0, R1;
    if (producer) { scan_load(R0, U, tok0, T, d ? T - 1 - tt0 : tt0, h, d, cg0); scan_load(R1, U, tok0, T, d ? T - 1 - tt1 : tt1, h, d, cg1); }
    __syncthreads();
    float tpr[3][4], tpk[3][4], tpv[3][4], kkc4[4];
#pragma unroll
    for (int tap = 0; tap < 3; ++tap)
#pragma unroll
        for (int j = 0; j < 4; ++j) { tpr[tap][j] = cst[(5 + tap) * 64 + 4 * cg0 + j]; tpk[tap][j] = cst[(8 + tap) * 64 + 4 * cg0 + j]; tpv[tap][j] = cst[(11 + tap) * 64 + 4 * cg0 + j]; }
#pragma unroll
    for (int j = 0; j < 4; ++j) kkc4[j] = cst[128 + 4 * cg0 + j];
    for (int ci = -1; ci < nchunk; ++ci) {
        const int pc = ci + 1;
        LAS float* pb = cb + (pc & 1) * 12288;
        const LAS float* qb = cb + (ci & 1) * 12288;
        LAS float* o_s = o_sb + (ci & 1) * 1024;
        const bool do_prep = producer && pc < nchunk, do_step = !producer && ci >= 0;
        LAS float* r_s = pb; LAS float* w_s = pb + 2048; LAS float* kd_s = pb + 4096; LAS float* v_s = pb + 6144; LAS float* kk_s = pb + 8192; LAS float* kka_s = pb + 10240;
#define SCAN_STEPS(SEG) if (do_step) { float oAr[8], oBr[8]; float pA = 0.f, pB = 0.f;     \
        _Pragma("unroll") for (int u8 = 0; u8 < 8; ++u8) { const int tt = (SEG) * 8 + u8; \
            const f32x4 w4 = *(const LAS f32x4*)(qb + 2048 + tt * 64 + 4 * c16), kk4 = *(const LAS f32x4*)(qb + 8192 + tt * 64 + 4 * c16), ka4 = *(const LAS f32x4*)(qb + 10240 + tt * 64 + 4 * c16); \
            const f32x4 kd4 = *(const LAS f32x4*)(qb + 4096 + tt * 64 + 4 * c16), r4 = *(const LAS f32x4*)(qb + tt * 64 + 4 * c16); \
            const float vA = qb[6144 + tt * 64 + rA], vB = qb[6144 + tt * 64 + rB]; \
            float saA = dot4(SA, kk4), saB = dot4(SB, kk4); \
            saA = dpp_add<0xB1>(saA); saB = dpp_add<0xB1>(saB); pA = dpp_add<0xB1>(pA); pB = dpp_add<0xB1>(pB); \
            saA = dpp_add<0x4E>(saA); saB = dpp_add<0x4E>(saB); pA = dpp_add<0x4E>(pA); pB = dpp_add<0x4E>(pB); \
            saA = dpp_add<0x141>(saA); saB = dpp_add<0x141>(saB); pA = dpp_add<0x141>(pA); pB = dpp_add<0x141>(pB); \
            saA = dpp_add<0x140>(saA); saB = dpp_add<0x140>(saB); pA = dpp_add<0x140>(pA); pB = dpp_add<0x140>(pB); \
            if (u8 > 0) { oAr[u8 - 1] = pA; oBr[u8 - 1] = pB; } \
            SA = SA * w4 - ka4 * saA + kd4 * vA; SB = SB * w4 - ka4 * saB + kd4 * vB; \
            pA = dot4(SA, r4); pB = dot4(SB, r4); } \
        pA = dpp_add<0xB1>(pA); pB = dpp_add<0xB1>(pB); pA = dpp_add<0x4E>(pA); pB = dpp_add<0x4E>(pB); pA = dpp_add<0x141>(pA); pB = dpp_add<0x141>(pB); pA = dpp_add<0x140>(pA); pB = dpp_add<0x140>(pB); \
        oAr[7] = pA; oBr[7] = pB; \
        if (c16 == 0) { _Pragma("unroll") for (int u8 = 0; u8 < 8; ++u8) { o_s[((SEG) * 8 + u8) * 32 + rp] = oAr[u8]; o_s[((SEG) * 8 + u8) * 32 + 16 + rp] = oBr[u8]; } } }
        if (do_prep) {
#pragma unroll
            for (int it = 0; it < 2; ++it) { const ScanRegs& R = it ? R1 : R0; const int tt_a = it ? tt1 : tt0, cg = cg0;
                float rv[4] = {0.f, 0.f, 0.f, 0.f}, kv[4] = {0.f, 0.f, 0.f, 0.f}, vv[4] = {0.f, 0.f, 0.f, 0.f};
#pragma unroll
                for (int tap = 0; tap < 3; ++tap) { float a[4], bb[4], c[4]; unpack4h(R.r[tap], a); unpack4h(R.k[tap], bb); unpack4h(R.v[tap], c);
#pragma unroll
                    for (int j = 0; j < 4; ++j) { rv[j] += a[j] * tpr[tap][j]; kv[j] += bb[j] * tpk[tap][j]; vv[j] += c[j] * tpv[tap][j]; } }
                float kkr[4], ss = 0.f;
#pragma unroll
                for (int j = 0; j < 4; ++j) { kkr[j] = kv[j] * kkc4[j]; ss += kkr[j] * kkr[j]; }
                ss = sum16(ss);
                const float inv = __builtin_amdgcn_rsqf(fmaxf(ss, 1e-24f));
                float wdv[4], adv[4]; unpack4h(R.wd, wdv); unpack4h(R.ad, adv);
#pragma unroll
                for (int j = 0; j < 4; ++j) { const int o = tt_a * 64 + 4 * cg + j;
                    r_s[o] = rv[j]; v_s[o] = vv[j]; kd_s[o] = kv[j]; kk_s[o] = kkr[j] * inv;
                    xwT[(4 * cg + j) * 33 + tt_a] = 1.0f - 2.0f * __builtin_amdgcn_rcpf(1.0f + __expf(2.0f * wdv[j])); xaT[(4 * cg + j) * 33 + tt_a] = adv[j]; } }
            if (pc + 1 < nchunk) { const int q0 = (pc + 1) * 32 + tt0, q1 = (pc + 1) * 32 + tt1;
                scan_load(R0, U, tok0, T, d ? T - 1 - q0 : q0, h, d, cg0); scan_load(R1, U, tok0, T, d ? T - 1 - q1 : q1, h, d, cg1); }
        }
        SCAN_STEPS(0)
        LDS_BARRIER();
        if (do_prep) {
            f32x16 accw, acca;
#pragma unroll
            for (int i = 0; i < 16; ++i) { accw[i] = 0.f; acca[i] = 0.f; }
#pragma unroll
            for (int s2 = 0; s2 < 16; ++s2) { const int r = kh * 32 + 2 * s2 + lk;
                accw = __builtin_amdgcn_mfma_f32_32x32x2f32(xwT[r * 33 + li], Bw[s2], accw, 0, 0, 0);
                acca = __builtin_amdgcn_mfma_f32_32x32x2f32(xaT[r * 33 + li], Ba[s2], acca, 0, 0, 0); }
#pragma unroll
            for (int reg = 0; reg < 16; ++reg) { const int o = ((reg & 3) + 8 * (reg >> 2) + 4 * lk) * 64 + nt * 32 + li;
                lora_s[(0 * 2 + kh) * 2048 + o] = accw[reg]; lora_s[(1 * 2 + kh) * 2048 + o] = acca[reg]; }
        }
        SCAN_STEPS(1)
        LDS_BARRIER();
        if (do_prep) {
            const f32x4 w0c4 = *(const LAS f32x4*)(cst + 4 * cg0), a0c4 = *(const LAS f32x4*)(cst + 64 + 4 * cg0), kac4 = *(const LAS f32x4*)(cst + 192 + 4 * cg0), rkc4 = *(const LAS f32x4*)(cst + 256 + 4 * cg0);
#pragma unroll
            for (int it = 0; it < 2; ++it) { const int tt = it ? tt1 : tt0, o = tt * 64 + 4 * cg0;
                const f32x4 l0 = *(const LAS f32x4*)(lora_s + o), l1 = *(const LAS f32x4*)(lora_s + 2048 + o), l2 = *(const LAS f32x4*)(lora_s + 4096 + o), l3 = *(const LAS f32x4*)(lora_s + 6144 + o);
                const f32x4 k4 = *(const LAS f32x4*)(kd_s + o), kkv = *(const LAS f32x4*)(kk_s + o), r4v = *(const LAS f32x4*)(r_s + o);
                f32x4 wo, kdo, kao; float bs = 0.f;
#pragma unroll
                for (int j = 0; j < 4; ++j) {
                    const float w = __expf(-0.6065306597f * fsig(w0c4[j] + l0[j] + l1[j]));
                    const float a = fsig(a0c4[j] + l2[j] + l3[j]);
                    const float kd = k4[j] * (1.0f + (a - 1.0f) * kac4[j]);
                    wo[j] = w; kdo[j] = kd; kao[j] = kkv[j] * a; bs += r4v[j] * kd * rkc4[j]; }
                *(LAS f32x4*)(w_s + o) = wo; *(LAS f32x4*)(kd_s + o) = kdo; *(LAS f32x4*)(kka_s + o) = kao;
                bs = sum16(bs);
                if (cg0 == 0 && half == 0) { const int q = pc * 32 + tt, t = d ? T - 1 - q : q; BS[(size_t)(tok0 + t) * 16 + h * 2 + d] = bs; } }
        }
        SCAN_STEPS(2)
        LDS_BARRIER();
        SCAN_STEPS(3)
        LDS_BARRIER();
        if (do_step) { const int tt = tid >> 3, seg = tid & 7, q = ci * 32 + tt, t = d ? T - 1 - q : q;
            u32x2 w2; w2.x = cvt_pk_bf16(o_s[tt * 32 + 4 * seg], o_s[tt * 32 + 4 * seg + 1]); w2.y = cvt_pk_bf16(o_s[tt * 32 + 4 * seg + 2], o_s[tt * 32 + 4 * seg + 3]);
            *(u32x2*)(Od + (size_t)(tok0 + t) * 512 + h * 64 + half * 32 + 4 * seg) = w2; }
#undef SCAN_STEPS
    }
    if (!producer && s < 16) { float* so = P.out + OUT_STATE + (size_t)d * 524288 + (size_t)(s * 8 + h) * 4096;
        *(f32x4*)(so + rA * 64 + 4 * c16) = SA; *(f32x4*)(so + rB * 64 + 4 * c16) = SB; }
    __syncthreads();
}
__device__ __forceinline__ void phase_scan(const Params& P, LAS unsigned char* lds) {
    for (int q = blockIdx.x; q < 768; q += gridDim.x) {
        int s, rem;
        if (q < 256) { s = 16 + (q >> 5); rem = q & 31; } else { const int p = q - 256; s = p >> 5; rem = p & 31; }
        scan_unit(P, (LAS float*)lds, s, rem >> 2, (rem >> 1) & 1, rem & 1);
    }
}

struct PostRaw { unsigned of, ob, v0, v1, v2, sg; float b0, b1; };
__device__ __forceinline__ void post_load(PostRaw& r, int m, int ch, int h, int lane, const u16* OF, const u16* OB, const u16* U, const float* BS, const u16* GT) {
    const int T = m < NPR ? 256 : 4096, t = m < NPR ? (m & 255) : ((m - NPR) & 4095);
    r.of = OF[(size_t)m * 512 + ch]; r.ob = OB[(size_t)m * 512 + ch];
    r.v1 = U[(size_t)m * 1792 + 1024 + ch];
    r.v0 = t > 0 ? U[(size_t)(m - 1) * 1792 + 1024 + ch] : 0u;
    r.v2 = t < T - 1 ? U[(size_t)(m + 1) * 1792 + 1024 + ch] : 0u;
    r.sg = *(const unsigned*)(GT + (size_t)m * GLD + 2048 + 2 * lane);
    r.b0 = BS[(size_t)m * 16 + h * 2]; r.b1 = BS[(size_t)m * 16 + h * 2 + 1];
}
__device__ __forceinline__ void phase_post(const Params& P, LAS unsigned char* lds) {
    const int lane = threadIdx.x & 63, h = threadIdx.x >> 6, ch = h * 64 + lane, G = gridDim.x;
    const u16* OF = (const u16*)(P.ws + WS_H); const u16* OB = OF + (size_t)MT * 512;
    const u16* U = (const u16*)(P.ws + WS_U16); const float* BS = (const float*)(P.ws + WS_BS);
    u16* OPRE = (u16*)(P.ws + WS_OPRE); const u16* GT = (const u16*)(P.ws + WS_R);
    LAS float* sgl = (LAS float*)lds + h * 128;
    float gu[128];
#pragma unroll
    for (int k = 0; k < 128; ++k) gu[k] = P.in[20][(size_t)k * 512 + ch];
    const float lw = P.in[24][ch], lb = P.in[25][ch];
    const float cv0 = P.in[15][0 * 1536 + 1024 + ch], cv1 = P.in[15][1 * 1536 + 1024 + ch], cv2 = P.in[15][2 * 1536 + 1024 + ch];
    PostRaw cur, nxt;
    int m = blockIdx.x;
    post_load(cur, m, ch, h, lane, OF, OB, U, BS, GT);
    for (; m < MT; m += G) {
        const int mn = m + G < MT ? m + G : m;
        post_load(nxt, mn, ch, h, lane, OF, OB, U, BS, GT);
        sgl[2 * lane] = h2f(cur.sg & 0xffffu); sgl[2 * lane + 1] = h2f(cur.sg >> 16);
        const float o = bf2f(cur.of) + bf2f(cur.ob);
        const float mean = sum64(o) * (1.0f / 64.0f), d = o - mean;
        const float rstd = rsqrtf(sum64(d * d) * (1.0f / 64.0f) + 64e-5f);
        const float v = h2f(cur.v0) * cv0 + h2f(cur.v1) * cv1 + h2f(cur.v2) * cv2;
        float g0 = 0.f, g1 = 0.f, g2 = 0.f, g3 = 0.f;
#pragma unroll
        for (int k = 0; k < 128; k += 4) { const f32x4 s4 = *(const LAS f32x4*)(sgl + k);
            g0 += s4[0] * gu[k]; g1 += s4[1] * gu[k + 1]; g2 += s4[2] * gu[k + 2]; g3 += s4[3] * gu[k + 3]; }
        const float y = (d * rstd * lw + lb + (cur.b0 + cur.b1) * v) * ((g0 + g1) + (g2 + g3));
        OPRE[(size_t)m * 512 + ch] = (u16)(cvt_pk_bf16(y, 0.f) & 0xffffu);
        cur = nxt;
    }
}


constexpr size_t WS_BAR = WS_END + 65536;
static_assert(WS_BAR + 4096 <= (size_t)536870912, "barrier words");
__device__ __forceinline__ void fast_grid_sync(unsigned char* ws, unsigned k) {
    asm volatile("s_waitcnt vmcnt(0) lgkmcnt(0)" ::: "memory");
    __builtin_amdgcn_s_barrier();
    if (threadIdx.x == 0) {
        unsigned* bar = (unsigned*)(ws + WS_BAR);
        const unsigned G = gridDim.x, g = blockIdx.x & 7u, gsz = (G - g + 7u) >> 3, ngrp = G < 8u ? G : 8u;
        __builtin_amdgcn_fence(__ATOMIC_RELEASE, "agent");
        asm volatile("s_waitcnt vmcnt(0)" ::: "memory");
        const unsigned old = __hip_atomic_fetch_add(bar + g * 32, 1u, __ATOMIC_RELAXED, __HIP_MEMORY_SCOPE_AGENT);
        if (old + 1u == k * gsz) __hip_atomic_fetch_add(bar + 8 * 32, 1u, __ATOMIC_RELAXED, __HIP_MEMORY_SCOPE_AGENT);
        unsigned spins = 0;
        while (__hip_atomic_load(bar + 8 * 32, __ATOMIC_RELAXED, __HIP_MEMORY_SCOPE_AGENT) < k * ngrp) { if (++spins > (1u << 26)) break; }
        __builtin_amdgcn_fence(__ATOMIC_ACQUIRE, "agent");
        asm volatile("s_waitcnt vmcnt(0)" ::: "memory");
    }
    __builtin_amdgcn_s_barrier();
    asm volatile("" ::: "memory");
}

__global__ void __launch_bounds__(512, 2) fwd_mega(Params P) {
    extern __shared__ __attribute__((aligned(16))) unsigned char lds_raw[];
    LAS unsigned char* lds = (LAS unsigned char*)lds_raw;
    cg::grid_group grid = cg::this_grid();
    if (threadIdx.x < 32) { const int i = threadIdx.x; const unsigned long long v = i < 30 ? (unsigned long long)P.in[i] : (i == 30 ? (unsigned long long)P.out : (unsigned long long)P.ws);
        *(LAS unsigned long long*)(lds + PTAB_OFF + i * 8) = v; }
    __syncthreads();
unsigned bark_ = 0; unsigned char* P_ws_ = P.ws;
#define PH_BEGIN { const Params Q = get_params(lds); unsigned char* ws = Q.ws; (void)ws;
#define PH_END } asm volatile("s_waitcnt vmcnt(0)" ::: "memory");   grid.sync();
#define PH_ENDF } fast_grid_sync(P_ws_, ++bark_);
    if (blockIdx.x == 0 && threadIdx.x < 9) ((unsigned*)(P.ws + WS_BAR))[threadIdx.x * 32] = 0u;
    PH_BEGIN phase_prep(Q, lds); PH_END
    PH_BEGIN phase_norm(Q, nullptr, 0, 0, 1, (u16*)(ws + WS_H)); PH_ENDF
    PH_BEGIN run_gemm(lds, (const u16*)(ws + WS_H), (const u16*)(ws + WS_W13A), MT, 5632, 1024, EpiSwiglu{(u16*)(ws + WS_BIG)}); PH_ENDF
    PH_BEGIN run_gemm(lds, (const u16*)(ws + WS_BIG), (const u16*)(ws + WS_W2A), MT, 1024, 2816, EpiResid{Q.in[0], Q.in[1], Q.out, (const float*)(ws + WS_MOD), 2, 0.5f}); PH_ENDF
    PH_BEGIN phase_norm(Q, Q.out, 1, 3, 4, (u16*)(ws + WS_H)); PH_ENDF
    PH_BEGIN run_gemm(lds, (const u16*)(ws + WS_WZ), (const u16*)(ws + WS_H), 1024, MT, 1024, EpiZT{(u16*)(ws + WS_ZL)}); PH_ENDF
    PH_BEGIN run_gemm(lds, (const u16*)(ws + WS_T), (const u16*)(ws + WS_ZL), 4096, 4096, 8192, EpiFour{(u16*)(ws + WS_FOUR), 1});
             run_gemm(lds, (const u16*)(ws + WS_T256), (const u16*)(ws + WS_ZP), 256, 8192, 512, EpiFour{(u16*)(ws + WS_FOUR), 0}); PH_ENDF
    PH_BEGIN run_gemm(lds, (const u16*)(ws + WS_H), (const u16*)(ws + WS_WIN), MT, 4096, 1024, EpiU{(u16*)(ws + WS_U16), (u16*)(ws + WS_SG), (u16*)(ws + WS_R), Q.in[14]}); PH_ENDF
    PH_BEGIN phase_scan(Q, lds); PH_ENDF
    PH_BEGIN phase_post(Q, lds); PH_ENDF
    PH_BEGIN run_gemm(lds, (const u16*)(ws + WS_OPRE), (const u16*)(ws + WS_WO), MT, 1024, 512, EpiMul{(u16*)(ws + WS_H), (const u16*)(ws + WS_R), 1}); PH_ENDF
    PH_BEGIN run_gemm(lds, (const u16*)(ws + WS_FOUR), (const u16*)(ws + WS_WF), MT, 1024, 512, EpiMul{(u16*)(ws + WS_H), (const u16*)(ws + WS_R), 2}); PH_ENDF
    PH_BEGIN run_gemm(lds, (const u16*)(ws + WS_H), (const u16*)(ws + WS_WOUT), MT, 1024, 1024, EpiResid{nullptr, nullptr, Q.out, (const float*)(ws + WS_MOD), 5, 1.0f}); PH_ENDF
    PH_BEGIN phase_norm(Q, Q.out, 2, 6, 7, (u16*)(ws + WS_H)); PH_ENDF
    PH_BEGIN run_gemm(lds, (const u16*)(ws + WS_H), (const u16*)(ws + WS_W13B), MT, 5632, 1024, EpiSwiglu{(u16*)(ws + WS_BIG)}); PH_ENDF
    PH_BEGIN run_gemm(lds, (const u16*)(ws + WS_BIG), (const u16*)(ws + WS_W2B), MT, 1024, 2816, EpiResid{nullptr, nullptr, Q.out, (const float*)(ws + WS_MOD), 8, 0.5f}); PH_ENDF
    { const Params Q = get_params(lds); phase_final_norm(Q); }
#undef PH_BEGIN
#undef PH_END
#undef PH_ENDF
}

extern "C" void kernel_launch(void* const* d_in, const int* in_sizes, int n_in, void* d_out, int out_size, void* d_ws, size_t ws_size, hipStream_t stream) {
    static int grid_blocks = 0;
    if (grid_blocks == 0) {
        if (n_in != 30 || ws_size < WS_END) { fprintf(stderr, "kernel_launch: unexpected n_in %d / ws_size %zu (need %zu)\n", n_in, ws_size, (size_t)WS_END); grid_blocks = -1; return; }
        int dev = 0, cus = 0, per_cu = 0;
        (void)hipGetDevice(&dev);
        (void)hipDeviceGetAttribute(&cus, hipDeviceAttributeMultiprocessorCount, dev);
        (void)hipFuncSetAttribute((const void*)fwd_mega, hipFuncAttributeMaxDynamicSharedMemorySize, LDS_BYTES);
        (void)hipOccupancyMaxActiveBlocksPerMultiprocessor(&per_cu, (const void*)fwd_mega, 512, LDS_BYTES);
        if (per_cu < 1) { fprintf(stderr, "kernel_launch: occupancy query reports %d blocks per CU\n", per_cu); per_cu = 1; }
        if (per_cu > 1) per_cu = 1;
        grid_blocks = cus * per_cu;
        (void)hipGetLastError();
    }
    if (grid_blocks < 0) return;
    Params p{};
    for (int i = 0; i < 30; ++i) p.in[i] = (const float*)d_in[i];
    p.out = (float*)d_out; p.ws = (unsigned char*)d_ws;
    void* args[] = {&p};
    hipError_t e = hipLaunchCooperativeKernel((const void*)fwd_mega, dim3(grid_blocks), dim3(512), args, LDS_BYTES, stream);
    if (e != hipSuccess) fprintf(stderr, "cooperative launch failed: %s (grid %d)\n", hipGetErrorString(e), grid_blocks);
}
```

```cpp
#include <hip/hip_runtime.h>
#include <hip/hip_cooperative_groups.h>
#include <cstdio>
namespace cg = cooperative_groups;
namespace pg8 {
#define PG8_LAS __attribute__((address_space(3)))
typedef unsigned short bf16_t;
typedef short bf16x8 __attribute__((ext_vector_type(8)));
typedef float f32x4 __attribute__((ext_vector_type(4)));
typedef unsigned u32x4 __attribute__((ext_vector_type(4)));
constexpr int BM = 256, BK = 64, HALF = 128, HTB = HALF * BK * 2  , STAGE_BYTES = 8 * HTB, NXCD = 8, WGM = 8;

__host__ __device__ __forceinline__ int lds_byte(int r, int c) { const int st = (r >> 4) * 2 + (c >> 5), rr = r & 15, cc = c & 31, ob = rr * 64 + cc * 2; return st * 1024 + (ob ^ (((ob >> 9) & 1) << 5)); }
__host__ __device__ __forceinline__ void stage_rc(int b, int& R, int& C) { const int st = b / 1024, sb = b % 1024, swz = sb ^ (((sb >> 9) & 1) << 5); R = (st >> 1) * 16 + swz / 64; C = (st & 1) * 32 + (swz % 64) / 2; }
__host__ __device__ __forceinline__ int perm32(int rho) { const int n = rho >> 4, i = rho & 15; return 8 * (i >> 2) + 4 * n + (i & 3); }

struct Unit { int pm, pn; };
struct Gemm { const bf16_t* A; const bf16_t* Bt; int M, N, K; };

struct StaticOrder {
    int nM, nN, nwg, G, c;
    __host__ __device__ __forceinline__ void init(int M, int N, int G_, int c_) { nM = M / BM; nN = N / BM; nwg = nM * nN; G = G_; c = c_; }
    __host__ __device__ __forceinline__ bool next(int i, Unit& u) const {
        const long L = (long)i * G + c; if (L >= nwg) return false;
        int wgid = (int)L; { const int q = nwg / NXCD, r = nwg % NXCD, xcd = wgid % NXCD, off = wgid / NXCD; wgid = (xcd < r ? xcd * (q + 1) : r * (q + 1) + (xcd - r) * q) + off; }
        const int nig = WGM * nN, gid = wgid / nig, fm = gid * WGM, gsz = (nM - fm) < WGM ? (nM - fm) : WGM;
        u.pm = fm + ((wgid % nig) % gsz); u.pn = (wgid % nig) / gsz; return true;
    }
    __device__ __forceinline__ void a_ready(const Unit&) const {}
    __device__ __forceinline__ void done(const Unit&) const {}
};
__device__ __forceinline__ unsigned cvt_pk_bf16(float lo, float hi) { unsigned r; asm volatile("v_cvt_pk_bf16_f32 %0, %1, %2" : "=v"(r) : "v"(lo), "v"(hi)); return r; }
template <class Epi, class Sched, bool STAMP = false>
__device__ __forceinline__ void gemm_phase(PG8_LAS unsigned char* lds, const Gemm g, const Sched& S, const Epi& E, unsigned long long* stamps) {
    int tid_ = threadIdx.x; asm volatile("" : "+v"(tid_));
    const int tid = tid_, wid = __builtin_amdgcn_readfirstlane(tid >> 6), lane = tid & 63, wr = wid >> 2, wc = wid & 3, fr = lane & 15, fq = lane >> 4;
    const int K = g.K, nt = K / BK;
    int ts_lo = 0, ts_hi = 0, nts = 0; const unsigned long long rt_entry = STAMP ? (unsigned long long)wall_clock64() : 0ull;
#define PG8_STAMP() do { if (STAMP && wid == 0 && nts < 64) { const unsigned long long _c = (unsigned long long)clock64(); \
        ts_lo = (lane == nts) ? (int)(unsigned)_c : ts_lo; ts_hi = (lane == nts) ? (int)(unsigned)(_c >> 32) : ts_hi; ++nts; } } while (0)
    PG8_STAMP();
    unsigned voffA[2], voffB[2];
#pragma unroll
    for (int i = 0; i < 2; ++i) { int R, C; stage_rc(tid * 16 + i * 8192, R, C); const int Rb = Epi::PERM ? ((R & ~31) + perm32(R & 31)) : R;
        voffA[i] = (unsigned)(R * K + C) * 2u; voffB[i] = (unsigned)(Rb * K + C) * 2u; }
    const size_t kstep = (size_t)(BK * 2);
    const size_t hstep = (size_t)HALF * K * 2;
    const size_t tstep = 2 * hstep;
    const unsigned ldsw = (unsigned)wid * 1024u;
    const int aoff = lds_byte(wr * 64 + fr, fq * 8), boff = lds_byte(wc * 32 + fr, fq * 8);
#define PG8_SA(b, h) (((b) * 2 + (h)) * HTB)
#define PG8_SB(b, h) ((4 + (b) * 2 + (h)) * HTB)
#define PG8_STAGE(bufoff, gbase, voff) do { _Pragma("unroll") for (int _i = 0; _i < 2; ++_i) \
        __builtin_amdgcn_global_load_lds((const unsigned*)((const char*)(gbase) + (voff)[_i]), (PG8_LAS unsigned*)(lds + (bufoff) + ldsw + _i * 8192), 16, 0, 0); } while (0)
#define PG8_LDA(dst, b, h) do { _Pragma("unroll") for (int m = 0; m < 4; ++m) _Pragma("unroll") for (int k = 0; k < 2; ++k) dst[m][k] = *(const PG8_LAS bf16x8*)(lds + PG8_SA(b, h) + aoff + m * 2048 + k * 1024); } while (0)
#define PG8_LDB(dst, b, h) do { _Pragma("unroll") for (int n = 0; n < 2; ++n) _Pragma("unroll") for (int k = 0; k < 2; ++k) dst[n][k] = *(const PG8_LAS bf16x8*)(lds + PG8_SB(b, h) + boff + n * 2048 + k * 1024); } while (0)
#define PG8_MMA(ai, bj, At, Bt) do { __builtin_amdgcn_s_setprio(1); _Pragma("unroll") for (int m = 0; m < 4; ++m) _Pragma("unroll") for (int n = 0; n < 2; ++n) _Pragma("unroll") for (int k = 0; k < 2; ++k) \
        acc[ai][bj][m][n] = __builtin_amdgcn_mfma_f32_16x16x32_bf16(Bt[n][k], At[m][k], acc[ai][bj][m][n], 0, 0, 0); __builtin_amdgcn_s_setprio(0); } while (0)
#define PG8_WAIT_V(n) asm volatile("s_waitcnt vmcnt(" #n ")" ::: "memory")
#define PG8_WAIT_L(n) asm volatile("s_waitcnt lgkmcnt(" #n ")" ::: "memory")
#define PG8_BAR __builtin_amdgcn_s_barrier()
#define PG8_SCHED __builtin_amdgcn_sched_barrier(0)
    Unit cur, nxt; int ui = 0;
    if (!S.next(0, cur)) return;
    f32x4 acc[2][2][4][2];
#pragma unroll
    for (int a = 0; a < 2; ++a)
#pragma unroll
        for (int b = 0; b < 2; ++b)
#pragma unroll
            for (int m = 0; m < 4; ++m)
#pragma unroll
                for (int n = 0; n < 2; ++n) acc[a][b][m][n] = (f32x4){0.f, 0.f, 0.f, 0.f};
    bf16x8 At[4][2], B0[2][2], B1[2][2];
    const char* cA = (const char*)g.A + (size_t)cur.pm * tstep; const char* cB = (const char*)g.Bt + (size_t)cur.pn * tstep;
    S.a_ready(cur);
    PG8_STAGE(PG8_SB(0, 0), cB, voffB); PG8_STAGE(PG8_SA(0, 0), cA, voffA); PG8_STAGE(PG8_SB(0, 1), cB + hstep, voffB); PG8_STAGE(PG8_SA(0, 1), cA + hstep, voffA);
    if (wr == 1) PG8_BAR;
    PG8_WAIT_V(4); PG8_BAR;
    PG8_STAGE(PG8_SB(1, 0), cB + kstep, voffB); PG8_STAGE(PG8_SA(1, 0), cA + kstep, voffA); PG8_STAGE(PG8_SB(1, 1), cB + hstep + kstep, voffB);
    PG8_WAIT_V(6); PG8_BAR;
    PG8_STAMP();
    for (;;) {
        const bool has_next = S.next(ui + 1, nxt);
        const char* nA = has_next ? (const char*)g.A + (size_t)nxt.pm * tstep : cA; const char* nB = has_next ? (const char*)g.Bt + (size_t)nxt.pn * tstep : cB;
        for (int t = 0; t < nt; t += 2) {
            const bool last = (t == nt - 2);
            const char* a1 = cA + (size_t)(t + 1) * kstep;
            const char* a2 = last ? nA : cA + (size_t)(t + 2) * kstep; const char* b2 = last ? nB : cB + (size_t)(t + 2) * kstep;
            const char* a3 = a2 + kstep; const char* b3 = b2 + kstep;
            if (last && has_next) S.a_ready(nxt);
            PG8_LDB(B0, 0, 0); PG8_SCHED; PG8_LDA(At, 0, 0); PG8_STAGE(PG8_SA(1, 1), a1 + hstep, voffA);
            PG8_WAIT_L(8); PG8_BAR; PG8_WAIT_L(0); PG8_MMA(0, 0, At, B0); PG8_BAR; PG8_SCHED;
            PG8_LDB(B1, 0, 1); PG8_STAGE(PG8_SB(0, 0), b2, voffB);
            PG8_BAR; PG8_WAIT_L(0); PG8_MMA(0, 1, At, B1); PG8_BAR;
            PG8_LDA(At, 0, 1); PG8_STAGE(PG8_SA(0, 0), a2, voffA);
            PG8_BAR; PG8_WAIT_L(0); PG8_MMA(1, 0, At, B0); PG8_BAR; PG8_SCHED;
            PG8_STAGE(PG8_SB(0, 1), b2 + hstep, voffB);
            PG8_WAIT_V(6); PG8_BAR; PG8_MMA(1, 1, At, B1); PG8_BAR;
            PG8_LDB(B0, 1, 0); PG8_SCHED; PG8_LDA(At, 1, 0); PG8_STAGE(PG8_SA(0, 1), a2 + hstep, voffA);
            PG8_WAIT_L(8); PG8_BAR; PG8_WAIT_L(0); PG8_MMA(0, 0, At, B0); PG8_BAR; PG8_SCHED;
            PG8_LDB(B1, 1, 1); PG8_STAGE(PG8_SB(1, 0), b3, voffB);
            PG8_BAR; PG8_WAIT_L(0); PG8_MMA(0, 1, At, B1); PG8_BAR;
            PG8_LDA(At, 1, 1); PG8_STAGE(PG8_SA(1, 0), a3, voffA);
            PG8_BAR; PG8_WAIT_L(0); PG8_MMA(1, 0, At, B0); PG8_BAR; PG8_SCHED;
            PG8_STAGE(PG8_SB(1, 1), b3 + hstep, voffB);
            PG8_WAIT_V(6); PG8_BAR; PG8_MMA(1, 1, At, B1); PG8_BAR;
        }
        PG8_STAMP();
        if constexpr (!Epi::AFTER_DRAIN) { E(acc, cur, wr, wc, fr, fq); S.done(cur); }
        PG8_STAMP();
        if (!has_next) break;
#pragma unroll
        for (int a = 0; a < 2; ++a)
#pragma unroll
            for (int b = 0; b < 2; ++b)
#pragma unroll
                for (int m = 0; m < 4; ++m)
#pragma unroll
                    for (int n = 0; n < 2; ++n) acc[a][b][m][n] = (f32x4){0.f, 0.f, 0.f, 0.f};
        cur = nxt; cA = nA; cB = nB; ++ui;
    }
    PG8_WAIT_V(0);
    if (wr == 0) PG8_BAR;
    PG8_BAR;
    if constexpr (Epi::AFTER_DRAIN) { E.fused(acc, cur, wr, wc, fr, fq, lds, wid, lane); S.done(cur); }
    PG8_STAMP();
    if (STAMP && wid == 0) { stamps[lane] = lane < nts ? (((unsigned long long)(unsigned)ts_hi << 32) | (unsigned)ts_lo) : 0ull;
        if (lane == 62) stamps[62] = rt_entry; if (lane == 63) stamps[63] = (unsigned long long)wall_clock64(); }
#undef PG8_STAMP
#undef PG8_SA
#undef PG8_SB
#undef PG8_STAGE
#undef PG8_LDA
#undef PG8_LDB
#undef PG8_MMA
#undef PG8_WAIT_V
#undef PG8_WAIT_L
#undef PG8_BAR
#undef PG8_SCHED
}
}

#define LAS __attribute__((address_space(3)))
typedef unsigned short u16;
typedef float f32x4 __attribute__((ext_vector_type(4)));
typedef unsigned u32x4 __attribute__((ext_vector_type(4)));
typedef unsigned u32x2 __attribute__((ext_vector_type(2)));
using pg8::cvt_pk_bf16;

constexpr int MT = 36864, NPR = 4096, DM = 1024, DFF = 2816;
constexpr int OUT_STATE = MT * DM;
constexpr int LDS_BYTES = 163840, PTAB_OFF = 163840 - 256;

constexpr size_t SZ_W13 = (size_t)5632 * 1024 * 2, SZ_W2 = (size_t)1024 * 2816 * 2;
constexpr size_t WS_W13A = 0, WS_W2A = WS_W13A + SZ_W13, WS_W13B = WS_W2A + SZ_W2, WS_W2B = WS_W13B + SZ_W13;
constexpr size_t WS_WIN = WS_W2B + SZ_W2;
constexpr size_t WS_WZ = WS_WIN + (size_t)4096 * 1024 * 2;
constexpr size_t WS_WO = WS_WZ + (size_t)1024 * 1024 * 2;
constexpr size_t WS_WF = WS_WO + (size_t)1024 * 512 * 2;
constexpr size_t WS_WOUT = WS_WF + (size_t)1024 * 512 * 2;
constexpr size_t WS_GUP = WS_WOUT + (size_t)1024 * 1024 * 2;
constexpr size_t WS_MOD = WS_GUP + (size_t)512 * 256 * 2;
constexpr size_t WS_BS = WS_MOD + (size_t)9 * 9216 * 4;
constexpr size_t WS_SG = WS_BS + (size_t)MT * 16 * 4;
constexpr size_t WS_H = WS_SG + (size_t)MT * 256 * 2;
constexpr size_t WS_BIG = WS_H + (size_t)MT * 1024 * 2;
constexpr size_t WS_U16 = WS_BIG;
constexpr size_t WS_FOUR = WS_U16 + (size_t)MT * 1792 * 2;
constexpr size_t WS_OPRE = WS_FOUR + (size_t)MT * 512 * 2;
constexpr size_t WS_R = WS_BIG + (size_t)MT * 2816 * 2;
constexpr size_t WS_T = WS_R;
constexpr size_t WS_T256 = WS_T + (size_t)4096 * 8192 * 2;
constexpr size_t WS_ZL = WS_T256 + (size_t)256 * 512 * 2;
constexpr size_t WS_ZP = WS_ZL + (size_t)4096 * 8192 * 2;
constexpr int GLD = 2304;
constexpr size_t WS_END = WS_R + (size_t)MT * GLD * 2;
static_assert(WS_ZP + (size_t)8192 * 512 * 2 <= WS_END, "R region");
static_assert(WS_OPRE + (size_t)MT * 512 * 2 <= WS_R, "BIG region");
static_assert(WS_END <= (size_t)536870912, "workspace");
static_assert(WS_ZP == WS_ZL + (size_t)4096 * 8192 * 2, "ZP behind ZL");

struct Params { const float* in[30]; float* out; unsigned char* ws; };
__device__ __forceinline__ unsigned long long ld_ptr(LAS unsigned char* lds, int i) {
    const u32x2 v = *(const LAS u32x2*)(lds + PTAB_OFF + i * 8);
    const unsigned lo = __builtin_amdgcn_readfirstlane(v.x), hi = __builtin_amdgcn_readfirstlane(v.y);
    return ((unsigned long long)hi << 32) | lo;
}
template <class T> __device__ __forceinline__ T* as_global(unsigned long long v) {
    return (T*)(__attribute__((address_space(1))) T*)v;
}
__device__ __forceinline__ Params get_params(LAS unsigned char* lds) {
    Params Q;
#pragma unroll
    for (int i = 0; i < 30; ++i) Q.in[i] = as_global<const float>(ld_ptr(lds, i));
    Q.out = as_global<float>(ld_ptr(lds, 30)); Q.ws = as_global<unsigned char>(ld_ptr(lds, 31));
    return Q;
}
__device__ __forceinline__ float bf2f(unsigned v16) { return __uint_as_float(v16 << 16); }
__device__ __forceinline__ float h2f(unsigned v16) { return (float)__builtin_bit_cast(_Float16, (unsigned short)v16); }
__device__ __forceinline__ unsigned pk_h(float a, float b) {
    const unsigned short ua = __builtin_bit_cast(unsigned short, (_Float16)a), ub = __builtin_bit_cast(unsigned short, (_Float16)b);
    return (unsigned)ua | ((unsigned)ub << 16);
}
__device__ __forceinline__ float sigmoidf_(float x) { return __builtin_amdgcn_rcpf(1.0f + __expf(-x)); }
__device__ __forceinline__ int modidx_pm(int pm) { return pm < 16 ? 8 : ((pm - 16) >> 4); }
__device__ __forceinline__ int modidx_m(int m) { return m < NPR ? 8 : ((m - NPR) >> 12); }

struct EpiSwiglu {
    static constexpr bool PERM = true, AFTER_DRAIN = false;
    u16* G;
    __device__ __forceinline__ void operator()(const f32x4 (&acc)[2][2][4][2], const pg8::Unit& u, int wr, int wc, int fr, int fq) const {
        const int row0 = u.pm * 256 + wr * 64 + fr, col0 = u.pn * 128 + wc * 32 + 8 * fq;
#pragma unroll
        for (int ai = 0; ai < 2; ++ai)
#pragma unroll
            for (int m = 0; m < 4; ++m) {
                float g[8];
#pragma unroll
                for (int n = 0; n < 2; ++n)
#pragma unroll
                    for (int j = 0; j < 4; ++j) { const float a = acc[ai][0][m][n][j], b = acc[ai][1][m][n][j]; g[n * 4 + j] = a * sigmoidf_(a) * b; }
                u32x4 w; w.x = cvt_pk_bf16(g[0], g[1]); w.y = cvt_pk_bf16(g[2], g[3]); w.z = cvt_pk_bf16(g[4], g[5]); w.w = cvt_pk_bf16(g[6], g[7]);
                *(u32x4*)(G + (size_t)(row0 + ai * 128 + m * 16) * DFF + col0) = w;
            }
    }
};
struct EpiResid {
    static constexpr bool PERM = false, AFTER_DRAIN = false;
    const float* xp; const float* xs; float* X; const float* MOD; int slot; float coef;
    __device__ __forceinline__ void operator()(const f32x4 (&acc)[2][2][4][2], const pg8::Unit& u, int wr, int wc, int fr, int fq) const {
        const int row0 = u.pm * 256 + wr * 64 + fr, col0 = u.pn * 256 + wc * 32 + 4 * fq;
        const float* g = MOD + (size_t)modidx_pm(u.pm) * 9216 + slot * 1024 + col0;
        f32x4 gv[2][2];
#pragma unroll
        for (int bj = 0; bj < 2; ++bj)
#pragma unroll
            for (int n = 0; n < 2; ++n) gv[bj][n] = *(const f32x4*)(g + bj * 128 + n * 16) * coef;
#pragma unroll
        for (int ai = 0; ai < 2; ++ai)
#pragma unroll
            for (int m = 0; m < 4; ++m) {
                const int row = row0 + ai * 128 + m * 16;
                const float* src = (xp ? (row < NPR ? xp + (size_t)row * DM : xs + (size_t)(row - NPR) * DM) : X + (size_t)row * DM) + col0;
                float* dst = X + (size_t)row * DM + col0;
#pragma unroll
                for (int bj = 0; bj < 2; ++bj)
#pragma unroll
                    for (int n = 0; n < 2; ++n) *(f32x4*)(dst + bj * 128 + n * 16) = *(const f32x4*)(src + bj * 128 + n * 16) + gv[bj][n] * acc[ai][bj][m][n];
            }
    }
};
struct EpiU {
    static constexpr bool PERM = true, AFTER_DRAIN = false;
    u16* U; u16* SG; u16* GATES; const float* gate_b;
    __device__ __forceinline__ void operator()(const f32x4 (&acc)[2][2][4][2], const pg8::Unit& u, int wr, int wc, int fr, int fq) const {
        const int row0 = u.pm * 256 + wr * 64 + fr, ct = wc * 32 + 8 * fq;
        if (u.pn < 7) {
#pragma unroll
            for (int ai = 0; ai < 2; ++ai)
#pragma unroll
                for (int m = 0; m < 4; ++m)
#pragma unroll
                    for (int bj = 0; bj < 2; ++bj) { const f32x4 v0 = acc[ai][bj][m][0], v1 = acc[ai][bj][m][1];
                        u32x4 w; w.x = pk_h(v0[0], v0[1]); w.y = pk_h(v0[2], v0[3]); w.z = pk_h(v1[0], v1[1]); w.w = pk_h(v1[2], v1[3]);
                        *(u32x4*)(U + (size_t)(row0 + ai * 128 + m * 16) * 1792 + u.pn * 256 + bj * 128 + ct) = w; }
        } else {
            const int gc0 = (u.pn == 7 ? 2048 : (u.pn - 8) * 256) + ct;
#pragma unroll
            for (int bj = 0; bj < 2; ++bj) {
                const int gbi = (u.pn == 7 ? 0 : (u.pn - 8) * 256) + ct; const float bsc = u.pn == 7 ? 0.f : 1.f;
                const f32x4 b0 = *(const f32x4*)(gate_b + gbi + bj * 128) * bsc, b1 = *(const f32x4*)(gate_b + gbi + bj * 128 + 4) * bsc;
#pragma unroll
                for (int ai = 0; ai < 2; ++ai)
#pragma unroll
                    for (int m = 0; m < 4; ++m) { const f32x4 v0 = acc[ai][bj][m][0] + b0, v1 = acc[ai][bj][m][1] + b1;
                        u32x4 w; w.x = pk_h(sigmoidf_(v0[0]), sigmoidf_(v0[1])); w.y = pk_h(sigmoidf_(v0[2]), sigmoidf_(v0[3]));
                        w.z = pk_h(sigmoidf_(v1[0]), sigmoidf_(v1[1])); w.w = pk_h(sigmoidf_(v1[2]), sigmoidf_(v1[3]));
                        *(u32x4*)(GATES + (size_t)(row0 + ai * 128 + m * 16) * GLD + gc0 + bj * 128) = w; }
            }
        }
    }
};
struct EpiZT {
    static constexpr bool PERM = true, AFTER_DRAIN = false;
    u16* ZL;
    __device__ __forceinline__ void operator()(const f32x4 (&acc)[2][2][4][2], const pg8::Unit& u, int wr, int wc, int fr, int fq) const {
#pragma unroll
        for (int bj = 0; bj < 2; ++bj) {
            const int c0 = u.pn * 256 + bj * 128 + wc * 32 + 8 * fq;
#pragma unroll
            for (int ai = 0; ai < 2; ++ai)
#pragma unroll
                for (int m = 0; m < 4; ++m) {
                    const int zr = u.pm * 256 + ai * 128 + wr * 64 + m * 16 + fr, g = zr >> 8, part = (zr >> 7) & 1, kn = zr & 127;
                    size_t off;
                    if (u.pn < 16) off = (size_t)4096 * 8192 + ((size_t)(u.pn * 512 + g * 128 + kn) * 512 + part * 256 + (c0 - u.pn * 256));
                    else { const int tok = c0 - NPR, b = tok >> 12, rc = tok & 4095; off = (size_t)(b * 512 + g * 128 + kn) * 8192 + part * 4096 + rc; }
                    u16* dst = ZL + off;
                    const f32x4 v0 = acc[ai][bj][m][0], v1 = acc[ai][bj][m][1];
                    u32x4 w; w.x = cvt_pk_bf16(v0[0], v0[1]); w.y = cvt_pk_bf16(v0[2], v0[3]); w.z = cvt_pk_bf16(v1[0], v1[1]); w.w = cvt_pk_bf16(v1[2], v1[3]);
                    *(u32x4*)dst = w;
                }
        }
    }
};
struct EpiFour {
    static constexpr bool PERM = true, AFTER_DRAIN = false;
    u16* FOUR; int latent;
    __device__ __forceinline__ void operator()(const f32x4 (&acc)[2][2][4][2], const pg8::Unit& u, int wr, int wc, int fr, int fq) const {
        const int b = u.pn >> 1, ch0 = (u.pn & 1) * 256 + wc * 32 + 8 * fq;
        const int tok0 = (latent ? NPR + b * 4096 : b * 256) + u.pm * 256 + wr * 64 + fr;
#pragma unroll
        for (int ai = 0; ai < 2; ++ai)
#pragma unroll
            for (int m = 0; m < 4; ++m)
#pragma unroll
                for (int bj = 0; bj < 2; ++bj) { const f32x4 v0 = acc[ai][bj][m][0], v1 = acc[ai][bj][m][1];
                    u32x4 w; w.x = cvt_pk_bf16(v0[0], v0[1]); w.y = cvt_pk_bf16(v0[2], v0[3]); w.z = cvt_pk_bf16(v1[0], v1[1]); w.w = cvt_pk_bf16(v1[2], v1[3]);
                    *(u32x4*)(FOUR + (size_t)(tok0 + ai * 128 + m * 16) * 512 + ch0 + bj * 128) = w; }
    }
};
struct EpiMul {
    static constexpr bool PERM = true, AFTER_DRAIN = false;
    u16* O; const u16* GATES; int mode;
    __device__ __forceinline__ void operator()(const f32x4 (&acc)[2][2][4][2], const pg8::Unit& u, int wr, int wc, int fr, int fq) const {
        const int row0 = u.pm * 256 + wr * 64 + fr, col0 = u.pn * 256 + wc * 32 + 8 * fq;
        const int ld = mode == 0 ? 512 : 1024;
#pragma unroll
        for (int ai = 0; ai < 2; ++ai)
#pragma unroll
            for (int m = 0; m < 4; ++m)
#pragma unroll
                for (int bj = 0; bj < 2; ++bj) {
                    const int row = row0 + ai * 128 + m * 16, col = col0 + bj * 128;
                    u16* p = O + (size_t)row * ld + col;
                    float v[8];
#pragma unroll
                    for (int j = 0; j < 4; ++j) { v[j] = acc[ai][bj][m][0][j]; v[4 + j] = acc[ai][bj][m][1][j]; }
                    if (mode == 0) {
                        const u32x4 q = *(const u32x4*)p;
#pragma unroll
                        for (int j = 0; j < 4; ++j) { v[2 * j] *= bf2f(q[j] & 0xffffu); v[2 * j + 1] *= bf2f(q[j] >> 16); }
                    } else {
                        const u32x4 gq = *(const u32x4*)(GATES + (size_t)row * GLD + (mode == 2 ? 1024 : 0) + col);
#pragma unroll
                        for (int j = 0; j < 4; ++j) { v[2 * j] *= h2f(gq[j] & 0xffffu); v[2 * j + 1] *= h2f(gq[j] >> 16); }
                        if (mode == 2) { const u32x4 q = *(const u32x4*)p;
#pragma unroll
                            for (int j = 0; j < 4; ++j) { v[2 * j] += bf2f(q[j] & 0xffffu); v[2 * j + 1] += bf2f(q[j] >> 16); } }
                    }
                    u32x4 w; w.x = cvt_pk_bf16(v[0], v[1]); w.y = cvt_pk_bf16(v[2], v[3]); w.z = cvt_pk_bf16(v[4], v[5]); w.w = cvt_pk_bf16(v[6], v[7]);
                    *(u32x4*)p = w;
                }
    }
};

template <class Epi>
__device__ __forceinline__ void run_gemm(LAS unsigned char* lds, const u16* A, const u16* Bt, int M, int N, int K, const Epi& E) {
    pg8::Gemm g{A, Bt, M, N, K}; pg8::StaticOrder S; S.init(M, N, (int)gridDim.x, (int)blockIdx.x);
    pg8::gemm_phase<Epi, pg8::StaticOrder, false>(lds, g, S, E, nullptr);
}

__device__ __forceinline__ void transpose_tile(const float* src, int ld_src, int col0, int k0, int krows, u16* dst, int n0, int K, LAS float* tile) {
    const int t = threadIdx.x;
#pragma unroll
    for (int i = 0; i < 8; ++i) { const int kk = (t >> 6) + 8 * i, nn = t & 63;
        float v = 0.f; if (col0 >= 0 && k0 + kk < krows) v = src[(size_t)(k0 + kk) * ld_src + col0 + nn];
        tile[kk * 65 + nn] = v; }
    __syncthreads();
    const int nn = t >> 3, ks = (t & 7) * 8;
    float v[8];
#pragma unroll
    for (int j = 0; j < 8; ++j) v[j] = tile[(ks + j) * 65 + nn];
    u32x4 w; w.x = cvt_pk_bf16(v[0], v[1]); w.y = cvt_pk_bf16(v[2], v[3]); w.z = cvt_pk_bf16(v[4], v[5]); w.w = cvt_pk_bf16(v[6], v[7]);
    *(u32x4*)(dst + (size_t)(n0 + nn) * K + k0 + ks) = w;
    __syncthreads();
}

__device__ __forceinline__ void phase_prep(const Params& P, LAS unsigned char* lds) {
    LAS float* L = (LAS float*)lds;
    LAS float* tile = L;
    LAS float* cs128 = L + 4160; LAS float* sn128 = cs128 + 128;
    LAS float* cs64 = sn128 + 128;  LAS float* sn64 = cs64 + 64;
    LAS float* cs256 = sn64 + 64;   LAS float* sn256 = cs256 + 256;
    LAS float* frow = sn256 + 256;
    LAS float* sc = frow + 512;
    LAS float* red = sc + 9216;
    const int tid = threadIdx.x, G = gridDim.x, bid = blockIdx.x;
    unsigned char* ws = P.ws;
    if (tid < 256) { float s, c; sincospif(2.0f * (float)tid / 256.0f, &s, &c); cs256[tid] = c; sn256[tid] = s; }
    if (tid < 128) { float s, c; sincospif(2.0f * (float)tid / 128.0f, &s, &c); cs128[tid] = c; sn128[tid] = s; }
    if (tid < 64)  { float s, c; sincospif(2.0f * (float)tid / 64.0f, &s, &c); cs64[tid] = c; sn64[tid] = s; }
    __syncthreads();

    if (bid < 144) {
        for (int i = tid; i < 9216; i += 512) { const int v = i >> 10, k = i & 1023; const float x = v < 8 ? P.in[4][v * 1024 + k] : P.in[5][k]; sc[i] = x / (1.0f + expf(-x)); }
        __syncthreads();
        const int c = tid & 63, kg = tid >> 6; const float* aw = P.in[6] + bid * 64 + c;
        float a[9];
#pragma unroll
        for (int v = 0; v < 9; ++v) a[v] = 0.f;
        for (int k0 = kg; k0 < 1024; k0 += 64) {
            float w8[8];
#pragma unroll
            for (int u = 0; u < 8; ++u) w8[u] = aw[(size_t)(k0 + 8 * u) * 9216];
#pragma unroll
            for (int u = 0; u < 8; ++u)
#pragma unroll
                for (int v = 0; v < 9; ++v) a[v] += sc[v * 1024 + k0 + 8 * u] * w8[u]; }
#pragma unroll
        for (int v = 0; v < 9; ++v) red[(kg * 9 + v) * 64 + c] = a[v];
        __syncthreads();
        float* MOD = (float*)(ws + WS_MOD);
        for (int i = tid; i < 576; i += 512) { const int v = i >> 6, cc = i & 63; float s = 0.f;
#pragma unroll
            for (int q = 0; q < 8; ++q) s += red[(q * 9 + v) * 64 + cc];
            MOD[v * 9216 + bid * 64 + cc] = s + P.in[7][bid * 64 + cc]; }
        __syncthreads();
    }

    {
        const int total = 5792;
#define PREP_DECODE(Q, SRC, LD, KROWS, KD, COL0, N0, K0, DST) { \
            int j = 0, r = (Q), nk = 16; \
            PREP_STEP(0, 88 * 16, 44) PREP_STEP(1, 16 * 44, 16) PREP_STEP(2, 88 * 16, 44) PREP_STEP(3, 16 * 44, 16) \
            PREP_STEP(4, 64 * 16, 8) PREP_STEP(5, 16 * 8, 8) PREP_STEP(6, 16 * 8, 16) PREP_STEP(7, 16 * 16, 4) \
            const int tn = r / nk, tk = r % nk; N0 = tn * 64; K0 = tk * 64; COL0 = N0; \
            if (j == 0 || j == 2) { SRC = j == 0 ? P.in[9] : P.in[11]; LD = 5632; KROWS = 1024; KD = 1024; DST = (u16*)(ws + (j == 0 ? WS_W13A : WS_W13B)); \
                const int pn = N0 >> 8, rr = N0 & 255; COL0 = rr < 128 ? 128 * pn + rr : 2816 + 128 * pn + (rr - 128); } \
            else if (j == 1 || j == 3) { SRC = j == 1 ? P.in[10] : P.in[12]; LD = 1024; KROWS = 2816; KD = 2816; DST = (u16*)(ws + (j == 1 ? WS_W2A : WS_W2B)); } \
            else if (j == 4) { SRC = P.in[13]; LD = 4480; KROWS = 1024; KD = 1024; DST = (u16*)(ws + WS_WIN); \
                COL0 = N0 < 1920 ? N0 : (N0 < 2048 ? -1 : 2432 + (N0 - 2048)); } \
            else if (j == 5) { SRC = P.in[26]; LD = 1024; KROWS = 512; KD = 512; DST = (u16*)(ws + WS_WO); } \
            else if (j == 6) { SRC = P.in[27]; LD = 1024; KROWS = 512; KD = 512; DST = (u16*)(ws + WS_WF); } \
            else if (j == 7) { SRC = P.in[28]; LD = 1024; KROWS = 1024; KD = 1024; DST = (u16*)(ws + WS_WOUT); } \
            else { SRC = P.in[20]; LD = 512; KROWS = 128; KD = 256; DST = (u16*)(ws + WS_GUP); } }
#define PREP_STEP(JJ, CNT, NKN) if (j == JJ && r >= (CNT)) { r -= (CNT); j = JJ + 1; nk = NKN; }
#define PREP_LOAD(V, SRC, LD, KROWS, COL0, K0) { _Pragma("unroll") for (int i = 0; i < 8; ++i) { const int kk = (tid >> 6) + 8 * i, nn = tid & 63; \
            V[i] = ((COL0) >= 0 && (K0) + kk < (KROWS)) ? SRC[(size_t)((K0) + kk) * (LD) + (COL0) + nn] : 0.f; } }
        float cur[8], nxt[8];
        const float* srcc = nullptr; int ldc = 0, krc = 0, kdc = 0, colc = 0, n0c = 0, k0c = 0; u16* dstc = nullptr;
        if (bid < total) { PREP_DECODE(bid, srcc, ldc, krc, kdc, colc, n0c, k0c, dstc) PREP_LOAD(cur, srcc, ldc, krc, colc, k0c) }
        for (int q = bid; q < total; q += G) {
            const float* srcn = srcc; int ldn = ldc, krn = krc, kdn = kdc, coln = colc, n0n = n0c, k0n = k0c; u16* dstn = dstc;
            if (q + G < total) { PREP_DECODE(q + G, srcn, ldn, krn, kdn, coln, n0n, k0n, dstn) PREP_LOAD(nxt, srcn, ldn, krn, coln, k0n) }
#pragma unroll
            for (int i = 0; i < 8; ++i) tile[((tid >> 6) + 8 * i) * 65 + (tid & 63)] = cur[i];
            __syncthreads();
            { const int nn = tid >> 3, ks = (tid & 7) * 8; float v[8];
#pragma unroll
              for (int jj = 0; jj < 8; ++jj) v[jj] = tile[(ks + jj) * 65 + nn];
              u32x4 w; w.x = cvt_pk_bf16(v[0], v[1]); w.y = cvt_pk_bf16(v[2], v[3]); w.z = cvt_pk_bf16(v[4], v[5]); w.w = cvt_pk_bf16(v[6], v[7]);
              *(u32x4*)(dstc + (size_t)(n0c + nn) * kdc + k0c + ks) = w; }
            __syncthreads();
            srcc = srcn; ldc = ldn; krc = krn; kdc = kdn; colc = coln; n0c = n0n; k0c = k0n; dstc = dstn;
#pragma unroll
            for (int i = 0; i < 8; ++i) cur[i] = nxt[i];
        }
#undef PREP_STEP
#undef PREP_DECODE
#undef PREP_LOAD
    }

    {
        u16* WZ = (u16*)(ws + WS_WZ);
        for (int k = bid; k < 1024; k += G) {
            frow[tid] = P.in[13][(size_t)k * 4480 + 1920 + tid];
            __syncthreads();
#pragma unroll
            for (int rep = 0; rep < 2; ++rep) { const int zc = tid + rep * 512, g = zc >> 8, part = (zc >> 7) & 1, kn = zc & 127;
                const LAS float* tab = part ? sn128 : cs128; float s = 0.f;
                for (int n = 0; n < 128; ++n) s += frow[g * 128 + n] * tab[(kn * n) & 127];
                s *= 0.08838834764831845f; if (part) s = -s;
                WZ[(size_t)zc * 1024 + k] = (u16)(cvt_pk_bf16(s, 0.f) & 0xffffu); }
            __syncthreads();
        }
    }

    {
        u16* T2 = (u16*)(ws + WS_T256);
        for (int vi = bid * 512 + tid; vi < 256 * 64; vi += G * 512) {
            const int kt = vi >> 6, cv = (vi & 63) * 8, part = cv >> 8, t0 = cv & 255;
            const LAS float* tab = part ? sn256 : cs256;
            float v[8];
#pragma unroll
            for (int j = 0; j < 8; ++j) v[j] = tab[(kt * (t0 + j)) & 255] * 0.0625f;
            u32x4 w; w.x = cvt_pk_bf16(v[0], v[1]); w.y = cvt_pk_bf16(v[2], v[3]); w.z = cvt_pk_bf16(v[4], v[5]); w.w = cvt_pk_bf16(v[6], v[7]);
            *(u32x4*)(T2 + (size_t)vi * 8) = w;
        }
    }
}

template <int CTRL> __device__ __forceinline__ float dpp_add(float v) {
    return v + __int_as_float(__builtin_amdgcn_update_dpp(0, __float_as_int(v), CTRL, 0xF, 0xF, true));
}
__device__ __forceinline__ float sum16(float v) {
    v = dpp_add<0xB1>(v); v = dpp_add<0x4E>(v); v = dpp_add<0x141>(v); v = dpp_add<0x140>(v); return v;
}
__device__ __forceinline__ float sum64(float v) {
    const float t = sum16(v);
    const int ti = __float_as_int(t);
    return __int_as_float(__builtin_amdgcn_readlane(ti, 0)) + __int_as_float(__builtin_amdgcn_readlane(ti, 16)) + __int_as_float(__builtin_amdgcn_readlane(ti, 32)) + __int_as_float(__builtin_amdgcn_readlane(ti, 48));
}
__device__ __forceinline__ float wave_sum(float v) {
#pragma unroll
    for (int o = 32; o >= 1; o >>= 1) v += __shfl_xor(v, o);
    return v;
}
__device__ __forceinline__ const float* norm_row(const Params& P, const float* X, int m) {
    return X ? X + (size_t)m * DM : (m < NPR ? P.in[0] + (size_t)m * DM : P.in[1] + (size_t)(m - NPR) * DM);
}
__device__ __forceinline__ void phase_norm(const Params& P, const float* X, int nwi, int slot_shift, int slot_scale, u16* H) {
    const int lane = threadIdx.x & 63, gw = blockIdx.x * 8 + (threadIdx.x >> 6), nw = gridDim.x * 8;
    const float* MOD = (const float*)(P.ws + WS_MOD); const float* normw = P.in[8] + nwi * 1024;
    f32x4 v[4], vn[4];
    if (gw < MT) { const float* xr = norm_row(P, X, gw);
#pragma unroll
        for (int i = 0; i < 4; ++i) v[i] = *(const f32x4*)(xr + i * 256 + lane * 4); }
    for (int m = gw; m < MT; m += nw) {
        const int mn = m + nw < MT ? m + nw : m;
        { const float* xr = norm_row(P, X, mn);
#pragma unroll
          for (int i = 0; i < 4; ++i) vn[i] = *(const f32x4*)(xr + i * 256 + lane * 4); }
        float ss = 0.f;
#pragma unroll
        for (int i = 0; i < 4; ++i) ss += v[i][0] * v[i][0] + v[i][1] * v[i][1] + v[i][2] * v[i][2] + v[i][3] * v[i][3];
        ss = sum64(ss);
        const float rs = rsqrtf(ss * (1.0f / 1024.0f) + 1e-6f);
        const float* md = MOD + (size_t)modidx_m(m) * 9216;
#pragma unroll
        for (int i = 0; i < 4; ++i) { const int c = i * 256 + lane * 4;
            const f32x4 w = *(const f32x4*)(normw + c), sc = *(const f32x4*)(md + slot_scale * 1024 + c), sh = *(const f32x4*)(md + slot_shift * 1024 + c);
            const f32x4 y = v[i] * rs * w * (sc + 1.0f) + sh;
            u32x2 o; o.x = cvt_pk_bf16(y[0], y[1]); o.y = cvt_pk_bf16(y[2], y[3]);
            *(u32x2*)(H + (size_t)m * DM + c) = o; }
#pragma unroll
        for (int i = 0; i < 4; ++i) v[i] = vn[i];
    }
}
__device__ __forceinline__ void phase_final_norm(const Params& P) {
    const int lane = threadIdx.x & 63, gw = blockIdx.x * 8 + (threadIdx.x >> 6), nw = gridDim.x * 8;
    const float* fw = P.in[29];
    f32x4 v[4], vn[4];
    if (gw < MT) { const float* xr = P.out + (size_t)gw * DM;
#pragma unroll
        for (int i = 0; i < 4; ++i) v[i] = *(const f32x4*)(xr + i * 256 + lane * 4); }
    for (int m = gw; m < MT; m += nw) {
        const int mn = m + nw < MT ? m + nw : m;
        { const float* xr = P.out + (size_t)mn * DM;
#pragma unroll
          for (int i = 0; i < 4; ++i) vn[i] = *(const f32x4*)(xr + i * 256 + lane * 4); }
        float ss = 0.f;
#pragma unroll
        for (int i = 0; i < 4; ++i) ss += v[i][0] * v[i][0] + v[i][1] * v[i][1] + v[i][2] * v[i][2] + v[i][3] * v[i][3];
        ss = sum64(ss);
        const float rs = rsqrtf(ss * (1.0f / 1024.0f) + 1e-6f);
        float* xo = P.out + (size_t)m * DM;
#pragma unroll
        for (int i = 0; i < 4; ++i) { const int c = i * 256 + lane * 4; *(f32x4*)(xo + c) = v[i] * rs * *(const f32x4*)(fw + c); }
#pragma unroll
        for (int i = 0; i < 4; ++i) v[i] = vn[i];
    }
}

__device__ __forceinline__ float dot4(const f32x4 a, const f32x4 b) {
    typedef float f32x2 __attribute__((ext_vector_type(2)));
    f32x2 p = (f32x2){a[0], a[1]} * (f32x2){b[0], b[1]};
    p = (f32x2){a[2], a[3]} * (f32x2){b[2], b[3]} + p;
    return p[0] + p[1];
}
__device__ __forceinline__ float fsig(float x) { return __builtin_amdgcn_rcpf(1.0f + __expf(-x)); }
struct ScanRegs { u32x2 r[3], k[3], v[3], wd, ad; };
__device__ __forceinline__ void scan_load(ScanRegs& R, const u16* U, int tok0, int T, int t, int h, int d, int cg) {
    const u32x2 z = {0u, 0u};
#pragma unroll
    for (int tap = 0; tap < 3; ++tap) { const int tn = t + tap - 1;
        if (tn >= 0 && tn < T) { const u16* row = U + (size_t)(tok0 + tn) * 1792 + h * 64 + 4 * cg;
            R.r[tap] = *(const u32x2*)row; R.k[tap] = *(const u32x2*)(row + 512); R.v[tap] = *(const u32x2*)(row + 1024); }
        else { R.r[tap] = z; R.k[tap] = z; R.v[tap] = z; } }
    const u16* row = U + (size_t)(tok0 + t) * 1792 + 1536 + d * 64 + 4 * cg;
    R.wd = *(const u32x2*)row; R.ad = *(const u32x2*)(row + 128);
}
__device__ __forceinline__ void unpack4h(const u32x2 q, float (&o)[4]) { o[0] = h2f(q.x & 0xffffu); o[1] = h2f(q.x >> 16); o[2] = h2f(q.y & 0xffffu); o[3] = h2f(q.y >> 16); }

#define LDS_BARRIER() do { asm volatile("s_waitcnt lgkmcnt(0)" ::: "memory"); __builtin_amdgcn_s_barrier(); asm volatile("" ::: "memory"); } while (0)
__device__ __forceinline__ void scan_unit(const Params& P, LAS float* L, int s, int h, int d, int half) {
    typedef float f32x16 __attribute__((ext_vector_type(16)));
    const int tid = threadIdx.x, lane = tid & 63;
    const bool producer = tid >= 256;
    const int T = s < 16 ? 256 : 4096, tok0 = s < 16 ? s * 256 : NPR + (s - 16) * 4096, nchunk = T / 32;
    const u16* U = (const u16*)(P.ws + WS_U16);
    u16* Od = (u16*)(P.ws + WS_H) + (size_t)d * MT * 512;
    float* BS = (float*)(P.ws + WS_BS);
    LAS float* cst = L;            LAS float* xwT = L + 1024;    LAS float* xaT = L + 3136;   LAS float* lora_s = L + 5248;
    LAS float* o_sb = L + 13440;   LAS float* cb = L + 15488;
    if (tid < 64) { const int c = tid, ch = h * 64 + c;
        cst[c] = P.in[16][d * 512 + ch]; cst[64 + c] = P.in[18][d * 512 + ch]; cst[128 + c] = P.in[21][ch]; cst[192 + c] = P.in[22][ch]; cst[256 + c] = P.in[23][ch];
#pragma unroll
        for (int ten = 0; ten < 3; ++ten)
#pragma unroll
            for (int tap = 0; tap < 3; ++tap) cst[(5 + ten * 3 + tap) * 64 + c] = P.in[15][tap * 1536 + ten * 512 + ch]; }
    const int c16 = tid & 15, rp = (tid >> 4) & 15, rA = half * 32 + rp, rB = rA + 16;
    f32x4 SA = {0.f, 0.f, 0.f, 0.f}, SB = {0.f, 0.f, 0.f, 0.f};
    if (!producer && s >= 16) { const float* st = (d ? P.in[3] : P.in[2]) + (size_t)((s - 16) * 8 + h) * 4096;
        SA = *(const f32x4*)(st + rA * 64 + 4 * c16); SB = *(const f32x4*)(st + rB * 64 + 4 * c16); }
    const int pt = tid - 256, pw = (pt >> 6) & 3, nt = pw & 1, kh = pw >> 1, li = lane & 31, lk = lane >> 5;
    float Bw[16], Ba[16];
    if (producer) {
#pragma unroll
        for (int s2 = 0; s2 < 16; ++s2) { const size_t o = (size_t)(d * 64 + kh * 32 + 2 * s2 + lk) * 512 + h * 64 + nt * 32 + li; Bw[s2] = P.in[17][o]; Ba[s2] = P.in[19][o]; }
    } else {
#pragma unroll
        for (int s2 = 0; s2 < 16; ++s2) { Bw[s2] = 0.f; Ba[s2] = 0.f; }
    }
    const int it0 = pt & 255, tt0 = it0 >> 4, cg0 = it0 & 15, tt1 = tt0 + 16, cg1 = cg0;
    ScanRegs R0, R1;
    if (producer) { scan_load(R0, U, tok0, T, d ? T - 1 - tt0 : tt0, h, d, cg0); scan_load(R1, U, tok0, T, d ? T - 1 - tt1 : tt1, h, d, cg1); }
    __syncthreads();
    float tpr[3][4], tpk[3][4], tpv[3][4], kkc4[4];
#pragma unroll
    for (int tap = 0; tap < 3; ++tap)
#pragma unroll
        for (int j = 0; j < 4; ++j) { tpr[tap][j] = cst[(5 + tap) * 64 + 4 * cg0 + j]; tpk[tap][j] = cst[(8 + tap) * 64 + 4 * cg0 + j]; tpv[tap][j] = cst[(11 + tap) * 64 + 4 * cg0 + j]; }
#pragma unroll
    for (int j = 0; j < 4; ++j) kkc4[j] = cst[128 + 4 * cg0 + j];
    for (int ci = -1; ci < nchunk; ++ci) {
        const int pc = ci + 1;
        LAS float* pb = cb + (pc & 1) * 12288;
        const LAS float* qb = cb + (ci & 1) * 12288;
        LAS float* o_s = o_sb + (ci & 1) * 1024;
        const bool do_prep = producer && pc < nchunk, do_step = !producer && ci >= 0;
        LAS float* r_s = pb; LAS float* w_s = pb + 2048; LAS float* kd_s = pb + 4096; LAS float* v_s = pb + 6144; LAS float* kk_s = pb + 8192; LAS float* kka_s = pb + 10240;
#define SCAN_STEPS(SEG) if (do_step) { float oAr[8], oBr[8]; float pA = 0.f, pB = 0.f;     \
        _Pragma("unroll") for (int u8 = 0; u8 < 8; ++u8) { const int tt = (SEG) * 8 + u8; \
            const f32x4 w4 = *(const LAS f32x4*)(qb + 2048 + tt * 64 + 4 * c16), kk4 = *(const LAS f32x4*)(qb + 8192 + tt * 64 + 4 * c16), ka4 = *(const LAS f32x4*)(qb + 10240 + tt * 64 + 4 * c16); \
            const f32x4 kd4 = *(const LAS f32x4*)(qb + 4096 + tt * 64 + 4 * c16), r4 = *(const LAS f32x4*)(qb + tt * 64 + 4 * c16); \
            const float vA = qb[6144 + tt * 64 + rA], vB = qb[6144 + tt * 64 + rB]; \
            float saA = dot4(SA, kk4), saB = dot4(SB, kk4); \
            saA = dpp_add<0xB1>(saA); saB = dpp_add<0xB1>(saB); pA = dpp_add<0xB1>(pA); pB = dpp_add<0xB1>(pB); \
            saA = dpp_add<0x4E>(saA); saB = dpp_add<0x4E>(saB); pA = dpp_add<0x4E>(pA); pB = dpp_add<0x4E>(pB); \
            saA = dpp_add<0x141>(saA); saB = dpp_add<0x141>(saB); pA = dpp_add<0x141>(pA); pB = dpp_add<0x141>(pB); \
            saA = dpp_add<0x140>(saA); saB = dpp_add<0x140>(saB); pA = dpp_add<0x140>(pA); pB = dpp_add<0x140>(pB); \
            if (u8 > 0) { oAr[u8 - 1] = pA; oBr[u8 - 1] = pB; } \
            SA = SA * w4 - ka4 * saA + kd4 * vA; SB = SB * w4 - ka4 * saB + kd4 * vB; \
            pA = dot4(SA, r4); pB = dot4(SB, r4); } \
        pA = dpp_add<0xB1>(pA); pB = dpp_add<0xB1>(pB); pA = dpp_add<0x4E>(pA); pB = dpp_add<0x4E>(pB); pA = dpp_add<0x141>(pA); pB = dpp_add<0x141>(pB); pA = dpp_add<0x140>(pA); pB = dpp_add<0x140>(pB); \
        oAr[7] = pA; oBr[7] = pB; \
        if (c16 == 0) { _Pragma("unroll") for (int u8 = 0; u8 < 8; ++u8) { o_s[((SEG) * 8 + u8) * 32 + rp] = oAr[u8]; o_s[((SEG) * 8 + u8) * 32 + 16 + rp] = oBr[u8]; } } }
        if (do_prep) {
#pragma unroll
            for (int it = 0; it < 2; ++it) { const ScanRegs& R = it ? R1 : R0; const int tt_a = it ? tt1 : tt0, cg = cg0;
                float rv[4] = {0.f, 0.f, 0.f, 0.f}, kv[4] = {0.f, 0.f, 0.f, 0.f}, vv[4] = {0.f, 0.f, 0.f, 0.f};
#pragma unroll
                for (int tap = 0; tap < 3; ++tap) { float a[4], bb[4], c[4]; unpack4h(R.r[tap], a); unpack4h(R.k[tap], bb); unpack4h(R.v[tap], c);
#pragma unroll
                    for (int j = 0; j < 4; ++j) { rv[j] += a[j] * tpr[tap][j]; kv[j] += bb[j] * tpk[tap][j]; vv[j] += c[j] * tpv[tap][j]; } }
                float kkr[4], ss = 0.f;
#pragma unroll
                for (int j = 0; j < 4; ++j) { kkr[j] = kv[j] * kkc4[j]; ss += kkr[j] * kkr[j]; }
                ss = sum16(ss);
                const float inv = __builtin_amdgcn_rsqf(fmaxf(ss, 1e-24f));
                float wdv[4], adv[4]; unpack4h(R.wd, wdv); unpack4h(R.ad, adv);
#pragma unroll
                for (int j = 0; j < 4; ++j) { const int o = tt_a * 64 + 4 * cg + j;
                    r_s[o] = rv[j]; v_s[o] = vv[j]; kd_s[o] = kv[j]; kk_s[o] = kkr[j] * inv;
                    xwT[(4 * cg + j) * 33 + tt_a] = 1.0f - 2.0f * __builtin_amdgcn_rcpf(1.0f + __expf(2.0f * wdv[j])); xaT[(4 * cg + j) * 33 + tt_a] = adv[j]; } }
            if (pc + 1 < nchunk) { const int q0 = (pc + 1) * 32 + tt0, q1 = (pc + 1) * 32 + tt1;
                scan_load(R0, U, tok0, T, d ? T - 1 - q0 : q0, h, d, cg0); scan_load(R1, U, tok0, T, d ? T - 1 - q1 : q1, h, d, cg1); }
        }
        SCAN_STEPS(0)
        LDS_BARRIER();
        if (do_prep) {
            f32x16 accw, acca;
#pragma unroll
            for (int i = 0; i < 16; ++i) { accw[i] = 0.f; acca[i] = 0.f; }
#pragma unroll
            for (int s2 = 0; s2 < 16; ++s2) { const int r = kh * 32 + 2 * s2 + lk;
                accw = __builtin_amdgcn_mfma_f32_32x32x2f32(xwT[r * 33 + li], Bw[s2], accw, 0, 0, 0);
                acca = __builtin_amdgcn_mfma_f32_32x32x2f32(xaT[r * 33 + li], Ba[s2], acca, 0, 0, 0); }
#pragma unroll
            for (int reg = 0; reg < 16; ++reg) { const int o = ((reg & 3) + 8 * (reg >> 2) + 4 * lk) * 64 + nt * 32 + li;
                lora_s[(0 * 2 + kh) * 2048 + o] = accw[reg]; lora_s[(1 * 2 + kh) * 2048 + o] = acca[reg]; }
        }
        SCAN_STEPS(1)
        LDS_BARRIER();
        if (do_prep) {
            const f32x4 w0c4 = *(const LAS f32x4*)(cst + 4 * cg0), a0c4 = *(const LAS f32x4*)(cst + 64 + 4 * cg0), kac4 = *(const LAS f32x4*)(cst + 192 + 4 * cg0), rkc4 = *(const LAS f32x4*)(cst + 256 + 4 * cg0);
#pragma unroll
            for (int it = 0; it < 2; ++it) { const int tt = it ? tt1 : tt0, o = tt * 64 + 4 * cg0;
                const f32x4 l0 = *(const LAS f32x4*)(lora_s + o), l1 = *(const LAS f32x4*)(lora_s + 2048 + o), l2 = *(const LAS f32x4*)(lora_s + 4096 + o), l3 = *(const LAS f32x4*)(lora_s + 6144 + o);
                const f32x4 k4 = *(const LAS f32x4*)(kd_s + o), kkv = *(const LAS f32x4*)(kk_s + o), r4v = *(const LAS f32x4*)(r_s + o);
                f32x4 wo, kdo, kao; float bs = 0.f;
#pragma unroll
                for (int j = 0; j < 4; ++j) {
                    const float w = __expf(-0.6065306597f * fsig(w0c4[j] + l0[j] + l1[j]));
                    const float a = fsig(a0c4[j] + l2[j] + l3[j]);
                    const float kd = k4[j] * (1.0f + (a - 1.0f) * kac4[j]);
                    wo[j] = w; kdo[j] = kd; kao[j] = kkv[j] * a; bs += r4v[j] * kd * rkc4[j]; }
                *(LAS f32x4*)(w_s + o) = wo; *(LAS f32x4*)(kd_s + o) = kdo; *(LAS f32x4*)(kka_s + o) = kao;
                bs = sum16(bs);
                if (cg0 == 0 && half == 0) { const int q = pc * 32 + tt, t = d ? T - 1 - q : q; BS[(size_t)(tok0 + t) * 16 + h * 2 + d] = bs; } }
        }
        SCAN_STEPS(2)
        LDS_BARRIER();
        SCAN_STEPS(3)
        LDS_BARRIER();
        if (do_step) { const int tt = tid >> 3, seg = tid & 7, q = ci * 32 + tt, t = d ? T - 1 - q : q;
            u32x2 w2; w2.x = cvt_pk_bf16(o_s[tt * 32 + 4 * seg], o_s[tt * 32 + 4 * seg + 1]); w2.y = cvt_pk_bf16(o_s[tt * 32 + 4 * seg + 2], o_s[tt * 32 + 4 * seg + 3]);
            *(u32x2*)(Od + (size_t)(tok0 + t) * 512 + h * 64 + half * 32 + 4 * seg) = w2; }
#undef SCAN_STEPS
    }
    if (!producer && s < 16) { float* so = P.out + OUT_STATE + (size_t)d * 524288 + (size_t)(s * 8 + h) * 4096;
        *(f32x4*)(so + rA * 64 + 4 * c16) = SA; *(f32x4*)(so + rB * 64 + 4 * c16) = SB; }
    __syncthreads();
}
__device__ __forceinline__ void phase_scan(const Params& P, LAS unsigned char* lds) {
    for (int q = blockIdx.x; q < 768; q += gridDim.x) {
        int s, rem;
        if (q < 256) { s = 16 + (q >> 5); rem = q & 31; } else { const int p = q - 256; s = p >> 5; rem = p & 31; }
        scan_unit(P, (LAS float*)lds, s, rem >> 2, (rem >> 1) & 1, rem & 1);
    }
}

struct PostRaw { unsigned of, ob, v0, v1, v2, sg; float b0, b1; };
__device__ __forceinline__ void post_load(PostRaw& r, int m, int ch, int h, int lane, const u16* OF, const u16* OB, const u16* U, const float* BS, const u16* GT) {
    const int T = m < NPR ? 256 : 4096, t = m < NPR ? (m & 255) : ((m - NPR) & 4095);
    r.of = OF[(size_t)m * 512 + ch]; r.ob = OB[(size_t)m * 512 + ch];
    r.v1 = U[(size_t)m * 1792 + 1024 + ch];
    r.v0 = t > 0 ? U[(size_t)(m - 1) * 1792 + 1024 + ch] : 0u;
    r.v2 = t < T - 1 ? U[(size_t)(m + 1) * 1792 + 1024 + ch] : 0u;
    r.sg = *(const unsigned*)(GT + (size_t)m * GLD + 2048 + 2 * lane);
    r.b0 = BS[(size_t)m * 16 + h * 2]; r.b1 = BS[(size_t)m * 16 + h * 2 + 1];
}
__device__ __forceinline__ void phase_post(const Params& P, LAS unsigned char* lds) {
    const int lane = threadIdx.x & 63, h = threadIdx.x >> 6, ch = h * 64 + lane, G = gridDim.x;
    const u16* OF = (const u16*)(P.ws + WS_H); const u16* OB = OF + (size_t)MT * 512;
    const u16* U = (const u16*)(P.ws + WS_U16); const float* BS = (const float*)(P.ws + WS_BS);
    u16* OPRE = (u16*)(P.ws + WS_OPRE); const u16* GT = (const u16*)(P.ws + WS_R);
    LAS float* sgl = (LAS float*)lds + h * 128;
    float gu[128];
#pragma unroll
    for (int k = 0; k < 128; ++k) gu[k] = P.in[20][(size_t)k * 512 + ch];
    const float lw = P.in[24][ch], lb = P.in[25][ch];
    const float cv0 = P.in[15][0 * 1536 + 1024 + ch], cv1 = P.in[15][1 * 1536 + 1024 + ch], cv2 = P.in[15][2 * 1536 + 1024 + ch];
    PostRaw cur, nxt;
    int m = blockIdx.x;
    post_load(cur, m, ch, h, lane, OF, OB, U, BS, GT);
    for (; m < MT; m += G) {
        const int mn = m + G < MT ? m + G : m;
        post_load(nxt, mn, ch, h, lane, OF, OB, U, BS, GT);
        sgl[2 * lane] = h2f(cur.sg & 0xffffu); sgl[2 * lane + 1] = h2f(cur.sg >> 16);
        const float o = bf2f(cur.of) + bf2f(cur.ob);
        const float mean = sum64(o) * (1.0f / 64.0f), d = o - mean;
        const float rstd = rsqrtf(sum64(d * d) * (1.0f / 64.0f) + 64e-5f);
        const float v = h2f(cur.v0) * cv0 + h2f(cur.v1) * cv1 + h2f(cur.v2) * cv2;
        float g0 = 0.f, g1 = 0.f, g2 = 0.f, g3 = 0.f;
#pragma unroll
        for (int k = 0; k < 128; k += 4) { const f32x4 s4 = *(const LAS f32x4*)(sgl + k);
            g0 += s4[0] * gu[k]; g1 += s4[1] * gu[k + 1]; g2 += s4[2] * gu[k + 2]; g3 += s4[3] * gu[k + 3]; }
        const float y = (d * rstd * lw + lb + (cur.b0 + cur.b1) * v) * ((g0 + g1) + (g2 + g3));
        OPRE[(size_t)m * 512 + ch] = (u16)(cvt_pk_bf16(y, 0.f) & 0xffffu);
        cur = nxt;
    }
}


constexpr size_t WS_BAR = WS_END + 65536;
static_assert(WS_BAR + 4096 <= (size_t)536870912, "barrier words");
__device__ __forceinline__ void fast_grid_sync(unsigned char* ws, unsigned k) {
    asm volatile("s_waitcnt vmcnt(0) lgkmcnt(0)" ::: "memory");
    __builtin_amdgcn_s_barrier();
    if (threadIdx.x == 0) {
        unsigned* bar = (unsigned*)(ws + WS_BAR);
        const unsigned G = gridDim.x, g = blockIdx.x & 7u, gsz = (G - g + 7u) >> 3, ngrp = G < 8u ? G : 8u;
        __builtin_amdgcn_fence(__ATOMIC_RELEASE, "agent");
        asm volatile("s_waitcnt vmcnt(0)" ::: "memory");
        const unsigned old = __hip_atomic_fetch_add(bar + g * 32, 1u, __ATOMIC_RELAXED, __HIP_MEMORY_SCOPE_AGENT);
        if (old + 1u == k * gsz) __hip_atomic_fetch_add(bar + 8 * 32, 1u, __ATOMIC_RELAXED, __HIP_MEMORY_SCOPE_AGENT);
        unsigned spins = 0;
        while (__hip_atomic_load(bar + 8 * 32, __ATOMIC_RELAXED, __HIP_MEMORY_SCOPE_AGENT) < k * ngrp) { if (++spins > (1u << 26)) break; }
        __builtin_amdgcn_fence(__ATOMIC_ACQUIRE, "agent");
        asm volatile("s_waitcnt vmcnt(0)" ::: "memory");
    }
    __builtin_amdgcn_s_barrier();
    asm volatile("" ::: "memory");
}


__device__ __forceinline__ void gen_T(const Params& P, LAS unsigned char* lds, int part_, int nparts) {
    LAS float* cs64 = (LAS float*)(lds + 131072); LAS float* sn64 = cs64 + 64;
    const int tid = threadIdx.x;
    if (tid < 64) { float s, c; sincospif(2.0f * (float)tid / 64.0f, &s, &c); cs64[tid] = c; sn64[tid] = s; }
    __syncthreads();
    u16* T = (u16*)(P.ws + WS_T);
    for (size_t vi = (size_t)part_ * 512 + tid; vi < (size_t)4096 * 1024; vi += (size_t)nparts * 512) {
        const int row = (int)(vi >> 10), cv = (int)(vi & 1023) * 8, part = cv >> 12, r = (cv >> 6) & 63, c0 = cv & 63, kr = row >> 6, kc = row & 63;
        const LAS float* tab = part ? sn64 : cs64; const int base = kr * r;
        float v[8];
#pragma unroll
        for (int j = 0; j < 8; ++j) v[j] = tab[(base + kc * (c0 + j)) & 63] * 0.015625f;
        u32x4 w; w.x = cvt_pk_bf16(v[0], v[1]); w.y = cvt_pk_bf16(v[2], v[3]); w.z = cvt_pk_bf16(v[4], v[5]); w.w = cvt_pk_bf16(v[6], v[7]);
        *(u32x4*)(T + vi * 8) = w;
    }
}

__global__ void __launch_bounds__(512, 2) fwd_mega(Params P) {
    extern __shared__ __attribute__((aligned(16))) unsigned char lds_raw[];
    LAS unsigned char* lds = (LAS unsigned char*)lds_raw;
    cg::grid_group grid = cg::this_grid();
    if (threadIdx.x < 32) { const int i = threadIdx.x; const unsigned long long v = i < 30 ? (unsigned long long)P.in[i] : (i == 30 ? (unsigned long long)P.out : (unsigned long long)P.ws);
        *(LAS unsigned long long*)(lds + PTAB_OFF + i * 8) = v; }
    __syncthreads();
unsigned bark_ = 0; unsigned char* P_ws_ = P.ws;
#define PH_BEGIN { const Params Q = get_params(lds); unsigned char* ws = Q.ws; (void)ws;
#define PH_END } asm volatile("s_waitcnt vmcnt(0)" ::: "memory");   grid.sync();
#define PH_ENDF } fast_grid_sync(P_ws_, ++bark_);
    if (blockIdx.x == 0 && threadIdx.x < 9) ((unsigned*)(P.ws + WS_BAR))[threadIdx.x * 32] = 0u;
    PH_BEGIN phase_prep(Q, lds); PH_END
    PH_BEGIN phase_norm(Q, nullptr, 0, 0, 1, (u16*)(ws + WS_H)); PH_ENDF
    PH_BEGIN run_gemm(lds, (const u16*)(ws + WS_H), (const u16*)(ws + WS_W13A), MT, 5632, 1024, EpiSwiglu{(u16*)(ws + WS_BIG)}); PH_ENDF
    PH_BEGIN run_gemm(lds, (const u16*)(ws + WS_BIG), (const u16*)(ws + WS_W2A), MT, 1024, 2816, EpiResid{Q.in[0], Q.in[1], Q.out, (const float*)(ws + WS_MOD), 2, 0.5f}); PH_ENDF
    PH_BEGIN phase_norm(Q, Q.out, 1, 3, 4, (u16*)(ws + WS_H)); PH_ENDF
    PH_BEGIN run_gemm(lds, (const u16*)(ws + WS_WZ), (const u16*)(ws + WS_H), 1024, MT, 1024, EpiZT{(u16*)(ws + WS_ZL)});
             { const int first = gridDim.x == 256 ? 64 : 0;
               if ((int)blockIdx.x >= first) gen_T(Q, lds, (int)blockIdx.x - first, (int)gridDim.x - first); } PH_ENDF
    PH_BEGIN run_gemm(lds, (const u16*)(ws + WS_T), (const u16*)(ws + WS_ZL), 4096, 4096, 8192, EpiFour{(u16*)(ws + WS_FOUR), 1});
             run_gemm(lds, (const u16*)(ws + WS_T256), (const u16*)(ws + WS_ZP), 256, 8192, 512, EpiFour{(u16*)(ws + WS_FOUR), 0}); PH_ENDF
    PH_BEGIN run_gemm(lds, (const u16*)(ws + WS_H), (const u16*)(ws + WS_WIN), MT, 4096, 1024, EpiU{(u16*)(ws + WS_U16), (u16*)(ws + WS_SG), (u16*)(ws + WS_R), Q.in[14]}); PH_ENDF
    PH_BEGIN phase_scan(Q, lds); PH_ENDF
    PH_BEGIN phase_post(Q, lds); PH_ENDF
    PH_BEGIN run_gemm(lds, (const u16*)(ws + WS_OPRE), (const u16*)(ws + WS_WO), MT, 1024, 512, EpiMul{(u16*)(ws + WS_H), (const u16*)(ws + WS_R), 1}); PH_ENDF
    PH_BEGIN run_gemm(lds, (const u16*)(ws + WS_FOUR), (const u16*)(ws + WS_WF), MT, 1024, 512, EpiMul{(u16*)(ws + WS_H), (const u16*)(ws + WS_R), 2}); PH_ENDF
    PH_BEGIN run_gemm(lds, (const u16*)(ws + WS_H), (const u16*)(ws + WS_WOUT), MT, 1024, 1024, EpiResid{nullptr, nullptr, Q.out, (const float*)(ws + WS_MOD), 5, 1.0f}); PH_ENDF
    PH_BEGIN phase_norm(Q, Q.out, 2, 6, 7, (u16*)(ws + WS_H)); PH_ENDF
    PH_BEGIN run_gemm(lds, (const u16*)(ws + WS_H), (const u16*)(ws + WS_W13B), MT, 5632, 1024, EpiSwiglu{(u16*)(ws + WS_BIG)}); PH_ENDF
    PH_BEGIN run_gemm(lds, (const u16*)(ws + WS_BIG), (const u16*)(ws + WS_W2B), MT, 1024, 2816, EpiResid{nullptr, nullptr, Q.out, (const float*)(ws + WS_MOD), 8, 0.5f}); PH_ENDF
    { const Params Q = get_params(lds); phase_final_norm(Q); }
#undef PH_BEGIN
#undef PH_END
#undef PH_ENDF
}

extern "C" void kernel_launch(void* const* d_in, const int* in_sizes, int n_in, void* d_out, int out_size, void* d_ws, size_t ws_size, hipStream_t stream) {
    static int grid_blocks = 0;
    if (grid_blocks == 0) {
        if (n_in != 30 || ws_size < WS_END) { fprintf(stderr, "kernel_launch: unexpected n_in %d / ws_size %zu (need %zu)\n", n_in, ws_size, (size_t)WS_END); grid_blocks = -1; return; }
        int dev = 0, cus = 0, per_cu = 0;
        (void)hipGetDevice(&dev);
        (void)hipDeviceGetAttribute(&cus, hipDeviceAttributeMultiprocessorCount, dev);
        (void)hipFuncSetAttribute((const void*)fwd_mega, hipFuncAttributeMaxDynamicSharedMemorySize, LDS_BYTES);
        (void)hipOccupancyMaxActiveBlocksPerMultiprocessor(&per_cu, (const void*)fwd_mega, 512, LDS_BYTES);
        if (per_cu < 1) { fprintf(stderr, "kernel_launch: occupancy query reports %d blocks per CU\n", per_cu); per_cu = 1; }
        if (per_cu > 1) per_cu = 1;
        grid_blocks = cus * per_cu;
        (void)hipGetLastError();
    }
    if (grid_blocks < 0) return;
    Params p{};
    for (int i = 0; i < 30; ++i) p.in[i] = (const float*)d_in[i];
    p.out = (float*)d_out; p.ws = (unsigned char*)d_ws;
    void* args[] = {&p};
    hipError_t e = hipLaunchCooperativeKernel((const void*)fwd_mega, dim3(grid_blocks), dim3(512), args, LDS_BYTES, stream);
    if (e != hipSuccess) fprintf(stderr, "cooperative launch failed: %s (grid %d)\n", hipGetErrorString(e), grid_blocks);
}
```
